# Optimizing an MI355X kernel written in HIP

```python
import math
import jax
import jax.numpy as jnp
from jax import lax
import numpy as np

D_MODEL = 1024
BATCH = 16
SEQ = 2048
DEPTH = 2

GRID_W = 64
CTX_LEN = 256

RWKV_HEADS = 6
RWKV_HEAD_DIM = 64
RWKV_WIDTH = RWKV_HEADS * RWKV_HEAD_DIM
RWKV_DECAY_RANK = 32
RWKV_ICLR_RANK = 32
RWKV_GATE_RANK = 64
RWKV_GN_EPS = 64e-5
RWKV_COLS = 3 * RWKV_WIDTH + 2 * RWKV_DECAY_RANK + 2 * RWKV_ICLR_RANK + RWKV_GATE_RANK

GLA_HEADS = 6
GLA_KEY_DIM = 32
GLA_VAL_DIM = 64
GLA_WIDTH = GLA_HEADS * GLA_VAL_DIM
GLA_GATE_RANK = 16
GLA_TEMP = 16.0
GLA_CHUNK = 64
GLA_COLS = 2 * GLA_HEADS * GLA_KEY_DIM + 2 * GLA_WIDTH + 2 * GLA_GATE_RANK

S5_GROUP = 16
S5_GROUPS = 16
S5_WIDTH = S5_GROUP * S5_GROUPS
S5_STATE = 64
S5_DT_MIN = 1e-3
S5_DT_MAX = 1e-1

MIX_WIDTH = RWKV_WIDTH + GLA_WIDTH + S5_WIDTH
N_IN = RWKV_COLS + GLA_COLS + S5_WIDTH

N_EXPERTS = 256
TOP_K = 8
N_EXPERT_GROUPS = 8
TOPK_GROUPS = 4
EXPERT_FF = 256
SHARED_FF = 256
ROUTE_SCALE = 2.5
MOE_BLOCK = 256
LN_EPS = 1e-6

kernel_name = 'hybrid_rwkv7_gla_s5_moe_diffusion_block'


def split_cols(z, sizes):
    return jnp.split(z, np.cumsum(sizes)[:-1].tolist(), axis=-1)


def layer_norm(z, g=None, b=None, eps=LN_EPS):
    zf = z.astype(jnp.float32)
    mu = zf.mean(-1, keepdims=True)
    var = jnp.square(zf - mu).mean(-1, keepdims=True)
    out = (zf - mu) * lax.rsqrt(var + eps)
    if g is not None:
        out = out * g.astype(jnp.float32) + b.astype(jnp.float32)
    return out.astype(z.dtype)


def modulate(z, shift, scale):
    return layer_norm(z) * (1 + scale) + shift


def dir_stack(fwd, bwd):
    return jnp.stack([fwd, jnp.flip(bwd, axis=1)])


def dir_merge(y2):
    return y2[0] + jnp.flip(y2[1], axis=1)


def short_conv(z, taps, rows):
    B_, T, C = z.shape
    if rows is None:
        return lax.conv_general_dilated(z, taps[1][:, None, :], (1,), 'SAME',
                                        dimension_numbers=('NWC', 'WIO', 'NWC'), feature_group_count=C)
    zi = z.reshape(B_, rows, GRID_W, C)
    out = lax.conv_general_dilated(zi, taps[:, :, None, :], (1, 1), 'SAME',
                                   dimension_numbers=('NHWC', 'HWIO', 'NHWC'), feature_group_count=C)
    return out.reshape(B_, T, C)


def rwkv7_inputs(pa, w0, w_up, a0, a_up, g_up, k_k, k_a):
    B_, T, _ = pa.shape
    W = RWKV_WIDTH
    r, k, v, wd, ad, gd = split_cols(pa, [W, W, W, 2 * RWKV_DECAY_RANK, 2 * RWKV_ICLR_RANK, RWKV_GATE_RANK])
    wd = wd.reshape(B_, T, 2, RWKV_DECAY_RANK)
    ad = ad.reshape(B_, T, 2, RWKV_ICLR_RANK)
    w_raw = w0[:, None, None, :] + jnp.einsum('btdr,drc->dbtc', jnp.tanh(wd), w_up)
    w_raw = -jax.nn.softplus(-w_raw) - 0.5
    decay = jnp.exp(-jnp.exp(w_raw))
    a = jax.nn.sigmoid(a0[:, None, None, :] + jnp.einsum('btdr,drc->dbtc', ad, a_up))
    g = jax.nn.sigmoid(gd) @ g_up
    hd = lambda z: z.reshape(*z.shape[:-1], RWKV_HEADS, RWKV_HEAD_DIM)
    kk = hd(k * k_k).astype(jnp.float32)
    kk = kk * lax.rsqrt(jnp.sum(kk * kk, axis=-1, keepdims=True) + 1e-12)
    k2 = k[None] * (1 + (a - 1) * k_a)
    return hd(r), hd(decay), hd(k2), hd(v), kk, hd(a), g


def rwkv7_scan(r, w, k, v, a_vec, b_vec, s0):
    def step(S, inp):
        r_t, w_t, k_t, v_t, a_t, b_t = inp
        sa = jnp.einsum('dbhij,dbhj->dbhi', S, a_t)
        S = S * w_t[..., None, :] + sa[..., :, None] * b_t[..., None, :] + v_t[..., :, None] * k_t[..., None, :]
        return S, jnp.einsum('dbhij,dbhj->dbhi', S, r_t)
    xs = tuple(jnp.moveaxis(z.astype(jnp.float32), 2, 0) for z in (r, w, k, v, a_vec, b_vec))
    s_fin, y = lax.scan(step, s0.astype(jnp.float32), xs)
    return jnp.moveaxis(y, 0, 2), s_fin


def gla_inputs(pb, a_up, a_bias):
    B_, T, _ = pb.shape
    KD = GLA_HEADS * GLA_KEY_DIM
    q, k, v, g, ad = split_cols(pb, [KD, KD, GLA_WIDTH, GLA_WIDTH, 2 * GLA_GATE_RANK])
    ad = ad.reshape(B_, T, 2, GLA_GATE_RANK)
    la = jax.nn.log_sigmoid(jnp.einsum('btdr,drc->dbtc', ad, a_up) + a_bias[:, None, None, :]) / GLA_TEMP
    hk = lambda z: z.reshape(*z.shape[:-1], GLA_HEADS, GLA_KEY_DIM)
    return (hk(q) * GLA_KEY_DIM ** -0.5, hk(k), v.reshape(B_, T, GLA_HEADS, GLA_VAL_DIM), g, hk(la))


def gla_chunked(q, k, v, log_a, s0):
    B_, T, H, K = q.shape
    V = v.shape[-1]
    n = T // GLA_CHUNK
    blk = lambda z: z.astype(jnp.float32).reshape(B_, n, GLA_CHUNK, H, z.shape[-1])
    q, k, v, log_a = blk(q), blk(k), blk(v), blk(log_a)
    b = jnp.cumsum(log_a, axis=2)
    b_last = b[:, :, -1:]
    q_in = q * jnp.exp(b)
    k_in = k * jnp.exp(-b)
    k_st = k * jnp.exp(b_last - b)
    causal = jnp.tril(jnp.ones((GLA_CHUNK, GLA_CHUNK), dtype=bool))
    att = jnp.where(causal, jnp.einsum('bnchk,bnshk->bnhcs', q_in, k_in), 0.0)
    o_intra = jnp.einsum('bnhcs,bnshv->bnchv', att, v)

    def step(S, inp):
        qn, kn, vn, dn = inp
        o = jnp.einsum('bchk,bhkv->bchv', qn, S)
        S = S * dn[..., None] + jnp.einsum('bchk,bchv->bhkv', kn, vn)
        return S, o
    xs = (jnp.moveaxis(q_in, 1, 0), jnp.moveaxis(k_st, 1, 0), jnp.moveaxis(v, 1, 0),
          jnp.moveaxis(jnp.exp(b_last[:, :, 0]), 1, 0))
    s_fin, o_inter = lax.scan(step, s0.astype(jnp.float32), xs)
    o = o_intra + jnp.moveaxis(o_inter, 0, 1)
    return o.reshape(B_, T, H, V), s_fin


def complex_affine_combine(e1, e2):
    a1r, a1i, b1r, b1i = e1
    a2r, a2i, b2r, b2i = e2
    return (a2r * a1r - a2i * a1i, a2r * a1i + a2i * a1r,
            a2r * b1r - a2i * b1i + b2r, a2r * b1i + a2i * b1r + b2i)


def s5_scan(u, lam_re, lam_im, log_dt, b_re, b_im, s0_re, s0_im):
    f32 = jnp.float32
    lam_re, lam_im = lam_re.astype(f32), lam_im.astype(f32)
    b_re, b_im = b_re.astype(f32), b_im.astype(f32)
    dt = jnp.exp(log_dt.astype(f32))[:, None]
    zr, zi = lam_re * dt, lam_im * dt
    mag = jnp.exp(zr)
    ab_r, ab_i = mag * jnp.cos(zi), mag * jnp.sin(zi)
    den = lam_re * lam_re + lam_im * lam_im
    f_r = ((ab_r - 1) * lam_re + ab_i * lam_im) / den
    f_i = (ab_i * lam_re - (ab_r - 1) * lam_im) / den
    bb_r = f_r[..., None] * b_re - f_i[..., None] * b_im
    bb_i = f_r[..., None] * b_im + f_i[..., None] * b_re
    bu_r = jnp.einsum('gpc,btgc->btgp', bb_r, u)
    bu_i = jnp.einsum('gpc,btgc->btgp', bb_i, u)
    bu_r = bu_r.at[:, 0].add(ab_r * s0_re - ab_i * s0_im)
    bu_i = bu_i.at[:, 0].add(ab_r * s0_im + ab_i * s0_re)
    a_r = jnp.broadcast_to(ab_r, bu_r.shape)
    a_i = jnp.broadcast_to(ab_i, bu_i.shape)
    _, _, x_r, x_i = lax.associative_scan(complex_affine_combine, (a_r, a_i, bu_r, bu_i), axis=1)
    return x_r, x_i


def token_mixers(h, rows, p, s_rwkv, s_gla, s5_re, s5_im, with_output):
    f32 = jnp.float32
    B_, T, _ = h.shape
    proj = h @ p['w_in']
    pa, pb, pc = split_cols(proj, [RWKV_COLS, GLA_COLS, S5_WIDTH])
    same = lambda z: dir_stack(z, z)
    pa = short_conv(pa, p['rwkv_conv'], rows)
    r, dec, k2, v, kk, a, g = rwkv7_inputs(pa, p['rwkv_w0'], p['rwkv_w_up'], p['rwkv_a0'], p['rwkv_a_up'],
                                           p['rwkv_g_up'], p['rwkv_k_k'], p['rwkv_k_a'])
    y_a2, s_rwkv = rwkv7_scan(same(r), dir_stack(dec[0], dec[1]), dir_stack(k2[0], k2[1]), same(v),
                              same(-kk), dir_stack(kk * a[0], kk * a[1]), s_rwkv)
    q, kg, vg, gg, la = gla_inputs(pb, p['gla_a_up'], p['gla_a_bias'])
    o2, s_gla = jax.vmap(gla_chunked)(same(q), same(kg), same(vg), dir_stack(la[0], la[1]), s_gla)
    u = pc.astype(f32).reshape(B_, T, S5_GROUPS, S5_GROUP)
    s5_x, fin_re, fin_im = [], [], []
    for d in range(2):
        ud = u if d == 0 else jnp.flip(u, axis=1)
        x_re, x_im = s5_scan(ud, p['s5_lam_re'][d], p['s5_lam_im'][d], p['s5_log_dt'][d],
                             p['s5_b_re'][d], p['s5_b_im'][d], s5_re[d], s5_im[d])
        s5_x.append((x_re, x_im))
        fin_re.append(x_re[:, -1])
        fin_im.append(x_im[:, -1])
    states = (s_rwkv, s_gla, jnp.stack(fin_re), jnp.stack(fin_im))
    if not with_output:
        return None, states
    y = dir_merge(y_a2)
    mu = y.mean(-1, keepdims=True)
    var = jnp.square(y - mu).mean(-1, keepdims=True)
    gn = ((y - mu) * lax.rsqrt(var + RWKV_GN_EPS) * p['rwkv_ln_g'].reshape(RWKV_HEADS, RWKV_HEAD_DIM)
          + p['rwkv_ln_b'].reshape(RWKV_HEADS, RWKV_HEAD_DIM))
    bonus = jnp.sum(r[None] * k2 * p['rwkv_r_k'], axis=(0, -1))[..., None] * v
    y_a = (gn.astype(h.dtype) + bonus).reshape(B_, T, RWKV_WIDTH) * g
    o = dir_merge(o2)
    o = o * lax.rsqrt(jnp.square(o).mean(-1, keepdims=True) + 1e-6) * p['gla_norm_g'].astype(f32)
    y_b = o.astype(h.dtype).reshape(B_, T, GLA_WIDTH) * jax.nn.silu(gg)
    y_c = p['s5_d'].astype(f32).reshape(S5_GROUPS, S5_GROUP) * u
    for d in range(2):
        x_re, x_im = s5_x[d]
        yd = (jnp.einsum('gcp,btgp->btgc', p['s5_c_re'][d].astype(f32), x_re)
              - jnp.einsum('gcp,btgp->btgc', p['s5_c_im'][d].astype(f32), x_im))
        y_c = y_c + (yd if d == 0 else jnp.flip(yd, axis=1))
    y_c = jax.nn.gelu(y_c.reshape(B_, T, S5_WIDTH)).astype(h.dtype)
    y_c = y_c * jax.nn.sigmoid(y_c @ p['s5_glu_w'] + p['s5_glu_b'])
    y_mix = jnp.concatenate([y_a, y_b, y_c], axis=-1) @ p['w_out']
    return y_mix, states


def moe_ffn(h, router_w, router_bias, w13, w2, sh_w13, sh_w2):
    n_tok, d_model = h.shape
    s = jax.nn.sigmoid(h.astype(jnp.float32) @ router_w.astype(jnp.float32))
    s_sel = s + router_bias.astype(jnp.float32)
    grp = s_sel.reshape(n_tok, N_EXPERT_GROUPS, N_EXPERTS // N_EXPERT_GROUPS)
    g_score = lax.top_k(grp, 2)[0].sum(-1)
    _, g_idx = lax.top_k(g_score, TOPK_GROUPS)
    g_mask = jnp.any(g_idx[..., None] == jnp.arange(N_EXPERT_GROUPS), axis=1)
    e_mask = jnp.repeat(g_mask, N_EXPERTS // N_EXPERT_GROUPS, axis=1)
    _, e_idx = lax.top_k(jnp.where(e_mask, s_sel, -jnp.inf), TOP_K)
    wts = jnp.take_along_axis(s, e_idx, axis=1)
    wts = wts / wts.sum(-1, keepdims=True) * ROUTE_SCALE
    n_pairs = n_tok * TOP_K
    n_blocks = (n_pairs + MOE_BLOCK - 1) // MOE_BLOCK + N_EXPERTS
    flat_e = e_idx.reshape(-1).astype(jnp.int32)
    order = jnp.argsort(flat_e)
    sorted_e = flat_e[order]
    tok = (order // TOP_K).astype(jnp.int32)
    sizes = jnp.bincount(flat_e, length=N_EXPERTS).astype(jnp.int32)
    padded = (sizes + MOE_BLOCK - 1) // MOE_BLOCK * MOE_BLOCK
    p_end = jnp.cumsum(padded)
    rank = jnp.arange(n_pairs, dtype=jnp.int32) - (jnp.cumsum(sizes) - sizes)[sorted_e]
    dest = (p_end - padded)[sorted_e] + rank
    slot_tok = jnp.full((n_blocks * MOE_BLOCK,), n_tok, jnp.int32).at[dest].set(tok)
    slot_w = jnp.zeros((n_blocks * MOE_BLOCK,), h.dtype).at[dest].set(wts.reshape(-1)[order].astype(h.dtype))
    block_e = jnp.minimum(jnp.searchsorted(p_end, jnp.arange(n_blocks, dtype=jnp.int32) * MOE_BLOCK,
                                           side='right'), N_EXPERTS - 1).astype(jnp.int32)
    h_pad = jnp.concatenate([h, jnp.zeros((1, d_model), h.dtype)], axis=0)
    xb = h_pad[slot_tok].reshape(n_blocks, MOE_BLOCK, d_model)

    def expert_block(args):
        xe, e = args
        gate, up = jnp.split(xe @ w13[e], 2, axis=-1)
        return (jax.nn.silu(gate) * up) @ w2[e]
    out = lax.map(expert_block, (xb, block_e)).reshape(n_blocks * MOE_BLOCK, d_model)
    routed = jax.ops.segment_sum(out * slot_w[:, None], slot_tok, num_segments=n_tok + 1)[:n_tok]
    sg, su = jnp.split(h @ sh_w13, 2, axis=-1)
    return routed + (jax.nn.silu(sg) * su) @ sh_w2


def setup_inputs(seed: int = 0) -> dict:
    key = jax.random.key(seed)
    keys = iter(jax.random.split(key, 64))
    f32 = jnp.float32
    L, D, E = DEPTH, D_MODEL, N_EXPERTS
    beta = (8 * DEPTH) ** -0.25

    def nrm(shape, scale):
        return jax.random.normal(next(keys), shape, f32) * scale

    x = nrm((BATCH, SEQ, D), 1.0)
    c = nrm((BATCH, D), 1.0)
    ctx = nrm((BATCH, CTX_LEN, D), 1.0)
    c_ctx = nrm((D,), 1.0)
    w_mod = nrm((L, D, 6 * D), 0.5 * D ** -0.5)
    b_mod = nrm((L, 6 * D), 0.02)
    w_in = nrm((L, D, N_IN), D ** -0.5)
    rwkv_conv = (1.0 / 16.0 + nrm((L, 3, 3, RWKV_COLS), 0.02)).at[:, 1, 1, :].add(0.5 - 1.0 / 16.0)
    rwkv_w0 = -1.0 + nrm((L, 2, RWKV_WIDTH), 0.5)
    rwkv_w_up = nrm((L, 2, RWKV_DECAY_RANK, RWKV_WIDTH), 0.5 * RWKV_DECAY_RANK ** -0.5)
    rwkv_a0 = nrm((L, 2, RWKV_WIDTH), 0.5)
    rwkv_a_up = nrm((L, 2, RWKV_ICLR_RANK, RWKV_WIDTH), 0.5 * RWKV_ICLR_RANK ** -0.5)
    rwkv_g_up = nrm((L, RWKV_GATE_RANK, RWKV_WIDTH), RWKV_GATE_RANK ** -0.5)
    rwkv_k_k = 0.85 + nrm((L, RWKV_WIDTH), 0.1)
    rwkv_k_a = 1.0 + nrm((L, RWKV_WIDTH), 0.1)
    rwkv_r_k = nrm((L, RWKV_HEADS, RWKV_HEAD_DIM), 0.1)
    rwkv_ln_g = 1.0 + nrm((L, RWKV_WIDTH), 0.05)
    rwkv_ln_b = nrm((L, RWKV_WIDTH), 0.02)
    gla_a_up = nrm((L, 2, GLA_GATE_RANK, GLA_HEADS * GLA_KEY_DIM), GLA_GATE_RANK ** -0.5)
    gla_a_bias = 2.0 + nrm((L, 2, GLA_HEADS * GLA_KEY_DIM), 0.5)
    gla_norm_g = 1.0 + nrm((L, GLA_VAL_DIM), 0.05)
    s5_lam_re = -0.5 + nrm((L, 2, S5_STATE), 0.01)
    s5_lam_im = jnp.pi * jnp.arange(S5_STATE, dtype=f32) + nrm((L, 2, S5_STATE), 0.01)
    s5_log_dt = jax.random.uniform(next(keys), (L, 2, S5_GROUPS), f32,
                                   minval=math.log(S5_DT_MIN), maxval=math.log(S5_DT_MAX))
    s5_b_re = nrm((L, 2, S5_GROUPS, S5_STATE, S5_GROUP), (2 * S5_GROUP) ** -0.5)
    s5_b_im = nrm((L, 2, S5_GROUPS, S5_STATE, S5_GROUP), (2 * S5_GROUP) ** -0.5)
    s5_c_re = nrm((L, 2, S5_GROUPS, S5_GROUP, S5_STATE), (2 * S5_STATE) ** -0.5)
    s5_c_im = nrm((L, 2, S5_GROUPS, S5_GROUP, S5_STATE), (2 * S5_STATE) ** -0.5)
    s5_d = nrm((L, S5_WIDTH), 1.0)
    s5_glu_w = nrm((L, S5_WIDTH, S5_WIDTH), S5_WIDTH ** -0.5)
    s5_glu_b = nrm((L, S5_WIDTH), 0.02)
    w_out = nrm((L, MIX_WIDTH, D), beta * MIX_WIDTH ** -0.5)
    ln1_g = 1.0 + nrm((L, D), 0.05)
    ln1_b = nrm((L, D), 0.02)
    router_w = nrm((L, D, E), D ** -0.5)
    router_bias = nrm((L, E), 0.01)
    exp_w13 = nrm((L, E, D, 2 * EXPERT_FF), D ** -0.5)
    exp_w2 = nrm((L, E, EXPERT_FF, D), beta * EXPERT_FF ** -0.5)
    sh_w13 = nrm((L, D, 2 * SHARED_FF), D ** -0.5)
    sh_w2 = nrm((L, SHARED_FF, D), beta * SHARED_FF ** -0.5)
    ln2_g = 1.0 + nrm((L, D), 0.05)
    ln2_b = nrm((L, D), 0.02)
    return {'x': x, 'c': c, 'ctx': ctx, 'c_ctx': c_ctx, 'w_mod': w_mod, 'b_mod': b_mod, 'w_in': w_in,
            'rwkv_conv': rwkv_conv, 'rwkv_w0': rwkv_w0, 'rwkv_w_up': rwkv_w_up, 'rwkv_a0': rwkv_a0,
            'rwkv_a_up': rwkv_a_up, 'rwkv_g_up': rwkv_g_up, 'rwkv_k_k': rwkv_k_k, 'rwkv_k_a': rwkv_k_a,
            'rwkv_r_k': rwkv_r_k, 'rwkv_ln_g': rwkv_ln_g, 'rwkv_ln_b': rwkv_ln_b, 'gla_a_up': gla_a_up,
            'gla_a_bias': gla_a_bias, 'gla_norm_g': gla_norm_g, 's5_lam_re': s5_lam_re,
            's5_lam_im': s5_lam_im, 's5_log_dt': s5_log_dt, 's5_b_re': s5_b_re, 's5_b_im': s5_b_im,
            's5_c_re': s5_c_re, 's5_c_im': s5_c_im, 's5_d': s5_d, 's5_glu_w': s5_glu_w,
            's5_glu_b': s5_glu_b, 'w_out': w_out, 'ln1_g': ln1_g, 'ln1_b': ln1_b, 'router_w': router_w,
            'router_bias': router_bias, 'exp_w13': exp_w13, 'exp_w2': exp_w2, 'sh_w13': sh_w13,
            'sh_w2': sh_w2, 'ln2_g': ln2_g, 'ln2_b': ln2_b}


def reference(x, c, ctx, c_ctx, w_mod, b_mod, w_in, rwkv_conv, rwkv_w0, rwkv_w_up, rwkv_a0, rwkv_a_up,
              rwkv_g_up, rwkv_k_k, rwkv_k_a, rwkv_r_k, rwkv_ln_g, rwkv_ln_b, gla_a_up, gla_a_bias,
              gla_norm_g, s5_lam_re, s5_lam_im, s5_log_dt, s5_b_re, s5_b_im, s5_c_re, s5_c_im, s5_d,
              s5_glu_w, s5_glu_b, w_out, ln1_g, ln1_b, router_w, router_bias, exp_w13, exp_w2, sh_w13,
              sh_w2, ln2_g, ln2_b):
    f32 = jnp.float32
    alpha = (2 * DEPTH) ** 0.25
    B_, T, D = x.shape
    rows = T // GRID_W
    n_ctx = ctx.shape[1]
    for l in range(DEPTH):
        last = l == DEPTH - 1
        p = {'w_in': w_in[l], 'rwkv_conv': rwkv_conv[l], 'rwkv_w0': rwkv_w0[l], 'rwkv_w_up': rwkv_w_up[l],
             'rwkv_a0': rwkv_a0[l], 'rwkv_a_up': rwkv_a_up[l], 'rwkv_g_up': rwkv_g_up[l],
             'rwkv_k_k': rwkv_k_k[l], 'rwkv_k_a': rwkv_k_a[l], 'rwkv_r_k': rwkv_r_k[l],
             'rwkv_ln_g': rwkv_ln_g[l], 'rwkv_ln_b': rwkv_ln_b[l], 'gla_a_up': gla_a_up[l],
             'gla_a_bias': gla_a_bias[l], 'gla_norm_g': gla_norm_g[l], 's5_lam_re': s5_lam_re[l],
             's5_lam_im': s5_lam_im[l], 's5_log_dt': s5_log_dt[l], 's5_b_re': s5_b_re[l],
             's5_b_im': s5_b_im[l], 's5_c_re': s5_c_re[l], 's5_c_im': s5_c_im[l], 's5_d': s5_d[l],
             's5_glu_w': s5_glu_w[l], 's5_glu_b': s5_glu_b[l], 'w_out': w_out[l]}
        mod_lat = jax.nn.silu(c) @ w_mod[l] + b_mod[l]
        mod_ctx = jax.nn.silu(c_ctx) @ w_mod[l] + b_mod[l]
        sh1, sc1, g1, sh2, sc2, g2 = jnp.split(mod_lat[:, None, :], 6, axis=-1)
        csh1, csc1, cg1, csh2, csc2, cg2 = jnp.split(mod_ctx, 6, axis=-1)
        zero_states = (jnp.zeros((2, B_, RWKV_HEADS, RWKV_HEAD_DIM, RWKV_HEAD_DIM), f32),
                       jnp.zeros((2, B_, GLA_HEADS, GLA_KEY_DIM, GLA_VAL_DIM), f32),
                       jnp.zeros((2, B_, S5_GROUPS, S5_STATE), f32),
                       jnp.zeros((2, B_, S5_GROUPS, S5_STATE), f32))
        y_ctx, ctx_states = token_mixers(modulate(ctx, csh1, csc1), None, p, *zero_states, not last)
        y_lat, _ = token_mixers(modulate(x, sh1, sc1), rows, p, *ctx_states, True)
        x = layer_norm(alpha * x + g1 * y_lat, ln1_g[l], ln1_b[l])
        h2 = modulate(x, sh2, sc2).reshape(B_ * T, D)
        if last:
            f_lat = moe_ffn(h2, router_w[l], router_bias[l], exp_w13[l], exp_w2[l], sh_w13[l], sh_w2[l])
        else:
            ctx = layer_norm(alpha * ctx + cg1 * y_ctx, ln1_g[l], ln1_b[l])
            hc2 = modulate(ctx, csh2, csc2).reshape(B_ * n_ctx, D)
            f_all = moe_ffn(jnp.concatenate([hc2, h2], axis=0), router_w[l], router_bias[l],
                            exp_w13[l], exp_w2[l], sh_w13[l], sh_w2[l])
            f_ctx, f_lat = f_all[:B_ * n_ctx], f_all[B_ * n_ctx:]
            ctx = layer_norm(alpha * ctx + cg2 * f_ctx.reshape(ctx.shape), ln2_g[l], ln2_b[l])
        x = layer_norm(alpha * x + g2 * f_lat.reshape(x.shape), ln2_g[l], ln2_b[l])
    return x
```

```cpp
#ifndef CFG_SMALL
#define D_ 1024
#define B_ 16
#define T_ 2048
#define CTX_ 256
#define GW_ 64
#define RH_ 6
#define GH_ 6
#define SNG_ 16
#define E_ 256
#define TOPK_ 8
#define NGRP_ 8
#define TKG_ 4
#define FF_ 256
#else
#define D_ 256
#define B_ 2
#define T_ 256
#define CTX_ 128
#define GW_ 16
#define RH_ 2
#define GH_ 2
#define SNG_ 4
#define E_ 16
#define TOPK_ 4
#define NGRP_ 4
#define TKG_ 2
#define FF_ 128
#endif
#define L_ 2
#define RN_ 64
#define RDR_ 32
#define RIR_ 32
#define RGR_ 64
#define GK_ 32
#define GV_ 64
#define GGR_ 16
#define SG_ 16
#define SP_ 64
#define CH_ 64

constexpr int pad256(int x) { return (x + 255) / 256 * 256; }
constexpr int RW = RH_ * RN_, RCOLS = 3 * RW + 2 * RDR_ + 2 * RIR_ + RGR_;
constexpr int GKD = GH_ * GK_, GWD = GH_ * GV_, GCOLS = 2 * GKD + 2 * GWD + 2 * GGR_;
constexpr int SW = SG_ * SNG_, MIXW = RW + GWD + SW, NIN = RCOLS + GCOLS + SW, NINP = pad256(NIN);
constexpr int GBASE = RCOLS, SBASE = RCOLS + GCOLS;
constexpr int NLAT = B_ * T_, NCTX = B_ * CTX_, NTOK = NLAT + NCTX;
constexpr int SPOS = CTX_ + T_, NPC = SPOS / CH_, NPCC = CTX_ / CH_, M5 = B_ * NPC, M5P = pad256(M5);
constexpr int KSM = 256, OWD = 0, OAD = 2 * RDR_, OGD = OAD + 2 * RIR_, OGL = OGD + RGR_;
constexpr int NSM = 5 * RW + 2 * GKD, NSMP = pad256(NSM), NGF = 2 * RW + 2 * GKD, NGB = 3 * RW;
constexpr int K5 = CH_ * SG_, KT5 = K5 + 4 * SP_, N5A = 4 * SP_, N5AP = pad256(N5A);
constexpr int EP = pad256(E_), NRS = EP + 2 * FF_;
constexpr int SWP = pad256(SW);
constexpr int NSLOT = pad256(NTOK * TOPK_) + E_ * 256, MAXT = NSLOT / 256;
constexpr int ROWS_ = T_ / GW_;
constexpr float LN_EPS = 1e-6f, GN_EPS = 64e-5f;
static_assert(OGL + 2 * GGR_ <= KSM, "ksm");
static_assert(NTOK % 256 == 0 && NLAT % 256 == 0, "rows");
static_assert(FF_ % 128 == 0 && D_ % 256 == 0, "ff");

typedef unsigned short bf16_t;
#ifdef CPU_TEST
#include <cmath>
#include <cstring>
#include <cstdio>
#include <cstdlib>
#include <vector>
#define HD static inline
#define HDM inline
#define NL 1
static inline float WSUM(float v) { return v; }
struct F4 { float v[4]; float& operator[](int i) { return v[i]; } const float& operator[](int i) const { return v[i]; } };
#else
#include <hip/hip_runtime.h>
#define HD __device__ __forceinline__
#define HDM __device__ __forceinline__
#define NL 64
#define DPP_ADD(v, ctrl) v += __builtin_bit_cast(float, __builtin_amdgcn_update_dpp(0, __builtin_bit_cast(int, v), ctrl, 0xF, 0xF, true))
HD float WSUM(float v) {
    DPP_ADD(v, 0xB1); DPP_ADD(v, 0x4E); DPP_ADD(v, 0x141); DPP_ADD(v, 0x140);
    const int b = __builtin_bit_cast(int, v);
    const float s0 = __builtin_bit_cast(float, __builtin_amdgcn_readlane(b, 0)), s1 = __builtin_bit_cast(float, __builtin_amdgcn_readlane(b, 16)),
                s2 = __builtin_bit_cast(float, __builtin_amdgcn_readlane(b, 32)), s3 = __builtin_bit_cast(float, __builtin_amdgcn_readlane(b, 48));
    return (s0 + s1) + (s2 + s3);
}
typedef float F4 __attribute__((ext_vector_type(4)));
#endif

#ifdef CPU_TEST
HD bf16_t f2bf(float f) { unsigned u; memcpy(&u, &f, 4); u += 0x7FFFu + ((u >> 16) & 1u); return (bf16_t)(u >> 16); }
#else
HD bf16_t f2bf(float f) { return __builtin_bit_cast(unsigned short, (__bf16)f); }
#endif
HD float bf2f(bf16_t b) { unsigned u = ((unsigned)b) << 16; float f; memcpy(&f, &u, 4); return f; }
#ifdef CPU_TEST
HD float fexp(float x) { return expf(x); }
HD float flog(float x) { return logf(x); }
HD float frcp(float x) { return 1.0f / x; }
#else
HD float fexp(float x) { return __expf(x); }
HD float flog(float x) { return __logf(x); }
HD float frcp(float x) { return __builtin_amdgcn_rcpf(x); }
#endif
HD float sigmoidf_(float x) { return frcp(1.0f + fexp(-x)); }
HD float siluf_(float x) { return x * sigmoidf_(x); }
HD float softplusf_(float x) { return x > 20.f ? x : flog(1.0f + fexp(x)); }
HD float ftanh(float x) { const float e = fexp(2.0f * (x > 15.f ? 15.f : x)); return 1.0f - 2.0f * frcp(e + 1.0f); }
HD float geluf_(float x) { return 0.5f * x * (1.0f + ftanh(0.7978845608028654f * (x + 0.044715f * x * x * x))); }

HD int row_of(int b, int pos) { return pos < CTX_ ? NLAT + b * CTX_ + pos : b * T_ + (pos - CTX_); }
HD int bidx_of(int n) { return n < NLAT ? n / T_ : B_; }
HD int seqpos(int d, int i) { return d == 0 ? i : (i < CTX_ ? CTX_ - 1 - i : CTX_ + T_ - 1 - (i - CTX_)); }

constexpr size_t al256(size_t x) { return (x + 255) / 256 * 256; }
struct WSMap {
    size_t ctl, silu_c, modv, w_inT, w_outT, wsmT, rsT, w13T, w2T, shw2T, gluT, s5Wa, s5Tb, s5pw, s5bb, s5K;
    size_t h, ymix, yo, xcur, x1, h2, eidx, ewt, slot_of, ecnt, efill, eoff, nunits, ulist, slot_tok;
    size_t proj, rkv, asmall, gs, gsb, yr, og, U2, xl, yc;
    size_t logits, sact, act, Y, Ysh;
    size_t end;
};
constexpr WSMap make_wsmap() {
    WSMap m{}; size_t o = 0;
#define TAKE(f, bytes) m.f = o; o = al256(o + (size_t)(bytes));
    TAKE(ctl, 65536)
    TAKE(silu_c, (B_ + 1) * D_ * 4) TAKE(modv, (size_t)L_ * (B_ + 1) * 6 * D_ * 4)
    TAKE(w_inT, (size_t)L_ * NINP * D_ * 2) TAKE(w_outT, (size_t)L_ * D_ * MIXW * 2) TAKE(wsmT, (size_t)L_ * NSMP * KSM * 2)
    TAKE(rsT, (size_t)L_ * NRS * D_ * 2) TAKE(w13T, (size_t)L_ * E_ * 2 * FF_ * D_ * 2) TAKE(w2T, (size_t)L_ * E_ * D_ * FF_ * 2)
    TAKE(shw2T, (size_t)L_ * D_ * FF_ * 2) TAKE(gluT, (size_t)L_ * SWP * SW * 2)
    TAKE(s5Wa, (size_t)L_ * SNG_ * N5AP * K5 * 2) TAKE(s5Tb, (size_t)L_ * SNG_ * K5 * KT5 * 2)
    TAKE(s5pw, (size_t)L_ * 2 * SNG_ * SP_ * (CH_ + 1) * 2 * 4) TAKE(s5bb, (size_t)L_ * 2 * SNG_ * SP_ * SG_ * 2 * 4) TAKE(s5K, (size_t)L_ * 2 * SNG_ * CH_ * SG_ * SG_ * 4)
    TAKE(h, (size_t)NTOK * D_ * 2) TAKE(ymix, (size_t)NTOK * MIXW * 2) TAKE(yo, (size_t)NTOK * D_ * 2) TAKE(xcur, (size_t)NTOK * D_ * 2)
    TAKE(x1, (size_t)NTOK * D_ * 2) TAKE(h2, (size_t)NTOK * D_ * 2)
    TAKE(eidx, (size_t)NTOK * TOPK_ * 4) TAKE(ewt, (size_t)NTOK * TOPK_ * 4) TAKE(slot_of, (size_t)NTOK * TOPK_ * 4)
    TAKE(ecnt, E_ * 4) TAKE(efill, E_ * 4) TAKE(eoff, (E_ + 1) * 4) TAKE(nunits, 256) TAKE(ulist, (size_t)MAXT * 16) TAKE(slot_tok, (size_t)NSLOT * 4)
    const size_t regA = o;
    TAKE(proj, (size_t)NTOK * NINP * 2) TAKE(rkv, (size_t)NTOK * 3 * RW * 2) TAKE(asmall, (size_t)NTOK * KSM * 2) TAKE(gs, (size_t)NTOK * NGF * 4) TAKE(gsb, (size_t)NTOK * NGB * 2)
    TAKE(yr, (size_t)2 * NTOK * RW * 4) TAKE(og, (size_t)2 * NTOK * GWD * 4) TAKE(U2, (size_t)SNG_ * M5P * KT5 * 2) TAKE(xl, (size_t)SNG_ * M5P * N5AP * 4)
    TAKE(yc, (size_t)NTOK * SW * 2)
    const size_t endA = o; o = regA;
    TAKE(logits, (size_t)NTOK * E_ * 4) TAKE(sact, (size_t)NTOK * FF_ * 2) TAKE(act, (size_t)NSLOT * FF_ * 2) TAKE(Y, (size_t)NSLOT * D_ * 2) TAKE(Ysh, (size_t)NTOK * D_ * 2)
    m.end = o > endA ? o : endA;
#undef TAKE
    return m;
}
constexpr WSMap WS = make_wsmap();

struct P {
    const float *x, *c, *ctx, *c_ctx, *w_mod, *b_mod, *w_in, *rwkv_conv, *rwkv_w0, *rwkv_w_up, *rwkv_a0, *rwkv_a_up, *rwkv_g_up, *rwkv_k_k, *rwkv_k_a,
        *rwkv_r_k, *rwkv_ln_g, *rwkv_ln_b, *gla_a_up, *gla_a_bias, *gla_norm_g, *s5_lam_re, *s5_lam_im, *s5_log_dt, *s5_b_re, *s5_b_im, *s5_c_re, *s5_c_im,
        *s5_d, *s5_glu_w, *s5_glu_b, *w_out, *ln1_g, *ln1_b, *router_w, *router_bias, *exp_w13, *exp_w2, *sh_w13, *sh_w2, *ln2_g, *ln2_b;
    float* out; unsigned char* ws;
};
#define WSP(type, field) ((type*)(p.ws + WS.field))
#define GIDX long gid = (long)wv * NL + lane; const long gsz = (long)nwv * NL
#ifdef CPU_TEST
HD void ld8bf(const bf16_t* q, float* o) { for (int j = 0; j < 8; ++j) o[j] = bf2f(q[j]); }
HD void ld8f(const float* q, float* o) { for (int j = 0; j < 8; ++j) o[j] = q[j]; }
HD void st8f(float* q, const float* v) { for (int j = 0; j < 8; ++j) q[j] = v[j]; }
HD void st8bf(bf16_t* q, const float* v) { for (int j = 0; j < 8; ++j) q[j] = f2bf(v[j]); }
HD void cp8bf(bf16_t* q, const bf16_t* s) { for (int j = 0; j < 8; ++j) q[j] = s[j]; }
HD void z8bf(bf16_t* q) { for (int j = 0; j < 8; ++j) q[j] = 0; }
#else
typedef unsigned U4 __attribute__((ext_vector_type(4)));
HD void ld8bf(const bf16_t* q, float* o) { const U4 w = *(const U4*)q;
#pragma unroll
    for (int j = 0; j < 4; ++j) { o[2 * j] = __uint_as_float(w[j] << 16); o[2 * j + 1] = __uint_as_float(w[j] & 0xffff0000u); } }
HD void ld8f(const float* q, float* o) { const F4 a = *(const F4*)q, b = *(const F4*)(q + 4); o[0] = a[0]; o[1] = a[1]; o[2] = a[2]; o[3] = a[3]; o[4] = b[0]; o[5] = b[1]; o[6] = b[2]; o[7] = b[3]; }
HD void st8f(float* q, const float* v) { *(F4*)q = (F4){v[0], v[1], v[2], v[3]}; *(F4*)(q + 4) = (F4){v[4], v[5], v[6], v[7]}; }
HD void st8bf(bf16_t* q, const float* v) { U4 w;
#pragma unroll
    for (int j = 0; j < 4; ++j) w[j] = (unsigned)f2bf(v[2 * j]) | ((unsigned)f2bf(v[2 * j + 1]) << 16);
    *(U4*)q = w; }
HD void cp8bf(bf16_t* q, const bf16_t* s) { *(U4*)q = *(const U4*)s; }
HD void z8bf(bf16_t* q) { *(U4*)q = (U4){0u, 0u, 0u, 0u}; }
#endif

HD void st_siluc(const P& p, int wv, int nwv, int lane) {
    GIDX; float* sc = WSP(float, silu_c);
    for (long i = gid; i < (long)(B_ + 1) * D_; i += gsz) { const int b = (int)(i / D_), k = (int)(i % D_); const float v = b < B_ ? p.c[(size_t)b * D_ + k] : p.c_ctx[k]; sc[i] = siluf_(v); }
}
HD void st_modv(const P& p, int wv, int nwv, int lane) {
    GIDX; const float* sc = WSP(float, silu_c); float* mv = WSP(float, modv);
    for (long i = gid; i < (long)L_ * 6 * D_; i += gsz) {
        const int l = (int)(i / (6 * D_)), col = (int)(i % (6 * D_));
        float acc[B_ + 1];
#pragma unroll
        for (int b = 0; b <= B_; ++b) acc[b] = 0.f;
        const float* w = p.w_mod + (size_t)l * D_ * 6 * D_ + col;
        for (int k = 0; k < D_; ++k) { const float wk = w[(size_t)k * 6 * D_];
#pragma unroll
            for (int b = 0; b <= B_; ++b) acc[b] += sc[b * D_ + k] * wk; }
        const float bm = p.b_mod[(size_t)l * 6 * D_ + col];
#pragma unroll
        for (int b = 0; b <= B_; ++b) mv[((size_t)l * (B_ + 1) + b) * 6 * D_ + col] = acc[b] + bm;
    }
}
HD void cvt_T(bf16_t* dst, const float* src, int Ndst, int K, int Nsrc, int nvalid, int src_col0, long gid, long gsz) {
    for (long i = gid; i < (long)Ndst * K; i += gsz) { const int n = (int)(i % Ndst), k = (int)(i / Ndst);
        dst[(size_t)n * K + k] = n < nvalid ? f2bf(src[(size_t)k * Nsrc + src_col0 + n]) : (bf16_t)0; }
}
HD void st_cvt1(const P& p, int l, int wv, int nwv, int lane) {
    GIDX;
    cvt_T(WSP(bf16_t, w_inT) + (size_t)l * NINP * D_, p.w_in + (size_t)l * D_ * NIN, NINP, D_, NIN, NIN, 0, gid, gsz);
    cvt_T(WSP(bf16_t, w_outT) + (size_t)l * D_ * MIXW, p.w_out + (size_t)l * MIXW * D_, D_, MIXW, D_, D_, 0, gid, gsz);
    cvt_T(WSP(bf16_t, shw2T) + (size_t)l * D_ * FF_, p.sh_w2 + (size_t)l * FF_ * D_, D_, FF_, D_, D_, 0, gid, gsz);
    cvt_T(WSP(bf16_t, gluT) + (size_t)l * SWP * SW, p.s5_glu_w + (size_t)l * SW * SW, SWP, SW, SW, SW, 0, gid, gsz);
}
HD void st_cvt2(const P& p, int l, int wv, int nwv, int lane) {
    GIDX;
    bf16_t* rs = WSP(bf16_t, rsT) + (size_t)l * NRS * D_;
    cvt_T(rs, p.router_w + (size_t)l * D_ * E_, EP, D_, E_, E_, 0, gid, gsz);
    for (int j = 0; j < FF_ / 128; ++j) {
        cvt_T(rs + (size_t)(EP + 256 * j) * D_, p.sh_w13 + (size_t)l * D_ * 2 * FF_, 128, D_, 2 * FF_, 128, 128 * j, gid, gsz);
        cvt_T(rs + (size_t)(EP + 256 * j + 128) * D_, p.sh_w13 + (size_t)l * D_ * 2 * FF_, 128, D_, 2 * FF_, 128, FF_ + 128 * j, gid, gsz);
    }
}
HD void st_cvt3(const P& p, int l, int wv, int nwv, int lane) {
    GIDX;
    for (long i = gid; i < (long)E_ * 2 * FF_ * D_; i += gsz) {
        const int n = (int)(i % (2 * FF_)); const long r = i / (2 * FF_); const int k = (int)(r % D_), e = (int)(r / D_);
        const int j = n / 256, w = n % 256, srcc = w < 128 ? 128 * j + w : FF_ + 128 * j + (w - 128);
        WSP(bf16_t, w13T)[(((size_t)l * E_ + e) * 2 * FF_ + n) * D_ + k] = f2bf(p.exp_w13[(((size_t)l * E_ + e) * D_ + k) * 2 * FF_ + srcc]);
    }
}
HD void st_cvt4(const P& p, int l, int wv, int nwv, int lane) {
    GIDX;
    for (long i = gid; i < (long)E_ * D_ * FF_; i += gsz) {
        const int n = (int)(i % D_); const long r = i / D_; const int k = (int)(r % FF_), e = (int)(r / FF_);
        WSP(bf16_t, w2T)[(((size_t)l * E_ + e) * D_ + n) * FF_ + k] = f2bf(p.exp_w2[(((size_t)l * E_ + e) * FF_ + k) * D_ + n]);
    }
}
HD void st_cvt5(const P& p, int l, int wv, int nwv, int lane) {
    GIDX;
    bf16_t* ws = WSP(bf16_t, wsmT) + (size_t)l * NSMP * KSM;
    for (long i = gid; i < (long)NSMP * KSM; i += gsz) {
        const int n = (int)(i / KSM), k = (int)(i % KSM); float v = 0.f;
        if (n < 2 * RW) { const int d = n / RW, c = n % RW, r = k - (OWD + d * RDR_); if (r >= 0 && r < RDR_) v = p.rwkv_w_up[(((size_t)l * 2 + d) * RDR_ + r) * RW + c]; }
        else if (n < 4 * RW) { const int d = (n - 2 * RW) / RW, c = n % RW, r = k - (OAD + d * RIR_); if (r >= 0 && r < RIR_) v = p.rwkv_a_up[(((size_t)l * 2 + d) * RIR_ + r) * RW + c]; }
        else if (n < 5 * RW) { const int c = n - 4 * RW, r = k - OGD; if (r >= 0 && r < RGR_) v = p.rwkv_g_up[((size_t)l * RGR_ + r) * RW + c]; }
        else if (n < NSM) { const int q = n - 5 * RW, d = q / GKD, c = q % GKD, r = k - (OGL + d * GGR_); if (r >= 0 && r < GGR_) v = p.gla_a_up[(((size_t)l * 2 + d) * GGR_ + r) * GKD + c]; }
        ws[i] = f2bf(v);
    }
}
HD void st_s5a(const P& p, int wv, int nwv, int lane) {
    GIDX; float* pw = WSP(float, s5pw); float* bb = WSP(float, s5bb);
    for (long i = gid; i < (long)L_ * 2 * SNG_ * SP_ * (CH_ + 1); i += gsz) {
        const int tau = (int)(i % (CH_ + 1)); long r = i / (CH_ + 1); const int pp = (int)(r % SP_); r /= SP_; const int g = (int)(r % SNG_); r /= SNG_; const int d = (int)(r % 2), l = (int)(r / 2);
        const double dt = exp((double)p.s5_log_dt[((size_t)l * 2 + d) * SNG_ + g]);
        const double zr = (double)p.s5_lam_re[((size_t)l * 2 + d) * SP_ + pp] * dt, zi = (double)p.s5_lam_im[((size_t)l * 2 + d) * SP_ + pp] * dt;
        const double mag = exp(zr * tau);
        pw[i * 2] = (float)(mag * cos(zi * tau)); pw[i * 2 + 1] = (float)(mag * sin(zi * tau));
    }
    for (long i = gid; i < (long)L_ * 2 * SNG_ * SP_ * SG_; i += gsz) {
        const int c = (int)(i % SG_); long r = i / SG_; const int pp = (int)(r % SP_); r /= SP_; const int g = (int)(r % SNG_); r /= SNG_; const int d = (int)(r % 2), l = (int)(r / 2);
        const double dt = exp((double)p.s5_log_dt[((size_t)l * 2 + d) * SNG_ + g]);
        const double lr = p.s5_lam_re[((size_t)l * 2 + d) * SP_ + pp], li = p.s5_lam_im[((size_t)l * 2 + d) * SP_ + pp];
        const double zr = lr * dt, zi = li * dt, mag = exp(zr), ar = mag * cos(zi), ai = mag * sin(zi), den = lr * lr + li * li;
        const double fr = ((ar - 1) * lr + ai * li) / den, fi = (ai * lr - (ar - 1) * li) / den;
        const size_t bi = ((((size_t)l * 2 + d) * SNG_ + g) * SP_ + pp) * SG_ + c;
        const double br = p.s5_b_re[bi], bim = p.s5_b_im[bi];
        bb[i * 2] = (float)(fr * br - fi * bim); bb[i * 2 + 1] = (float)(fr * bim + fi * br);
    }
}
HD void st_s5b(const P& p, int wv, int nwv, int lane) {
    GIDX; const float* pw = WSP(float, s5pw); const float* bb = WSP(float, s5bb); float* K = WSP(float, s5K);
    for (long i = gid; i < (long)L_ * 2 * SNG_ * CH_ * SG_ * SG_; i += gsz) {
        const int c2 = (int)(i % SG_); long r = i / SG_; const int c = (int)(r % SG_); r /= SG_; const int tau = (int)(r % CH_); r /= CH_; const long ldg = r;
        float acc = 0.f;
        for (int pp = 0; pp < SP_; ++pp) {
            const float cr = p.s5_c_re[(ldg * SG_ + c) * SP_ + pp], ci = p.s5_c_im[(ldg * SG_ + c) * SP_ + pp];
            const float ar = pw[((ldg * SP_ + pp) * (CH_ + 1) + tau) * 2], ai = pw[((ldg * SP_ + pp) * (CH_ + 1) + tau) * 2 + 1];
            const float br = bb[((ldg * SP_ + pp) * SG_ + c2) * 2], bi = bb[((ldg * SP_ + pp) * SG_ + c2) * 2 + 1];
            const float er = cr * ar - ci * ai, ei = cr * ai + ci * ar;
            acc += er * br - ei * bi;
        }
        K[i] = acc;
    }
}
static_assert(SG_ == 16 && K5 % 8 == 0 && KT5 % 8 == 0 && SP_ % 8 == 0, "s5c item shape");
HD void st_s5c(const P& p, int wv, int nwv, int lane) {
    GIDX; const float* pw = WSP(float, s5pw); const float* bb = WSP(float, s5bb); const float* K = WSP(float, s5K);
    bf16_t* Tb = WSP(bf16_t, s5Tb); bf16_t* Wa = WSP(bf16_t, s5Wa);
    for (long i = gid; i < (long)L_ * SNG_ * K5 * (KT5 / 8); i += gsz) {
        const int k = (int)(i % (KT5 / 8)) * 8; long r = i / (KT5 / 8); const int n = (int)(r % K5); r /= K5; const int g = (int)(r % SNG_), l = (int)(r / SNG_);
        const int t = n / SG_, c = n % SG_; float v[8];
        const long ldg0 = ((long)l * 2 + 0) * SNG_ + g, ldg1 = ((long)l * 2 + 1) * SNG_ + g;
        if (k < K5) { const int s = k / SG_, c2 = k % SG_; const float m0 = s <= t ? 1.f : 0.f, m1 = s >= t ? 1.f : 0.f; const int t0 = s <= t ? t - s : 0, t1 = s >= t ? s - t : 0;
            float a[8], b[8]; ld8f(K + ((ldg0 * CH_ + t0) * SG_ + c) * SG_ + c2, a); ld8f(K + ((ldg1 * CH_ + t1) * SG_ + c) * SG_ + c2, b);
            const float dd = p.s5_d[(size_t)l * SW + g * SG_ + c];
#pragma unroll
            for (int j = 0; j < 8; ++j) v[j] = m0 * a[j] + m1 * b[j] + ((s == t && c == c2 + j) ? dd : 0.f);
        } else { const int q = k - K5, d = q / (2 * SP_), part = (q / SP_) & 1, pp0 = q % SP_; const long ldg = d ? ldg1 : ldg0; const int ex = d ? (CH_ - t) : (t + 1);
            float cr[8], ci[8]; ld8f(p.s5_c_re + (ldg * SG_ + c) * SP_ + pp0, cr); ld8f(p.s5_c_im + (ldg * SG_ + c) * SP_ + pp0, ci);
#pragma unroll
            for (int j = 0; j < 8; ++j) { const float ar = pw[((ldg * SP_ + pp0 + j) * (CH_ + 1) + ex) * 2], ai = pw[((ldg * SP_ + pp0 + j) * (CH_ + 1) + ex) * 2 + 1];
                v[j] = part == 0 ? (cr[j] * ar - ci[j] * ai) : -(cr[j] * ai + ci[j] * ar); } }
        st8bf(Tb + i * 8, v);
    }
    for (long i = gid; i < (long)L_ * SNG_ * N5AP * (K5 / 8); i += gsz) {
        const int k = (int)(i % (K5 / 8)) * 8; long r = i / (K5 / 8); const int n = (int)(r % N5AP); r /= N5AP; const int g = (int)(r % SNG_), l = (int)(r / SNG_);
        float v[8];
#pragma unroll
        for (int j = 0; j < 8; ++j) v[j] = 0.f;
        if (n < N5A) { const int d = n / (2 * SP_), part = (n / SP_) & 1, pp = n % SP_, s = k / SG_, c2 = k % SG_; const long ldg = ((long)l * 2 + d) * SNG_ + g; const int ex = d ? s : (CH_ - 1 - s);
            const float ar = pw[((ldg * SP_ + pp) * (CH_ + 1) + ex) * 2], ai = pw[((ldg * SP_ + pp) * (CH_ + 1) + ex) * 2 + 1];
            float b0[8], b1[8]; ld8f(bb + ((ldg * SP_ + pp) * SG_ + c2) * 2, b0); ld8f(bb + ((ldg * SP_ + pp) * SG_ + c2) * 2 + 8, b1);
#pragma unroll
            for (int j = 0; j < 8; ++j) { const float br = j < 4 ? b0[2 * j] : b1[2 * (j - 4)], bi = j < 4 ? b0[2 * j + 1] : b1[2 * (j - 4) + 1]; v[j] = part == 0 ? (ar * br - ai * bi) : (ar * bi + ai * br); } }
        st8bf(Wa + i * 8, v);
    }
}
HD const float* xsrc0(const P& p, int n) { return n < NLAT ? p.x + (size_t)n * D_ : p.ctx + (size_t)(n - NLAT) * D_; }
HD void ln_stats(const float* z, int lane, float& mu, float& rstd) {
    float s = 0.f; for (int k = lane; k < D_; k += NL) s += z[k]; s = WSUM(s); mu = s * (1.0f / D_);
    float q = 0.f; for (int k = lane; k < D_; k += NL) { const float d = z[k] - mu; q += d * d; } q = WSUM(q); rstd = 1.0f / sqrtf(q * (1.0f / D_) + LN_EPS);
}
constexpr int PERL = D_ / NL, NCHK = PERL / 4;
HD void row_stats(const float* xv, float& mu, float& rstd) {
    float s = 0.f;
#pragma unroll
    for (int i = 0; i < PERL; ++i) s += xv[i];
    s = WSUM(s); mu = s * (1.0f / D_); float q = 0.f;
#pragma unroll
    for (int i = 0; i < PERL; ++i) { const float d = xv[i] - mu; q += d * d; }
    q = WSUM(q); rstd = 1.0f / sqrtf(q * (1.0f / D_) + LN_EPS);
}
HD void row_ld(const float* z, int lane, float* xv) {
#pragma unroll
    for (int i = 0; i < NCHK; ++i) { const F4 v = *(const F4*)(z + 4 * lane + 4 * NL * i); xv[4 * i] = v[0]; xv[4 * i + 1] = v[1]; xv[4 * i + 2] = v[2]; xv[4 * i + 3] = v[3]; }
}
HD void st4bf(bf16_t* q, const float* v) {
#ifdef CPU_TEST
    for (int j = 0; j < 4; ++j) q[j] = f2bf(v[j]);
#else
    uint2 w; w.x = (unsigned)f2bf(v[0]) | ((unsigned)f2bf(v[1]) << 16); w.y = (unsigned)f2bf(v[2]) | ((unsigned)f2bf(v[3]) << 16); *(uint2*)q = w;
#endif
}
HD void ld4bf(const bf16_t* q, float* o) {
#ifdef CPU_TEST
    for (int j = 0; j < 4; ++j) o[j] = bf2f(q[j]);
#else
    const uint2 w = *(const uint2*)q; o[0] = __uint_as_float(w.x << 16); o[1] = __uint_as_float(w.x & 0xffff0000u); o[2] = __uint_as_float(w.y << 16); o[3] = __uint_as_float(w.y & 0xffff0000u);
#endif
}
HD void row_mod_store(const float* xv, const float* mv, int sh_off, int sc_off, bf16_t* hrow, int lane) {
    float mu, rstd; row_stats(xv, mu, rstd);
#pragma unroll
    for (int i = 0; i < NCHK; ++i) { const int k = 4 * lane + 4 * NL * i; const F4 sc = *(const F4*)(mv + sc_off + k), sh = *(const F4*)(mv + sh_off + k); float o[4];
#pragma unroll
        for (int j = 0; j < 4; ++j) o[j] = (xv[4 * i + j] - mu) * rstd * (1.0f + sc[j]) + sh[j];
        st4bf(hrow + k, o); }
}
HD void row_affine(float* xv, const float* g, const float* bb, int lane) {
    float mu, rstd; row_stats(xv, mu, rstd);
#pragma unroll
    for (int i = 0; i < NCHK; ++i) { const int k = 4 * lane + 4 * NL * i; const F4 gg = *(const F4*)(g + k), be = *(const F4*)(bb + k);
#pragma unroll
        for (int j = 0; j < 4; ++j) xv[4 * i + j] = (xv[4 * i + j] - mu) * rstd * gg[j] + be[j]; }
}
HD void row_ld_bf(const bf16_t* z, int lane, float* xv) {
#pragma unroll
    for (int i = 0; i < NCHK; ++i) ld4bf(z + 4 * lane + 4 * NL * i, xv + 4 * i);
}
HD void row_st_bf(bf16_t* z, int lane, const float* xv) {
#pragma unroll
    for (int i = 0; i < NCHK; ++i) st4bf(z + 4 * lane + 4 * NL * i, xv + 4 * i);
}
HD void row_ld_x(const P& p, int l, int n, int lane, float* xv) { if (l == 0) row_ld(xsrc0(p, n), lane, xv); else row_ld_bf(WSP(bf16_t, xcur) + (size_t)n * D_, lane, xv); }
HD void row_st(float* z, int lane, const float* xv) {
#pragma unroll
    for (int i = 0; i < NCHK; ++i) { F4 v; v[0] = xv[4 * i]; v[1] = xv[4 * i + 1]; v[2] = xv[4 * i + 2]; v[3] = xv[4 * i + 3]; *(F4*)(z + 4 * lane + 4 * NL * i) = v; }
}
HD void st_hmod(const P& p, int l, int wv, int nwv, int lane) {
    bf16_t* h = WSP(bf16_t, h);
    for (int n = wv; n < NTOK; n += nwv) {
        float xv[PERL]; row_ld_x(p, l, n, lane, xv);
        const float* mv = WSP(float, modv) + ((size_t)l * (B_ + 1) + bidx_of(n)) * 6 * D_;
        row_mod_store(xv, mv, 0, D_, h + (size_t)n * D_, lane);
    }
}
static_assert(RCOLS % 8 == 0 && RW % 8 == 0 && RDR_ % 4 == 0, "prep1 groups");
HD void st_prep1(const P& p, int l, int wv, int nwv, int lane) {
    GIDX; const bf16_t* proj = WSP(bf16_t, proj); bf16_t* rkv = WSP(bf16_t, rkv); bf16_t* as = WSP(bf16_t, asmall); bf16_t* U2 = WSP(bf16_t, U2);
    const float* taps = p.rwkv_conv + (size_t)l * 9 * RCOLS; constexpr int NG = RCOLS / 8;
    for (long i0 = gid; i0 < (long)NTOK * NG; i0 += 2 * gsz) {
#pragma unroll
      for (int u2 = 0; u2 < 2; ++u2) { const long i = i0 + u2 * gsz; if (i < (long)NTOK * NG) {
        const int n = (int)(i / NG), ch = (int)(i % NG) * 8; float acc[8];
#pragma unroll
        for (int j = 0; j < 8; ++j) acc[j] = 0.f;
        if (n < NLAT) { const int b = n / T_, t = n % T_, gr = t / GW_, gc = t % GW_;
#pragma unroll
            for (int a = 0; a < 3; ++a)
#pragma unroll
                for (int j = 0; j < 3; ++j) { const int rr = gr + a - 1, cc = gc + j - 1; const bool ok = rr >= 0 && rr < ROWS_ && cc >= 0 && cc < GW_;
                    const int nn = ok ? b * T_ + rr * GW_ + cc : n; float x[8], w[8]; ld8bf(proj + (size_t)nn * NINP + ch, x); ld8f(taps + (a * 3 + j) * RCOLS + ch, w); const float m = ok ? 1.f : 0.f;
#pragma unroll
                    for (int q = 0; q < 8; ++q) acc[q] += (w[q] * m) * x[q]; }
        } else { const int s = (n - NLAT) % CTX_;
#pragma unroll
            for (int j = 0; j < 3; ++j) { const int ss = s + j - 1; const bool ok = ss >= 0 && ss < CTX_; const int nn = ok ? n + j - 1 : n; float x[8], w[8]; ld8bf(proj + (size_t)nn * NINP + ch, x); ld8f(taps + (3 + j) * RCOLS + ch, w); const float m = ok ? 1.f : 0.f;
#pragma unroll
                for (int q = 0; q < 8; ++q) acc[q] += (w[q] * m) * x[q]; } }
        if (ch < 3 * RW) st8bf(rkv + (size_t)n * 3 * RW + ch, acc);
        else { const int q0 = ch - 3 * RW;
            if (q0 < 2 * RDR_) {
#pragma unroll
                for (int q = 0; q < 8; ++q) acc[q] = ftanh(acc[q]); }
            else if (q0 >= 2 * RDR_ + 2 * RIR_) {
#pragma unroll
                for (int q = 0; q < 8; ++q) acc[q] = sigmoidf_(acc[q]); }
            st8bf(as + (size_t)n * KSM + q0, acc); }
          } }
    }
    constexpr int NT8 = (KSM - OGL) / 8;
    for (long i = gid; i < (long)NTOK * NT8; i += gsz) { const int n = (int)(i / NT8), q = (int)(i % NT8) * 8;
        if (q < 2 * GGR_) cp8bf(as + (size_t)n * KSM + OGL + q, proj + (size_t)n * NINP + GBASE + 2 * GKD + 2 * GWD + q); else z8bf(as + (size_t)n * KSM + OGL + q); }
    for (long i = gid; i < (long)B_ * SPOS * (SW / 8); i += gsz) { const int c = (int)(i % (SW / 8)) * 8; const long r = i / (SW / 8); const int pos = (int)(r % SPOS), b = (int)(r / SPOS);
        const int g = c / SG_, cc = c % SG_, pc = pos / CH_, t = pos % CH_, m = b * NPC + pc;
        cp8bf(U2 + ((size_t)g * M5P + m) * KT5 + t * SG_ + cc, proj + (size_t)row_of(b, pos) * NINP + SBASE + c); }
}
HD void st_s5carry(const P& p, int l, int wv, int nwv, int lane) {
    GIDX; const float* xl = WSP(float, xl); bf16_t* U2 = WSP(bf16_t, U2); const float* pw = WSP(float, s5pw);
    for (long i = gid; i < (long)2 * B_ * SNG_ * SP_; i += gsz) {
        const int pp = (int)(i % SP_); long r = i / SP_; const int g = (int)(r % SNG_); r /= SNG_; const int b = (int)(r % B_), d = (int)(r / B_);
        const long ldg = ((long)l * 2 + d) * SNG_ + g; const float ar = pw[((ldg * SP_ + pp) * (CH_ + 1) + CH_) * 2], ai = pw[((ldg * SP_ + pp) * (CH_ + 1) + CH_) * 2 + 1];
        float xr = 0.f, xi = 0.f;
        for (int q = 0; q < NPC; ++q) {
            const int pc = d == 0 ? q : (q < NPCC ? NPCC - 1 - q : NPC - 1 - (q - NPCC)); const size_t m = (size_t)b * NPC + pc;
            bf16_t* x0 = U2 + ((size_t)g * M5P + m) * KT5 + K5 + d * 2 * SP_; x0[pp] = f2bf(xr); x0[SP_ + pp] = f2bf(xi);
            const float lr = xl[((size_t)g * M5P + m) * N5AP + d * 2 * SP_ + pp], li = xl[((size_t)g * M5P + m) * N5AP + d * 2 * SP_ + SP_ + pp];
            const float nr = ar * xr - ai * xi + lr, ni = ar * xi + ai * xr + li; xr = nr; xi = ni;
        }
    }
}
struct RV { float r, w, k2, a, b, v, kkraw; };
HD void rwkv_elem(const P& p, int l, int d, int n, int hh, int j, float kknorm_rs, RV& o) {
    const bf16_t* rkv = WSP(bf16_t, rkv) + (size_t)n * 3 * RW; const float* gs = WSP(float, gs) + (size_t)n * NGF; const bf16_t* gb = WSP(bf16_t, gsb) + (size_t)n * NGB; const int c = hh * RN_ + j;
    const float k = bf2f(rkv[RW + c]); o.kkraw = k * p.rwkv_k_k[(size_t)l * RW + c]; const float kk = o.kkraw * kknorm_rs;
    const float a = bf2f(gb[d * RW + c]); o.w = fexp(gs[d * RW + c]); o.k2 = k * (1.0f + (a - 1.0f) * p.rwkv_k_a[(size_t)l * RW + c]);
    o.a = -kk; o.b = kk * a; o.r = bf2f(rkv[c]); o.v = bf2f(rkv[2 * RW + c]);
}
HD void st_post(const P& p, int l, int wv, int nwv, int lane) {
    bf16_t* ymix = WSP(bf16_t, ymix); const float* yr = WSP(float, yr); const float* og = WSP(float, og); const bf16_t* proj = WSP(bf16_t, proj); const bf16_t* gsbb = WSP(bf16_t, gsb); const bf16_t* rkvb = WSP(bf16_t, rkv);
    const int nrow = (l == L_ - 1) ? NLAT : NTOK; constexpr int PJ = RN_ / NL;
    for (int n = wv; n < nrow; n += nwv) {
        const bf16_t* rk = rkvb + (size_t)n * 3 * RW; const bf16_t* gb = gsbb + (size_t)n * NGB;
        float r_[RH_][PJ], k_[RH_][PJ], v_[RH_][PJ], y_[RH_][PJ], a0_[RH_][PJ], a1_[RH_][PJ], g_[RH_][PJ], o_[GH_][PJ], gg_[GH_][PJ];
#pragma unroll
        for (int hh = 0; hh < RH_; ++hh)
#pragma unroll
            for (int q = 0; q < PJ; ++q) { const int c = hh * RN_ + lane + NL * q; r_[hh][q] = bf2f(rk[c]); k_[hh][q] = bf2f(rk[RW + c]); v_[hh][q] = bf2f(rk[2 * RW + c]);
                y_[hh][q] = yr[(size_t)n * RW + c] + yr[((size_t)NTOK + n) * RW + c]; a0_[hh][q] = bf2f(gb[c]); a1_[hh][q] = bf2f(gb[RW + c]); g_[hh][q] = bf2f(gb[2 * RW + c]); }
#pragma unroll
        for (int hh = 0; hh < GH_; ++hh)
#pragma unroll
            for (int q = 0; q < PJ; ++q) { const int c = hh * GV_ + lane + NL * q; o_[hh][q] = og[(size_t)n * GWD + c] + og[((size_t)NTOK + n) * GWD + c]; gg_[hh][q] = bf2f(proj[(size_t)n * NINP + GBASE + 2 * GKD + GWD + c]); }
#pragma unroll
        for (int hh = 0; hh < RH_; ++hh) {
            float s = 0.f, bs = 0.f;
#pragma unroll
            for (int q = 0; q < PJ; ++q) { const int c = hh * RN_ + lane + NL * q; const float ka = p.rwkv_k_a[(size_t)l * RW + c];
                const float k20 = k_[hh][q] * (1.0f + (a0_[hh][q] - 1.0f) * ka), k21 = k_[hh][q] * (1.0f + (a1_[hh][q] - 1.0f) * ka);
                s += y_[hh][q]; bs += r_[hh][q] * (k20 + k21) * p.rwkv_r_k[(size_t)l * RW + c]; }
            s = WSUM(s); bs = WSUM(bs); const float mu = s * (1.0f / RN_); float qq = 0.f;
#pragma unroll
            for (int q = 0; q < PJ; ++q) { const float d = y_[hh][q] - mu; qq += d * d; }
            qq = WSUM(qq); const float rstd = 1.0f / sqrtf(qq * (1.0f / RN_) + GN_EPS);
#pragma unroll
            for (int q = 0; q < PJ; ++q) { const int c = hh * RN_ + lane + NL * q; const float gn = (y_[hh][q] - mu) * rstd * p.rwkv_ln_g[(size_t)l * RW + c] + p.rwkv_ln_b[(size_t)l * RW + c];
                ymix[(size_t)n * MIXW + c] = f2bf((gn + bs * v_[hh][q]) * g_[hh][q]); }
        }
#pragma unroll
        for (int hh = 0; hh < GH_; ++hh) { float qq = 0.f;
#pragma unroll
            for (int q = 0; q < PJ; ++q) qq += o_[hh][q] * o_[hh][q];
            qq = WSUM(qq); const float rs = 1.0f / sqrtf(qq * (1.0f / GV_) + 1e-6f);
#pragma unroll
            for (int q = 0; q < PJ; ++q) { const int j = lane + NL * q; ymix[(size_t)n * MIXW + RW + hh * GV_ + j] = f2bf(o_[hh][q] * rs * p.gla_norm_g[(size_t)l * GV_ + j] * siluf_(gg_[hh][q])); }
        }
    }
}
HD void st_ln1(const P& p, int l, int wv, int nwv, int lane) {
    GIDX; const float alpha = sqrtf(2.0f);
    for (long i = gid; i < E_; i += gsz) { WSP(int, ecnt)[i] = 0; WSP(int, efill)[i] = 0; }
    const int nrow = (l == L_ - 1) ? NLAT : NTOK; bf16_t* x1 = WSP(bf16_t, x1); bf16_t* h2 = WSP(bf16_t, h2); const bf16_t* yo = WSP(bf16_t, yo);
    for (int n = wv; n < nrow; n += nwv) {
        const float* mv = WSP(float, modv) + ((size_t)l * (B_ + 1) + bidx_of(n)) * 6 * D_;
        float xv[PERL], yv[PERL]; row_ld_x(p, l, n, lane, xv); row_ld_bf(yo + (size_t)n * D_, lane, yv);
#pragma unroll
        for (int i = 0; i < NCHK; ++i) { const F4 g1 = *(const F4*)(mv + 2 * D_ + 4 * lane + 4 * NL * i);
#pragma unroll
            for (int j = 0; j < 4; ++j) xv[4 * i + j] = alpha * xv[4 * i + j] + g1[j] * yv[4 * i + j]; }
        row_affine(xv, p.ln1_g + (size_t)l * D_, p.ln1_b + (size_t)l * D_, lane);
        row_st_bf(x1 + (size_t)n * D_, lane, xv);
        row_mod_store(xv, mv, 3 * D_, 4 * D_, h2 + (size_t)n * D_, lane);
    }
}
HD void st_topk(const P& p, int l, int wv, int nwv, int lane) {
    GIDX; const int nrow = (l == L_ - 1) ? NLAT : NTOK; const float* lg = WSP(float, logits); constexpr int EG = E_ / NGRP_;
    for (long n = gid; n < nrow; n += gsz) {
        const float* z = lg + (size_t)n * E_; const float* rb = p.router_bias + (size_t)l * E_;
        float gsc[NGRP_];
#pragma unroll
        for (int g = 0; g < NGRP_; ++g) { float m1 = -1e30f, m2 = -1e30f;
            for (int e = 0; e < EG; ++e) { const float s = sigmoidf_(z[g * EG + e]) + rb[g * EG + e]; if (s > m1) { m2 = m1; m1 = s; } else if (s > m2) m2 = s; }
            gsc[g] = m1 + m2; }
        unsigned gmask = 0;
#pragma unroll
        for (int g = 0; g < NGRP_; ++g) { int rank = 0;
#pragma unroll
            for (int g2 = 0; g2 < NGRP_; ++g2) rank += (gsc[g2] > gsc[g] || (gsc[g2] == gsc[g] && g2 < g)) ? 1 : 0;
            if (rank < TKG_) gmask |= 1u << g; }
        float pv = 1e30f; int pi = -1; float wsum = 0.f; int* ei = WSP(int, eidx) + (size_t)n * TOPK_; float* ew = WSP(float, ewt) + (size_t)n * TOPK_;
        for (int kk = 0; kk < TOPK_; ++kk) { float bv = -1e30f; int bi = -1;
            for (int e = 0; e < E_; ++e) { if (!((gmask >> (e / EG)) & 1u)) continue; const float s = sigmoidf_(z[e]) + rb[e];
                const bool after = (s < pv) || (s == pv && e > pi); if (after && s > bv) { bv = s; bi = e; } }
            pv = bv; pi = bi; ei[kk] = bi; const float w = sigmoidf_(z[bi]); ew[kk] = w; wsum += w; }
        for (int kk = 0; kk < TOPK_; ++kk) ew[kk] = ew[kk] / wsum * 2.5f;
#ifdef CPU_TEST
        for (int kk = 0; kk < TOPK_; ++kk) WSP(int, ecnt)[ei[kk]]++;
#else
        for (int kk = 0; kk < TOPK_; ++kk) atomicAdd(WSP(int, ecnt) + ei[kk], 1);
#endif
    }
}
HD void st_offsets(const P& p, int l, int wv, int nwv, int lane) {
    if (wv != 0 || lane != 0) return;
    int* eoff = WSP(int, eoff); const int* ecnt = WSP(int, ecnt); int* ul = WSP(int, ulist); int o = 0, nu = 0;
    for (int e = 0; e < E_; ++e) { eoff[e] = o; const int nt = (ecnt[e] + 255) / 256;
        for (int t = 0; t < nt; ++t) { ul[nu * 4 + 0] = o + 256 * t; ul[nu * 4 + 1] = e; ul[nu * 4 + 2] = (ecnt[e] - 256 * t) < 256 ? (ecnt[e] - 256 * t) : 256; ul[nu * 4 + 3] = 0; ++nu; }
        o += nt * 256; }
    eoff[E_] = o; WSP(int, nunits)[0] = nu;
}
HD void st_scatter0(const P& p, int l, int wv, int nwv, int lane) { GIDX; int* st = WSP(int, slot_tok); for (long i = gid; i < NSLOT; i += gsz) st[i] = 0; }
HD void st_scatter(const P& p, int l, int wv, int nwv, int lane) {
    GIDX; const int nrow = (l == L_ - 1) ? NLAT : NTOK; const int* ei = WSP(int, eidx); const int* eoff = WSP(int, eoff); int* so = WSP(int, slot_of); int* st = WSP(int, slot_tok);
    for (long i = gid; i < (long)nrow * TOPK_; i += gsz) { const int e = ei[i];
#ifdef CPU_TEST
        const int r = WSP(int, efill)[e]++;
#else
        const int r = atomicAdd(WSP(int, efill) + e, 1);
#endif
        const int s = eoff[e] + r; so[i] = s; st[s] = (int)(i / TOPK_); }
}
HD void st_ln2(const P& p, int l, int wv, int nwv, int lane) {
    const float alpha = sqrtf(2.0f); const bool last = (l == L_ - 1); const int nrow = last ? NLAT : NTOK;
    const bf16_t* x1 = WSP(bf16_t, x1); const bf16_t* Y = WSP(bf16_t, Y); const bf16_t* Ysh = WSP(bf16_t, Ysh); const int* so = WSP(int, slot_of); const float* ew = WSP(float, ewt);
    for (int n = wv; n < nrow; n += nwv) {
        const float* mv = WSP(float, modv) + ((size_t)l * (B_ + 1) + bidx_of(n)) * 6 * D_;
        float xv[PERL], fv[PERL]; row_ld_bf(x1 + (size_t)n * D_, lane, xv);
#pragma unroll
        for (int i = 0; i < NCHK; ++i) ld4bf(Ysh + (size_t)n * D_ + 4 * lane + 4 * NL * i, fv + 4 * i);
#pragma unroll
        for (int kk = 0; kk < TOPK_; ++kk) { const float w = ew[(size_t)n * TOPK_ + kk]; const bf16_t* yr_ = Y + (size_t)so[(size_t)n * TOPK_ + kk] * D_;
#pragma unroll
            for (int i = 0; i < NCHK; ++i) { float t4[4]; ld4bf(yr_ + 4 * lane + 4 * NL * i, t4);
#pragma unroll
                for (int j = 0; j < 4; ++j) fv[4 * i + j] += w * t4[j]; } }
#pragma unroll
        for (int i = 0; i < NCHK; ++i) { const F4 g2 = *(const F4*)(mv + 5 * D_ + 4 * lane + 4 * NL * i);
#pragma unroll
            for (int j = 0; j < 4; ++j) xv[4 * i + j] = alpha * xv[4 * i + j] + g2[j] * fv[4 * i + j]; }
        row_affine(xv, p.ln2_g + (size_t)l * D_, p.ln2_b + (size_t)l * D_, lane);
        if (last) row_st(p.out + (size_t)n * D_, lane, xv);
        else { row_st_bf(WSP(bf16_t, xcur) + (size_t)n * D_, lane, xv);
            const float* mv2 = WSP(float, modv) + ((size_t)(l + 1) * (B_ + 1) + bidx_of(n)) * 6 * D_;
            row_mod_store(xv, mv2, 0, D_, WSP(bf16_t, h) + (size_t)n * D_, lane); }
    }
}
struct UnitInfo { int arow0, brow0, g, pm, pn, nv; };
struct GemmArgs { const bf16_t* A; int lda; const int* rowmap; const bf16_t* Bt; int ldb; int K; };

struct StaticSched {
    int nb, nM, nN, aM, bN, G, c;
    HDM void init(int nb_, int M, int N, int aM_, int bN_, int G_, int c_) { nb = nb_; nM = M / 256; nN = N / 256; aM = aM_; bN = bN_; G = G_; c = c_; }
    HDM int max_units() const { return (nb * nM * nN + G - 1) / G; }
    HDM bool next(int i, UnitInfo& u) const {
        const long L = (long)i * G + c; const int per = nM * nN; if (L >= (long)nb * per) return false;
        const int g = (int)(L / per); int wgid = (int)(L % per);
        { const int q = per / 8, r = per % 8, xcd = wgid % 8, off = wgid / 8; wgid = (xcd < r ? xcd * (q + 1) : r * (q + 1) + (xcd - r) * q) + off; }
        const int nig = 8 * nN, gid = wgid / nig, fm = gid * 8, gsz = (nM - fm) < 8 ? (nM - fm) : 8;
        u.pm = fm + ((wgid % nig) % gsz); u.pn = (wgid % nig) / gsz; u.g = g; u.arow0 = g * aM + 256 * u.pm; u.brow0 = g * bN + 256 * u.pn; u.nv = 256; return true;
    }
};
HD int ld_int(const int* q) {
#ifdef CPU_TEST
    return *q;
#else
    return __hip_atomic_load(q, __ATOMIC_RELAXED, __HIP_MEMORY_SCOPE_AGENT);
#endif
}
struct ListSched {
    const int* ulist; const int* nunits; int ntn, bN, G, c;
    HDM int max_units() const { return 0; }
    HDM bool next(int i, UnitInfo& u) const {
        const long L = (long)i * G + c; const int nt = ld_int(nunits); if (L >= (long)((nt + 7) / 8) * 8 * ntn) return false;
        const int r_ = (int)(L % (8 * ntn)); const int t = (r_ & 7) * ((nt + 7) / 8) + (int)(L / (8 * ntn)), pn = r_ >> 3; if (t >= nt) return false;
        const int s0 = ld_int(ulist + 4 * t), e = ld_int(ulist + 4 * t + 1);
        u.arow0 = s0; u.brow0 = e * bN + 256 * pn; u.g = e; u.pm = s0 / 256; u.pn = pn; u.nv = ld_int(ulist + 4 * t + 2); return true;
    }
};

#ifndef PROBE_EpiBf16Plain
#define PROBE_EpiBf16Plain false
#endif
#ifndef PROBE_EpiF32Plain
#define PROBE_EpiF32Plain false
#endif
#ifndef PROBE_EpiSmall
#define PROBE_EpiSmall false
#endif
#ifndef PROBE_EpiS5b
#define PROBE_EpiS5b false
#endif
#ifndef PROBE_EpiGlu
#define PROBE_EpiGlu false
#endif
#ifndef PROBE_EpiRS
#define PROBE_EpiRS false
#endif
#ifndef PROBE_EpiUp
#define PROBE_EpiUp false
#endif
#ifndef PROBE_EpiDown
#define PROBE_EpiDown false
#endif
HD void st4_bf16(bf16_t* q, const F4& v) {
#ifdef CPU_TEST
    for (int j = 0; j < 4; ++j) q[j] = f2bf(v[j]);
#else
    uint2 w; w.x = (unsigned)f2bf(v[0]) | ((unsigned)f2bf(v[1]) << 16); w.y = (unsigned)f2bf(v[2]) | ((unsigned)f2bf(v[3]) << 16); *(uint2*)q = w;
#endif
}
HD void st4_f32(float* q, const F4& v) {
#ifdef CPU_TEST
    for (int j = 0; j < 4; ++j) q[j] = v[j];
#else
    *(F4*)q = v;
#endif
}
HD void st8_bf16(bf16_t* q, const F4& lo, const F4& hi) {
#ifdef CPU_TEST
    for (int j = 0; j < 4; ++j) { q[j] = f2bf(lo[j]); q[4 + j] = f2bf(hi[j]); }
#else
    typedef unsigned U4e __attribute__((ext_vector_type(4))); U4e w;
    w[0] = (unsigned)f2bf(lo[0]) | ((unsigned)f2bf(lo[1]) << 16); w[1] = (unsigned)f2bf(lo[2]) | ((unsigned)f2bf(lo[3]) << 16);
    w[2] = (unsigned)f2bf(hi[0]) | ((unsigned)f2bf(hi[1]) << 16); w[3] = (unsigned)f2bf(hi[2]) | ((unsigned)f2bf(hi[3]) << 16); *(U4e*)q = w;
#endif
}
HD int perm32(int rho) { const int n = rho >> 4, i = rho & 15; return 8 * (i >> 2) + 4 * n + (i & 3); }
struct EpiBf16Plain { static constexpr bool PROBE = PROBE_EpiBf16Plain; bf16_t* O; int ldo; HDM void shift() { O += 800000000; }
    static constexpr bool PERM = true;
    HDM void st8(const UnitInfo& u, int r, int c, const F4& al, const F4& ah, const F4& bl, const F4& bh) const { bf16_t* q = O + (size_t)(256 * u.pm + r) * ldo + 256 * u.pn + c; st8_bf16(q, al, ah); st8_bf16(q + 128, bl, bh); } };
struct EpiF32Plain { static constexpr bool PROBE = PROBE_EpiF32Plain; static constexpr bool PERM = false; HDM void shift() {} float* O; int ldo; size_t gstride;
    HDM void st(const UnitInfo& u, int r, int c, const F4& v0, const F4& v1) const { float* q = O + (size_t)u.g * gstride + (size_t)(256 * u.pm + r) * ldo + 256 * u.pn + c; st4_f32(q, v0); st4_f32(q + 128, v1); } };
struct EpiSmall { static constexpr bool PROBE = PROBE_EpiSmall; static constexpr bool PERM = false; HDM void shift() {} float* gs; bf16_t* gsb; const float* w0; const float* a0; const float* ab;
    HDM void half(int n, int col, const F4& v) const {
        if (col >= NSM) return; F4 o;
        if (col < 2 * RW) { for (int j = 0; j < 4; ++j) { float w = w0[col + j] + v[j]; w = -softplusf_(-w) - 0.5f; o[j] = -fexp(w); } st4_f32(gs + (size_t)n * NGF + col, o); }
        else if (col < 4 * RW) { for (int j = 0; j < 4; ++j) o[j] = sigmoidf_(a0[col - 2 * RW + j] + v[j]); st4_bf16(gsb + (size_t)n * NGB + (col - 2 * RW), o); }
        else if (col < 5 * RW) st4_bf16(gsb + (size_t)n * NGB + 2 * RW + (col - 4 * RW), v);
        else { for (int j = 0; j < 4; ++j) o[j] = -softplusf_(-(v[j] + ab[col - 5 * RW + j])) * (1.0f / 16.0f); st4_f32(gs + (size_t)n * NGF + 2 * RW + (col - 5 * RW), o); }
    }
    HDM void st(const UnitInfo& u, int r, int c, const F4& v0, const F4& v1) const { const int n = 256 * u.pm + r, col = 256 * u.pn + c; half(n, col, v0); half(n, col + 128, v1); } };
struct EpiS5b { static constexpr bool PROBE = PROBE_EpiS5b; static constexpr bool PERM = true; HDM void shift() {} bf16_t* yc;
    HDM void half(const UnitInfo& u, int b, int pc, int col, const F4& lo, const F4& hi) const { const int t = col / SG_, cc = col % SG_; const int n = row_of(b, pc * CH_ + t);
        F4 ol, oh; for (int j = 0; j < 4; ++j) { ol[j] = geluf_(lo[j]); oh[j] = geluf_(hi[j]); } st8_bf16(yc + (size_t)n * SW + u.g * SG_ + cc, ol, oh); }
    HDM void st8(const UnitInfo& u, int r, int c, const F4& al, const F4& ah, const F4& bl, const F4& bh) const {
        const int m = 256 * u.pm + r; if (m >= M5) return; const int b = m / NPC, pc = m % NPC; half(u, b, pc, 256 * u.pn + c, al, ah); half(u, b, pc, 256 * u.pn + c + 128, bl, bh); } };
HD void ld4_bf16(const bf16_t* q, F4& o) {
#ifdef CPU_TEST
    for (int j = 0; j < 4; ++j) o[j] = bf2f(q[j]);
#else
    const uint2 w = *(const uint2*)q; o[0] = __uint_as_float(w.x << 16); o[1] = __uint_as_float(w.x & 0xffff0000u); o[2] = __uint_as_float(w.y << 16); o[3] = __uint_as_float(w.y & 0xffff0000u);
#endif
}
struct EpiGlu { static constexpr bool PROBE = PROBE_EpiGlu; static constexpr bool PERM = true; HDM void shift() {} bf16_t* ymix; const bf16_t* yc; const float* gb;
    HDM void half(int n, int col, const F4& lo, const F4& hi) const { if (col >= SW) return; F4 y0, y1, ol, oh; ld4_bf16(yc + (size_t)n * SW + col, y0); ld4_bf16(yc + (size_t)n * SW + col + 4, y1);
        for (int j = 0; j < 4; ++j) { ol[j] = y0[j] * sigmoidf_(lo[j] + gb[col + j]); oh[j] = y1[j] * sigmoidf_(hi[j] + gb[col + 4 + j]); } st8_bf16(ymix + (size_t)n * MIXW + RW + GWD + col, ol, oh); }
    HDM void st8(const UnitInfo& u, int r, int c, const F4& al, const F4& ah, const F4& bl, const F4& bh) const { const int n = 256 * u.pm + r, col = 256 * u.pn + c; half(n, col, al, ah); half(n, col + 128, bl, bh); } };
struct EpiRS { static constexpr bool PROBE = PROBE_EpiRS; static constexpr bool PERM = true; HDM void shift() {} float* logits; bf16_t* sact;
    HDM void st8(const UnitInfo& u, int r, int c, const F4& al, const F4& ah, const F4& bl, const F4& bh) const {
        const int n = 256 * u.pm + r;
        if (u.pn < EP / 256) { const int col = 256 * u.pn + c; if (col < E_) { st4_f32(logits + (size_t)n * E_ + col, al); st4_f32(logits + (size_t)n * E_ + col + 4, ah); } if (col + 128 < E_) { st4_f32(logits + (size_t)n * E_ + col + 128, bl); st4_f32(logits + (size_t)n * E_ + col + 132, bh); } }
        else { const int j = u.pn - EP / 256; F4 ol, oh; for (int q = 0; q < 4; ++q) { ol[q] = siluf_(al[q]) * bl[q]; oh[q] = siluf_(ah[q]) * bh[q]; } st8_bf16(sact + (size_t)n * FF_ + 128 * j + c, ol, oh); }
    } };
struct EpiUp { static constexpr bool PROBE = PROBE_EpiUp; static constexpr bool PERM = true; HDM void shift() {} bf16_t* act;
    HDM void st8(const UnitInfo& u, int r, int c, const F4& al, const F4& ah, const F4& bl, const F4& bh) const { if (r >= u.nv) return; F4 ol, oh; for (int q = 0; q < 4; ++q) { ol[q] = siluf_(al[q]) * bl[q]; oh[q] = siluf_(ah[q]) * bh[q]; } st8_bf16(act + (size_t)(u.arow0 + r) * FF_ + 128 * u.pn + c, ol, oh); } };
struct EpiDown { static constexpr bool PROBE = PROBE_EpiDown; static constexpr bool PERM = true; HDM void shift() {} bf16_t* Y;
    HDM void st8(const UnitInfo& u, int r, int c, const F4& al, const F4& ah, const F4& bl, const F4& bh) const { if (r >= u.nv) return; bf16_t* q = Y + (size_t)(u.arow0 + r) * D_ + 256 * u.pn + c; st8_bf16(q, al, ah); st8_bf16(q + 128, bl, bh); } };

#ifdef CPU_TEST
template <class Epi, class Sched> static void gemm_phase(const GemmArgs& g, const Sched& S, const Epi& E) {
    UnitInfo u; std::vector<float> arow(g.K);
    for (int i = 0; S.next(i, u); ++i)
        for (int r = 0; r < 256; ++r) {
            const int ar = g.rowmap ? g.rowmap[u.arow0 + r] : u.arow0 + r; const bf16_t* a = g.A + (size_t)ar * g.lda;
            for (int k = 0; k < g.K; ++k) arow[k] = bf2f(a[k]);
            float out[256];
            for (int c = 0; c < 256; ++c) { const bf16_t* b0 = g.Bt + (size_t)(u.brow0 + c) * g.ldb; float s0 = 0.f; for (int k = 0; k < g.K; ++k) s0 += arow[k] * bf2f(b0[k]); out[c] = s0; }
            if constexpr (Epi::PERM) { for (int c = 0; c < 128; c += 8) { F4 al, ah, bl, bh; for (int j = 0; j < 4; ++j) { al[j] = out[c + j]; ah[j] = out[c + 4 + j]; bl[j] = out[128 + c + j]; bh[j] = out[128 + c + 4 + j]; } E.st8(u, r, c, al, ah, bl, bh); } }
            else { for (int c = 0; c < 128; c += 4) { F4 v0, v1; for (int j = 0; j < 4; ++j) { v0[j] = out[c + j]; v1[j] = out[128 + c + j]; } E.st(u, r, c, v0, v1); } }
        }
}
#else
#define LAS __attribute__((address_space(3)))
typedef short bf16x8 __attribute__((ext_vector_type(8)));
constexpr int HTB = 128 * 64 * 2, STAGE_BYTES = 8 * HTB;
HD int lds_byte(int r, int c) { const int st = (r >> 4) * 2 + (c >> 5), rr = r & 15, cc = c & 31, ob = rr * 64 + cc * 2; return st * 1024 + (ob ^ (((ob >> 9) & 1) << 5)); }
HD void stage_rc(int b, int& R, int& C) { const int st = b / 1024, sb = b % 1024, swz = sb ^ (((sb >> 9) & 1) << 5); R = (st >> 1) * 16 + swz / 64; C = (st & 1) * 32 + (swz % 64) / 2; }

struct XcdBarrier; __device__ __forceinline__ void xcd_barrier(const XcdBarrier& b);
#ifndef GP_RS
#define GP_RS 0
#endif
HD int lane_id() { return (int)__builtin_amdgcn_mbcnt_hi(~0u, __builtin_amdgcn_mbcnt_lo(~0u, 0u)); }
template <bool GATHER, class Epi, class Sched>
__device__ __forceinline__ void gemm_phase(LAS unsigned char* lds, const int wid, const GemmArgs g, const Sched& S, const Epi& E, const XcdBarrier* pbar) {
    int lane = lane_id(); asm volatile("" : "+v"(lane)); const int tid = wid * 64 + lane;
    const int wr = wid >> 2, wc = wid & 3, fr = lane & 15, fq = lane >> 4;
    float zero_ = 0.f; asm volatile("" : "+v"(zero_));
    const int nt = g.K / 64;
    const unsigned ldsw = (unsigned)wid * 1024u;
    const int aoff = lds_byte(wr * 64 + fr, fq * 8), boff = lds_byte(wc * 32 + fr, fq * 8);
    const char* Ab = (const char*)g.A; const char* Bb = (const char*)g.Bt;
#define G_SA(b, h) (((b) * 2 + (h)) * HTB)
#define G_SB(b, h) ((4 + (b) * 2 + (h)) * HTB)
#define G_STAGE(bufoff, gbase, voff) do { _Pragma("unroll") for (int _i = 0; _i < 2; ++_i) \
        __builtin_amdgcn_global_load_lds((const unsigned*)((gbase) + (voff)[_i]), (LAS unsigned*)(lds + (bufoff) + ldsw + _i * 8192), 16, 0, 0); } while (0)
#define G_LDA(dst, b, h) do { _Pragma("unroll") for (int m = 0; m < 4; ++m) _Pragma("unroll") for (int k = 0; k < 2; ++k) dst[m][k] = *(const LAS bf16x8*)(lds + G_SA(b, h) + aoff + m * 2048 + k * 1024); } while (0)
#define G_LDB(dst, b, h) do { _Pragma("unroll") for (int n = 0; n < 2; ++n) _Pragma("unroll") for (int k = 0; k < 2; ++k) dst[n][k] = *(const LAS bf16x8*)(lds + G_SB(b, h) + boff + n * 2048 + k * 1024); } while (0)
#define G_MMA(ai, bj, At, Bt) do { __builtin_amdgcn_s_setprio(1); _Pragma("unroll") for (int m = 0; m < 4; ++m) _Pragma("unroll") for (int n = 0; n < 2; ++n) _Pragma("unroll") for (int k = 0; k < 2; ++k) \
        acc[ai][bj][m][n] = __builtin_amdgcn_mfma_f32_16x16x32_bf16(Bt[n][k], At[m][k], acc[ai][bj][m][n], 0, 0, 0); __builtin_amdgcn_s_setprio(0); } while (0)
#define G_WAIT_V(n) asm volatile("s_waitcnt vmcnt(" #n ")" ::: "memory")
#define G_WAIT_L(n) asm volatile("s_waitcnt lgkmcnt(" #n ")" ::: "memory")
#define G_BAR __builtin_amdgcn_s_barrier()
#define G_SCHED __builtin_amdgcn_sched_barrier(0)
    const unsigned hA = 128u * (unsigned)g.lda * 2u, hB = 128u * (unsigned)g.ldb * 2u;
#define G_SETOFF(u) do { int _t = lane_id(); asm volatile("" : "+v"(_t)); _t += wid * 64; _Pragma("unroll") for (int _i = 0; _i < 2; ++_i) { int _R, _C; stage_rc(_t * 16 + _i * 8192, _R, _C); \
        const int _Rb = Epi::PERM ? ((_R & ~31) + perm32(_R & 31)) : _R; OB[_i] = ((unsigned)((u).brow0 + _Rb) * (unsigned)g.ldb + (unsigned)_C) * 2u; \
        if (GATHER) { OA[0][_i] = ((unsigned)ld_int(g.rowmap + (u).arow0 + _R) * (unsigned)g.lda + (unsigned)_C) * 2u; OA[1][_i] = ((unsigned)ld_int(g.rowmap + (u).arow0 + 128 + _R) * (unsigned)g.lda + (unsigned)_C) * 2u; } \
        else { OA[0][_i] = ((unsigned)((u).arow0 + _R) * (unsigned)g.lda + (unsigned)_C) * 2u; } } } while (0)
#define G_STA(bufoff, h, kb) G_STAGE(bufoff, Ab + (kb) + (GATHER ? 0u : (h) * hA), OA[GATHER ? (h) : 0])
#define G_STB(bufoff, h, kb) G_STAGE(bufoff, Bb + (kb) + (h) * hB, OB)
#ifndef GP_K2
#define GP_K2 0
#endif
#ifndef GP_E2
#define GP_E2 0
#endif
    constexpr bool K2 = GP_K2 && Epi::PROBE, E2 = GP_E2 && Epi::PROBE;
    UnitInfo cur, nxt; int ui = 0;
    if (!S.next(0, cur)) return;
    F4 acc[2][2][4][2];
#pragma unroll
    for (int a = 0; a < 2; ++a)
#pragma unroll
        for (int b = 0; b < 2; ++b)
#pragma unroll
            for (int m = 0; m < 4; ++m)
#pragma unroll
                for (int n = 0; n < 2; ++n) acc[a][b][m][n] = (F4){zero_, zero_, zero_, zero_};
    bf16x8 At[4][2], B0[2][2], B1[2][2];
    unsigned OA[GATHER ? 2 : 1][2], OB[2];
    G_SETOFF(cur);
    G_STB(G_SB(0, 0), 0, 0); G_STA(G_SA(0, 0), 0, 0); G_STB(G_SB(0, 1), 1, 0); G_STA(G_SA(0, 1), 1, 0);
    if (wr == 1) G_BAR;
    G_WAIT_V(4); G_BAR;
    G_STB(G_SB(1, 0), 0, 128); G_STA(G_SA(1, 0), 0, 128); G_STB(G_SB(1, 1), 1, 128);
    G_WAIT_V(6); G_BAR;
    for (;;) {
        const bool has_next = K2 ? S.next((ui + 1) >> 1, nxt) : S.next(ui + 1, nxt);
#pragma unroll 1
        for (int t = 0; t < nt; t += 2) {
            const bool last = (t == nt - 2);
            G_LDB(B0, 0, 0); G_SCHED; G_LDA(At, 0, 0); G_STA(G_SA(1, 1), 1, (size_t)(t + 1) * 128);
            if (last && has_next) G_SETOFF(nxt);
            const size_t k2 = last ? 0 : (size_t)(t + 2) * 128, k3 = k2 + 128;
            G_WAIT_L(8); G_BAR; G_WAIT_L(0); G_MMA(0, 0, At, B0); G_BAR; G_SCHED;
            G_LDB(B1, 0, 1); G_STB(G_SB(0, 0), 0, k2);
            G_BAR; G_WAIT_L(0); G_MMA(0, 1, At, B1); G_BAR;
            G_LDA(At, 0, 1); G_STA(G_SA(0, 0), 0, k2);
            G_BAR; G_WAIT_L(0); G_MMA(1, 0, At, B0); G_BAR; G_SCHED;
            G_STB(G_SB(0, 1), 1, k2);
            G_WAIT_V(6); G_BAR; G_MMA(1, 1, At, B1); G_BAR;
            G_LDB(B0, 1, 0); G_SCHED; G_LDA(At, 1, 0); G_STA(G_SA(0, 1), 1, k2);
            G_WAIT_L(8); G_BAR; G_WAIT_L(0); G_MMA(0, 0, At, B0); G_BAR; G_SCHED;
            G_LDB(B1, 1, 1); G_STB(G_SB(1, 0), 0, k3);
            G_BAR; G_WAIT_L(0); G_MMA(0, 1, At, B1); G_BAR;
            G_LDA(At, 1, 1); G_STA(G_SA(1, 0), 0, k3);
            G_BAR; G_WAIT_L(0); G_MMA(1, 0, At, B0); G_BAR; G_SCHED;
            G_STB(G_SB(1, 1), 1, k3);
            G_WAIT_V(6); G_BAR; G_MMA(1, 1, At, B1); G_BAR;
        }
        if (!K2 || (ui & 1)) {
        if (wr == 0) G_BAR;
        int te = lane_id(); asm volatile("" : "+v"(te)); const int ewr = wid >> 2, ewc = wid & 3, efr = te & 15, efq = te >> 4;
#pragma unroll
        for (int ai = 0; ai < 2; ++ai)
#pragma unroll
            for (int m = 0; m < 4; ++m)
            { int rr = ai * 128 + ewr * 64 + m * 16 + efr; asm volatile("" : "+v"(rr) :: "memory"); const float sc_ = K2 ? 0.5f : 1.0f;
                if constexpr (Epi::PERM) { E.st8(cur, rr, ewc * 32 + 8 * efq, acc[ai][0][m][0] * sc_, acc[ai][0][m][1] * sc_, acc[ai][1][m][0] * sc_, acc[ai][1][m][1] * sc_); }
                else {
#pragma unroll
                    for (int n = 0; n < 2; ++n) { E.st(cur, rr, ewc * 32 + n * 16 + 4 * efq, acc[ai][0][m][n] * sc_, acc[ai][1][m][n] * sc_); asm volatile("" ::: "memory"); } } }
        }
        if (GP_RS && Epi::PROBE) xcd_barrier(*pbar);
        if (!has_next) break;
        if (!K2 || (ui & 1)) {
#pragma unroll
        for (int a = 0; a < 2; ++a)
#pragma unroll
            for (int b = 0; b < 2; ++b)
#pragma unroll
                for (int m = 0; m < 4; ++m)
#pragma unroll
                    for (int n = 0; n < 2; ++n) acc[a][b][m][n] = (F4){zero_, zero_, zero_, zero_};
        if (wr == 1) G_BAR;
        }
        cur = nxt; ++ui;
    }
    G_WAIT_V(0);
    if (K2 && !(ui & 1)) { if (wr == 0) G_BAR; }
    G_BAR;
    if (GP_RS && Epi::PROBE) { for (int r_ = ui + 1; r_ < S.max_units(); ++r_) xcd_barrier(*pbar); }
}
#endif
#ifndef MULTI_LAUNCH
#define FUSED 1
#endif
constexpr int NPH_PRO = 3, NPH_LAYER = 16, NPH = NPH_PRO + L_ * NPH_LAYER;

#ifdef CPU_TEST
static void rwkv_scan_all(const P& p, int l) {
    float* yr = WSP(float, yr);
    for (int d = 0; d < 2; ++d) for (int b = 0; b < B_; ++b) for (int hh = 0; hh < RH_; ++hh) {
        static float S[RN_][RN_]; memset(S, 0, sizeof(S));
        for (int idx = 0; idx < SPOS; ++idx) { const int n = row_of(b, seqpos(d, idx)); RV e[RN_]; float q = 0.f;
            for (int j = 0; j < RN_; ++j) { rwkv_elem(p, l, d, n, hh, j, 1.0f, e[j]); q += e[j].kkraw * e[j].kkraw; }
            const float rs = 1.0f / sqrtf(q + 1e-12f);
            for (int j = 0; j < RN_; ++j) { e[j].a *= rs; e[j].b *= rs; }
            for (int i = 0; i < RN_; ++i) { float sa = 0.f; for (int j = 0; j < RN_; ++j) sa += S[i][j] * e[j].a;
                float y = 0.f; for (int j = 0; j < RN_; ++j) { S[i][j] = S[i][j] * e[j].w + sa * e[j].b + e[i].v * e[j].k2; y += S[i][j] * e[j].r; }
                yr[((size_t)d * NTOK + n) * RW + hh * RN_ + i] = y; }
        }
    }
}
static void gla_scan_all(const P& p, int l) {
    float* og = WSP(float, og); const bf16_t* proj = WSP(bf16_t, proj); const float* gs = WSP(float, gs);
    for (int d = 0; d < 2; ++d) for (int b = 0; b < B_; ++b) for (int hh = 0; hh < GH_; ++hh) {
        static float S[GK_][GV_]; memset(S, 0, sizeof(S));
        for (int idx = 0; idx < SPOS; ++idx) { const int n = row_of(b, seqpos(d, idx)); const bf16_t* pr = proj + (size_t)n * NINP + GBASE;
            for (int j = 0; j < GV_; ++j) { const float v = bf2f(pr[2 * GKD + hh * GV_ + j]); float o = 0.f;
                for (int k = 0; k < GK_; ++k) { const float q = bf2f(pr[hh * GK_ + k]) * 0.17677669529663687f, kg = bf2f(pr[GKD + hh * GK_ + k]), al = fexp(gs[(size_t)n * NGF + 2 * RW + d * GKD + hh * GK_ + k]);
                    S[k][j] = S[k][j] * al + kg * v; o += q * S[k][j]; }
                og[((size_t)d * NTOK + n) * GWD + hh * GV_ + j] = o; }
        }
    }
}
#else
__device__ __forceinline__ float dpp_sum8(float v) {
    v += __builtin_bit_cast(float, __builtin_amdgcn_update_dpp(0, __builtin_bit_cast(int, v), 0xB1, 0xF, 0xF, true));
    v += __builtin_bit_cast(float, __builtin_amdgcn_update_dpp(0, __builtin_bit_cast(int, v), 0x4E, 0xF, 0xF, true));
    v += __builtin_bit_cast(float, __builtin_amdgcn_update_dpp(0, __builtin_bit_cast(int, v), 0x141, 0xF, 0xF, true));
    return v;
}
__device__ __forceinline__ float dpp_sum16(float v) {
    v = dpp_sum8(v);
    v += __builtin_bit_cast(float, __builtin_amdgcn_update_dpp(0, __builtin_bit_cast(int, v), 0x140, 0xF, 0xF, true));
    return v;
}
__device__ __forceinline__ float dpp_sum4(float v) {
    v += __builtin_bit_cast(float, __builtin_amdgcn_update_dpp(0, __builtin_bit_cast(int, v), 0xB1, 0xF, 0xF, true));
    v += __builtin_bit_cast(float, __builtin_amdgcn_update_dpp(0, __builtin_bit_cast(int, v), 0x4E, 0xF, 0xF, true));
    return v;
}
constexpr int RT = 16;
__device__ __forceinline__ void rwkv_seq_blk(const P& p, int l, int d, int b, int hh, LAS unsigned char* lds, int wid, int lane) {
    LAS float* stage = (LAS float*)lds;
    LAS float* ybuf = (LAS float*)(lds + 2 * RT * 6 * 64 * 4);
    const int r = lane >> 3, c = lane & 7, i = wid * 8 + r, cj = hh * RN_ + lane;
    const float kkc = p.rwkv_k_k[(size_t)l * RW + cj], kac = p.rwkv_k_a[(size_t)l * RW + cj];
    const bf16_t* rkv = WSP(bf16_t, rkv); const float* gs = WSP(float, gs); const bf16_t* gsb = WSP(bf16_t, gsb); float* yr = WSP(float, yr) + (size_t)d * NTOK * RW;
    float S[8];
#pragma unroll
    for (int q = 0; q < 8; ++q) S[q] = 0.f;
    float rawA[2][5], rawB[2][5];
#define RW_LOAD(chunk, raw) do { _Pragma("unroll") for (int tt = 0; tt < 2; ++tt) { const int n = __builtin_amdgcn_readfirstlane(row_of(b, seqpos(d, (chunk) * RT + 2 * wid + tt))); \
        const bf16_t* rk = rkv + (size_t)n * 3 * RW; \
        raw[tt][0] = bf2f(rk[cj]); raw[tt][1] = bf2f(rk[RW + cj]); raw[tt][2] = bf2f(rk[2 * RW + cj]); raw[tt][3] = gs[(size_t)n * NGF + d * RW + cj]; raw[tt][4] = bf2f(gsb[(size_t)n * NGB + d * RW + cj]); } } while (0)
#define RW_PUT(buf, raw) do { _Pragma("unroll") for (int tt = 0; tt < 2; ++tt) { const float k = raw[tt][1], a = raw[tt][4], kkraw = k * kkc; \
        const float kk = kkraw * (1.0f / sqrtf(WSUM(kkraw * kkraw) + 1e-12f)); LAS float* sv = stage + (((buf) * RT + 2 * wid + tt) * 6) * 64 + lane; \
        sv[0] = fexp(raw[tt][3]); sv[64] = k * (1.0f + (a - 1.0f) * kac); sv[128] = -kk; sv[192] = kk * a; sv[256] = raw[tt][0]; sv[320] = raw[tt][2]; } } while (0)
#define RW_YST(ch_, buf_) do { _Pragma("unroll") for (int tt = 0; tt < 2; ++tt) { const int n = __builtin_amdgcn_readfirstlane(row_of(b, seqpos(d, (ch_) * RT + 2 * wid + tt))); \
        const LAS float* yp = ybuf + (((buf_) * RT + 2 * wid + tt) * 64 + lane) * 8; const F4 ya = *(const LAS F4*)yp, yb = *(const LAS F4*)(yp + 4); \
        yr[(size_t)n * RW + cj] = ((ya[0] + ya[1]) + (ya[2] + ya[3])) + ((yb[0] + yb[1]) + (yb[2] + yb[3])); } } while (0)
    RW_LOAD(0, rawA); RW_PUT(0, rawA); RW_LOAD(1, rawB);
    __syncthreads();
    constexpr int NCH = SPOS / RT; static_assert(NCH % 2 == 0, "chunk pairs");
    for (int ch = 0; ch < NCH; ch += 2) {
        {
            constexpr int buf = 0;
            if (ch + 2 < NCH) RW_LOAD(ch + 2, rawA);
        { F4 cw0, cw1, ck0, ck1, ca0, ca1, cb0, cb1, cr0, cr1; float cvi;
#define RW_LDV(t_, W0, W1, K0, K1, A0, A1, B0, B1, R0, R1, VI) do { const LAS float* sv = stage + ((buf * RT + (t_)) * 6) * 64 + 8 * c; \
            W0 = *(const LAS F4*)(sv); W1 = *(const LAS F4*)(sv + 4); K0 = *(const LAS F4*)(sv + 64); K1 = *(const LAS F4*)(sv + 68); A0 = *(const LAS F4*)(sv + 128); A1 = *(const LAS F4*)(sv + 132); \
            B0 = *(const LAS F4*)(sv + 192); B1 = *(const LAS F4*)(sv + 196); R0 = *(const LAS F4*)(sv + 256); R1 = *(const LAS F4*)(sv + 260); VI = sv[320 - 8 * c + i]; } while (0)
          RW_LDV(0, cw0, cw1, ck0, ck1, ca0, ca1, cb0, cb1, cr0, cr1, cvi);
#pragma unroll
          for (int t = 0; t < RT; ++t) {
            F4 nw0 = cw0, nw1 = cw1, nk0 = ck0, nk1 = ck1, na0 = ca0, na1 = ca1, nb0 = cb0, nb1 = cb1, nr0 = cr0, nr1 = cr1; float nvi = cvi;
            if (t + 1 < RT) RW_LDV(t + 1, nw0, nw1, nk0, nk1, na0, na1, nb0, nb1, nr0, nr1, nvi);
            float sa = ((S[0] * ca0[0] + S[1] * ca0[1]) + (S[2] * ca0[2] + S[3] * ca0[3])) + ((S[4] * ca1[0] + S[5] * ca1[1]) + (S[6] * ca1[2] + S[7] * ca1[3]));
            sa = dpp_sum8(sa);
            float y0 = 0.f, y1 = 0.f;
#pragma unroll
            for (int q = 0; q < 4; ++q) { S[q] = S[q] * cw0[q] + (sa * cb0[q] + cvi * ck0[q]); y0 += S[q] * cr0[q]; S[4 + q] = S[4 + q] * cw1[q] + (sa * cb1[q] + cvi * ck1[q]); y1 += S[4 + q] * cr1[q]; }
            ybuf[((buf * RT + t) * 64 + i) * 8 + c] = y0 + y1;
            cw0 = nw0; cw1 = nw1; ck0 = nk0; ck1 = nk1; ca0 = na0; ca1 = na1; cb0 = nb0; cb1 = nb1; cr0 = nr0; cr1 = nr1; cvi = nvi;
          }
#undef RW_LDV
        }
            RW_PUT(1, rawB);
            __syncthreads();
            RW_YST(ch, 0);
        }
        {
            constexpr int buf = 1;
            if (ch + 3 < NCH) RW_LOAD(ch + 3, rawB);
        { F4 cw0, cw1, ck0, ck1, ca0, ca1, cb0, cb1, cr0, cr1; float cvi;
#define RW_LDV(t_, W0, W1, K0, K1, A0, A1, B0, B1, R0, R1, VI) do { const LAS float* sv = stage + ((buf * RT + (t_)) * 6) * 64 + 8 * c; \
            W0 = *(const LAS F4*)(sv); W1 = *(const LAS F4*)(sv + 4); K0 = *(const LAS F4*)(sv + 64); K1 = *(const LAS F4*)(sv + 68); A0 = *(const LAS F4*)(sv + 128); A1 = *(const LAS F4*)(sv + 132); \
            B0 = *(const LAS F4*)(sv + 192); B1 = *(const LAS F4*)(sv + 196); R0 = *(const LAS F4*)(sv + 256); R1 = *(const LAS F4*)(sv + 260); VI = sv[320 - 8 * c + i]; } while (0)
          RW_LDV(0, cw0, cw1, ck0, ck1, ca0, ca1, cb0, cb1, cr0, cr1, cvi);
#pragma unroll
          for (int t = 0; t < RT; ++t) {
            F4 nw0 = cw0, nw1 = cw1, nk0 = ck0, nk1 = ck1, na0 = ca0, na1 = ca1, nb0 = cb0, nb1 = cb1, nr0 = cr0, nr1 = cr1; float nvi = cvi;
            if (t + 1 < RT) RW_LDV(t + 1, nw0, nw1, nk0, nk1, na0, na1, nb0, nb1, nr0, nr1, nvi);
            float sa = ((S[0] * ca0[0] + S[1] * ca0[1]) + (S[2] * ca0[2] + S[3] * ca0[3])) + ((S[4] * ca1[0] + S[5] * ca1[1]) + (S[6] * ca1[2] + S[7] * ca1[3]));
            sa = dpp_sum8(sa);
            float y0 = 0.f, y1 = 0.f;
#pragma unroll
            for (int q = 0; q < 4; ++q) { S[q] = S[q] * cw0[q] + (sa * cb0[q] + cvi * ck0[q]); y0 += S[q] * cr0[q]; S[4 + q] = S[4 + q] * cw1[q] + (sa * cb1[q] + cvi * ck1[q]); y1 += S[4 + q] * cr1[q]; }
            ybuf[((buf * RT + t) * 64 + i) * 8 + c] = y0 + y1;
            cw0 = nw0; cw1 = nw1; ck0 = nk0; ck1 = nk1; ca0 = na0; ca1 = na1; cb0 = nb0; cb1 = nb1; cr0 = nr0; cr1 = nr1; cvi = nvi;
          }
#undef RW_LDV
        }
            if (ch + 2 < NCH) RW_PUT(0, rawA);
            __syncthreads();
            RW_YST(ch + 1, 1);
        }
    }
    __syncthreads();
#undef RW_YST
#undef RW_LOAD
#undef RW_PUT
}
__device__ __forceinline__ void gla_seq_wave(const P& p, int l, int d, int b, int hh, int hv, LAS float* st, int lane) {
    float S[2][8];
#pragma unroll
    for (int k = 0; k < 8; ++k) { S[0][k] = 0.f; S[1][k] = 0.f; }
    const int vp = lane >> 2, kg = lane & 3;
    float* og = WSP(float, og) + (size_t)d * NTOK * GWD; const bf16_t* proj = WSP(bf16_t, proj); const float* gs = WSP(float, gs);
    constexpr int SB = RT * 128;
    const int kh = lane >> 5, jj = lane & 31;
    float vec[24], vv[RT / 2];
#define GL_LOAD(chunk) do { _Pragma("unroll") for (int it = 0; it < 8; ++it) { const int n = row_of(b, seqpos(d, (chunk) * RT + 2 * it + kh)); const bf16_t* pr = proj + (size_t)n * NINP + GBASE + hh * GK_ + jj; \
        vec[3 * it] = bf2f(pr[0]) * 0.17677669529663687f; vec[3 * it + 1] = bf2f(pr[GKD]); vec[3 * it + 2] = gs[(size_t)n * NGF + 2 * RW + d * GKD + hh * GK_ + jj]; \
        vv[it] = bf2f(pr[2 * GKD - hh * GK_ + hh * GV_ + 32 * hv]); } } while (0)
#define GL_PUT(buf) do { _Pragma("unroll") for (int it = 0; it < 8; ++it) { LAS float* q = st + (buf) * SB + (2 * it + kh) * 128 + jj; q[0] = vec[3 * it]; q[32] = vec[3 * it + 1]; q[64] = fexp(vec[3 * it + 2]); q[96] = vv[it]; } } while (0)
#define WAVE_SYNC() do { __builtin_amdgcn_fence(__ATOMIC_RELEASE, "wavefront"); __builtin_amdgcn_wave_barrier(); __builtin_amdgcn_fence(__ATOMIC_ACQUIRE, "wavefront"); } while (0)
    GL_LOAD(0); GL_PUT(0); WAVE_SYNC();
    constexpr int NCH = SPOS / RT;
    for (int ch = 0; ch < NCH; ++ch) {
        const int buf = ch & 1;
        if (ch + 1 < NCH) GL_LOAD(ch + 1);
        { typedef float F2 __attribute__((ext_vector_type(2))); F4 cq[2], ck[2], ca[2]; F2 cv;
#define GL_LDV(t_, Q, K, A, V) do { const LAS float* sv = st + buf * SB + (t_) * 128 + 8 * kg; _Pragma("unroll") for (int k4 = 0; k4 < 2; ++k4) { Q[k4] = *(const LAS F4*)(sv + 4 * k4); K[k4] = *(const LAS F4*)(sv + 32 + 4 * k4); A[k4] = *(const LAS F4*)(sv + 64 + 4 * k4); } \
            V = *(const LAS F2*)(st + buf * SB + (t_) * 128 + 96 + 2 * vp); } while (0)
          GL_LDV(0, cq, ck, ca, cv);
#pragma unroll
          for (int t = 0; t < RT; ++t) {
            F4 nq[2], nk[2], na[2]; F2 nv = cv;
#pragma unroll
            for (int k4 = 0; k4 < 2; ++k4) { nq[k4] = cq[k4]; nk[k4] = ck[k4]; na[k4] = ca[k4]; }
            if (t + 1 < RT) GL_LDV(t + 1, nq, nk, na, nv);
            float o0 = 0.f, o1 = 0.f;
#pragma unroll
            for (int k4 = 0; k4 < 2; ++k4)
#pragma unroll
                for (int q = 0; q < 4; ++q) { S[0][4 * k4 + q] = S[0][4 * k4 + q] * ca[k4][q] + ck[k4][q] * cv[0]; o0 += cq[k4][q] * S[0][4 * k4 + q]; S[1][4 * k4 + q] = S[1][4 * k4 + q] * ca[k4][q] + ck[k4][q] * cv[1]; o1 += cq[k4][q] * S[1][4 * k4 + q]; }
            o0 = dpp_sum4(o0); o1 = dpp_sum4(o1);
            const int n = __builtin_amdgcn_readfirstlane(row_of(b, seqpos(d, ch * RT + t)));
            if (kg == 0) { F2 oo; oo[0] = o0; oo[1] = o1; *(F2*)(og + (size_t)n * GWD + hh * GV_ + 32 * hv + 2 * vp) = oo; }
#pragma unroll
            for (int k4 = 0; k4 < 2; ++k4) { cq[k4] = nq[k4]; ck[k4] = nk[k4]; ca[k4] = na[k4]; }
            cv = nv;
          }
#undef GL_LDV
        }
        if (ch + 1 < NCH) GL_PUT(buf ^ 1);
        WAVE_SYNC();
    }
#undef GL_LOAD
#undef GL_PUT
}
#define BSYNC() do { asm volatile("s_waitcnt lgkmcnt(0)" ::: "memory"); __builtin_amdgcn_s_barrier(); asm volatile("" ::: "memory"); } while (0)
template <int M, int N, int K, int NW, class F>
__device__ __forceinline__ void bmm(const LAS bf16_t* A, int lda, const LAS bf16_t* Bt, int ldb, int w, int lane, F f) {
    const int r = lane & 15, q = lane >> 4;
#pragma unroll 1
    for (int t = w; t < (M / 16) * (N / 16); t += NW) { const int tm = t / (N / 16), tn = t % (N / 16); F4 acc = (F4){0.f, 0.f, 0.f, 0.f};
#pragma unroll
        for (int kk = 0; kk < K / 32; ++kk) { const bf16x8 a = *(const LAS bf16x8*)(A + (tm * 16 + r) * lda + kk * 32 + 8 * q), bb = *(const LAS bf16x8*)(Bt + (tn * 16 + r) * ldb + kk * 32 + 8 * q);
            acc = __builtin_amdgcn_mfma_f32_16x16x32_bf16(a, bb, acc, 0, 0, 0); }
        f(tm * 16 + 4 * q, tn * 16 + r, acc); }
}
template <int M, int N, int K1, int K2, int NW, class F>
__device__ __forceinline__ void bmm2(const LAS bf16_t* A1, int lda1, const LAS bf16_t* Bt1, int ldb1, const LAS bf16_t* A2, int lda2, const LAS bf16_t* Bt2, int ldb2, int w, int lane, F f) {
    const int r = lane & 15, q = lane >> 4;
#pragma unroll 1
    for (int t = w; t < (M / 16) * (N / 16); t += NW) { const int tm = t / (N / 16), tn = t % (N / 16); F4 acc = (F4){0.f, 0.f, 0.f, 0.f};
#pragma unroll
        for (int kk = 0; kk < K1 / 32; ++kk) { const bf16x8 a = *(const LAS bf16x8*)(A1 + (tm * 16 + r) * lda1 + kk * 32 + 8 * q), bb = *(const LAS bf16x8*)(Bt1 + (tn * 16 + r) * ldb1 + kk * 32 + 8 * q);
            acc = __builtin_amdgcn_mfma_f32_16x16x32_bf16(a, bb, acc, 0, 0, 0); }
#pragma unroll
        for (int kk = 0; kk < K2 / 32; ++kk) { const bf16x8 a = *(const LAS bf16x8*)(A2 + (tm * 16 + r) * lda2 + kk * 32 + 8 * q), bb = *(const LAS bf16x8*)(Bt2 + (tn * 16 + r) * ldb2 + kk * 32 + 8 * q);
            acc = __builtin_amdgcn_mfma_f32_16x16x32_bf16(a, bb, acc, 0, 0, 0); }
        f(tm * 16 + 4 * q, tn * 16 + r, acc); }
}
template <int M, int N, int K1, int K2, int K3, int NW, class F>
__device__ __forceinline__ void bmm3(const LAS bf16_t* A1, int lda1, const LAS bf16_t* Bt1, int ldb1, const LAS bf16_t* A2, int lda2, const LAS bf16_t* Bt2, int ldb2,
                                     const LAS bf16_t* A3, int lda3, const LAS bf16_t* Bt3, int ldb3, int w, int lane, F f) {
    const int r = lane & 15, q = lane >> 4;
#pragma unroll 1
    for (int t = w; t < (M / 16) * (N / 16); t += NW) { const int tm = t / (N / 16), tn = t % (N / 16); F4 acc = (F4){0.f, 0.f, 0.f, 0.f};
#pragma unroll
        for (int kk = 0; kk < K1 / 32; ++kk) acc = __builtin_amdgcn_mfma_f32_16x16x32_bf16(*(const LAS bf16x8*)(A1 + (tm * 16 + r) * lda1 + kk * 32 + 8 * q), *(const LAS bf16x8*)(Bt1 + (tn * 16 + r) * ldb1 + kk * 32 + 8 * q), acc, 0, 0, 0);
#pragma unroll
        for (int kk = 0; kk < K2 / 32; ++kk) acc = __builtin_amdgcn_mfma_f32_16x16x32_bf16(*(const LAS bf16x8*)(A2 + (tm * 16 + r) * lda2 + kk * 32 + 8 * q), *(const LAS bf16x8*)(Bt2 + (tn * 16 + r) * ldb2 + kk * 32 + 8 * q), acc, 0, 0, 0);
#pragma unroll
        for (int kk = 0; kk < K3 / 32; ++kk) acc = __builtin_amdgcn_mfma_f32_16x16x32_bf16(*(const LAS bf16x8*)(A3 + (tm * 16 + r) * lda3 + kk * 32 + 8 * q), *(const LAS bf16x8*)(Bt3 + (tn * 16 + r) * ldb3 + kk * 32 + 8 * q), acc, 0, 0, 0);
        f(tm * 16 + 4 * q, tn * 16 + r, acc); }
}
typedef unsigned u32x2_t __attribute__((ext_vector_type(2)));
typedef unsigned u32x4_t __attribute__((ext_vector_type(4)));
__device__ __forceinline__ unsigned gload_u16(const bf16_t* p) { unsigned x; asm volatile("global_load_ushort %0, %1, off" : "=v"(x) : "v"(p) : "memory"); return x; }
template <int OFF> __device__ __forceinline__ unsigned gload_u16s(const void* sbase, unsigned voff) { unsigned x; asm volatile("global_load_ushort %0, %1, %2 offset:%3" : "=v"(x) : "v"(voff), "s"(sbase), "n"(OFF) : "memory"); return x; }
__device__ __forceinline__ float gload_f32s(const void* sbase, unsigned voff) { float x; asm volatile("global_load_dword %0, %1, %2" : "=v"(x) : "v"(voff), "s"(sbase) : "memory"); return x; }
__device__ __forceinline__ float gload_f32(const float* p) { float x; asm volatile("global_load_dword %0, %1, off" : "=v"(x) : "v"(p) : "memory"); return x; }
__device__ __forceinline__ void rwkv_chunk_blk(const P& p, int l, int d, int b, int hh, LAS unsigned char* lds, int wid, int lane) {
    static_assert(RN_ == 64 && RT == 16, "rwkv chunk geometry");
#define ZF ((LAS float*)lds)
#define ZT ((LAS bf16_t*)(lds + 16384))
#define RHS ((LAS float*)(lds + 34816))
#define LW ((LAS float*)(lds + 38912))
#define UT ((LAS bf16_t*)(lds + 43008))
#define SETB(s) (lds + 48128 + (s) * 29952)
#define AT(s) ((LAS bf16_t*)SETB(s))
#define RTm(s) (AT(s) + 16 * 72)
#define BH(s) (AT(s) + 32 * 72)
#define KH(s) (AT(s) + 48 * 72)
#define BHT(s) ((LAS bf16_t*)(SETB(s) + 9216))
#define KHT(s) (BHT(s) + 64 * 40)
#define VT(s) (BHT(s) + 128 * 40)
#define MAK(s) ((LAS bf16_t*)(SETB(s) + 24576))
#define MRB(s) (MAK(s) + 16 * 40)
#define MRK(s) (MAK(s) + 32 * 40)
#define MABF(s) ((LAS float*)(SETB(s) + 28416))
#define PL(s) ((LAS float*)(SETB(s) + 29440))
#define NR(s) ((LAS int*)(SETB(s) + 29696))
    const int tid = wid * 64 + lane, cj = hh * RN_ + lane;
    const float kkc = p.rwkv_k_k[(size_t)l * RW + cj], kac = p.rwkv_k_a[(size_t)l * RW + cj];
    const bf16_t* rkv = WSP(bf16_t, rkv); const float* gs = WSP(float, gs); const bf16_t* gsb = WSP(bf16_t, gsb); float* yr = WSP(float, yr) + (size_t)d * NTOK * RW;
    F4 za = (F4){0.f, 0.f, 0.f, 0.f}, zb = za;
    for (int i = tid; i < 2 * 64 * 72; i += 512) ZT[i] = 0;
    for (int i = tid; i < 64 * 40; i += 512) UT[i] = 0;
    for (int i = tid; i < 2 * 29952 / 2; i += 512) AT(0)[i] = 0;
    const int ntk = wid == 0 ? 0 : ((wid == 4 || wid == 5) ? 3 : 2);
#define TKI(tt) ((tt) < 2 ? 2 * wid + (tt) : wid - 4)
    unsigned rawu[3][4]; float rawf[3]; int rn[3];
    const unsigned vo2 = (unsigned)cj * 2u, vo4 = (unsigned)cj * 4u;
#define RC_LOAD(chunk) do { _Pragma("unroll") for (int tt = 0; tt < 3; ++tt) { const int n = __builtin_amdgcn_readfirstlane(row_of(b, seqpos(d, (chunk) * RT + (tt < ntk ? TKI(tt) : 0)))); rn[tt] = n;        \
        const bf16_t* rk = rkv + (size_t)n * 3 * RW; const float* gp = gs + (size_t)n * NGF + d * RW; const bf16_t* gb = gsb + (size_t)n * NGB + d * RW; \
        rawu[tt][0] = gload_u16s<0>(rk, vo2); rawu[tt][1] = gload_u16s<2 * RW>(rk, vo2); rawu[tt][2] = gload_u16s<4 * RW>(rk, vo2); rawf[tt] = gload_f32s(gp, vo4); rawu[tt][3] = gload_u16s<0>(gb, vo2); } } while (0)
    float vr[3], vk2[3], va[3], vb[3], vv[3], vlw[3];
#define RC_RETIRE() do { asm volatile("s_waitcnt vmcnt(0)" ::: "memory"); _Pragma("unroll") for (int tt = 0; tt < 3; ++tt) { asm volatile("" : "+v"(rawu[tt][0]), "+v"(rawu[tt][1]), "+v"(rawu[tt][2]), "+v"(rawu[tt][3]), "+v"(rawf[tt])); } } while (0)
#define RC_P0(s) do { \
        _Pragma("unroll") for (int tt = 0; tt < 3; ++tt) if (tt < ntk) { const float k = bf2f((bf16_t)rawu[tt][1]), a = bf2f((bf16_t)rawu[tt][3]), kkraw = k * kkc; const float kk = kkraw * __builtin_amdgcn_rsqf(WSUM(kkraw * kkraw) + 1e-12f); \
            vr[tt] = bf2f((bf16_t)rawu[tt][0]); vk2[tt] = k * (1.0f + (a - 1.0f) * kac); va[tt] = -kk; vb[tt] = kk * a; vv[tt] = bf2f((bf16_t)rawu[tt][2]); vlw[tt] = rawf[tt]; \
            LW[TKI(tt) * 64 + lane] = vlw[tt]; if (lane == 0) NR(s)[TKI(tt)] = rn[tt]; } } while (0)
#define RC_TOK(s, t_, lp_, tt) do { const int t = (t_); const float lp = (lp_); const float em = fexp(lp - vlw[tt]), ep = fexp(lp), en = fexp(-lp); \
            AT(s)[t * 72 + lane] = f2bf(va[tt] * em); RTm(s)[t * 72 + lane] = f2bf(vr[tt] * ep); const bf16_t bh = f2bf(vb[tt] * en), kh = f2bf(vk2[tt] * en); \
            BH(s)[t * 72 + lane] = bh; KH(s)[t * 72 + lane] = kh; BHT(s)[lane * 40 + t] = bh; KHT(s)[lane * 40 + t] = kh; VT(s)[lane * 40 + t] = f2bf(vv[tt]); \
            if (t == RT - 1) PL(s)[lane] = ep; } while (0)
#define RC_P0B(s) do { if (ntk) { float lpb = 0.f, lpc = 0.f; const float l0 = LW[lane]; \
            _Pragma("unroll") for (int q = 0; q < RT - 2; q += 2) { const float x0 = LW[q * 64 + lane], x1 = LW[(q + 1) * 64 + lane]; const bool on = q < 2 * wid; lpb += on ? x0 : 0.f; lpc += on ? x1 : 0.f; } \
            lpb += lpc; lpb += vlw[0]; RC_TOK(s, 2 * wid, lpb, 0); lpb += vlw[1]; RC_TOK(s, 2 * wid + 1, lpb, 1); \
            if (ntk == 3) { const float lp3 = (wid == 5 ? l0 : 0.f) + vlw[2]; RC_TOK(s, wid - 4, lp3, 2); } } } while (0)
#define RC_P1(s, w4) do { const LAS bf16_t* Aop = ((w4) < 2) ? AT(s) : RTm(s); const LAS bf16_t* Bop = ((w4) & 1) ? KH(s) : BH(s); \
            bmm<16, 16, 64, 1>(Aop, 72, Bop, 72, 0, lane, [&](int r0, int cc, const F4& acc) { \
                _Pragma("unroll") for (int j = 0; j < 4; ++j) { const int rr = r0 + j; const bool keep = ((w4) < 2) ? (cc < rr) : (cc <= rr); const float val = keep ? acc[j] : 0.f; \
                    if ((w4) == 0) MABF(s)[cc * 16 + rr] = val; else if ((w4) == 1) MAK(s)[rr * 40 + cc] = f2bf(val); else if ((w4) == 2) MRB(s)[rr * 40 + cc] = f2bf(val); else MRK(s)[rr * 40 + cc] = f2bf(val); } }); } while (0)
    constexpr int NCH = SPOS / RT;
    RC_LOAD(0);
    __syncthreads();
    RC_RETIRE(); RC_P0(0); BSYNC(); RC_LOAD(1); RC_P0B(0); BSYNC(); if (wid < 4) RC_P1(0, wid); BSYNC();
    F4 yacc = (F4){0.f, 0.f, 0.f, 0.f}; int yrow[4] = {0, 0, 0, 0}; int ycol = 0;
#define RC_YST() do { _Pragma("unroll") for (int j = 0; j < 4; ++j) yr[(size_t)yrow[j] * RW + ycol] = yacc[j]; } while (0)
    for (int ch = 0; ch < NCH; ++ch) {
        int lnv = lane; asm volatile("" : "+v"(lnv)); const int lane = lnv;
        const int cs = ch & 1, ns = cs ^ 1; LAS bf16_t* ZTc = ZT + cs * 64 * 72; LAS bf16_t* ZTn = ZT + ns * 64 * 72; const bool more = ch + 1 < NCH;
        if (wid < 4) bmm3<16, 64, 64, 32, 0, 4>(AT(cs), 72, ZTc, 72, MAK(cs), 40, VT(cs), 40, AT(cs), 72, ZTc, 72, wid, lane, [&](int r0, int cc, const F4& acc) {
#pragma unroll
            for (int j = 0; j < 4; ++j) RHS[(r0 + j) * 64 + cc] = acc[j]; });
        RC_RETIRE();
        if (wid < 4 && ch > 0) RC_YST();
        if (more) RC_P0(ns);
        typedef float F2 __attribute__((ext_vector_type(2)));
        constexpr int MPRE = 6;
        F2 mm[RT - 1][RT / 2];
        if (wid == 0) { unsigned mtb = (unsigned)(size_t)MABF(cs); asm volatile("" : "+v"(mtb)); const LAS float* MT = (const LAS float*)(size_t)mtb;
#pragma unroll
            for (int s = 0; s < MPRE; ++s) {
#pragma unroll
                for (int i = (s + 1) >> 1; i < RT / 2; ++i) mm[s][i] = *(const LAS F2*)(MT + s * 16 + 2 * i); } }
        BSYNC();
        RC_LOAD(ch + 2 < NCH ? ch + 2 : NCH - 1);
        if (wid == 0) {
            __builtin_amdgcn_s_setprio(2);
            F2 acc2[RT / 2];
#pragma unroll
            for (int i = 0; i < RT / 2; ++i) { acc2[i][0] = RHS[(2 * i) * 64 + lane]; acc2[i][1] = RHS[(2 * i + 1) * 64 + lane]; }
#pragma unroll
            for (int s = 0; s < RT - 1; ++s) { const float u = acc2[s >> 1][s & 1]; const F2 uu = (F2){u, u};
                if (s == 2) { asm volatile("" ::: "memory"); unsigned mtb = (unsigned)(size_t)MABF(cs); asm volatile("" : "+v"(mtb)); const LAS float* MT = (const LAS float*)(size_t)mtb;
#pragma unroll
                    for (int s2 = MPRE; s2 < RT - 1; ++s2) {
#pragma unroll
                        for (int i = (s2 + 1) >> 1; i < RT / 2; ++i) mm[s2][i] = *(const LAS F2*)(MT + s2 * 16 + 2 * i); } }
#pragma unroll
                for (int i = (s + 1) >> 1; i < RT / 2; ++i) acc2[i] = __builtin_elementwise_fma(mm[s][i], uu, acc2[i]); }
#pragma unroll
            for (int i = 0; i < RT / 2; ++i) { UT[lane * 40 + 2 * i] = f2bf(acc2[i][0]); UT[lane * 40 + 2 * i + 1] = f2bf(acc2[i][1]); }
            __builtin_amdgcn_s_setprio(0); }
        if (more) RC_P0B(ns);
        BSYNC();
        if (wid < 4) bmm3<16, 64, 64, 32, 32, 4>(RTm(cs), 72, ZTc, 72, MRB(cs), 40, UT, 40, MRK(cs), 40, VT(cs), 40, wid, lane, [&](int r0, int cc, const F4& acc) {
#pragma unroll
            for (int j = 0; j < 4; ++j) yrow[j] = NR(cs)[r0 + j];
            yacc = acc; ycol = hh * RN_ + cc; });
        else if (more) RC_P1(ns, wid - 4);
        {
            const int r = lane & 15, q = lane >> 4, tn = wid & 3, cc = tn * 16 + r;
            typedef __bf16 bf2_t __attribute__((ext_vector_type(2))); typedef float F2s __attribute__((ext_vector_type(2)));
#pragma unroll
            for (int h = 0; h < 2; ++h) { const int tm = (wid >> 2) + 2 * h, r0 = tm * 16 + 4 * q; F4 acc = (F4){0.f, 0.f, 0.f, 0.f};
                acc = __builtin_amdgcn_mfma_f32_16x16x32_bf16(*(const LAS bf16x8*)(BHT(cs) + (tm * 16 + r) * 40 + 8 * q), *(const LAS bf16x8*)(UT + cc * 40 + 8 * q), acc, 0, 0, 0);
                acc = __builtin_amdgcn_mfma_f32_16x16x32_bf16(*(const LAS bf16x8*)(KHT(cs) + (tm * 16 + r) * 40 + 8 * q), *(const LAS bf16x8*)(VT(cs) + cc * 40 + 8 * q), acc, 0, 0, 0);
                const F4 pl = *(const LAS F4*)(PL(cs) + r0);
                const F4 zn = pl * ((h ? zb : za) + acc); if (h) zb = zn; else za = zn;
                const bf2_t p01 = __builtin_convertvector((F2s){zn[0], zn[1]}, bf2_t), p23 = __builtin_convertvector((F2s){zn[2], zn[3]}, bf2_t);
                u32x2_t w2; w2[0] = __builtin_bit_cast(unsigned, p01); w2[1] = __builtin_bit_cast(unsigned, p23);
                *(LAS u32x2_t*)(ZTn + cc * 72 + r0) = w2; } }
        BSYNC();
    }
    RC_RETIRE();
    if (wid < 4) RC_YST();
    __syncthreads();
#undef RC_YST
#undef RC_RETIRE
#undef RC_LOAD
#undef RC_P0
#undef RC_P0B
#undef RC_TOK
#undef TKI
#undef RC_P1
#undef ZF
#undef ZT
#undef RHS
#undef LW
#undef UT
#undef SETB
#undef AT
#undef RTm
#undef BH
#undef KH
#undef BHT
#undef KHT
#undef VT
#undef MAK
#undef MRB
#undef MRK
#undef MABF
#undef PL
#undef NR
}
__device__ __forceinline__ u32x2_t gload_x2(const void* p) { u32x2_t x; asm volatile("global_load_dwordx2 %0, %1, off" : "=v"(x) : "v"(p) : "memory"); return x; }
__device__ __forceinline__ u32x4_t gload_x4(const void* p) { u32x4_t x; asm volatile("global_load_dwordx4 %0, %1, off" : "=v"(x) : "v"(p) : "memory"); return x; }
template <int K1, int K2>
__device__ __forceinline__ F4 bmm2_tile(const LAS bf16_t* A1, int lda1, const LAS bf16_t* Bt1, int ldb1, const LAS bf16_t* A2, int lda2, const LAS bf16_t* Bt2, int ldb2, int tm, int tn, int lane) {
    const int r = lane & 15, q = lane >> 4; F4 acc = (F4){0.f, 0.f, 0.f, 0.f};
#pragma unroll
    for (int kk = 0; kk < K1 / 32; ++kk) acc = __builtin_amdgcn_mfma_f32_16x16x32_bf16(*(const LAS bf16x8*)(A1 + (tm * 16 + r) * lda1 + kk * 32 + 8 * q), *(const LAS bf16x8*)(Bt1 + (tn * 16 + r) * ldb1 + kk * 32 + 8 * q), acc, 0, 0, 0);
#pragma unroll
    for (int kk = 0; kk < K2 / 32; ++kk) acc = __builtin_amdgcn_mfma_f32_16x16x32_bf16(*(const LAS bf16x8*)(A2 + (tm * 16 + r) * lda2 + kk * 32 + 8 * q), *(const LAS bf16x8*)(Bt2 + (tn * 16 + r) * ldb2 + kk * 32 + 8 * q), acc, 0, 0, 0);
    return acc;
}
__device__ __forceinline__ void gla_chunk_blk(const P& p, int l, int d, int b, int hh, LAS unsigned char* lds, int wid, int lane) {
    static_assert(GK_ == 32 && GV_ == 64 && CH_ == 64, "gla chunk geometry");
    const int tid = wid * 64 + lane;
    LAS float* LA = (LAS float*)lds;
    LAS float* QR = (LAS float*)(lds + 8192);
    LAS float* KR = (LAS float*)(lds + 16384);
    LAS float* SF = (LAS float*)(lds + 24576);
    LAS bf16_t* QIN = (LAS bf16_t*)(lds + 32768);
    LAS bf16_t* KIN = (LAS bf16_t*)(lds + 32768 + 5120);
    LAS bf16_t* STT = (LAS bf16_t*)(lds + 32768 + 10240);
    LAS bf16_t* KSTT = (LAS bf16_t*)(lds + 32768 + 15360);
    LAS bf16_t* VT = (LAS bf16_t*)(lds + 32768 + 19968);
    LAS bf16_t* ATT = (LAS bf16_t*)(lds + 32768 + 29184);
    LAS int* NR = (LAS int*)(lds + 32768 + 38400);
    const bf16_t* proj = WSP(bf16_t, proj); const float* gs = WSP(float, gs); float* og = WSP(float, og) + (size_t)d * NTOK * GWD;
    for (int i = tid; i < 32 * 64; i += 512) SF[i] = 0.f;
    for (int i = tid; i < 64 * 40; i += 512) STT[i] = 0;
    const int t = tid >> 3, k4 = (tid & 7) * 4, v8 = (tid & 7) * 8;
    u32x2_t rq, rk; u32x4_t rv, rla; int rn_;
#define GC_LOAD(c_) do { rn_ = row_of(b, seqpos(d, (c_) * 64 + t)); const bf16_t* pr = proj + (size_t)rn_ * NINP + GBASE; \
        rq = gload_x2(pr + hh * GK_ + k4); rk = gload_x2(pr + GKD + hh * GK_ + k4); rv = gload_x4(pr + 2 * GKD + hh * GV_ + v8); rla = gload_x4(gs + (size_t)rn_ * NGF + 2 * RW + d * GKD + hh * GK_ + k4); } while (0)
#define GC_WAIT() do { asm volatile("s_waitcnt vmcnt(0)" ::: "memory"); asm volatile("" : "+v"(rq), "+v"(rk), "+v"(rv), "+v"(rla)); } while (0)
#define GC_PUT() do { _Pragma("unroll") for (int j = 0; j < 4; ++j) { const unsigned wq = rq[j >> 1], wk = rk[j >> 1]; const float qf = __builtin_bit_cast(float, (j & 1) ? (wq & 0xFFFF0000u) : (wq << 16)), kf = __builtin_bit_cast(float, (j & 1) ? (wk & 0xFFFF0000u) : (wk << 16)); \
            QR[t * 32 + k4 + j] = qf * 0.17677669529663687f; KR[t * 32 + k4 + j] = kf; } \
        *(LAS u32x4_t*)(LA + t * 32 + k4) = rla; \
        _Pragma("unroll") for (int j = 0; j < 8; ++j) { const unsigned wv_ = rv[j >> 1]; VT[(v8 + j) * 72 + t] = (bf16_t)((j & 1) ? (wv_ >> 16) : (wv_ & 0xFFFFu)); } if ((tid & 7) == 0) NR[t] = rn_; } while (0)
    F4 o0 = (F4){0.f, 0.f, 0.f, 0.f}, o1 = o0; int orow0[4] = {0, 0, 0, 0}, orow1[4] = {0, 0, 0, 0};
    const int ocol = hh * GV_ + (wid & 3) * 16 + (lane & 15);
#define GC_OST() do { _Pragma("unroll") for (int j = 0; j < 4; ++j) { og[(size_t)orow0[j] * GWD + ocol] = o0[j]; og[(size_t)orow1[j] * GWD + ocol] = o1[j]; } } while (0)
    GC_LOAD(0);
    __syncthreads();
#pragma unroll 1
    for (int c = 0; c < NPC; ++c) {
        GC_WAIT();
        if (c > 0) GC_OST();
        GC_PUT();
        BSYNC();
        GC_LOAD(c + 1 < NPC ? c + 1 : NPC - 1);
        if (wid == 0) { const int kc = lane & 31, t0 = (lane >> 5) * 32; float cs[32];
#pragma unroll
            for (int tt = 0; tt < 32; ++tt) cs[tt] = LA[(t0 + tt) * 32 + kc];
#pragma unroll
            for (int tt = 1; tt < 32; ++tt) cs[tt] += cs[tt - 1];
            const float up = __builtin_bit_cast(float, __builtin_amdgcn_ds_bpermute(((lane + 32) & 63) * 4, __builtin_bit_cast(int, cs[31]))); const float add = lane >= 32 ? up : 0.f;
#pragma unroll
            for (int tt = 0; tt < 32; ++tt) LA[(t0 + tt) * 32 + kc] = cs[tt] + add; }
        BSYNC();
#pragma unroll
        for (int j = 0; j < 4; ++j) { const float bb = LA[t * 32 + k4 + j], bl = LA[63 * 32 + k4 + j], qv = QR[t * 32 + k4 + j], kv = KR[t * 32 + k4 + j];
            QIN[t * 40 + k4 + j] = f2bf(qv * fexp(bb)); KIN[t * 40 + k4 + j] = f2bf(kv * fexp(-bb)); KSTT[(k4 + j) * 72 + t] = f2bf(kv * fexp(bl - bb)); }
        BSYNC();
        bmm<64, 64, 32, 8>(QIN, 40, KIN, 40, wid, lane, [&](int r0, int cc, const F4& acc) {
#pragma unroll
            for (int j = 0; j < 4; ++j) ATT[(r0 + j) * 72 + cc] = f2bf(cc <= r0 + j ? acc[j] : 0.f); });
        BSYNC();
        { const int tm0 = wid >> 2, tn = wid & 3, q4 = 4 * (lane >> 4);
          o0 = bmm2_tile<64, 32>(ATT, 72, VT, 72, QIN, 40, STT, 40, tm0, tn, lane); o1 = bmm2_tile<64, 32>(ATT, 72, VT, 72, QIN, 40, STT, 40, tm0 + 2, tn, lane);
#pragma unroll
          for (int j = 0; j < 4; ++j) { orow0[j] = NR[tm0 * 16 + q4 + j]; orow1[j] = NR[(tm0 + 2) * 16 + q4 + j]; } }
        BSYNC();
        bmm<32, 64, 64, 8>(KSTT, 72, VT, 72, wid, lane, [&](int r0, int cc, const F4& acc) {
#pragma unroll
            for (int j = 0; j < 4; ++j) { const float sn = fexp(LA[63 * 32 + r0 + j]) * SF[(r0 + j) * 64 + cc] + acc[j]; SF[(r0 + j) * 64 + cc] = sn; STT[cc * 40 + r0 + j] = f2bf(sn); } });
        BSYNC();
    }
    GC_WAIT();
    GC_OST();
#undef GC_PUT
#undef GC_LOAD
#undef GC_WAIT
#undef GC_OST
}
#endif

#ifndef CPU_TEST
__device__ __forceinline__ void cvt_job(LAS unsigned char* lds, int tid, const float* src, bf16_t* dst, int nb, size_t sbs, size_t dbs, int K, int Nsrc, int Ndst, int nvalid, int perm) {
    LAS unsigned short* tl = (LAS unsigned short*)lds;
    const int tK = K / 64, tN = Ndst / 64, per = tK * tN; const long total = (long)nb * per;
    for (long t = blockIdx.x; t < total; t += gridDim.x) {
        const int e = (int)(t / per), r = (int)(t % per), tn = r / tK, tk = r % tK, n0 = tn * 64, k0 = tk * 64;
        int sc0 = n0; if (perm) { const int j = n0 / 256, w = n0 % 256; sc0 = w < 128 ? 128 * j + w : FF_ + 128 * j + (w - 128); }
        const int nv = nvalid - n0;
        const float* s = src + (size_t)e * sbs + (size_t)(k0 + (tid >> 3)) * Nsrc + sc0 + (tid & 7) * 8; const int c8 = (tid & 7) * 8, kk = tid >> 3;
        float v[8];
        if (c8 + 8 <= nv) { const F4 a = *(const F4*)s, b = *(const F4*)(s + 4); v[0] = a[0]; v[1] = a[1]; v[2] = a[2]; v[3] = a[3]; v[4] = b[0]; v[5] = b[1]; v[6] = b[2]; v[7] = b[3]; }
        else {
#pragma unroll
            for (int j = 0; j < 8; ++j) v[j] = (c8 + j < nv) ? s[j] : 0.f; }
#pragma unroll
        for (int j = 0; j < 8; ++j) tl[(c8 + j) * 72 + kk] = f2bf(v[j]);
        __syncthreads();
        { const int n = tid >> 3, ks = (tid & 7) * 8; typedef unsigned u32x4_t __attribute__((ext_vector_type(4))); const u32x4_t w = *(const LAS u32x4_t*)(tl + n * 72 + ks); *(u32x4_t*)(dst + (size_t)e * dbs + (size_t)(n0 + n) * K + k0 + ks) = w; }
        __syncthreads();
    }
}
__device__ __forceinline__ void st_cvt_tiles(const P& p, int l, LAS unsigned char* lds, int tid) {
    cvt_job(lds, tid, p.w_in + (size_t)l * D_ * NIN, WSP(bf16_t, w_inT) + (size_t)l * NINP * D_, 1, 0, 0, D_, NIN, NINP, NIN, 0);
    cvt_job(lds, tid, p.w_out + (size_t)l * MIXW * D_, WSP(bf16_t, w_outT) + (size_t)l * D_ * MIXW, 1, 0, 0, MIXW, D_, D_, D_, 0);
    cvt_job(lds, tid, p.sh_w2 + (size_t)l * FF_ * D_, WSP(bf16_t, shw2T) + (size_t)l * D_ * FF_, 1, 0, 0, FF_, D_, D_, D_, 0);
    cvt_job(lds, tid, p.s5_glu_w + (size_t)l * SW * SW, WSP(bf16_t, gluT) + (size_t)l * SWP * SW, 1, 0, 0, SW, SW, SWP, SW, 0);
    cvt_job(lds, tid, p.router_w + (size_t)l * D_ * E_, WSP(bf16_t, rsT) + (size_t)l * NRS * D_, 1, 0, 0, D_, E_, EP, E_, 0);
    cvt_job(lds, tid, p.sh_w13 + (size_t)l * D_ * 2 * FF_, WSP(bf16_t, rsT) + (size_t)l * NRS * D_ + (size_t)EP * D_, 1, 0, 0, D_, 2 * FF_, 2 * FF_, 2 * FF_, 1);
    cvt_job(lds, tid, p.exp_w13 + (size_t)l * E_ * D_ * 2 * FF_, WSP(bf16_t, w13T) + (size_t)l * E_ * 2 * FF_ * D_, E_, (size_t)D_ * 2 * FF_, (size_t)2 * FF_ * D_, D_, 2 * FF_, 2 * FF_, 2 * FF_, 1);
    cvt_job(lds, tid, p.exp_w2 + (size_t)l * E_ * FF_ * D_, WSP(bf16_t, w2T) + (size_t)l * E_ * D_ * FF_, E_, (size_t)FF_ * D_, (size_t)D_ * FF_, FF_, D_, D_, D_, 0);
}
#endif

#ifndef CPU_TEST
__device__ __forceinline__ void st_prep1_blk(const P& p, int l, int wid, int lane, int wv, int nwv) {
    const bf16_t* proj = WSP(bf16_t, proj); bf16_t* rkv = WSP(bf16_t, rkv); bf16_t* as = WSP(bf16_t, asmall); bf16_t* U2 = WSP(bf16_t, U2);
    const float* taps = p.rwkv_conv + (size_t)l * 9 * RCOLS; constexpr int NG = RCOLS / 8, TPB = 512 / NG;
    const int tid = wid * 64 + lane;
    if (tid < TPB * NG) {
        const int cg = tid % NG, ts = tid / NG, ch = cg * 8; const int step = (int)gridDim.x * TPB;
        float w[9][8];
#pragma unroll
        for (int k = 0; k < 9; ++k) ld8f(taps + k * RCOLS + ch, w[k]);
#define P1_OUT(n_, acc) do { if (ch < 3 * RW) st8bf(rkv + (size_t)(n_) * 3 * RW + ch, acc); else { const int q0 = ch - 3 * RW; \
            if (q0 < 2 * RDR_) { _Pragma("unroll") for (int q = 0; q < 8; ++q) acc[q] = ftanh(acc[q]); } \
            else if (q0 >= 2 * RDR_ + 2 * RIR_) { _Pragma("unroll") for (int q = 0; q < 8; ++q) acc[q] = sigmoidf_(acc[q]); } \
            st8bf(as + (size_t)(n_) * KSM + q0, acc); } } while (0)
#define P1_FMA(acc, xv, k) do { _Pragma("unroll") for (int j_ = 0; j_ < 4; ++j_) { acc[2 * j_] += w[k][2 * j_] * __uint_as_float((xv)[j_] << 16); acc[2 * j_ + 1] += w[k][2 * j_ + 1] * __uint_as_float((xv)[j_] & 0xffff0000u); } } while (0)
        constexpr int NPT = 4; static_assert(GW_ % NPT == 0 && NLAT % NPT == 0, "token groups");
        for (int pi = (int)blockIdx.x * TPB + ts; pi < NLAT / NPT; pi += step) { const int n0 = NPT * pi, t_ = n0 % T_, gr = t_ / GW_, gc = t_ % GW_; const bf16_t* pb_ = proj + (size_t)n0 * NINP + ch;
            const bool rok0 = gr > 0, rok2 = gr < ROWS_ - 1, cokl = gc > 0, cokr = gc + NPT < GW_; U4 xw[3][NPT + 2];
#pragma unroll
            for (int a = 0; a < 3; ++a)
#pragma unroll
                for (int jw = 0; jw < NPT + 2; ++jw) { const bool ok = (a == 0 ? rok0 : a == 2 ? rok2 : true) && (jw == 0 ? cokl : jw == NPT + 1 ? cokr : true);
                    const int off_ = ok ? ((a - 1) * GW_ + (jw - 1)) * NINP : 0; const U4 v = *(const U4*)(pb_ + off_); xw[a][jw] = ok ? v : (U4){0u, 0u, 0u, 0u}; }
#pragma unroll
            for (int tk = 0; tk < NPT; ++tk) { float acc[8];
#pragma unroll
                for (int q = 0; q < 8; ++q) acc[q] = 0.f;
#pragma unroll
                for (int a = 0; a < 3; ++a)
#pragma unroll
                    for (int jj = 0; jj < 3; ++jj) P1_FMA(acc, xw[a][tk + jj], a * 3 + jj);
                P1_OUT(n0 + tk, acc); } }
        for (int n = NLAT + (int)blockIdx.x * TPB + ts; n < NTOK; n += step) { const int s_ = (n - NLAT) % CTX_; U4 xc[3];
#pragma unroll
            for (int j = 0; j < 3; ++j) { const int ss = s_ + j - 1; const bool ok = ss >= 0 && ss < CTX_; const int nn = ok ? n + j - 1 : n; const U4 v = *(const U4*)(proj + (size_t)nn * NINP + ch); xc[j] = ok ? v : (U4){0u, 0u, 0u, 0u}; }
            float acc[8];
#pragma unroll
            for (int q = 0; q < 8; ++q) acc[q] = 0.f;
#pragma unroll
            for (int jj = 0; jj < 3; ++jj) P1_FMA(acc, xc[jj], 3 + jj);
            P1_OUT(n, acc); }
#undef P1_FMA
#undef P1_OUT
    }
    GIDX;
    constexpr int NT8 = (KSM - OGL) / 8;
    for (long i = gid; i < (long)NTOK * NT8; i += gsz) { const int n = (int)(i / NT8), q = (int)(i % NT8) * 8;
        if (q < 2 * GGR_) cp8bf(as + (size_t)n * KSM + OGL + q, proj + (size_t)n * NINP + GBASE + 2 * GKD + 2 * GWD + q); else z8bf(as + (size_t)n * KSM + OGL + q); }
    for (long i = gid; i < (long)B_ * SPOS * (SW / 8); i += gsz) { const int c = (int)(i % (SW / 8)) * 8; const long r = i / (SW / 8); const int pos = (int)(r % SPOS), b = (int)(r / SPOS);
        const int g = c / SG_, cc = c % SG_, pc = pos / CH_, t = pos % CH_, m = b * NPC + pc;
        cp8bf(U2 + ((size_t)g * M5P + m) * KT5 + t * SG_ + cc, proj + (size_t)row_of(b, pos) * NINP + SBASE + c); }
}
#define DPP_MOVF(v, ctrl) __builtin_bit_cast(float, __builtin_amdgcn_update_dpp(0, __builtin_bit_cast(int, v), ctrl, 0xF, 0xF, true))
#define DPP_MOVI(v, ctrl) __builtin_amdgcn_update_dpp(0, v, ctrl, 0xF, 0xF, true)
__device__ __forceinline__ void st_topk_wave(const P& p, int l, int wv, int nwv, int lane, LAS unsigned char* lds) {
    LAS int* hist = (LAS int*)lds;
    { const int tid_ = (int)threadIdx.x; if (tid_ < E_) hist[tid_] = 0; }
    __syncthreads();
    static_assert(E_ == 256 && NGRP_ == 8 && TKG_ == 4 && TOPK_ == 8, "wave top-k is written for 256 experts in 8 groups");
    const int nrow = (l == L_ - 1) ? NLAT : NTOK; const float* lg = WSP(float, logits); const F4 rb = *(const F4*)(p.router_bias + (size_t)l * E_ + 4 * lane);
    for (int n = wv; n < nrow; n += nwv) {
        const F4 z = *(const F4*)(lg + (size_t)n * E_ + 4 * lane); float sg[4], sv[4];
#pragma unroll
        for (int j = 0; j < 4; ++j) { sg[j] = sigmoidf_(z[j]); sv[j] = sg[j] + rb[j]; }
        float m1 = fmaxf(fmaxf(sv[0], sv[1]), fmaxf(sv[2], sv[3])), m2;
        { float a = fmaxf(sv[0], sv[1]), b = fminf(sv[0], sv[1]), c = fmaxf(sv[2], sv[3]), d = fminf(sv[2], sv[3]); m2 = fmaxf(fminf(a, c), fmaxf(b, d)); }
        { float o1 = DPP_MOVF(m1, 0xB1), o2 = DPP_MOVF(m2, 0xB1); float n1 = fmaxf(m1, o1), n2 = fmaxf(fminf(m1, o1), fmaxf(m2, o2)); m1 = n1; m2 = n2;
          o1 = DPP_MOVF(m1, 0x4E); o2 = DPP_MOVF(m2, 0x4E); n1 = fmaxf(m1, o1); n2 = fmaxf(fminf(m1, o1), fmaxf(m2, o2)); m1 = n1; m2 = n2;
          o1 = DPP_MOVF(m1, 0x141); o2 = DPP_MOVF(m2, 0x141); n1 = fmaxf(m1, o1); n2 = fmaxf(fminf(m1, o1), fmaxf(m2, o2)); m1 = n1; m2 = n2; }
        const float gsc = m1 + m2; const int g = lane >> 3, gb = __builtin_bit_cast(int, gsc); int rank = 0;
#pragma unroll
        for (int g2 = 0; g2 < 8; ++g2) { const float o = __builtin_bit_cast(float, __builtin_amdgcn_readlane(gb, 8 * g2)); rank += (o > gsc || (o == gsc && g2 < g)) ? 1 : 0; }
        const bool sel = rank < TKG_;
        int ck[4];
#pragma unroll
        for (int j = 0; j < 4; ++j) ck[j] = (sel && sv[j] > 0.f) ? __builtin_bit_cast(int, sv[j]) : 0;
        float myw = 0.f; int mye = 0; float wsum = 0.f;
#pragma unroll
        for (int kk = 0; kk < TOPK_; ++kk) {
            int bk = ck[0] > ck[1] ? ck[0] : ck[1]; { const int b2 = ck[2] > ck[3] ? ck[2] : ck[3]; bk = bk > b2 ? bk : b2; }
            int mk = bk;
            { int o = DPP_MOVI(mk, 0xB1); mk = mk > o ? mk : o; o = DPP_MOVI(mk, 0x4E); mk = mk > o ? mk : o; o = DPP_MOVI(mk, 0x141); mk = mk > o ? mk : o; o = DPP_MOVI(mk, 0x140); mk = mk > o ? mk : o; }
            const int r0 = __builtin_amdgcn_readlane(mk, 0), r1 = __builtin_amdgcn_readlane(mk, 16), r2 = __builtin_amdgcn_readlane(mk, 32), r3 = __builtin_amdgcn_readlane(mk, 48);
            const int K = (r0 > r1 ? r0 : r1) > (r2 > r3 ? r2 : r3) ? (r0 > r1 ? r0 : r1) : (r2 > r3 ? r2 : r3);
            const unsigned long long ball = __ballot(bk == K); const int wl = __builtin_amdgcn_readfirstlane((int)__ffsll((long long)ball) - 1);
            int wj = 0; float sgw = 0.f;
            if (lane == wl) {
#pragma unroll
                for (int j = 3; j >= 0; --j) if (ck[j] == K) wj = j;
#pragma unroll
                for (int j = 0; j < 4; ++j) if (wj == j) { ck[j] = 0; sgw = sg[j]; } }
            const int wjb = __builtin_amdgcn_readlane(wj, wl); sgw = __builtin_bit_cast(float, __builtin_amdgcn_readlane(__builtin_bit_cast(int, sgw), wl)); wsum += sgw;
            if (lane == kk) { myw = sgw; mye = 4 * wl + wjb; }
        }
        if (lane < TOPK_) { WSP(int, eidx)[(size_t)n * TOPK_ + lane] = mye; WSP(float, ewt)[(size_t)n * TOPK_ + lane] = myw / wsum * 2.5f; __hip_atomic_fetch_add(hist + mye, 1, __ATOMIC_RELAXED, __HIP_MEMORY_SCOPE_WORKGROUP); }
    }
    __syncthreads();
    { const int tid_ = (int)threadIdx.x; if (tid_ < E_) { const int c = hist[tid_]; if (c > 0) atomicAdd(WSP(int, ecnt) + tid_, c); } }
    __syncthreads();
}
__device__ __forceinline__ void st_scatter_blk(const P& p, int l, LAS unsigned char* lds, int wid, int lane, int wv, int nwv) {
    LAS int* eo = (LAS int*)lds;
    if (wid == 0) {
        const int* ecnt = WSP(int, ecnt); int c4[4], t4[4], tsum = 0;
#pragma unroll
        for (int j = 0; j < 4; ++j) { c4[j] = ld_int(ecnt + 4 * lane + j); t4[j] = (c4[j] + 255) / 256; tsum += t4[j]; }
        int incl = tsum;
#pragma unroll
        for (int o = 1; o < 64; o <<= 1) { const int v = __shfl_up(incl, o); if (lane >= o) incl += v; }
        int tb = incl - tsum;
#pragma unroll
        for (int j = 0; j < 4; ++j) { eo[4 * lane + j] = tb * 256;
            if (blockIdx.x == 0) { WSP(int, eoff)[4 * lane + j] = tb * 256; for (int t = 0; t < t4[j]; ++t) { int* u = WSP(int, ulist) + (size_t)(tb + t) * 4; u[0] = (tb + t) * 256; u[1] = 4 * lane + j; u[2] = (c4[j] - 256 * t) < 256 ? (c4[j] - 256 * t) : 256; u[3] = 0; } }
            tb += t4[j]; }
        if (lane == 63) { eo[E_] = tb * 256; if (blockIdx.x == 0) { WSP(int, eoff)[E_] = tb * 256; WSP(int, nunits)[0] = tb; } }
    }
    __syncthreads();
    const long gid = (long)wv * 64 + lane, gsz = (long)nwv * 64; const int nrow = (l == L_ - 1) ? NLAT : NTOK; const int* ei = WSP(int, eidx); int* so = WSP(int, slot_of); int* st = WSP(int, slot_tok);
    LAS int* lc = eo + E_ + 1;
    constexpr int MAXI = 4; const long total = (long)nrow * TOPK_;
#pragma unroll 1
    for (long base = 0; base < total; base += (long)MAXI * gsz) {
        if ((int)threadIdx.x < E_) lc[threadIdx.x] = 0;
        __syncthreads();
        int ie[MAXI], ir[MAXI];
#pragma unroll
        for (int u = 0; u < MAXI; ++u) { const long i = base + gid + (long)u * gsz; ie[u] = -1; ir[u] = 0; if (i < total) { ie[u] = ei[i]; ir[u] = __hip_atomic_fetch_add(lc + ie[u], 1, __ATOMIC_RELAXED, __HIP_MEMORY_SCOPE_WORKGROUP); } }
        __syncthreads();
        if ((int)threadIdx.x < E_) { const int c = lc[threadIdx.x]; lc[threadIdx.x] = c > 0 ? atomicAdd(WSP(int, efill) + threadIdx.x, c) : 0; }
        __syncthreads();
#pragma unroll
        for (int u = 0; u < MAXI; ++u) { const long i = base + gid + (long)u * gsz; if (ie[u] >= 0) { const int s = eo[ie[u]] + lc[ie[u]] + ir[u]; so[i] = s; st[s] = (int)(i / TOPK_); } }
        __syncthreads();
    }
}
#endif

#ifndef CPU_TEST
__device__ __forceinline__ void st_post_wave(const P& p, int l, int wv, int nwv, int lane) {
    static_assert(RH_ == 6 && GH_ == 6 && RN_ == 64 && GV_ == 64, "post_wave geometry");
    bf16_t* ymix = WSP(bf16_t, ymix); const float* yr = WSP(float, yr); const float* og = WSP(float, og); const bf16_t* proj = WSP(bf16_t, proj); const bf16_t* gsb = WSP(bf16_t, gsb); const bf16_t* rkv = WSP(bf16_t, rkv);
    const int nrow = (l == L_ - 1) ? NLAT : NTOK; const int hq = lane >> 4, c4 = (lane & 15) * 4;
    for (int n = wv; n < nrow; n += nwv) {
        float o[3][4];
#pragma unroll
        for (int i = 0; i < 3; ++i) {
            const int hd = hq + 4 * i;
            if (hd < RH_) { const int c = hd * RN_ + c4; float r[4], k[4], v[4], a0[4], a1[4], g[4];
                ld4bf(rkv + (size_t)n * 3 * RW + c, r); ld4bf(rkv + (size_t)n * 3 * RW + RW + c, k); ld4bf(rkv + (size_t)n * 3 * RW + 2 * RW + c, v);
                ld4bf(gsb + (size_t)n * NGB + c, a0); ld4bf(gsb + (size_t)n * NGB + RW + c, a1); ld4bf(gsb + (size_t)n * NGB + 2 * RW + c, g);
                const F4 y0 = *(const F4*)(yr + (size_t)n * RW + c), y1 = *(const F4*)(yr + ((size_t)NTOK + n) * RW + c);
                const F4 ka = *(const F4*)(p.rwkv_k_a + (size_t)l * RW + c), rk = *(const F4*)(p.rwkv_r_k + (size_t)l * RW + c), lg = *(const F4*)(p.rwkv_ln_g + (size_t)l * RW + c), lb = *(const F4*)(p.rwkv_ln_b + (size_t)l * RW + c);
                float y[4], s = 0.f, bs = 0.f;
#pragma unroll
                for (int j = 0; j < 4; ++j) { y[j] = y0[j] + y1[j]; s += y[j]; const float k20 = k[j] * (1.0f + (a0[j] - 1.0f) * ka[j]), k21 = k[j] * (1.0f + (a1[j] - 1.0f) * ka[j]); bs += r[j] * (k20 + k21) * rk[j]; }
                s = dpp_sum16(s); bs = dpp_sum16(bs); const float mu = s * (1.0f / RN_); float qq = 0.f;
#pragma unroll
                for (int j = 0; j < 4; ++j) { const float dlt = y[j] - mu; qq += dlt * dlt; }
                qq = dpp_sum16(qq); const float rstd = 1.0f / sqrtf(qq * (1.0f / RN_) + GN_EPS);
#pragma unroll
                for (int j = 0; j < 4; ++j) o[i][j] = ((y[j] - mu) * rstd * lg[j] + lb[j] + bs * v[j]) * g[j];
            } else { const int h2 = hd - RH_, c = h2 * GV_ + c4; float gg[4];
                const F4 o0 = *(const F4*)(og + (size_t)n * GWD + c), o1 = *(const F4*)(og + ((size_t)NTOK + n) * GWD + c); ld4bf(proj + (size_t)n * NINP + GBASE + 2 * GKD + GWD + c, gg);
                const F4 ng = *(const F4*)(p.gla_norm_g + (size_t)l * GV_ + c4); float oo[4], qq = 0.f;
#pragma unroll
                for (int j = 0; j < 4; ++j) { oo[j] = o0[j] + o1[j]; qq += oo[j] * oo[j]; }
                qq = dpp_sum16(qq); const float rs = 1.0f / sqrtf(qq * (1.0f / GV_) + 1e-6f);
#pragma unroll
                for (int j = 0; j < 4; ++j) o[i][j] = oo[j] * rs * ng[j] * siluf_(gg[j]);
            }
        }
#pragma unroll
        for (int i = 0; i < 3; ++i) st4bf(ymix + (size_t)n * MIXW + (hq + 4 * i) * 64 + c4, o[i]);
    }
}
#endif

#ifndef CPU_TEST
__device__ __forceinline__ void st_modv_blk(const P& p, LAS unsigned char* lds, int tid) {
    static_assert(D_ == 1024 && B_ + 1 <= 17, "modv_blk geometry");
    LAS float* sc = (LAS float*)lds;
    LAS float* red = (LAS float*)(lds + 17 * 1024 * 4);
    const float* scg = WSP(float, silu_c); float* mv = WSP(float, modv);
    for (int i = tid; i < (B_ + 1) * D_; i += 512) sc[i] = scg[i];
    __syncthreads();
    const int cl = tid & 63, ks = tid >> 6;
    for (int task = blockIdx.x; task < L_ * 6 * D_ / 64; task += gridDim.x) {
        const int l = task / (6 * D_ / 64), col = (task % (6 * D_ / 64)) * 64 + cl;
        float acc[B_ + 1];
#pragma unroll
        for (int b = 0; b <= B_; ++b) acc[b] = 0.f;
        const float* w = p.w_mod + (size_t)l * D_ * 6 * D_ + col;
#pragma unroll 4
        for (int k = ks * 128; k < ks * 128 + 128; ++k) { const float wk = w[(size_t)k * 6 * D_];
#pragma unroll
            for (int b = 0; b <= B_; ++b) acc[b] += sc[b * D_ + k] * wk; }
#pragma unroll
        for (int b = 0; b <= B_; ++b) red[(ks * (B_ + 1) + b) * 64 + cl] = acc[b];
        __syncthreads();
        for (int i = tid; i < (B_ + 1) * 64; i += 512) { const int b = i >> 6, c2 = i & 63; float s = p.b_mod[(size_t)l * 6 * D_ + (task % (6 * D_ / 64)) * 64 + c2];
#pragma unroll
            for (int q = 0; q < 8; ++q) s += red[(q * (B_ + 1) + b) * 64 + c2];
            mv[((size_t)l * (B_ + 1) + b) * 6 * D_ + (task % (6 * D_ / 64)) * 64 + c2] = s; }
        __syncthreads();
    }
}
#endif

#ifdef CPU_TEST
#define GEMM_CALL(g, S, E) gemm_phase(g, S, E)
#define GEMM_CALL_G(g, S, E) gemm_phase(g, S, E)
#define SCHED_GC 1, 0
#define SYNC(k)
#define LOADP
#else
#define CAS __attribute__((address_space(4)))
#define LOADP const CAS P* _q = pk; asm volatile("" : "+s"(_q)); const P& p = *(const P*)_q; int lane = lane_id(); asm volatile("" : "+v"(lane)); \
    const int wv = blockIdx.x * 8 + wid, nwv = gridDim.x * 8; (void)lane; (void)wv; (void)nwv;
#define GEMM_CALL(g, S, E) gemm_phase<false>(lds, wid, g, S, E, &bar)
#define GEMM_CALL_G(g, S, E) gemm_phase<true>(lds, wid, g, S, E, &bar)
#define SCHED_GC (int)gridDim.x, sched_id((const unsigned*)(p.ws + WS.ctl), lds)
#define VC_WORD(x) (3584 + 64 * (x))
__device__ __forceinline__ int sched_id(const unsigned* ctl, LAS unsigned char* lds) {
    const unsigned G = gridDim.x; bool ok = (G % 8u) == 0u;
#pragma unroll
    for (int x = 0; x < 8; ++x) ok = ok && (__hip_atomic_load(ctl + VC_WORD(x), __ATOMIC_RELAXED, __HIP_MEMORY_SCOPE_AGENT) == G / 8u);
    const unsigned v = ((volatile LAS unsigned*)(lds + STAGE_BYTES))[2];
    return __builtin_amdgcn_readfirstlane(ok ? (int)v : (int)blockIdx.x);
}
#define SYNC(k) if (lo <= (k) && (k) + 1 < hi) xcd_barrier(bar);
#define XB_TMO      128
#define XB_XCNT(j)  (256  + 64 * (j))
#define XB_XSUB(j)  (1280 + 64 * (j))
#define XB_XGEN(j)  (2304 + 64 * (j))
#define XB_TOP      3328
#define XB_TOPGEN   3392
#define XCD_BAR_WORDS 3456
#define XB_SPIN_CAP (1u << 18)
__device__ __forceinline__ unsigned xb_ld(unsigned* p)              { return __hip_atomic_load(p, __ATOMIC_RELAXED, __HIP_MEMORY_SCOPE_AGENT); }
__device__ __forceinline__ unsigned xb_add(unsigned* p, unsigned v) { return __hip_atomic_fetch_add(p, v, __ATOMIC_RELAXED, __HIP_MEMORY_SCOPE_AGENT); }
__device__ __forceinline__ unsigned xb_xcc_id() { return (unsigned)__builtin_amdgcn_s_getreg((3 << 11) | 20) & 0xFu; }
#define XB_SPIN(cond, bar) do { unsigned _sp = 0; while (cond) { __builtin_amdgcn_s_sleep(1); \
    if ((++_sp & 255u) == 0u) { if (xb_ld(&(bar)[XB_TMO])) break; if (_sp > XB_SPIN_CAP) { atomicAdd(&(bar)[XB_TMO], 1u); break; } } } } while (0)
struct XcdBarrier { unsigned* bar; unsigned x; volatile LAS unsigned* st; int wid; };
__device__ __forceinline__ XcdBarrier xcd_barrier_post(unsigned* bar, volatile LAS unsigned* st) {
    XcdBarrier b; b.bar = bar; b.x = xb_xcc_id(); b.st = st; b.wid = 0;
    if (threadIdx.x == 0) (void)xb_add(&bar[XB_XCNT(b.x)], 1u);
    return b;
}
__device__ __forceinline__ void xcd_barrier_complete(unsigned* bar, unsigned x, unsigned& nloc, unsigned& nx) {
    const unsigned G = gridDim.x * gridDim.y * gridDim.z;
    unsigned sum, cnt, mine, sp = 0u;
    for (;;) {
        sum = 0u; cnt = 0u; mine = 0u;
#pragma unroll
        for (unsigned j = 0; j < 16; ++j) { const unsigned c = xb_ld(&bar[XB_XCNT(j)]); sum += c; cnt += (c > 0u) ? 1u : 0u; mine = (j == x) ? c : mine; }
        if (sum == G) break;
        __builtin_amdgcn_s_sleep(1);
        if ((++sp & 255u) == 0u) { if (xb_ld(&bar[XB_TMO])) break; if (sp > XB_SPIN_CAP) { atomicAdd(&bar[XB_TMO], 1u); break; } }
    }
    nloc = mine > 0u ? mine : 1u; nx = cnt > 0u ? cnt : 1u;
}
__device__ __forceinline__ void xcd_barrier(const XcdBarrier& b) {
    asm volatile("s_waitcnt vmcnt(0)" ::: "memory");
    __syncthreads();
    if (b.wid == 0 && lane_id() == 0) {
        unsigned* bar = b.bar;
        __builtin_amdgcn_s_waitcnt(0);
        unsigned nloc = b.st[0], nx = b.st[1];
        if (nloc == 0u) { xcd_barrier_complete(bar, b.x, nloc, nx); b.st[0] = nloc; b.st[1] = nx; }
        const unsigned old = xb_add(&bar[XB_XSUB(b.x)], 1u);
        const unsigned gen = old / nloc;
        if (old + 1u == (gen + 1u) * nloc) {
            __builtin_amdgcn_fence(__ATOMIC_RELEASE, "agent");
            asm volatile("s_waitcnt vmcnt(0)" ::: "memory");
            const unsigned og = xb_add(&bar[XB_TOP], 1u);
            const unsigned tg = og / nx;
            if (og + 1u == (tg + 1u) * nx) xb_add(&bar[XB_TOPGEN], 1u);
            else XB_SPIN(xb_ld(&bar[XB_TOPGEN]) == tg, bar);
            __builtin_amdgcn_fence(__ATOMIC_ACQUIRE, "agent");
            xb_add(&bar[XB_XGEN(b.x)], 1u);
            asm volatile("s_waitcnt vmcnt(0)" ::: "memory");
        } else {
            XB_SPIN(xb_ld(&bar[XB_XGEN(b.x)]) == gen, bar);
            __builtin_amdgcn_fence(__ATOMIC_ACQUIRE, "agent");
            asm volatile("s_waitcnt vmcnt(0)" ::: "memory");
        }
    }
    __syncthreads();
}
#endif

#define IN(k) (lo <= (k) && (k) < hi)
#ifndef PROBE_MASK
#define PROBE_MASK 0
#endif
#ifdef CPU_TEST
#define REP_BEGIN(k)
#define REP_END
#else
#define REP_BEGIN(k) for (int rep_ = 0; rep_ < (((PROBE_MASK) >> (k)) & 1) + 1; ++rep_) { if (rep_) xcd_barrier(bar);
#define REP_END }
#endif
#ifdef CPU_TEST
template <int lo, int hi, int l> static void run_layer(const P& p) { const int wv = 0, nwv = 1, lane = 0; (void)wv; (void)nwv; (void)lane;
#else
template <int lo, int hi, int l> __device__ __forceinline__ void run_layer(const CAS P* pk, LAS unsigned char* lds, const int wid, const XcdBarrier& bar) {
#endif

        const int pb = NPH_PRO + l * NPH_LAYER; const bool last = (l == L_ - 1); const int MR = last ? NLAT : NTOK;
        if (IN(pb + 0)) { REP_BEGIN(0) LOADP GemmArgs g{WSP(bf16_t, h), D_, nullptr, WSP(bf16_t, w_inT) + (size_t)l * NINP * D_, D_, D_}; StaticSched S; S.init(1, NTOK, NINP, 0, 0, SCHED_GC);
            EpiBf16Plain E{WSP(bf16_t, proj), NINP}; GEMM_CALL(g, S, E); REP_END } SYNC(pb + 0)
#ifdef CPU_TEST
        if (IN(pb + 1)) { REP_BEGIN(1) LOADP st_prep1(p, l, wv, nwv, lane); REP_END } SYNC(pb + 1)
#else
        if (IN(pb + 1)) { REP_BEGIN(1) LOADP st_prep1_blk(p, l, wid, lane, wv, nwv); REP_END } SYNC(pb + 1)
#endif
        if (IN(pb + 2)) { REP_BEGIN(2) LOADP
            { GemmArgs g{WSP(bf16_t, asmall), KSM, nullptr, WSP(bf16_t, wsmT) + (size_t)l * NSMP * KSM, KSM, KSM}; StaticSched S; S.init(1, NTOK, NSMP, 0, 0, SCHED_GC);
              EpiSmall E{WSP(float, gs), WSP(bf16_t, gsb), p.rwkv_w0 + (size_t)l * 2 * RW, p.rwkv_a0 + (size_t)l * 2 * RW, p.gla_a_bias + (size_t)l * 2 * GKD}; GEMM_CALL(g, S, E); }
            { GemmArgs g{WSP(bf16_t, U2), KT5, nullptr, WSP(bf16_t, s5Wa) + (size_t)l * SNG_ * N5AP * K5, K5, K5}; StaticSched S; S.init(SNG_, M5P, N5AP, M5P, N5AP, SCHED_GC);
              EpiF32Plain E{WSP(float, xl), N5AP, (size_t)M5P * N5AP}; GEMM_CALL(g, S, E); }
        REP_END } SYNC(pb + 2)
        if (IN(pb + 3)) { REP_BEGIN(3) LOADP
#ifdef CPU_TEST
            rwkv_scan_all(p, l); gla_scan_all(p, l);
#else
            { constexpr int NRS_ = 2 * B_ * RH_, NGS_ = 2 * B_ * GH_, NGG = (NGS_ + 2) / 3;
              for (int task = blockIdx.x; task < NRS_; task += gridDim.x) { const int hh = task % RH_, b = (task / RH_) % B_, d = task / (RH_ * B_); rwkv_chunk_blk(p, l, d, b, hh, lds, wid, lane); } }
            { LOADP constexpr int NRS_ = 2 * B_ * RH_, NGS_ = 2 * B_ * GH_, NGG = (NGS_ + 2) / 3;
              for (int task = (int)blockIdx.x + (((int)blockIdx.x < NRS_) ? (int)gridDim.x * ((NRS_ - 1 - (int)blockIdx.x) / (int)gridDim.x + 1) : 0); task < NRS_ + NGG; task += gridDim.x) {
                  for (int s3 = 0; s3 < 3; ++s3) { const int t2 = (task - NRS_) + NGG * s3; if (t2 < NGS_) { const int hh = t2 % GH_, b = (t2 / GH_) % B_, d = t2 / (GH_ * B_); gla_chunk_blk(p, l, d, b, hh, lds, wid, lane); } __syncthreads(); } } }
#endif
            st_s5carry(p, l, wv, nwv, lane); REP_END } SYNC(pb + 3)
        if (IN(pb + 4)) { REP_BEGIN(4) LOADP
            { GemmArgs g{WSP(bf16_t, U2), KT5, nullptr, WSP(bf16_t, s5Tb) + (size_t)l * SNG_ * K5 * KT5, KT5, KT5}; StaticSched S; S.init(SNG_, M5P, K5, M5P, K5, SCHED_GC);
              EpiS5b E{WSP(bf16_t, yc)}; GEMM_CALL(g, S, E); }
#ifdef CPU_TEST
            st_post(p, l, wv, nwv, lane);
#else
            st_post_wave(p, l, wv, nwv, lane);
#endif
            REP_END } SYNC(pb + 4)
        if (IN(pb + 5)) { REP_BEGIN(5) LOADP GemmArgs g{WSP(bf16_t, yc), SW, nullptr, WSP(bf16_t, gluT) + (size_t)l * SWP * SW, SW, SW}; StaticSched S; S.init(1, MR, SWP, 0, 0, SCHED_GC);
            EpiGlu E{WSP(bf16_t, ymix), WSP(bf16_t, yc), p.s5_glu_b + (size_t)l * SW}; GEMM_CALL(g, S, E); REP_END } SYNC(pb + 5)
        if (IN(pb + 6)) { REP_BEGIN(6) LOADP GemmArgs g{WSP(bf16_t, ymix), MIXW, nullptr, WSP(bf16_t, w_outT) + (size_t)l * D_ * MIXW, MIXW, MIXW}; StaticSched S; S.init(1, MR, D_, 0, 0, SCHED_GC);
            EpiBf16Plain E{WSP(bf16_t, yo), D_}; GEMM_CALL(g, S, E); REP_END } SYNC(pb + 6)
        if (IN(pb + 7)) { REP_BEGIN(7) LOADP st_ln1(p, l, wv, nwv, lane); REP_END } SYNC(pb + 7)
        if (IN(pb + 8)) { REP_BEGIN(8) LOADP GemmArgs g{WSP(bf16_t, h2), D_, nullptr, WSP(bf16_t, rsT) + (size_t)l * NRS * D_, D_, D_}; StaticSched S; S.init(1, MR, NRS, 0, 0, SCHED_GC);
            EpiRS E{WSP(float, logits), WSP(bf16_t, sact)}; GEMM_CALL(g, S, E); REP_END } SYNC(pb + 8)
        if (IN(pb + 9)) { REP_BEGIN(9) LOADP
#ifdef CPU_TEST
            st_topk(p, l, wv, nwv, lane);
#else
            st_topk_wave(p, l, wv, nwv, lane, lds);
#endif
            st_scatter0(p, l, wv, nwv, lane); REP_END } SYNC(pb + 9)
#ifdef CPU_TEST
        if (IN(pb + 10)) { LOADP st_offsets(p, l, wv, nwv, lane); }
        if (IN(pb + 11)) { LOADP st_scatter(p, l, wv, nwv, lane); }
#else
        if (IN(pb + 11)) { LOADP st_scatter_blk(p, l, lds, wid, lane, wv, nwv); } SYNC(pb + 11)
#endif
        if (IN(pb + 12)) { REP_BEGIN(12) LOADP
            { GemmArgs g{WSP(bf16_t, h2), D_, WSP(int, slot_tok), WSP(bf16_t, w13T) + (size_t)l * E_ * 2 * FF_ * D_, D_, D_}; ListSched S{WSP(int, ulist), WSP(int, nunits), 2 * FF_ / 256, 2 * FF_, SCHED_GC};
              EpiUp E{WSP(bf16_t, act)}; GEMM_CALL_G(g, S, E); }
            { GemmArgs g{WSP(bf16_t, sact), FF_, nullptr, WSP(bf16_t, shw2T) + (size_t)l * D_ * FF_, FF_, FF_}; StaticSched S; S.init(1, MR, D_, 0, 0, SCHED_GC);
              EpiBf16Plain E{WSP(bf16_t, Ysh), D_}; GEMM_CALL(g, S, E); }
        REP_END } SYNC(pb + 12)
        if (IN(pb + 13)) { REP_BEGIN(13) LOADP GemmArgs g{WSP(bf16_t, act), FF_, nullptr, WSP(bf16_t, w2T) + (size_t)l * E_ * D_ * FF_, FF_, FF_}; ListSched S{WSP(int, ulist), WSP(int, nunits), D_ / 256, D_, SCHED_GC};
            EpiDown E{WSP(bf16_t, Y)}; GEMM_CALL(g, S, E); REP_END } SYNC(pb + 13)
        if (IN(pb + 14)) { REP_BEGIN(14) LOADP st_ln2(p, l, wv, nwv, lane); REP_END } SYNC(pb + 14)
    }
#ifdef CPU_TEST
template <int lo, int hi> static void run_program(const P& p) { const int wv = 0, nwv = 1, lane = 0;
#else
template <int lo, int hi> __device__ __forceinline__ void run_program(const CAS P* pk, LAS unsigned char* lds, const int wid, const XcdBarrier& bar) {
#endif
    if (IN(0)) { { LOADP st_siluc(p, wv, nwv, lane); } { LOADP st_s5a(p, wv, nwv, lane); }
#ifdef CPU_TEST
        { LOADP st_cvt1(p, 0, wv, nwv, lane); } { LOADP st_cvt2(p, 0, wv, nwv, lane); } { LOADP st_cvt3(p, 0, wv, nwv, lane); } { LOADP st_cvt4(p, 0, wv, nwv, lane); }
        { LOADP st_cvt1(p, 1, wv, nwv, lane); } { LOADP st_cvt2(p, 1, wv, nwv, lane); } { LOADP st_cvt3(p, 1, wv, nwv, lane); } { LOADP st_cvt4(p, 1, wv, nwv, lane); }
#else
        { LOADP st_cvt_tiles(p, 0, lds, wid * 64 + lane); } { LOADP st_cvt_tiles(p, 1, lds, wid * 64 + lane); }
#endif
        { LOADP st_cvt5(p, 0, wv, nwv, lane); } { LOADP st_cvt5(p, 1, wv, nwv, lane); } } SYNC(0)
#ifdef CPU_TEST
    if (IN(1)) { { LOADP st_modv(p, wv, nwv, lane); } { LOADP st_s5b(p, wv, nwv, lane); } } SYNC(1)
#else
#ifndef PRO_PROBE
#define PRO_PROBE 0
#endif
    if (IN(1)) { { LOADP st_modv_blk(p, lds, wid * 64 + lane); } for (int rp_ = 0; rp_ < ((PRO_PROBE & 1) ? 2 : 1); ++rp_) { LOADP st_s5b(p, wv, nwv, lane); } } SYNC(1)
#endif
#ifdef CPU_TEST
    if (IN(2)) { { LOADP st_s5c(p, wv, nwv, lane); } { LOADP st_hmod(p, 0, wv, nwv, lane); } } SYNC(2)
#else
    if (IN(2)) { for (int rp_ = 0; rp_ < ((PRO_PROBE & 2) ? 2 : 1); ++rp_) { LOADP st_s5c(p, wv, nwv, lane); } for (int rp_ = 0; rp_ < ((PRO_PROBE & 4) ? 2 : 1); ++rp_) { LOADP st_hmod(p, 0, wv, nwv, lane); } } SYNC(2)
#endif
#ifdef CPU_TEST
    run_layer<lo, hi, 0>(p); run_layer<lo, hi, 1>(p);
#else
    run_layer<lo, hi, 0>(pk, lds, wid, bar); run_layer<lo, hi, 1>(pk, lds, wid, bar);
#endif
}
#undef IN
#ifndef CPU_TEST
constexpr int LDS_BYTES = STAGE_BYTES + 1024;
struct KArgs { P p; };
template <int LO, int HI> __global__ void __launch_bounds__(512, 2) fwd_kernel(KArgs a) {
    extern __shared__ __attribute__((aligned(16))) unsigned char lds_raw[];
    LAS unsigned char* lds = (LAS unsigned char*)lds_raw;
    volatile LAS unsigned* xbw = (volatile LAS unsigned*)(lds + STAGE_BYTES);
    const int wid = __builtin_amdgcn_readfirstlane(threadIdx.x >> 6);
    const CAS P* pk = (const CAS P*)__builtin_amdgcn_kernarg_segment_ptr();
    if (threadIdx.x < 4) xbw[threadIdx.x] = 0u;
    __syncthreads();
    if (threadIdx.x == 0) { const unsigned xcc = xb_xcc_id() & 7u; const unsigned rank = xb_add((unsigned*)(pk->ws + WS.ctl) + VC_WORD(xcc), 1u); xbw[2] = rank * 8u + xcc; }
    __syncthreads();
    XcdBarrier bar; bar.bar = (unsigned*)(pk->ws + WS.ctl); bar.x = 0; bar.st = xbw; bar.wid = wid;
    if (HI - LO > 1) { bar = xcd_barrier_post((unsigned*)(pk->ws + WS.ctl), xbw); bar.wid = wid; }
    run_program<LO, HI>(pk, lds, wid, bar);
}
template <int PH> static void launch_each(int grid, hipStream_t stream, const KArgs& a) {
    if constexpr (PH < NPH) {
        static bool attr = false;
        if (!attr) { (void)hipFuncSetAttribute((const void*)fwd_kernel<PH, PH + 1>, hipFuncAttributeMaxDynamicSharedMemorySize, LDS_BYTES); attr = true; }
        hipLaunchKernelGGL((fwd_kernel<PH, PH + 1>), dim3(grid), dim3(512), LDS_BYTES, stream, a);
        launch_each<PH + 1>(grid, stream, a);
    }
}
extern "C" void kernel_launch(void* const* d_in, const int* in_sizes, int n_in, void* d_out, int out_size, void* d_ws, size_t ws_size, hipStream_t stream) {
    static int grid = 0;
    if (grid == 0) {
        if (n_in != 42 || ws_size < WS.end) { fprintf(stderr, "kernel_launch: bad inputs (n_in %d, ws %zu, need %zu)\n", n_in, ws_size, (size_t)WS.end); grid = -1; return; }
        int dev = 0, cus = 0; (void)hipGetDevice(&dev); (void)hipDeviceGetAttribute(&cus, hipDeviceAttributeMultiprocessorCount, dev);
        grid = cus;
    }
    if (grid < 0) return;
    KArgs a{}; const float** pp = (const float**)&a.p;
    for (int i = 0; i < 42; ++i) pp[i] = (const float*)d_in[i];
    a.p.out = (float*)d_out; a.p.ws = (unsigned char*)d_ws;
    (void)hipMemsetAsync((char*)d_ws + WS.ctl, 0, 16384, stream);
#ifdef FUSED
    static bool attr = false;
    if (!attr) { (void)hipFuncSetAttribute((const void*)fwd_kernel<0, NPH>, hipFuncAttributeMaxDynamicSharedMemorySize, LDS_BYTES); attr = true; }
    hipLaunchKernelGGL((fwd_kernel<0, NPH>), dim3(grid), dim3(512), LDS_BYTES, stream, a);
#else
    launch_each<0>(grid, stream, a);
#endif
}
#else
static void cpu_forward(const P& p) { run_program<0, NPH>(p); }
#endif
```

```cpp
#ifndef CFG_SMALL
#define D_ 1024
#define B_ 16
#define T_ 2048
#define CTX_ 256
#define GW_ 64
#define RH_ 6
#define GH_ 6
#define SNG_ 16
#define E_ 256
#define TOPK_ 8
#define NGRP_ 8
#define TKG_ 4
#define FF_ 256
#else
#define D_ 256
#define B_ 2
#define T_ 256
#define CTX_ 128
#define GW_ 16
#define RH_ 2
#define GH_ 2
#define SNG_ 4
#define E_ 16
#define TOPK_ 4
#define NGRP_ 4
#define TKG_ 2
#define FF_ 128
#endif
#define L_ 2
#define RN_ 64
#define RDR_ 32
#define RIR_ 32
#define RGR_ 64
#define GK_ 32
#define GV_ 64
#define GGR_ 16
#define SG_ 16
#define SP_ 64
#define CH_ 64

constexpr int pad256(int x) { return (x + 255) / 256 * 256; }
constexpr int RW = RH_ * RN_, RCOLS = 3 * RW + 2 * RDR_ + 2 * RIR_ + RGR_;
constexpr int GKD = GH_ * GK_, GWD = GH_ * GV_, GCOLS = 2 * GKD + 2 * GWD + 2 * GGR_;
constexpr int SW = SG_ * SNG_, MIXW = RW + GWD + SW, NIN = RCOLS + GCOLS + SW, NINP = pad256(NIN);
constexpr int GBASE = RCOLS, SBASE = RCOLS + GCOLS;
constexpr int NLAT = B_ * T_, NCTX = B_ * CTX_, NTOK = NLAT + NCTX;
constexpr int SPOS = CTX_ + T_, NPC = SPOS / CH_, NPCC = CTX_ / CH_, M5 = B_ * NPC, M5P = pad256(M5);
constexpr int KSM = 256, OWD = 0, OAD = 2 * RDR_, OGD = OAD + 2 * RIR_, OGL = OGD + RGR_;
constexpr int NSM = 5 * RW + 2 * GKD, NSMP = pad256(NSM), NGF = 2 * RW + 2 * GKD, NGB = 3 * RW;
constexpr int K5 = CH_ * SG_, KT5 = K5 + 4 * SP_, N5A = 4 * SP_, N5AP = pad256(N5A);
constexpr int EP = pad256(E_), NRS = EP + 2 * FF_;
constexpr int SWP = pad256(SW);
constexpr int NSLOT = pad256(NTOK * TOPK_) + E_ * 256, MAXT = NSLOT / 256;
constexpr int ROWS_ = T_ / GW_;
constexpr float LN_EPS = 1e-6f, GN_EPS = 64e-5f;
static_assert(OGL + 2 * GGR_ <= KSM, "ksm");
static_assert(NTOK % 256 == 0 && NLAT % 256 == 0, "rows");
static_assert(FF_ % 128 == 0 && D_ % 256 == 0, "ff");

typedef unsigned short bf16_t;
#ifdef CPU_TEST
#include <cmath>
#include <cstring>
#include <cstdio>
#include <cstdlib>
#include <vector>
#define HD static inline
#define HDM inline
#define NL 1
static inline float WSUM(float v) { return v; }
struct F4 { float v[4]; float& operator[](int i) { return v[i]; } const float& operator[](int i) const { return v[i]; } };
#else
#include <hip/hip_runtime.h>
#define HD __device__ __forceinline__
#define HDM __device__ __forceinline__
#define NL 64
#define DPP_ADD(v, ctrl) v += __builtin_bit_cast(float, __builtin_amdgcn_update_dpp(0, __builtin_bit_cast(int, v), ctrl, 0xF, 0xF, true))
HD float WSUM(float v) {
    DPP_ADD(v, 0xB1); DPP_ADD(v, 0x4E); DPP_ADD(v, 0x141); DPP_ADD(v, 0x140);
    const int b = __builtin_bit_cast(int, v);
    const float s0 = __builtin_bit_cast(float, __builtin_amdgcn_readlane(b, 0)), s1 = __builtin_bit_cast(float, __builtin_amdgcn_readlane(b, 16)),
                s2 = __builtin_bit_cast(float, __builtin_amdgcn_readlane(b, 32)), s3 = __builtin_bit_cast(float, __builtin_amdgcn_readlane(b, 48));
    return (s0 + s1) + (s2 + s3);
}
typedef float F4 __attribute__((ext_vector_type(4)));
#endif

#ifdef CPU_TEST
HD bf16_t f2bf(float f) { unsigned u; memcpy(&u, &f, 4); u += 0x7FFFu + ((u >> 16) & 1u); return (bf16_t)(u >> 16); }
#else
HD bf16_t f2bf(float f) { return __builtin_bit_cast(unsigned short, (__bf16)f); }
#endif
HD float bf2f(bf16_t b) { unsigned u = ((unsigned)b) << 16; float f; memcpy(&f, &u, 4); return f; }
#ifdef CPU_TEST
HD float fexp(float x) { return expf(x); }
HD float flog(float x) { return logf(x); }
HD float frcp(float x) { return 1.0f / x; }
#else
HD float fexp(float x) { return __expf(x); }
HD float flog(float x) { return __logf(x); }
HD float frcp(float x) { return __builtin_amdgcn_rcpf(x); }
#endif
HD float sigmoidf_(float x) { return frcp(1.0f + fexp(-x)); }
HD float siluf_(float x) { return x * sigmoidf_(x); }
HD float softplusf_(float x) { return x > 20.f ? x : flog(1.0f + fexp(x)); }
HD float ftanh(float x) { const float e = fexp(2.0f * (x > 15.f ? 15.f : x)); return 1.0f - 2.0f * frcp(e + 1.0f); }
HD float geluf_(float x) { return 0.5f * x * (1.0f + ftanh(0.7978845608028654f * (x + 0.044715f * x * x * x))); }

HD int row_of(int b, int pos) { return pos < CTX_ ? NLAT + b * CTX_ + pos : b * T_ + (pos - CTX_); }
HD int bidx_of(int n) { return n < NLAT ? n / T_ : B_; }
HD int seqpos(int d, int i) { return d == 0 ? i : (i < CTX_ ? CTX_ - 1 - i : CTX_ + T_ - 1 - (i - CTX_)); }

constexpr size_t al256(size_t x) { return (x + 255) / 256 * 256; }
struct WSMap {
    size_t ctl, silu_c, modv, w_inT, w_outT, wsmT, rsT, w13T, w2T, shw2T, gluT, s5Wa, s5Tb, s5pw, s5bb, s5K;
    size_t h, ymix, yo, xcur, x1, h2, eidx, ewt, slot_of, ecnt, efill, eoff, nunits, ulist, slot_tok;
    size_t proj, rkv, asmall, gs, gsb, yr, og, U2, xl, yc;
    size_t logits, sact, act, Y, Ysh;
    size_t end;
};
constexpr WSMap make_wsmap() {
    WSMap m{}; size_t o = 0;
#define TAKE(f, bytes) m.f = o; o = al256(o + (size_t)(bytes));
    TAKE(ctl, 65536)
    TAKE(silu_c, (B_ + 1) * D_ * 4) TAKE(modv, (size_t)L_ * (B_ + 1) * 6 * D_ * 4)
    TAKE(w_inT, (size_t)L_ * NINP * D_ * 2) TAKE(w_outT, (size_t)L_ * D_ * MIXW * 2) TAKE(wsmT, (size_t)L_ * NSMP * KSM * 2)
    TAKE(rsT, (size_t)L_ * NRS * D_ * 2) TAKE(w13T, (size_t)L_ * E_ * 2 * FF_ * D_ * 2) TAKE(w2T, (size_t)L_ * E_ * D_ * FF_ * 2)
    TAKE(shw2T, (size_t)L_ * D_ * FF_ * 2) TAKE(gluT, (size_t)L_ * SWP * SW * 2)
    TAKE(s5Wa, (size_t)L_ * SNG_ * N5AP * K5 * 2) TAKE(s5Tb, (size_t)L_ * SNG_ * K5 * KT5 * 2)
    TAKE(s5pw, (size_t)L_ * 2 * SNG_ * SP_ * (CH_ + 1) * 2 * 4) TAKE(s5bb, (size_t)L_ * 2 * SNG_ * SP_ * SG_ * 2 * 4) TAKE(s5K, (size_t)L_ * 2 * SNG_ * CH_ * SG_ * SG_ * 4)
    TAKE(h, (size_t)NTOK * D_ * 2) TAKE(ymix, (size_t)NTOK * MIXW * 2) TAKE(yo, (size_t)NTOK * D_ * 2) TAKE(xcur, (size_t)NTOK * D_ * 2)
    TAKE(x1, (size_t)NTOK * D_ * 2) TAKE(h2, (size_t)NTOK * D_ * 2)
    TAKE(eidx, (size_t)NTOK * TOPK_ * 4) TAKE(ewt, (size_t)NTOK * TOPK_ * 4) TAKE(slot_of, (size_t)NTOK * TOPK_ * 4)
    TAKE(ecnt, E_ * 4) TAKE(efill, E_ * 4) TAKE(eoff, (E_ + 1) * 4) TAKE(nunits, 256) TAKE(ulist, (size_t)MAXT * 16) TAKE(slot_tok, (size_t)NSLOT * 4)
    const size_t regA = o;
    TAKE(proj, (size_t)NTOK * NINP * 2) TAKE(rkv, (size_t)NTOK * 3 * RW * 2) TAKE(asmall, (size_t)NTOK * KSM * 2) TAKE(gs, (size_t)NTOK * NGF * 4) TAKE(gsb, (size_t)NTOK * NGB * 2)
    TAKE(yr, (size_t)2 * NTOK * RW * 4) TAKE(og, (size_t)2 * NTOK * GWD * 4) TAKE(U2, (size_t)SNG_ * M5P * KT5 * 2) TAKE(xl, (size_t)SNG_ * M5P * N5AP * 4)
    TAKE(yc, (size_t)NTOK * SW * 2)
    const size_t endA = o; o = regA;
    TAKE(logits, (size_t)NTOK * E_ * 4) TAKE(sact, (size_t)NTOK * FF_ * 2) TAKE(act, (size_t)NSLOT * FF_ * 2) TAKE(Y, (size_t)NSLOT * D_ * 2) TAKE(Ysh, (size_t)NTOK * D_ * 2)
    m.end = o > endA ? o : endA;
#undef TAKE
    return m;
}
constexpr WSMap WS = make_wsmap();

struct P {
    const float *x, *c, *ctx, *c_ctx, *w_mod, *b_mod, *w_in, *rwkv_conv, *rwkv_w0, *rwkv_w_up, *rwkv_a0, *rwkv_a_up, *rwkv_g_up, *rwkv_k_k, *rwkv_k_a,
        *rwkv_r_k, *rwkv_ln_g, *rwkv_ln_b, *gla_a_up, *gla_a_bias, *gla_norm_g, *s5_lam_re, *s5_lam_im, *s5_log_dt, *s5_b_re, *s5_b_im, *s5_c_re, *s5_c_im,
        *s5_d, *s5_glu_w, *s5_glu_b, *w_out, *ln1_g, *ln1_b, *router_w, *router_bias, *exp_w13, *exp_w2, *sh_w13, *sh_w2, *ln2_g, *ln2_b;
    float* out; unsigned char* ws;
};
#define WSP(type, field) ((type*)(p.ws + WS.field))
#define GIDX long gid = (long)wv * NL + lane; const long gsz = (long)nwv * NL
#ifdef CPU_TEST
HD void ld8bf(const bf16_t* q, float* o) { for (int j = 0; j < 8; ++j) o[j] = bf2f(q[j]); }
HD void ld8f(const float* q, float* o) { for (int j = 0; j < 8; ++j) o[j] = q[j]; }
HD void st8f(float* q, const float* v) { for (int j = 0; j < 8; ++j) q[j] = v[j]; }
HD void st8bf(bf16_t* q, const float* v) { for (int j = 0; j < 8; ++j) q[j] = f2bf(v[j]); }
HD void cp8bf(bf16_t* q, const bf16_t* s) { for (int j = 0; j < 8; ++j) q[j] = s[j]; }
HD void z8bf(bf16_t* q) { for (int j = 0; j < 8; ++j) q[j] = 0; }
#else
typedef unsigned U4 __attribute__((ext_vector_type(4)));
HD void ld8bf(const bf16_t* q, float* o) { const U4 w = *(const U4*)q;
#pragma unroll
    for (int j = 0; j < 4; ++j) { o[2 * j] = __uint_as_float(w[j] << 16); o[2 * j + 1] = __uint_as_float(w[j] & 0xffff0000u); } }
HD void ld8f(const float* q, float* o) { const F4 a = *(const F4*)q, b = *(const F4*)(q + 4); o[0] = a[0]; o[1] = a[1]; o[2] = a[2]; o[3] = a[3]; o[4] = b[0]; o[5] = b[1]; o[6] = b[2]; o[7] = b[3]; }
HD void st8f(float* q, const float* v) { *(F4*)q = (F4){v[0], v[1], v[2], v[3]}; *(F4*)(q + 4) = (F4){v[4], v[5], v[6], v[7]}; }
HD void st8bf(bf16_t* q, const float* v) { U4 w;
#pragma unroll
    for (int j = 0; j < 4; ++j) w[j] = (unsigned)f2bf(v[2 * j]) | ((unsigned)f2bf(v[2 * j + 1]) << 16);
    *(U4*)q = w; }
HD void cp8bf(bf16_t* q, const bf16_t* s) { *(U4*)q = *(const U4*)s; }
HD void z8bf(bf16_t* q) { *(U4*)q = (U4){0u, 0u, 0u, 0u}; }
#endif

HD void st_siluc(const P& p, int wv, int nwv, int lane) {
    GIDX; float* sc = WSP(float, silu_c);
    for (long i = gid; i < (long)(B_ + 1) * D_; i += gsz) { const int b = (int)(i / D_), k = (int)(i % D_); const float v = b < B_ ? p.c[(size_t)b * D_ + k] : p.c_ctx[k]; sc[i] = siluf_(v); }
}
HD void st_modv(const P& p, int wv, int nwv, int lane) {
    GIDX; const float* sc = WSP(float, silu_c); float* mv = WSP(float, modv);
    for (long i = gid; i < (long)L_ * 6 * D_; i += gsz) {
        const int l = (int)(i / (6 * D_)), col = (int)(i % (6 * D_));
        float acc[B_ + 1];
#pragma unroll
        for (int b = 0; b <= B_; ++b) acc[b] = 0.f;
        const float* w = p.w_mod + (size_t)l * D_ * 6 * D_ + col;
        for (int k = 0; k < D_; ++k) { const float wk = w[(size_t)k * 6 * D_];
#pragma unroll
            for (int b = 0; b <= B_; ++b) acc[b] += sc[b * D_ + k] * wk; }
        const float bm = p.b_mod[(size_t)l * 6 * D_ + col];
#pragma unroll
        for (int b = 0; b <= B_; ++b) mv[((size_t)l * (B_ + 1) + b) * 6 * D_ + col] = acc[b] + bm;
    }
}
HD void cvt_T(bf16_t* dst, const float* src, int Ndst, int K, int Nsrc, int nvalid, int src_col0, long gid, long gsz) {
    for (long i = gid; i < (long)Ndst * K; i += gsz) { const int n = (int)(i % Ndst), k = (int)(i / Ndst);
        dst[(size_t)n * K + k] = n < nvalid ? f2bf(src[(size_t)k * Nsrc + src_col0 + n]) : (bf16_t)0; }
}
HD void st_cvt1(const P& p, int l, int wv, int nwv, int lane) {
    GIDX;
    cvt_T(WSP(bf16_t, w_inT) + (size_t)l * NINP * D_, p.w_in + (size_t)l * D_ * NIN, NINP, D_, NIN, NIN, 0, gid, gsz);
    cvt_T(WSP(bf16_t, w_outT) + (size_t)l * D_ * MIXW, p.w_out + (size_t)l * MIXW * D_, D_, MIXW, D_, D_, 0, gid, gsz);
    cvt_T(WSP(bf16_t, shw2T) + (size_t)l * D_ * FF_, p.sh_w2 + (size_t)l * FF_ * D_, D_, FF_, D_, D_, 0, gid, gsz);
    cvt_T(WSP(bf16_t, gluT) + (size_t)l * SWP * SW, p.s5_glu_w + (size_t)l * SW * SW, SWP, SW, SW, SW, 0, gid, gsz);
}
HD void st_cvt2(const P& p, int l, int wv, int nwv, int lane) {
    GIDX;
    bf16_t* rs = WSP(bf16_t, rsT) + (size_t)l * NRS * D_;
    cvt_T(rs, p.router_w + (size_t)l * D_ * E_, EP, D_, E_, E_, 0, gid, gsz);
    for (int j = 0; j < FF_ / 128; ++j) {
        cvt_T(rs + (size_t)(EP + 256 * j) * D_, p.sh_w13 + (size_t)l * D_ * 2 * FF_, 128, D_, 2 * FF_, 128, 128 * j, gid, gsz);
        cvt_T(rs + (size_t)(EP + 256 * j + 128) * D_, p.sh_w13 + (size_t)l * D_ * 2 * FF_, 128, D_, 2 * FF_, 128, FF_ + 128 * j, gid, gsz);
    }
}
HD void st_cvt3(const P& p, int l, int wv, int nwv, int lane) {
    GIDX;
    for (long i = gid; i < (long)E_ * 2 * FF_ * D_; i += gsz) {
        const int n = (int)(i % (2 * FF_)); const long r = i / (2 * FF_); const int k = (int)(r % D_), e = (int)(r / D_);
        const int j = n / 256, w = n % 256, srcc = w < 128 ? 128 * j + w : FF_ + 128 * j + (w - 128);
        WSP(bf16_t, w13T)[(((size_t)l * E_ + e) * 2 * FF_ + n) * D_ + k] = f2bf(p.exp_w13[(((size_t)l * E_ + e) * D_ + k) * 2 * FF_ + srcc]);
    }
}
HD void st_cvt4(const P& p, int l, int wv, int nwv, int lane) {
    GIDX;
    for (long i = gid; i < (long)E_ * D_ * FF_; i += gsz) {
        const int n = (int)(i % D_); const long r = i / D_; const int k = (int)(r % FF_), e = (int)(r / FF_);
        WSP(bf16_t, w2T)[(((size_t)l * E_ + e) * D_ + n) * FF_ + k] = f2bf(p.exp_w2[(((size_t)l * E_ + e) * FF_ + k) * D_ + n]);
    }
}
HD void st_cvt5(const P& p, int l, int wv, int nwv, int lane) {
    GIDX;
    bf16_t* ws = WSP(bf16_t, wsmT) + (size_t)l * NSMP * KSM;
    for (long i = gid; i < (long)NSMP * KSM; i += gsz) {
        const int n = (int)(i / KSM), k = (int)(i % KSM); float v = 0.f;
        if (n < 2 * RW) { const int d = n / RW, c = n % RW, r = k - (OWD + d * RDR_); if (r >= 0 && r < RDR_) v = p.rwkv_w_up[(((size_t)l * 2 + d) * RDR_ + r) * RW + c]; }
        else if (n < 4 * RW) { const int d = (n - 2 * RW) / RW, c = n % RW, r = k - (OAD + d * RIR_); if (r >= 0 && r < RIR_) v = p.rwkv_a_up[(((size_t)l * 2 + d) * RIR_ + r) * RW + c]; }
        else if (n < 5 * RW) { const int c = n - 4 * RW, r = k - OGD; if (r >= 0 && r < RGR_) v = p.rwkv_g_up[((size_t)l * RGR_ + r) * RW + c]; }
        else if (n < NSM) { const int q = n - 5 * RW, d = q / GKD, c = q % GKD, r = k - (OGL + d * GGR_); if (r >= 0 && r < GGR_) v = p.gla_a_up[(((size_t)l * 2 + d) * GGR_ + r) * GKD + c]; }
        ws[i] = f2bf(v);
    }
}
HD void st_s5a(const P& p, int wv, int nwv, int lane) {
    GIDX; float* pw = WSP(float, s5pw); float* bb = WSP(float, s5bb);
    for (long i = gid; i < (long)L_ * 2 * SNG_ * SP_ * (CH_ + 1); i += gsz) {
        const int tau = (int)(i % (CH_ + 1)); long r = i / (CH_ + 1); const int pp = (int)(r % SP_); r /= SP_; const int g = (int)(r % SNG_); r /= SNG_; const int d = (int)(r % 2), l = (int)(r / 2);
        const double dt = exp((double)p.s5_log_dt[((size_t)l * 2 + d) * SNG_ + g]);
        const double zr = (double)p.s5_lam_re[((size_t)l * 2 + d) * SP_ + pp] * dt, zi = (double)p.s5_lam_im[((size_t)l * 2 + d) * SP_ + pp] * dt;
        const double mag = exp(zr * tau);
        pw[i * 2] = (float)(mag * cos(zi * tau)); pw[i * 2 + 1] = (float)(mag * sin(zi * tau));
    }
    for (long i = gid; i < (long)L_ * 2 * SNG_ * SP_ * SG_; i += gsz) {
        const int c = (int)(i % SG_); long r = i / SG_; const int pp = (int)(r % SP_); r /= SP_; const int g = (int)(r % SNG_); r /= SNG_; const int d = (int)(r % 2), l = (int)(r / 2);
        const double dt = exp((double)p.s5_log_dt[((size_t)l * 2 + d) * SNG_ + g]);
        const double lr = p.s5_lam_re[((size_t)l * 2 + d) * SP_ + pp], li = p.s5_lam_im[((size_t)l * 2 + d) * SP_ + pp];
        const double zr = lr * dt, zi = li * dt, mag = exp(zr), ar = mag * cos(zi), ai = mag * sin(zi), den = lr * lr + li * li;
        const double fr = ((ar - 1) * lr + ai * li) / den, fi = (ai * lr - (ar - 1) * li) / den;
        const size_t bi = ((((size_t)l * 2 + d) * SNG_ + g) * SP_ + pp) * SG_ + c;
        const double br = p.s5_b_re[bi], bim = p.s5_b_im[bi];
        bb[i * 2] = (float)(fr * br - fi * bim); bb[i * 2 + 1] = (float)(fr * bim + fi * br);
    }
}
HD void st_s5b(const P& p, int wv, int nwv, int lane) {
    GIDX; const float* pw = WSP(float, s5pw); const float* bb = WSP(float, s5bb); float* K = WSP(float, s5K);
    for (long i = gid; i < (long)L_ * 2 * SNG_ * CH_ * SG_ * SG_; i += gsz) {
        const int c2 = (int)(i % SG_); long r = i / SG_; const int c = (int)(r % SG_); r /= SG_; const int tau = (int)(r % CH_); r /= CH_; const long ldg = r;
        float acc = 0.f;
        for (int pp = 0; pp < SP_; ++pp) {
            const float cr = p.s5_c_re[(ldg * SG_ + c) * SP_ + pp], ci = p.s5_c_im[(ldg * SG_ + c) * SP_ + pp];
            const float ar = pw[((ldg * SP_ + pp) * (CH_ + 1) + tau) * 2], ai = pw[((ldg * SP_ + pp) * (CH_ + 1) + tau) * 2 + 1];
            const float br = bb[((ldg * SP_ + pp) * SG_ + c2) * 2], bi = bb[((ldg * SP_ + pp) * SG_ + c2) * 2 + 1];
            const float er = cr * ar - ci * ai, ei = cr * ai + ci * ar;
            acc += er * br - ei * bi;
        }
        K[i] = acc;
    }
}
static_assert(SG_ == 16 && K5 % 8 == 0 && KT5 % 8 == 0 && SP_ % 8 == 0, "s5c item shape");
HD void st_s5c(const P& p, int wv, int nwv, int lane) {
    GIDX; const float* pw = WSP(float, s5pw); const float* bb = WSP(float, s5bb); const float* K = WSP(float, s5K);
    bf16_t* Tb = WSP(bf16_t, s5Tb); bf16_t* Wa = WSP(bf16_t, s5Wa);
    for (long i = gid; i < (long)L_ * SNG_ * K5 * (KT5 / 8); i += gsz) {
        const int k = (int)(i % (KT5 / 8)) * 8; long r = i / (KT5 / 8); const int n = (int)(r % K5); r /= K5; const int g = (int)(r % SNG_), l = (int)(r / SNG_);
        const int t = n / SG_, c = n % SG_; float v[8];
        const long ldg0 = ((long)l * 2 + 0) * SNG_ + g, ldg1 = ((long)l * 2 + 1) * SNG_ + g;
        if (k < K5) { const int s = k / SG_, c2 = k % SG_; const float m0 = s <= t ? 1.f : 0.f, m1 = s >= t ? 1.f : 0.f; const int t0 = s <= t ? t - s : 0, t1 = s >= t ? s - t : 0;
            float a[8], b[8]; ld8f(K + ((ldg0 * CH_ + t0) * SG_ + c) * SG_ + c2, a); ld8f(K + ((ldg1 * CH_ + t1) * SG_ + c) * SG_ + c2, b);
            const float dd = p.s5_d[(size_t)l * SW + g * SG_ + c];
#pragma unroll
            for (int j = 0; j < 8; ++j) v[j] = m0 * a[j] + m1 * b[j] + ((s == t && c == c2 + j) ? dd : 0.f);
        } else { const int q = k - K5, d = q / (2 * SP_), part = (q / SP_) & 1, pp0 = q % SP_; const long ldg = d ? ldg1 : ldg0; const int ex = d ? (CH_ - t) : (t + 1);
            float cr[8], ci[8]; ld8f(p.s5_c_re + (ldg * SG_ + c) * SP_ + pp0, cr); ld8f(p.s5_c_im + (ldg * SG_ + c) * SP_ + pp0, ci);
#pragma unroll
            for (int j = 0; j < 8; ++j) { const float ar = pw[((ldg * SP_ + pp0 + j) * (CH_ + 1) + ex) * 2], ai = pw[((ldg * SP_ + pp0 + j) * (CH_ + 1) + ex) * 2 + 1];
                v[j] = part == 0 ? (cr[j] * ar - ci[j] * ai) : -(cr[j] * ai + ci[j] * ar); } }
        st8bf(Tb + i * 8, v);
    }
    for (long i = gid; i < (long)L_ * SNG_ * N5AP * (K5 / 8); i += gsz) {
        const int k = (int)(i % (K5 / 8)) * 8; long r = i / (K5 / 8); const int n = (int)(r % N5AP); r /= N5AP; const int g = (int)(r % SNG_), l = (int)(r / SNG_);
        float v[8];
#pragma unroll
        for (int j = 0; j < 8; ++j) v[j] = 0.f;
        if (n < N5A) { const int d = n / (2 * SP_), part = (n / SP_) & 1, pp = n % SP_, s = k / SG_, c2 = k % SG_; const long ldg = ((long)l * 2 + d) * SNG_ + g; const int ex = d ? s : (CH_ - 1 - s);
            const float ar = pw[((ldg * SP_ + pp) * (CH_ + 1) + ex) * 2], ai = pw[((ldg * SP_ + pp) * (CH_ + 1) + ex) * 2 + 1];
            float b0[8], b1[8]; ld8f(bb + ((ldg * SP_ + pp) * SG_ + c2) * 2, b0); ld8f(bb + ((ldg * SP_ + pp) * SG_ + c2) * 2 + 8, b1);
#pragma unroll
            for (int j = 0; j < 8; ++j) { const float br = j < 4 ? b0[2 * j] : b1[2 * (j - 4)], bi = j < 4 ? b0[2 * j + 1] : b1[2 * (j - 4) + 1]; v[j] = part == 0 ? (ar * br - ai * bi) : (ar * bi + ai * br); } }
        st8bf(Wa + i * 8, v);
    }
}
HD const float* xsrc0(const P& p, int n) { return n < NLAT ? p.x + (size_t)n * D_ : p.ctx + (size_t)(n - NLAT) * D_; }
HD void ln_stats(const float* z, int lane, float& mu, float& rstd) {
    float s = 0.f; for (int k = lane; k < D_; k += NL) s += z[k]; s = WSUM(s); mu = s * (1.0f / D_);
    float q = 0.f; for (int k = lane; k < D_; k += NL) { const float d = z[k] - mu; q += d * d; } q = WSUM(q); rstd = 1.0f / sqrtf(q * (1.0f / D_) + LN_EPS);
}
constexpr int PERL = D_ / NL, NCHK = PERL / 4;
HD void row_stats(const float* xv, float& mu, float& rstd) {
    float s = 0.f;
#pragma unroll
    for (int i = 0; i < PERL; ++i) s += xv[i];
    s = WSUM(s); mu = s * (1.0f / D_); float q = 0.f;
#pragma unroll
    for (int i = 0; i < PERL; ++i) { const float d = xv[i] - mu; q += d * d; }
    q = WSUM(q); rstd = 1.0f / sqrtf(q * (1.0f / D_) + LN_EPS);
}
HD void row_ld(const float* z, int lane, float* xv) {
#pragma unroll
    for (int i = 0; i < NCHK; ++i) { const F4 v = *(const F4*)(z + 4 * lane + 4 * NL * i); xv[4 * i] = v[0]; xv[4 * i + 1] = v[1]; xv[4 * i + 2] = v[2]; xv[4 * i + 3] = v[3]; }
}
HD void st4bf(bf16_t* q, const float* v) {
#ifdef CPU_TEST
    for (int j = 0; j < 4; ++j) q[j] = f2bf(v[j]);
#else
    uint2 w; w.x = (unsigned)f2bf(v[0]) | ((unsigned)f2bf(v[1]) << 16); w.y = (unsigned)f2bf(v[2]) | ((unsigned)f2bf(v[3]) << 16); *(uint2*)q = w;
#endif
}
HD void ld4bf(const bf16_t* q, float* o) {
#ifdef CPU_TEST
    for (int j = 0; j < 4; ++j) o[j] = bf2f(q[j]);
#else
    const uint2 w = *(const uint2*)q; o[0] = __uint_as_float(w.x << 16); o[1] = __uint_as_float(w.x & 0xffff0000u); o[2] = __uint_as_float(w.y << 16); o[3] = __uint_as_float(w.y & 0xffff0000u);
#endif
}
HD void row_mod_store(const float* xv, const float* mv, int sh_off, int sc_off, bf16_t* hrow, int lane) {
    float mu, rstd; row_stats(xv, mu, rstd);
#pragma unroll
    for (int i = 0; i < NCHK; ++i) { const int k = 4 * lane + 4 * NL * i; const F4 sc = *(const F4*)(mv + sc_off + k), sh = *(const F4*)(mv + sh_off + k); float o[4];
#pragma unroll
        for (int j = 0; j < 4; ++j) o[j] = (xv[4 * i + j] - mu) * rstd * (1.0f + sc[j]) + sh[j];
        st4bf(hrow + k, o); }
}
HD void row_affine(float* xv, const float* g, const float* bb, int lane) {
    float mu, rstd; row_stats(xv, mu, rstd);
#pragma unroll
    for (int i = 0; i < NCHK; ++i) { const int k = 4 * lane + 4 * NL * i; const F4 gg = *(const F4*)(g + k), be = *(const F4*)(bb + k);
#pragma unroll
        for (int j = 0; j < 4; ++j) xv[4 * i + j] = (xv[4 * i + j] - mu) * rstd * gg[j] + be[j]; }
}
HD void row_ld_bf(const bf16_t* z, int lane, float* xv) {
#pragma unroll
    for (int i = 0; i < NCHK; ++i) ld4bf(z + 4 * lane + 4 * NL * i, xv + 4 * i);
}
HD void row_st_bf(bf16_t* z, int lane, const float* xv) {
#pragma unroll
    for (int i = 0; i < NCHK; ++i) st4bf(z + 4 * lane + 4 * NL * i, xv + 4 * i);
}
HD void row_ld_x(const P& p, int l, int n, int lane, float* xv) { if (l == 0) row_ld(xsrc0(p, n), lane, xv); else row_ld_bf(WSP(bf16_t, xcur) + (size_t)n * D_, lane, xv); }
HD void row_st(float* z, int lane, const float* xv) {
#pragma unroll
    for (int i = 0; i < NCHK; ++i) { F4 v; v[0] = xv[4 * i]; v[1] = xv[4 * i + 1]; v[2] = xv[4 * i + 2]; v[3] = xv[4 * i + 3]; *(F4*)(z + 4 * lane + 4 * NL * i) = v; }
}
HD void st_hmod(const P& p, int l, int wv, int nwv, int lane) {
    bf16_t* h = WSP(bf16_t, h);
    for (int n = wv; n < NTOK; n += nwv) {
        float xv[PERL]; row_ld_x(p, l, n, lane, xv);
        const float* mv = WSP(float, modv) + ((size_t)l * (B_ + 1) + bidx_of(n)) * 6 * D_;
        row_mod_store(xv, mv, 0, D_, h + (size_t)n * D_, lane);
    }
}
static_assert(RCOLS % 8 == 0 && RW % 8 == 0 && RDR_ % 4 == 0, "prep1 groups");
HD void st_prep1(const P& p, int l, int wv, int nwv, int lane) {
    GIDX; const bf16_t* proj = WSP(bf16_t, proj); bf16_t* rkv = WSP(bf16_t, rkv); bf16_t* as = WSP(bf16_t, asmall); bf16_t* U2 = WSP(bf16_t, U2);
    const float* taps = p.rwkv_conv + (size_t)l * 9 * RCOLS; constexpr int NG = RCOLS / 8;
    for (long i0 = gid; i0 < (long)NTOK * NG; i0 += 2 * gsz) {
#pragma unroll
      for (int u2 = 0; u2 < 2; ++u2) { const long i = i0 + u2 * gsz; if (i < (long)NTOK * NG) {
        const int n = (int)(i / NG), ch = (int)(i % NG) * 8; float acc[8];
#pragma unroll
        for (int j = 0; j < 8; ++j) acc[j] = 0.f;
        if (n < NLAT) { const int b = n / T_, t = n % T_, gr = t / GW_, gc = t % GW_;
#pragma unroll
            for (int a = 0; a < 3; ++a)
#pragma unroll
                for (int j = 0; j < 3; ++j) { const int rr = gr + a - 1, cc = gc + j - 1; const bool ok = rr >= 0 && rr < ROWS_ && cc >= 0 && cc < GW_;
                    const int nn = ok ? b * T_ + rr * GW_ + cc : n; float x[8], w[8]; ld8bf(proj + (size_t)nn * NINP + ch, x); ld8f(taps + (a * 3 + j) * RCOLS + ch, w); const float m = ok ? 1.f : 0.f;
#pragma unroll
                    for (int q = 0; q < 8; ++q) acc[q] += (w[q] * m) * x[q]; }
        } else { const int s = (n - NLAT) % CTX_;
#pragma unroll
            for (int j = 0; j < 3; ++j) { const int ss = s + j - 1; const bool ok = ss >= 0 && ss < CTX_; const int nn = ok ? n + j - 1 : n; float x[8], w[8]; ld8bf(proj + (size_t)nn * NINP + ch, x); ld8f(taps + (3 + j) * RCOLS + ch, w); const float m = ok ? 1.f : 0.f;
#pragma unroll
                for (int q = 0; q < 8; ++q) acc[q] += (w[q] * m) * x[q]; } }
        if (ch < 3 * RW) st8bf(rkv + (size_t)n * 3 * RW + ch, acc);
        else { const int q0 = ch - 3 * RW;
            if (q0 < 2 * RDR_) {
#pragma unroll
                for (int q = 0; q < 8; ++q) acc[q] = ftanh(acc[q]); }
            else if (q0 >= 2 * RDR_ + 2 * RIR_) {
#pragma unroll
                for (int q = 0; q < 8; ++q) acc[q] = sigmoidf_(acc[q]); }
            st8bf(as + (size_t)n * KSM + q0, acc); }
          } }
    }
    constexpr int NT8 = (KSM - OGL) / 8;
    for (long i = gid; i < (long)NTOK * NT8; i += gsz) { const int n = (int)(i / NT8), q = (int)(i % NT8) * 8;
        if (q < 2 * GGR_) cp8bf(as + (size_t)n * KSM + OGL + q, proj + (size_t)n * NINP + GBASE + 2 * GKD + 2 * GWD + q); else z8bf(as + (size_t)n * KSM + OGL + q); }
    for (long i = gid; i < (long)B_ * SPOS * (SW / 8); i += gsz) { const int c = (int)(i % (SW / 8)) * 8; const long r = i / (SW / 8); const int pos = (int)(r % SPOS), b = (int)(r / SPOS);
        const int g = c / SG_, cc = c % SG_, pc = pos / CH_, t = pos % CH_, m = b * NPC + pc;
        cp8bf(U2 + ((size_t)g * M5P + m) * KT5 + t * SG_ + cc, proj + (size_t)row_of(b, pos) * NINP + SBASE + c); }
}
HD void st_s5carry(const P& p, int l, int wv, int nwv, int lane) {
    GIDX; const float* xl = WSP(float, xl); bf16_t* U2 = WSP(bf16_t, U2); const float* pw = WSP(float, s5pw);
    for (long i = gid; i < (long)2 * B_ * SNG_ * SP_; i += gsz) {
        const int pp = (int)(i % SP_); long r = i / SP_; const int g = (int)(r % SNG_); r /= SNG_; const int b = (int)(r % B_), d = (int)(r / B_);
        const long ldg = ((long)l * 2 + d) * SNG_ + g; const float ar = pw[((ldg * SP_ + pp) * (CH_ + 1) + CH_) * 2], ai = pw[((ldg * SP_ + pp) * (CH_ + 1) + CH_) * 2 + 1];
        float xr = 0.f, xi = 0.f;
        for (int q = 0; q < NPC; ++q) {
            const int pc = d == 0 ? q : (q < NPCC ? NPCC - 1 - q : NPC - 1 - (q - NPCC)); const size_t m = (size_t)b * NPC + pc;
            bf16_t* x0 = U2 + ((size_t)g * M5P + m) * KT5 + K5 + d * 2 * SP_; x0[pp] = f2bf(xr); x0[SP_ + pp] = f2bf(xi);
            const float lr = xl[((size_t)g * M5P + m) * N5AP + d * 2 * SP_ + pp], li = xl[((size_t)g * M5P + m) * N5AP + d * 2 * SP_ + SP_ + pp];
            const float nr = ar * xr - ai * xi + lr, ni = ar * xi + ai * xr + li; xr = nr; xi = ni;
        }
    }
}
struct RV { float r, w, k2, a, b, v, kkraw; };
HD void rwkv_elem(const P& p, int l, int d, int n, int hh, int j, float kknorm_rs, RV& o) {
    const bf16_t* rkv = WSP(bf16_t, rkv) + (size_t)n * 3 * RW; const float* gs = WSP(float, gs) + (size_t)n * NGF; const bf16_t* gb = WSP(bf16_t, gsb) + (size_t)n * NGB; const int c = hh * RN_ + j;
    const float k = bf2f(rkv[RW + c]); o.kkraw = k * p.rwkv_k_k[(size_t)l * RW + c]; const float kk = o.kkraw * kknorm_rs;
    const float a = bf2f(gb[d * RW + c]); o.w = fexp(gs[d * RW + c]); o.k2 = k * (1.0f + (a - 1.0f) * p.rwkv_k_a[(size_t)l * RW + c]);
    o.a = -kk; o.b = kk * a; o.r = bf2f(rkv[c]); o.v = bf2f(rkv[2 * RW + c]);
}
HD void st_post(const P& p, int l, int wv, int nwv, int lane) {
    bf16_t* ymix = WSP(bf16_t, ymix); const float* yr = WSP(float, yr); const float* og = WSP(float, og); const bf16_t* proj = WSP(bf16_t, proj); const bf16_t* gsbb = WSP(bf16_t, gsb); const bf16_t* rkvb = WSP(bf16_t, rkv);
    const int nrow = (l == L_ - 1) ? NLAT : NTOK; constexpr int PJ = RN_ / NL;
    for (int n = wv; n < nrow; n += nwv) {
        const bf16_t* rk = rkvb + (size_t)n * 3 * RW; const bf16_t* gb = gsbb + (size_t)n * NGB;
        float r_[RH_][PJ], k_[RH_][PJ], v_[RH_][PJ], y_[RH_][PJ], a0_[RH_][PJ], a1_[RH_][PJ], g_[RH_][PJ], o_[GH_][PJ], gg_[GH_][PJ];
#pragma unroll
        for (int hh = 0; hh < RH_; ++hh)
#pragma unroll
            for (int q = 0; q < PJ; ++q) { const int c = hh * RN_ + lane + NL * q; r_[hh][q] = bf2f(rk[c]); k_[hh][q] = bf2f(rk[RW + c]); v_[hh][q] = bf2f(rk[2 * RW + c]);
                y_[hh][q] = yr[(size_t)n * RW + c] + yr[((size_t)NTOK + n) * RW + c]; a0_[hh][q] = bf2f(gb[c]); a1_[hh][q] = bf2f(gb[RW + c]); g_[hh][q] = bf2f(gb[2 * RW + c]); }
#pragma unroll
        for (int hh = 0; hh < GH_; ++hh)
#pragma unroll
            for (int q = 0; q < PJ; ++q) { const int c = hh * GV_ + lane + NL * q; o_[hh][q] = og[(size_t)n * GWD + c] + og[((size_t)NTOK + n) * GWD + c]; gg_[hh][q] = bf2f(proj[(size_t)n * NINP + GBASE + 2 * GKD + GWD + c]); }
#pragma unroll
        for (int hh = 0; hh < RH_; ++hh) {
            float s = 0.f, bs = 0.f;
#pragma unroll
            for (int q = 0; q < PJ; ++q) { const int c = hh * RN_ + lane + NL * q; const float ka = p.rwkv_k_a[(size_t)l * RW + c];
                const float k20 = k_[hh][q] * (1.0f + (a0_[hh][q] - 1.0f) * ka), k21 = k_[hh][q] * (1.0f + (a1_[hh][q] - 1.0f) * ka);
                s += y_[hh][q]; bs += r_[hh][q] * (k20 + k21) * p.rwkv_r_k[(size_t)l * RW + c]; }
            s = WSUM(s); bs = WSUM(bs); const float mu = s * (1.0f / RN_); float qq = 0.f;
#pragma unroll
            for (int q = 0; q < PJ; ++q) { const float d = y_[hh][q] - mu; qq += d * d; }
            qq = WSUM(qq); const float rstd = 1.0f / sqrtf(qq * (1.0f / RN_) + GN_EPS);
#pragma unroll
            for (int q = 0; q < PJ; ++q) { const int c = hh * RN_ + lane + NL * q; const float gn = (y_[hh][q] - mu) * rstd * p.rwkv_ln_g[(size_t)l * RW + c] + p.rwkv_ln_b[(size_t)l * RW + c];
                ymix[(size_t)n * MIXW + c] = f2bf((gn + bs * v_[hh][q]) * g_[hh][q]); }
        }
#pragma unroll
        for (int hh = 0; hh < GH_; ++hh) { float qq = 0.f;
#pragma unroll
            for (int q = 0; q < PJ; ++q) qq += o_[hh][q] * o_[hh][q];
            qq = WSUM(qq); const float rs = 1.0f / sqrtf(qq * (1.0f / GV_) + 1e-6f);
#pragma unroll
            for (int q = 0; q < PJ; ++q) { const int j = lane + NL * q; ymix[(size_t)n * MIXW + RW + hh * GV_ + j] = f2bf(o_[hh][q] * rs * p.gla_norm_g[(size_t)l * GV_ + j] * siluf_(gg_[hh][q])); }
        }
    }
}
HD void st_ln1(const P& p, int l, int wv, int nwv, int lane) {
    GIDX; const float alpha = sqrtf(2.0f);
    for (long i = gid; i < E_; i += gsz) { WSP(int, ecnt)[i] = 0; WSP(int, efill)[i] = 0; }
    const int nrow = (l == L_ - 1) ? NLAT : NTOK; bf16_t* x1 = WSP(bf16_t, x1); bf16_t* h2 = WSP(bf16_t, h2); const bf16_t* yo = WSP(bf16_t, yo);
    for (int n = wv; n < nrow; n += nwv) {
        const float* mv = WSP(float, modv) + ((size_t)l * (B_ + 1) + bidx_of(n)) * 6 * D_;
        float xv[PERL], yv[PERL]; row_ld_x(p, l, n, lane, xv); row_ld_bf(yo + (size_t)n * D_, lane, yv);
#pragma unroll
        for (int i = 0; i < NCHK; ++i) { const F4 g1 = *(const F4*)(mv + 2 * D_ + 4 * lane + 4 * NL * i);
#pragma unroll
            for (int j = 0; j < 4; ++j) xv[4 * i + j] = alpha * xv[4 * i + j] + g1[j] * yv[4 * i + j]; }
        row_affine(xv, p.ln1_g + (size_t)l * D_, p.ln1_b + (size_t)l * D_, lane);
        row_st_bf(x1 + (size_t)n * D_, lane, xv);
        row_mod_store(xv, mv, 3 * D_, 4 * D_, h2 + (size_t)n * D_, lane);
    }
}
HD void st_topk(const P& p, int l, int wv, int nwv, int lane) {
    GIDX; const int nrow = (l == L_ - 1) ? NLAT : NTOK; const float* lg = WSP(float, logits); constexpr int EG = E_ / NGRP_;
    for (long n = gid; n < nrow; n += gsz) {
        const float* z = lg + (size_t)n * E_; const float* rb = p.router_bias + (size_t)l * E_;
        float gsc[NGRP_];
#pragma unroll
        for (int g = 0; g < NGRP_; ++g) { float m1 = -1e30f, m2 = -1e30f;
            for (int e = 0; e < EG; ++e) { const float s = sigmoidf_(z[g * EG + e]) + rb[g * EG + e]; if (s > m1) { m2 = m1; m1 = s; } else if (s > m2) m2 = s; }
            gsc[g] = m1 + m2; }
        unsigned gmask = 0;
#pragma unroll
        for (int g = 0; g < NGRP_; ++g) { int rank = 0;
#pragma unroll
            for (int g2 = 0; g2 < NGRP_; ++g2) rank += (gsc[g2] > gsc[g] || (gsc[g2] == gsc[g] && g2 < g)) ? 1 : 0;
            if (rank < TKG_) gmask |= 1u << g; }
        float pv = 1e30f; int pi = -1; float wsum = 0.f; int* ei = WSP(int, eidx) + (size_t)n * TOPK_; float* ew = WSP(float, ewt) + (size_t)n * TOPK_;
        for (int kk = 0; kk < TOPK_; ++kk) { float bv = -1e30f; int bi = -1;
            for (int e = 0; e < E_; ++e) { if (!((gmask >> (e / EG)) & 1u)) continue; const float s = sigmoidf_(z[e]) + rb[e];
                const bool after = (s < pv) || (s == pv && e > pi); if (after && s > bv) { bv = s; bi = e; } }
            pv = bv; pi = bi; ei[kk] = bi; const float w = sigmoidf_(z[bi]); ew[kk] = w; wsum += w; }
        for (int kk = 0; kk < TOPK_; ++kk) ew[kk] = ew[kk] / wsum * 2.5f;
#ifdef CPU_TEST
        for (int kk = 0; kk < TOPK_; ++kk) WSP(int, ecnt)[ei[kk]]++;
#else
        for (int kk = 0; kk < TOPK_; ++kk) atomicAdd(WSP(int, ecnt) + ei[kk], 1);
#endif
    }
}
HD void st_offsets(const P& p, int l, int wv, int nwv, int lane) {
    if (wv != 0 || lane != 0) return;
    int* eoff = WSP(int, eoff); const int* ecnt = WSP(int, ecnt); int* ul = WSP(int, ulist); int o = 0, nu = 0;
    for (int e = 0; e < E_; ++e) { eoff[e] = o; const int nt = (ecnt[e] + 255) / 256;
        for (int t = 0; t < nt; ++t) { ul[nu * 4 + 0] = o + 256 * t; ul[nu * 4 + 1] = e; ul[nu * 4 + 2] = (ecnt[e] - 256 * t) < 256 ? (ecnt[e] - 256 * t) : 256; ul[nu * 4 + 3] = 0; ++nu; }
        o += nt * 256; }
    eoff[E_] = o; WSP(int, nunits)[0] = nu;
}
HD void st_scatter0(const P& p, int l, int wv, int nwv, int lane) { GIDX; int* st = WSP(int, slot_tok); for (long i = gid; i < NSLOT; i += gsz) st[i] = 0; }
HD void st_scatter(const P& p, int l, int wv, int nwv, int lane) {
    GIDX; const int nrow = (l == L_ - 1) ? NLAT : NTOK; const int* ei = WSP(int, eidx); const int* eoff = WSP(int, eoff); int* so = WSP(int, slot_of); int* st = WSP(int, slot_tok);
    for (long i = gid; i < (long)nrow * TOPK_; i += gsz) { const int e = ei[i];
#ifdef CPU_TEST
        const int r = WSP(int, efill)[e]++;
#else
        const int r = atomicAdd(WSP(int, efill) + e, 1);
#endif
        const int s = eoff[e] + r; so[i] = s; st[s] = (int)(i / TOPK_); }
}
HD void st_ln2(const P& p, int l, int wv, int nwv, int lane) {
    const float alpha = sqrtf(2.0f); const bool last = (l == L_ - 1); const int nrow = last ? NLAT : NTOK;
    const bf16_t* x1 = WSP(bf16_t, x1); const bf16_t* Y = WSP(bf16_t, Y); const bf16_t* Ysh = WSP(bf16_t, Ysh); const int* so = WSP(int, slot_of); const float* ew = WSP(float, ewt);
    for (int n = wv; n < nrow; n += nwv) {
        const float* mv = WSP(float, modv) + ((size_t)l * (B_ + 1) + bidx_of(n)) * 6 * D_;
        float xv[PERL], fv[PERL]; row_ld_bf(x1 + (size_t)n * D_, lane, xv);
#pragma unroll
        for (int i = 0; i < NCHK; ++i) ld4bf(Ysh + (size_t)n * D_ + 4 * lane + 4 * NL * i, fv + 4 * i);
#pragma unroll
        for (int kk = 0; kk < TOPK_; ++kk) { const float w = ew[(size_t)n * TOPK_ + kk]; const bf16_t* yr_ = Y + (size_t)so[(size_t)n * TOPK_ + kk] * D_;
#pragma unroll
            for (int i = 0; i < NCHK; ++i) { float t4[4]; ld4bf(yr_ + 4 * lane + 4 * NL * i, t4);
#pragma unroll
                for (int j = 0; j < 4; ++j) fv[4 * i + j] += w * t4[j]; } }
#pragma unroll
        for (int i = 0; i < NCHK; ++i) { const F4 g2 = *(const F4*)(mv + 5 * D_ + 4 * lane + 4 * NL * i);
#pragma unroll
            for (int j = 0; j < 4; ++j) xv[4 * i + j] = alpha * xv[4 * i + j] + g2[j] * fv[4 * i + j]; }
        row_affine(xv, p.ln2_g + (size_t)l * D_, p.ln2_b + (size_t)l * D_, lane);
        if (last) row_st(p.out + (size_t)n * D_, lane, xv);
        else { row_st_bf(WSP(bf16_t, xcur) + (size_t)n * D_, lane, xv);
            const float* mv2 = WSP(float, modv) + ((size_t)(l + 1) * (B_ + 1) + bidx_of(n)) * 6 * D_;
            row_mod_store(xv, mv2, 0, D_, WSP(bf16_t, h) + (size_t)n * D_, lane); }
    }
}
struct UnitInfo { int arow0, brow0, g, pm, pn, nv; };
struct GemmArgs { const bf16_t* A; int lda; const int* rowmap; const bf16_t* Bt; int ldb; int K; };

struct StaticSched {
    int nb, nM, nN, aM, bN, G, c;
    HDM void init(int nb_, int M, int N, int aM_, int bN_, int G_, int c_) { nb = nb_; nM = M / 256; nN = N / 256; aM = aM_; bN = bN_; G = G_; c = c_; }
    HDM int max_units() const { return (nb * nM * nN + G - 1) / G; }
    HDM bool next(int i, UnitInfo& u) const {
        const long L = (long)i * G + c; const int per = nM * nN; if (L >= (long)nb * per) return false;
        const int g = (int)(L / per); int wgid = (int)(L % per);
        { const int q = per / 8, r = per % 8, xcd = wgid % 8, off = wgid / 8; wgid = (xcd < r ? xcd * (q + 1) : r * (q + 1) + (xcd - r) * q) + off; }
        const int nig = 8 * nN, gid = wgid / nig, fm = gid * 8, gsz = (nM - fm) < 8 ? (nM - fm) : 8;
        u.pm = fm + ((wgid % nig) % gsz); u.pn = (wgid % nig) / gsz; u.g = g; u.arow0 = g * aM + 256 * u.pm; u.brow0 = g * bN + 256 * u.pn; u.nv = 256; return true;
    }
};
HD int ld_int(const int* q) {
#ifdef CPU_TEST
    return *q;
#else
    return __hip_atomic_load(q, __ATOMIC_RELAXED, __HIP_MEMORY_SCOPE_AGENT);
#endif
}
struct ListSched {
    const int* ulist; const int* nunits; int ntn, bN, G, c;
    HDM int max_units() const { return 0; }
    HDM bool next(int i, UnitInfo& u) const {
        const long L = (long)i * G + c; const int nt = ld_int(nunits); if (L >= (long)((nt + 7) / 8) * 8 * ntn) return false;
        const int r_ = (int)(L % (8 * ntn)); const int t = (r_ & 7) * ((nt + 7) / 8) + (int)(L / (8 * ntn)), pn = r_ >> 3; if (t >= nt) return false;
        const int s0 = ld_int(ulist + 4 * t), e = ld_int(ulist + 4 * t + 1);
        u.arow0 = s0; u.brow0 = e * bN + 256 * pn; u.g = e; u.pm = s0 / 256; u.pn = pn; u.nv = ld_int(ulist + 4 * t + 2); return true;
    }
};

#ifndef PROBE_EpiBf16Plain
#define PROBE_EpiBf16Plain false
#endif
#ifndef PROBE_EpiF32Plain
#define PROBE_EpiF32Plain false
#endif
#ifndef PROBE_EpiSmall
#define PROBE_EpiSmall false
#endif
#ifndef PROBE_EpiS5b
#define PROBE_EpiS5b false
#endif
#ifndef PROBE_EpiGlu
#define PROBE_EpiGlu false
#endif
#ifndef PROBE_EpiRS
#define PROBE_EpiRS false
#endif
#ifndef PROBE_EpiUp
#define PROBE_EpiUp false
#endif
#ifndef PROBE_EpiDown
#define PROBE_EpiDown false
#endif
HD void st4_bf16(bf16_t* q, const F4& v) {
#ifdef CPU_TEST
    for (int j = 0; j < 4; ++j) q[j] = f2bf(v[j]);
#else
    uint2 w; w.x = (unsigned)f2bf(v[0]) | ((unsigned)f2bf(v[1]) << 16); w.y = (unsigned)f2bf(v[2]) | ((unsigned)f2bf(v[3]) << 16); *(uint2*)q = w;
#endif
}
HD void st4_f32(float* q, const F4& v) {
#ifdef CPU_TEST
    for (int j = 0; j < 4; ++j) q[j] = v[j];
#else
    *(F4*)q = v;
#endif
}
HD void st8_bf16(bf16_t* q, const F4& lo, const F4& hi) {
#ifdef CPU_TEST
    for (int j = 0; j < 4; ++j) { q[j] = f2bf(lo[j]); q[4 + j] = f2bf(hi[j]); }
#else
    typedef unsigned U4e __attribute__((ext_vector_type(4))); U4e w;
    w[0] = (unsigned)f2bf(lo[0]) | ((unsigned)f2bf(lo[1]) << 16); w[1] = (unsigned)f2bf(lo[2]) | ((unsigned)f2bf(lo[3]) << 16);
    w[2] = (unsigned)f2bf(hi[0]) | ((unsigned)f2bf(hi[1]) << 16); w[3] = (unsigned)f2bf(hi[2]) | ((unsigned)f2bf(hi[3]) << 16); *(U4e*)q = w;
#endif
}
HD int perm32(int rho) { const int n = rho >> 4, i = rho & 15; return 8 * (i >> 2) + 4 * n + (i & 3); }
struct EpiBf16Plain { static constexpr bool PROBE = PROBE_EpiBf16Plain; bf16_t* O; int ldo; HDM void shift() { O += 800000000; }
    static constexpr bool PERM = true;
    HDM void st8(const UnitInfo& u, int r, int c, const F4& al, const F4& ah, const F4& bl, const F4& bh) const { bf16_t* q = O + (size_t)(256 * u.pm + r) * ldo + 256 * u.pn + c; st8_bf16(q, al, ah); st8_bf16(q + 128, bl, bh); } };
struct EpiF32Plain { static constexpr bool PROBE = PROBE_EpiF32Plain; static constexpr bool PERM = false; HDM void shift() {} float* O; int ldo; size_t gstride;
    HDM void st(const UnitInfo& u, int r, int c, const F4& v0, const F4& v1) const { float* q = O + (size_t)u.g * gstride + (size_t)(256 * u.pm + r) * ldo + 256 * u.pn + c; st4_f32(q, v0); st4_f32(q + 128, v1); } };
struct EpiSmall { static constexpr bool PROBE = PROBE_EpiSmall; static constexpr bool PERM = false; HDM void shift() {} float* gs; bf16_t* gsb; const float* w0; const float* a0; const float* ab;
    HDM void half(int n, int col, const F4& v) const {
        if (col >= NSM) return; F4 o;
        if (col < 2 * RW) { for (int j = 0; j < 4; ++j) { float w = w0[col + j] + v[j]; w = -softplusf_(-w) - 0.5f; o[j] = -fexp(w); } st4_f32(gs + (size_t)n * NGF + col, o); }
        else if (col < 4 * RW) { for (int j = 0; j < 4; ++j) o[j] = sigmoidf_(a0[col - 2 * RW + j] + v[j]); st4_bf16(gsb + (size_t)n * NGB + (col - 2 * RW), o); }
        else if (col < 5 * RW) st4_bf16(gsb + (size_t)n * NGB + 2 * RW + (col - 4 * RW), v);
        else { for (int j = 0; j < 4; ++j) o[j] = -softplusf_(-(v[j] + ab[col - 5 * RW + j])) * (1.0f / 16.0f); st4_f32(gs + (size_t)n * NGF + 2 * RW + (col - 5 * RW), o); }
    }
    HDM void st(const UnitInfo& u, int r, int c, const F4& v0, const F4& v1) const { const int n = 256 * u.pm + r, col = 256 * u.pn + c; half(n, col, v0); half(n, col + 128, v1); } };
struct EpiS5b { static constexpr bool PROBE = PROBE_EpiS5b; static constexpr bool PERM = true; HDM void shift() {} bf16_t* yc;
    HDM void half(const UnitInfo& u, int b, int pc, int col, const F4& lo, const F4& hi) const { const int t = col / SG_, cc = col % SG_; const int n = row_of(b, pc * CH_ + t);
        F4 ol, oh; for (int j = 0; j < 4; ++j) { ol[j] = geluf_(lo[j]); oh[j] = geluf_(hi[j]); } st8_bf16(yc + (size_t)n * SW + u.g * SG_ + cc, ol, oh); }
    HDM void st8(const UnitInfo& u, int r, int c, const F4& al, const F4& ah, const F4& bl, const F4& bh) const {
        const int m = 256 * u.pm + r; if (m >= M5) return; const int b = m / NPC, pc = m % NPC; half(u, b, pc, 256 * u.pn + c, al, ah); half(u, b, pc, 256 * u.pn + c + 128, bl, bh); } };
HD void ld4_bf16(const bf16_t* q, F4& o) {
#ifdef CPU_TEST
    for (int j = 0; j < 4; ++j) o[j] = bf2f(q[j]);
#else
    const uint2 w = *(const uint2*)q; o[0] = __uint_as_float(w.x << 16); o[1] = __uint_as_float(w.x & 0xffff0000u); o[2] = __uint_as_float(w.y << 16); o[3] = __uint_as_float(w.y & 0xffff0000u);
#endif
}
struct EpiGlu { static constexpr bool PROBE = PROBE_EpiGlu; static constexpr bool PERM = true; HDM void shift() {} bf16_t* ymix; const bf16_t* yc; const float* gb;
    HDM void half(int n, int col, const F4& lo, const F4& hi) const { if (col >= SW) return; F4 y0, y1, ol, oh; ld4_bf16(yc + (size_t)n * SW + col, y0); ld4_bf16(yc + (size_t)n * SW + col + 4, y1);
        for (int j = 0; j < 4; ++j) { ol[j] = y0[j] * sigmoidf_(lo[j] + gb[col + j]); oh[j] = y1[j] * sigmoidf_(hi[j] + gb[col + 4 + j]); } st8_bf16(ymix + (size_t)n * MIXW + RW + GWD + col, ol, oh); }
    HDM void st8(const UnitInfo& u, int r, int c, const F4& al, const F4& ah, const F4& bl, const F4& bh) const { const int n = 256 * u.pm + r, col = 256 * u.pn + c; half(n, col, al, ah); half(n, col + 128, bl, bh); } };
struct EpiRS { static constexpr bool PROBE = PROBE_EpiRS; static constexpr bool PERM = true; HDM void shift() {} float* logits; bf16_t* sact;
    HDM void st8(const UnitInfo& u, int r, int c, const F4& al, const F4& ah, const F4& bl, const F4& bh) const {
        const int n = 256 * u.pm + r;
        if (u.pn < EP / 256) { const int col = 256 * u.pn + c; if (col < E_) { st4_f32(logits + (size_t)n * E_ + col, al); st4_f32(logits + (size_t)n * E_ + col + 4, ah); } if (col + 128 < E_) { st4_f32(logits + (size_t)n * E_ + col + 128, bl); st4_f32(logits + (size_t)n * E_ + col + 132, bh); } }
        else { const int j = u.pn - EP / 256; F4 ol, oh; for (int q = 0; q < 4; ++q) { ol[q] = siluf_(al[q]) * bl[q]; oh[q] = siluf_(ah[q]) * bh[q]; } st8_bf16(sact + (size_t)n * FF_ + 128 * j + c, ol, oh); }
    } };
struct EpiUp { static constexpr bool PROBE = PROBE_EpiUp; static constexpr bool PERM = true; HDM void shift() {} bf16_t* act;
    HDM void st8(const UnitInfo& u, int r, int c, const F4& al, const F4& ah, const F4& bl, const F4& bh) const { if (r >= u.nv) return; F4 ol, oh; for (int q = 0; q < 4; ++q) { ol[q] = siluf_(al[q]) * bl[q]; oh[q] = siluf_(ah[q]) * bh[q]; } st8_bf16(act + (size_t)(u.arow0 + r) * FF_ + 128 * u.pn + c, ol, oh); } };
struct EpiDown { static constexpr bool PROBE = PROBE_EpiDown; static constexpr bool PERM = true; HDM void shift() {} bf16_t* Y;
    HDM void st8(const UnitInfo& u, int r, int c, const F4& al, const F4& ah, const F4& bl, const F4& bh) const { if (r >= u.nv) return; bf16_t* q = Y + (size_t)(u.arow0 + r) * D_ + 256 * u.pn + c; st8_bf16(q, al, ah); st8_bf16(q + 128, bl, bh); } };

#ifdef CPU_TEST
template <class Epi, class Sched> static void gemm_phase(const GemmArgs& g, const Sched& S, const Epi& E) {
    UnitInfo u; std::vector<float> arow(g.K);
    for (int i = 0; S.next(i, u); ++i)
        for (int r = 0; r < 256; ++r) {
            const int ar = g.rowmap ? g.rowmap[u.arow0 + r] : u.arow0 + r; const bf16_t* a = g.A + (size_t)ar * g.lda;
            for (int k = 0; k < g.K; ++k) arow[k] = bf2f(a[k]);
            float out[256];
            for (int c = 0; c < 256; ++c) { const bf16_t* b0 = g.Bt + (size_t)(u.brow0 + c) * g.ldb; float s0 = 0.f; for (int k = 0; k < g.K; ++k) s0 += arow[k] * bf2f(b0[k]); out[c] = s0; }
            if constexpr (Epi::PERM) { for (int c = 0; c < 128; c += 8) { F4 al, ah, bl, bh; for (int j = 0; j < 4; ++j) { al[j] = out[c + j]; ah[j] = out[c + 4 + j]; bl[j] = out[128 + c + j]; bh[j] = out[128 + c + 4 + j]; } E.st8(u, r, c, al, ah, bl, bh); } }
            else { for (int c = 0; c < 128; c += 4) { F4 v0, v1; for (int j = 0; j < 4; ++j) { v0[j] = out[c + j]; v1[j] = out[128 + c + j]; } E.st(u, r, c, v0, v1); } }
        }
}
#else
#define LAS __attribute__((address_space(3)))
typedef short bf16x8 __attribute__((ext_vector_type(8)));
constexpr int HTB = 128 * 64 * 2, STAGE_BYTES = 8 * HTB;
HD int lds_byte(int r, int c) { const int st = (r >> 4) * 2 + (c >> 5), rr = r & 15, cc = c & 31, ob = rr * 64 + cc * 2; return st * 1024 + (ob ^ (((ob >> 9) & 1) << 5)); }
HD void stage_rc(int b, int& R, int& C) { const int st = b / 1024, sb = b % 1024, swz = sb ^ (((sb >> 9) & 1) << 5); R = (st >> 1) * 16 + swz / 64; C = (st & 1) * 32 + (swz % 64) / 2; }

struct XcdBarrier; __device__ __forceinline__ void xcd_barrier(const XcdBarrier& b);
#ifndef GP_RS
#define GP_RS 0
#endif
HD int lane_id() { return (int)__builtin_amdgcn_mbcnt_hi(~0u, __builtin_amdgcn_mbcnt_lo(~0u, 0u)); }
template <bool GATHER, class Epi, class Sched>
__device__ __forceinline__ void gemm_phase(LAS unsigned char* lds, const int wid, const GemmArgs g, const Sched& S, const Epi& E, const XcdBarrier* pbar) {
    int lane = lane_id(); asm volatile("" : "+v"(lane)); const int tid = wid * 64 + lane;
    const int wr = wid >> 2, wc = wid & 3, fr = lane & 15, fq = lane >> 4;
    float zero_ = 0.f; asm volatile("" : "+v"(zero_));
    const int nt = g.K / 64;
    const unsigned ldsw = (unsigned)wid * 1024u;
    const int aoff = lds_byte(wr * 64 + fr, fq * 8), boff = lds_byte(wc * 32 + fr, fq * 8);
    const char* Ab = (const char*)g.A; const char* Bb = (const char*)g.Bt;
#define G_SA(b, h) (((b) * 2 + (h)) * HTB)
#define G_SB(b, h) ((4 + (b) * 2 + (h)) * HTB)
#define G_STAGE(bufoff, gbase, voff) do { _Pragma("unroll") for (int _i = 0; _i < 2; ++_i) \
        __builtin_amdgcn_global_load_lds((const unsigned*)((gbase) + (voff)[_i]), (LAS unsigned*)(lds + (bufoff) + ldsw + _i * 8192), 16, 0, 0); } while (0)
#define G_LDA(dst, b, h) do { _Pragma("unroll") for (int m = 0; m < 4; ++m) _Pragma("unroll") for (int k = 0; k < 2; ++k) dst[m][k] = *(const LAS bf16x8*)(lds + G_SA(b, h) + aoff + m * 2048 + k * 1024); } while (0)
#define G_LDB(dst, b, h) do { _Pragma("unroll") for (int n = 0; n < 2; ++n) _Pragma("unroll") for (int k = 0; k < 2; ++k) dst[n][k] = *(const LAS bf16x8*)(lds + G_SB(b, h) + boff + n * 2048 + k * 1024); } while (0)
#define G_MMA(ai, bj, At, Bt) do { __builtin_amdgcn_s_setprio(1); _Pragma("unroll") for (int m = 0; m < 4; ++m) _Pragma("unroll") for (int n = 0; n < 2; ++n) _Pragma("unroll") for (int k = 0; k < 2; ++k) \
        acc[ai][bj][m][n] = __builtin_amdgcn_mfma_f32_16x16x32_bf16(Bt[n][k], At[m][k], acc[ai][bj][m][n], 0, 0, 0); __builtin_amdgcn_s_setprio(0); } while (0)
#define G_WAIT_V(n) asm volatile("s_waitcnt vmcnt(" #n ")" ::: "memory")
#define G_WAIT_L(n) asm volatile("s_waitcnt lgkmcnt(" #n ")" ::: "memory")
#define G_BAR __builtin_amdgcn_s_barrier()
#define G_SCHED __builtin_amdgcn_sched_barrier(0)
    const unsigned hA = 128u * (unsigned)g.lda * 2u, hB = 128u * (unsigned)g.ldb * 2u;
#define G_SETOFF(u) do { int _t = lane_id(); asm volatile("" : "+v"(_t)); _t += wid * 64; _Pragma("unroll") for (int _i = 0; _i < 2; ++_i) { int _R, _C; stage_rc(_t * 16 + _i * 8192, _R, _C); \
        const int _Rb = Epi::PERM ? ((_R & ~31) + perm32(_R & 31)) : _R; OB[_i] = ((unsigned)((u).brow0 + _Rb) * (unsigned)g.ldb + (unsigned)_C) * 2u; \
        if (GATHER) { OA[0][_i] = ((unsigned)ld_int(g.rowmap + (u).arow0 + _R) * (unsigned)g.lda + (unsigned)_C) * 2u; OA[1][_i] = ((unsigned)ld_int(g.rowmap + (u).arow0 + 128 + _R) * (unsigned)g.lda + (unsigned)_C) * 2u; } \
        else { OA[0][_i] = ((unsigned)((u).arow0 + _R) * (unsigned)g.lda + (unsigned)_C) * 2u; } } } while (0)
#define G_STA(bufoff, h, kb) G_STAGE(bufoff, Ab + (kb) + (GATHER ? 0u : (h) * hA), OA[GATHER ? (h) : 0])
#define G_STB(bufoff, h, kb) G_STAGE(bufoff, Bb + (kb) + (h) * hB, OB)
#ifndef GP_K2
#define GP_K2 0
#endif
#ifndef GP_E2
#define GP_E2 0
#endif
    constexpr bool K2 = GP_K2 && Epi::PROBE, E2 = GP_E2 && Epi::PROBE;
    UnitInfo cur, nxt; int ui = 0;
    if (!S.next(0, cur)) return;
    F4 acc[2][2][4][2];
#pragma unroll
    for (int a = 0; a < 2; ++a)
#pragma unroll
        for (int b = 0; b < 2; ++b)
#pragma unroll
            for (int m = 0; m < 4; ++m)
#pragma unroll
                for (int n = 0; n < 2; ++n) acc[a][b][m][n] = (F4){zero_, zero_, zero_, zero_};
    bf16x8 At[4][2], B0[2][2], B1[2][2];
    unsigned OA[GATHER ? 2 : 1][2], OB[2];
    G_SETOFF(cur);
    G_STB(G_SB(0, 0), 0, 0); G_STA(G_SA(0, 0), 0, 0); G_STB(G_SB(0, 1), 1, 0); G_STA(G_SA(0, 1), 1, 0);
    if (wr == 1) G_BAR;
    G_WAIT_V(4); G_BAR;
    G_STB(G_SB(1, 0), 0, 128); G_STA(G_SA(1, 0), 0, 128); G_STB(G_SB(1, 1), 1, 128);
    G_WAIT_V(6); G_BAR;
    for (;;) {
        const bool has_next = K2 ? S.next((ui + 1) >> 1, nxt) : S.next(ui + 1, nxt);
#pragma unroll 1
        for (int t = 0; t < nt; t += 2) {
            const bool last = (t == nt - 2);
            G_LDB(B0, 0, 0); G_SCHED; G_LDA(At, 0, 0); G_STA(G_SA(1, 1), 1, (size_t)(t + 1) * 128);
            if (last && has_next) G_SETOFF(nxt);
            const size_t k2 = last ? 0 : (size_t)(t + 2) * 128, k3 = k2 + 128;
            G_WAIT_L(8); G_BAR; G_WAIT_L(0); G_MMA(0, 0, At, B0); G_BAR; G_SCHED;
            G_LDB(B1, 0, 1); G_STB(G_SB(0, 0), 0, k2);
            G_BAR; G_WAIT_L(0); G_MMA(0, 1, At, B1); G_BAR;
            G_LDA(At, 0, 1); G_STA(G_SA(0, 0), 0, k2);
            G_BAR; G_WAIT_L(0); G_MMA(1, 0, At, B0); G_BAR; G_SCHED;
            G_STB(G_SB(0, 1), 1, k2);
            G_WAIT_V(6); G_BAR; G_MMA(1, 1, At, B1); G_BAR;
            G_LDB(B0, 1, 0); G_SCHED; G_LDA(At, 1, 0); G_STA(G_SA(0, 1), 1, k2);
            G_WAIT_L(8); G_BAR; G_WAIT_L(0); G_MMA(0, 0, At, B0); G_BAR; G_SCHED;
            G_LDB(B1, 1, 1); G_STB(G_SB(1, 0), 0, k3);
            G_BAR; G_WAIT_L(0); G_MMA(0, 1, At, B1); G_BAR;
            G_LDA(At, 1, 1); G_STA(G_SA(1, 0), 0, k3);
            G_BAR; G_WAIT_L(0); G_MMA(1, 0, At, B0); G_BAR; G_SCHED;
            G_STB(G_SB(1, 1), 1, k3);
            G_WAIT_V(6); G_BAR; G_MMA(1, 1, At, B1); G_BAR;
        }
        if (!K2 || (ui & 1)) {
        if (wr == 0) G_BAR;
        int te = lane_id(); asm volatile("" : "+v"(te)); const int ewr = wid >> 2, ewc = wid & 3, efr = te & 15, efq = te >> 4;
#pragma unroll
        for (int ai = 0; ai < 2; ++ai)
#pragma unroll
            for (int m = 0; m < 4; ++m)
            { int rr = ai * 128 + ewr * 64 + m * 16 + efr; asm volatile("" : "+v"(rr) :: "memory"); const float sc_ = K2 ? 0.5f : 1.0f;
                if constexpr (Epi::PERM) { E.st8(cur, rr, ewc * 32 + 8 * efq, acc[ai][0][m][0] * sc_, acc[ai][0][m][1] * sc_, acc[ai][1][m][0] * sc_, acc[ai][1][m][1] * sc_); }
                else {
#pragma unroll
                    for (int n = 0; n < 2; ++n) { E.st(cur, rr, ewc * 32 + n * 16 + 4 * efq, acc[ai][0][m][n] * sc_, acc[ai][1][m][n] * sc_); asm volatile("" ::: "memory"); } } }
        }
        if (GP_RS && Epi::PROBE) xcd_barrier(*pbar);
        if (!has_next) break;
        if (!K2 || (ui & 1)) {
#pragma unroll
        for (int a = 0; a < 2; ++a)
#pragma unroll
            for (int b = 0; b < 2; ++b)
#pragma unroll
                for (int m = 0; m < 4; ++m)
#pragma unroll
                    for (int n = 0; n < 2; ++n) acc[a][b][m][n] = (F4){zero_, zero_, zero_, zero_};
        if (wr == 1) G_BAR;
        }
        cur = nxt; ++ui;
    }
    G_WAIT_V(0);
    if (K2 && !(ui & 1)) { if (wr == 0) G_BAR; }
    G_BAR;
    if (GP_RS && Epi::PROBE) { for (int r_ = ui + 1; r_ < S.max_units(); ++r_) xcd_barrier(*pbar); }
}
#endif
#ifndef MULTI_LAUNCH
#define FUSED 1
#endif
constexpr int NPH_PRO = 3, NPH_LAYER = 16, NPH = NPH_PRO + L_ * NPH_LAYER;

#ifdef CPU_TEST
static void rwkv_scan_all(const P& p, int l) {
    float* yr = WSP(float, yr);
    for (int d = 0; d < 2; ++d) for (int b = 0; b < B_; ++b) for (int hh = 0; hh < RH_; ++hh) {
        static float S[RN_][RN_]; memset(S, 0, sizeof(S));
        for (int idx = 0; idx < SPOS; ++idx) { const int n = row_of(b, seqpos(d, idx)); RV e[RN_]; float q = 0.f;
            for (int j = 0; j < RN_; ++j) { rwkv_elem(p, l, d, n, hh, j, 1.0f, e[j]); q += e[j].kkraw * e[j].kkraw; }
            const float rs = 1.0f / sqrtf(q + 1e-12f);
            for (int j = 0; j < RN_; ++j) { e[j].a *= rs; e[j].b *= rs; }
            for (int i = 0; i < RN_; ++i) { float sa = 0.f; for (int j = 0; j < RN_; ++j) sa += S[i][j] * e[j].a;
                float y = 0.f; for (int j = 0; j < RN_; ++j) { S[i][j] = S[i][j] * e[j].w + sa * e[j].b + e[i].v * e[j].k2; y += S[i][j] * e[j].r; }
                yr[((size_t)d * NTOK + n) * RW + hh * RN_ + i] = y; }
        }
    }
}
static void gla_scan_all(const P& p, int l) {
    float* og = WSP(float, og); const bf16_t* proj = WSP(bf16_t, proj); const float* gs = WSP(float, gs);
    for (int d = 0; d < 2; ++d) for (int b = 0; b < B_; ++b) for (int hh = 0; hh < GH_; ++hh) {
        static float S[GK_][GV_]; memset(S, 0, sizeof(S));
        for (int idx = 0; idx < SPOS; ++idx) { const int n = row_of(b, seqpos(d, idx)); const bf16_t* pr = proj + (size_t)n * NINP + GBASE;
            for (int j = 0; j < GV_; ++j) { const float v = bf2f(pr[2 * GKD + hh * GV_ + j]); float o = 0.f;
                for (int k = 0; k < GK_; ++k) { const float q = bf2f(pr[hh * GK_ + k]) * 0.17677669529663687f, kg = bf2f(pr[GKD + hh * GK_ + k]), al = fexp(gs[(size_t)n * NGF + 2 * RW + d * GKD + hh * GK_ + k]);
                    S[k][j] = S[k][j] * al + kg * v; o += q * S[k][j]; }
                og[((size_t)d * NTOK + n) * GWD + hh * GV_ + j] = o; }
        }
    }
}
#else
__device__ __forceinline__ float dpp_sum8(float v) {
    v += __builtin_bit_cast(float, __builtin_amdgcn_update_dpp(0, __builtin_bit_cast(int, v), 0xB1, 0xF, 0xF, true));
    v += __builtin_bit_cast(float, __builtin_amdgcn_update_dpp(0, __builtin_bit_cast(int, v), 0x4E, 0xF, 0xF, true));
    v += __builtin_bit_cast(float, __builtin_amdgcn_update_dpp(0, __builtin_bit_cast(int, v), 0x141, 0xF, 0xF, true));
    return v;
}
__device__ __forceinline__ float dpp_sum16(float v) {
    v = dpp_sum8(v);
    v += __builtin_bit_cast(float, __builtin_amdgcn_update_dpp(0, __builtin_bit_cast(int, v), 0x140, 0xF, 0xF, true));
    return v;
}
__device__ __forceinline__ float dpp_sum4(float v) {
    v += __builtin_bit_cast(float, __builtin_amdgcn_update_dpp(0, __builtin_bit_cast(int, v), 0xB1, 0xF, 0xF, true));
    v += __builtin_bit_cast(float, __builtin_amdgcn_update_dpp(0, __builtin_bit_cast(int, v), 0x4E, 0xF, 0xF, true));
    return v;
}
constexpr int RT = 16;
__device__ __forceinline__ void rwkv_seq_blk(const P& p, int l, int d, int b, int hh, LAS unsigned char* lds, int wid, int lane) {
    LAS float* stage = (LAS float*)lds;
    LAS float* ybuf = (LAS float*)(lds + 2 * RT * 6 * 64 * 4);
    const int r = lane >> 3, c = lane & 7, i = wid * 8 + r, cj = hh * RN_ + lane;
    const float kkc = p.rwkv_k_k[(size_t)l * RW + cj], kac = p.rwkv_k_a[(size_t)l * RW + cj];
    const bf16_t* rkv = WSP(bf16_t, rkv); const float* gs = WSP(float, gs); const bf16_t* gsb = WSP(bf16_t, gsb); float* yr = WSP(float, yr) + (size_t)d * NTOK * RW;
    float S[8];
#pragma unroll
    for (int q = 0; q < 8; ++q) S[q] = 0.f;
    float rawA[2][5], rawB[2][5];
#define RW_LOAD(chunk, raw) do { _Pragma("unroll") for (int tt = 0; tt < 2; ++tt) { const int n = __builtin_amdgcn_readfirstlane(row_of(b, seqpos(d, (chunk) * RT + 2 * wid + tt))); \
        const bf16_t* rk = rkv + (size_t)n * 3 * RW; \
        raw[tt][0] = bf2f(rk[cj]); raw[tt][1] = bf2f(rk[RW + cj]); raw[tt][2] = bf2f(rk[2 * RW + cj]); raw[tt][3] = gs[(size_t)n * NGF + d * RW + cj]; raw[tt][4] = bf2f(gsb[(size_t)n * NGB + d * RW + cj]); } } while (0)
#define RW_PUT(buf, raw) do { _Pragma("unroll") for (int tt = 0; tt < 2; ++tt) { const float k = raw[tt][1], a = raw[tt][4], kkraw = k * kkc; \
        const float kk = kkraw * (1.0f / sqrtf(WSUM(kkraw * kkraw) + 1e-12f)); LAS float* sv = stage + (((buf) * RT + 2 * wid + tt) * 6) * 64 + lane; \
        sv[0] = fexp(raw[tt][3]); sv[64] = k * (1.0f + (a - 1.0f) * kac); sv[128] = -kk; sv[192] = kk * a; sv[256] = raw[tt][0]; sv[320] = raw[tt][2]; } } while (0)
#define RW_YST(ch_, buf_) do { _Pragma("unroll") for (int tt = 0; tt < 2; ++tt) { const int n = __builtin_amdgcn_readfirstlane(row_of(b, seqpos(d, (ch_) * RT + 2 * wid + tt))); \
        const LAS float* yp = ybuf + (((buf_) * RT + 2 * wid + tt) * 64 + lane) * 8; const F4 ya = *(const LAS F4*)yp, yb = *(const LAS F4*)(yp + 4); \
        yr[(size_t)n * RW + cj] = ((ya[0] + ya[1]) + (ya[2] + ya[3])) + ((yb[0] + yb[1]) + (yb[2] + yb[3])); } } while (0)
    RW_LOAD(0, rawA); RW_PUT(0, rawA); RW_LOAD(1, rawB);
    __syncthreads();
    constexpr int NCH = SPOS / RT; static_assert(NCH % 2 == 0, "chunk pairs");
    for (int ch = 0; ch < NCH; ch += 2) {
        {
            constexpr int buf = 0;
            if (ch + 2 < NCH) RW_LOAD(ch + 2, rawA);
        { F4 cw0, cw1, ck0, ck1, ca0, ca1, cb0, cb1, cr0, cr1; float cvi;
#define RW_LDV(t_, W0, W1, K0, K1, A0, A1, B0, B1, R0, R1, VI) do { const LAS float* sv = stage + ((buf * RT + (t_)) * 6) * 64 + 8 * c; \
            W0 = *(const LAS F4*)(sv); W1 = *(const LAS F4*)(sv + 4); K0 = *(const LAS F4*)(sv + 64); K1 = *(const LAS F4*)(sv + 68); A0 = *(const LAS F4*)(sv + 128); A1 = *(const LAS F4*)(sv + 132); \
            B0 = *(const LAS F4*)(sv + 192); B1 = *(const LAS F4*)(sv + 196); R0 = *(const LAS F4*)(sv + 256); R1 = *(const LAS F4*)(sv + 260); VI = sv[320 - 8 * c + i]; } while (0)
          RW_LDV(0, cw0, cw1, ck0, ck1, ca0, ca1, cb0, cb1, cr0, cr1, cvi);
#pragma unroll
          for (int t = 0; t < RT; ++t) {
            F4 nw0 = cw0, nw1 = cw1, nk0 = ck0, nk1 = ck1, na0 = ca0, na1 = ca1, nb0 = cb0, nb1 = cb1, nr0 = cr0, nr1 = cr1; float nvi = cvi;
            if (t + 1 < RT) RW_LDV(t + 1, nw0, nw1, nk0, nk1, na0, na1, nb0, nb1, nr0, nr1, nvi);
            float sa = ((S[0] * ca0[0] + S[1] * ca0[1]) + (S[2] * ca0[2] + S[3] * ca0[3])) + ((S[4] * ca1[0] + S[5] * ca1[1]) + (S[6] * ca1[2] + S[7] * ca1[3]));
            sa = dpp_sum8(sa);
            float y0 = 0.f, y1 = 0.f;
#pragma unroll
            for (int q = 0; q < 4; ++q) { S[q] = S[q] * cw0[q] + (sa * cb0[q] + cvi * ck0[q]); y0 += S[q] * cr0[q]; S[4 + q] = S[4 + q] * cw1[q] + (sa * cb1[q] + cvi * ck1[q]); y1 += S[4 + q] * cr1[q]; }
            ybuf[((buf * RT + t) * 64 + i) * 8 + c] = y0 + y1;
            cw0 = nw0; cw1 = nw1; ck0 = nk0; ck1 = nk1; ca0 = na0; ca1 = na1; cb0 = nb0; cb1 = nb1; cr0 = nr0; cr1 = nr1; cvi = nvi;
          }
#undef RW_LDV
        }
            RW_PUT(1, rawB);
            __syncthreads();
            RW_YST(ch, 0);
        }
        {
            constexpr int buf = 1;
            if (ch + 3 < NCH) RW_LOAD(ch + 3, rawB);
        { F4 cw0, cw1, ck0, ck1, ca0, ca1, cb0, cb1, cr0, cr1; float cvi;
#define RW_LDV(t_, W0, W1, K0, K1, A0, A1, B0, B1, R0, R1, VI) do { const LAS float* sv = stage + ((buf * RT + (t_)) * 6) * 64 + 8 * c; \
            W0 = *(const LAS F4*)(sv); W1 = *(const LAS F4*)(sv + 4); K0 = *(const LAS F4*)(sv + 64); K1 = *(const LAS F4*)(sv + 68); A0 = *(const LAS F4*)(sv + 128); A1 = *(const LAS F4*)(sv + 132); \
            B0 = *(const LAS F4*)(sv + 192); B1 = *(const LAS F4*)(sv + 196); R0 = *(const LAS F4*)(sv + 256); R1 = *(const LAS F4*)(sv + 260); VI = sv[320 - 8 * c + i]; } while (0)
          RW_LDV(0, cw0, cw1, ck0, ck1, ca0, ca1, cb0, cb1, cr0, cr1, cvi);
#pragma unroll
          for (int t = 0; t < RT; ++t) {
            F4 nw0 = cw0, nw1 = cw1, nk0 = ck0, nk1 = ck1, na0 = ca0, na1 = ca1, nb0 = cb0, nb1 = cb1, nr0 = cr0, nr1 = cr1; float nvi = cvi;
            if (t + 1 < RT) RW_LDV(t + 1, nw0, nw1, nk0, nk1, na0, na1, nb0, nb1, nr0, nr1, nvi);
            float sa = ((S[0] * ca0[0] + S[1] * ca0[1]) + (S[2] * ca0[2] + S[3] * ca0[3])) + ((S[4] * ca1[0] + S[5] * ca1[1]) + (S[6] * ca1[2] + S[7] * ca1[3]));
            sa = dpp_sum8(sa);
            float y0 = 0.f, y1 = 0.f;
#pragma unroll
            for (int q = 0; q < 4; ++q) { S[q] = S[q] * cw0[q] + (sa * cb0[q] + cvi * ck0[q]); y0 += S[q] * cr0[q]; S[4 + q] = S[4 + q] * cw1[q] + (sa * cb1[q] + cvi * ck1[q]); y1 += S[4 + q] * cr1[q]; }
            ybuf[((buf * RT + t) * 64 + i) * 8 + c] = y0 + y1;
            cw0 = nw0; cw1 = nw1; ck0 = nk0; ck1 = nk1; ca0 = na0; ca1 = na1; cb0 = nb0; cb1 = nb1; cr0 = nr0; cr1 = nr1; cvi = nvi;
          }
#undef RW_LDV
        }
            if (ch + 2 < NCH) RW_PUT(0, rawA);
            __syncthreads();
            RW_YST(ch + 1, 1);
        }
    }
    __syncthreads();
#undef RW_YST
#undef RW_LOAD
#undef RW_PUT
}
__device__ __forceinline__ void gla_seq_wave(const P& p, int l, int d, int b, int hh, int hv, LAS float* st, int lane) {
    float S[2][8];
#pragma unroll
    for (int k = 0; k < 8; ++k) { S[0][k] = 0.f; S[1][k] = 0.f; }
    const int vp = lane >> 2, kg = lane & 3;
    float* og = WSP(float, og) + (size_t)d * NTOK * GWD; const bf16_t* proj = WSP(bf16_t, proj); const float* gs = WSP(float, gs);
    constexpr int SB = RT * 128;
    const int kh = lane >> 5, jj = lane & 31;
    float vec[24], vv[RT / 2];
#define GL_LOAD(chunk) do { _Pragma("unroll") for (int it = 0; it < 8; ++it) { const int n = row_of(b, seqpos(d, (chunk) * RT + 2 * it + kh)); const bf16_t* pr = proj + (size_t)n * NINP + GBASE + hh * GK_ + jj; \
        vec[3 * it] = bf2f(pr[0]) * 0.17677669529663687f; vec[3 * it + 1] = bf2f(pr[GKD]); vec[3 * it + 2] = gs[(size_t)n * NGF + 2 * RW + d * GKD + hh * GK_ + jj]; \
        vv[it] = bf2f(pr[2 * GKD - hh * GK_ + hh * GV_ + 32 * hv]); } } while (0)
#define GL_PUT(buf) do { _Pragma("unroll") for (int it = 0; it < 8; ++it) { LAS float* q = st + (buf) * SB + (2 * it + kh) * 128 + jj; q[0] = vec[3 * it]; q[32] = vec[3 * it + 1]; q[64] = fexp(vec[3 * it + 2]); q[96] = vv[it]; } } while (0)
#define WAVE_SYNC() do { __builtin_amdgcn_fence(__ATOMIC_RELEASE, "wavefront"); __builtin_amdgcn_wave_barrier(); __builtin_amdgcn_fence(__ATOMIC_ACQUIRE, "wavefront"); } while (0)
    GL_LOAD(0); GL_PUT(0); WAVE_SYNC();
    constexpr int NCH = SPOS / RT;
    for (int ch = 0; ch < NCH; ++ch) {
        const int buf = ch & 1;
        if (ch + 1 < NCH) GL_LOAD(ch + 1);
        { typedef float F2 __attribute__((ext_vector_type(2))); F4 cq[2], ck[2], ca[2]; F2 cv;
#define GL_LDV(t_, Q, K, A, V) do { const LAS float* sv = st + buf * SB + (t_) * 128 + 8 * kg; _Pragma("unroll") for (int k4 = 0; k4 < 2; ++k4) { Q[k4] = *(const LAS F4*)(sv + 4 * k4); K[k4] = *(const LAS F4*)(sv + 32 + 4 * k4); A[k4] = *(const LAS F4*)(sv + 64 + 4 * k4); } \
            V = *(const LAS F2*)(st + buf * SB + (t_) * 128 + 96 + 2 * vp); } while (0)
          GL_LDV(0, cq, ck, ca, cv);
#pragma unroll
          for (int t = 0; t < RT; ++t) {
            F4 nq[2], nk[2], na[2]; F2 nv = cv;
#pragma unroll
            for (int k4 = 0; k4 < 2; ++k4) { nq[k4] = cq[k4]; nk[k4] = ck[k4]; na[k4] = ca[k4]; }
            if (t + 1 < RT) GL_LDV(t + 1, nq, nk, na, nv);
            float o0 = 0.f, o1 = 0.f;
#pragma unroll
            for (int k4 = 0; k4 < 2; ++k4)
#pragma unroll
                for (int q = 0; q < 4; ++q) { S[0][4 * k4 + q] = S[0][4 * k4 + q] * ca[k4][q] + ck[k4][q] * cv[0]; o0 += cq[k4][q] * S[0][4 * k4 + q]; S[1][4 * k4 + q] = S[1][4 * k4 + q] * ca[k4][q] + ck[k4][q] * cv[1]; o1 += cq[k4][q] * S[1][4 * k4 + q]; }
            o0 = dpp_sum4(o0); o1 = dpp_sum4(o1);
            const int n = __builtin_amdgcn_readfirstlane(row_of(b, seqpos(d, ch * RT + t)));
            if (kg == 0) { F2 oo; oo[0] = o0; oo[1] = o1; *(F2*)(og + (size_t)n * GWD + hh * GV_ + 32 * hv + 2 * vp) = oo; }
#pragma unroll
            for (int k4 = 0; k4 < 2; ++k4) { cq[k4] = nq[k4]; ck[k4] = nk[k4]; ca[k4] = na[k4]; }
            cv = nv;
          }
#undef GL_LDV
        }
        if (ch + 1 < NCH) GL_PUT(buf ^ 1);
        WAVE_SYNC();
    }
#undef GL_LOAD
#undef GL_PUT
}
#define BSYNC() do { asm volatile("s_waitcnt lgkmcnt(0)" ::: "memory"); __builtin_amdgcn_s_barrier(); asm volatile("" ::: "memory"); } while (0)
template <int M, int N, int K, int NW, class F>
__device__ __forceinline__ void bmm(const LAS bf16_t* A, int lda, const LAS bf16_t* Bt, int ldb, int w, int lane, F f) {
    const int r = lane & 15, q = lane >> 4;
#pragma unroll 1
    for (int t = w; t < (M / 16) * (N / 16); t += NW) { const int tm = t / (N / 16), tn = t % (N / 16); F4 acc = (F4){0.f, 0.f, 0.f, 0.f};
#pragma unroll
        for (int kk = 0; kk < K / 32; ++kk) { const bf16x8 a = *(const LAS bf16x8*)(A + (tm * 16 + r) * lda + kk * 32 + 8 * q), bb = *(const LAS bf16x8*)(Bt + (tn * 16 + r) * ldb + kk * 32 + 8 * q);
            acc = __builtin_amdgcn_mfma_f32_16x16x32_bf16(a, bb, acc, 0, 0, 0); }
        f(tm * 16 + 4 * q, tn * 16 + r, acc); }
}
template <int M, int N, int K1, int K2, int NW, class F>
__device__ __forceinline__ void bmm2(const LAS bf16_t* A1, int lda1, const LAS bf16_t* Bt1, int ldb1, const LAS bf16_t* A2, int lda2, const LAS bf16_t* Bt2, int ldb2, int w, int lane, F f) {
    const int r = lane & 15, q = lane >> 4;
#pragma unroll 1
    for (int t = w; t < (M / 16) * (N / 16); t += NW) { const int tm = t / (N / 16), tn = t % (N / 16); F4 acc = (F4){0.f, 0.f, 0.f, 0.f};
#pragma unroll
        for (int kk = 0; kk < K1 / 32; ++kk) { const bf16x8 a = *(const LAS bf16x8*)(A1 + (tm * 16 + r) * lda1 + kk * 32 + 8 * q), bb = *(const LAS bf16x8*)(Bt1 + (tn * 16 + r) * ldb1 + kk * 32 + 8 * q);
            acc = __builtin_amdgcn_mfma_f32_16x16x32_bf16(a, bb, acc, 0, 0, 0); }
#pragma unroll
        for (int kk = 0; kk < K2 / 32; ++kk) { const bf16x8 a = *(const LAS bf16x8*)(A2 + (tm * 16 + r) * lda2 + kk * 32 + 8 * q), bb = *(const LAS bf16x8*)(Bt2 + (tn * 16 + r) * ldb2 + kk * 32 + 8 * q);
            acc = __builtin_amdgcn_mfma_f32_16x16x32_bf16(a, bb, acc, 0, 0, 0); }
        f(tm * 16 + 4 * q, tn * 16 + r, acc); }
}
template <int M, int N, int K1, int K2, int K3, int NW, class F>
__device__ __forceinline__ void bmm3(const LAS bf16_t* A1, int lda1, const LAS bf16_t* Bt1, int ldb1, const LAS bf16_t* A2, int lda2, const LAS bf16_t* Bt2, int ldb2,
                                     const LAS bf16_t* A3, int lda3, const LAS bf16_t* Bt3, int ldb3, int w, int lane, F f) {
    const int r = lane & 15, q = lane >> 4;
#pragma unroll 1
    for (int t = w; t < (M / 16) * (N / 16); t += NW) { const int tm = t / (N / 16), tn = t % (N / 16); F4 acc = (F4){0.f, 0.f, 0.f, 0.f};
#pragma unroll
        for (int kk = 0; kk < K1 / 32; ++kk) acc = __builtin_amdgcn_mfma_f32_16x16x32_bf16(*(const LAS bf16x8*)(A1 + (tm * 16 + r) * lda1 + kk * 32 + 8 * q), *(const LAS bf16x8*)(Bt1 + (tn * 16 + r) * ldb1 + kk * 32 + 8 * q), acc, 0, 0, 0);
#pragma unroll
        for (int kk = 0; kk < K2 / 32; ++kk) acc = __builtin_amdgcn_mfma_f32_16x16x32_bf16(*(const LAS bf16x8*)(A2 + (tm * 16 + r) * lda2 + kk * 32 + 8 * q), *(const LAS bf16x8*)(Bt2 + (tn * 16 + r) * ldb2 + kk * 32 + 8 * q), acc, 0, 0, 0);
#pragma unroll
        for (int kk = 0; kk < K3 / 32; ++kk) acc = __builtin_amdgcn_mfma_f32_16x16x32_bf16(*(const LAS bf16x8*)(A3 + (tm * 16 + r) * lda3 + kk * 32 + 8 * q), *(const LAS bf16x8*)(Bt3 + (tn * 16 + r) * ldb3 + kk * 32 + 8 * q), acc, 0, 0, 0);
        f(tm * 16 + 4 * q, tn * 16 + r, acc); }
}
typedef unsigned u32x2_t __attribute__((ext_vector_type(2)));
typedef unsigned u32x4_t __attribute__((ext_vector_type(4)));
__device__ __forceinline__ unsigned gload_u16(const bf16_t* p) { unsigned x; asm volatile("global_load_ushort %0, %1, off" : "=v"(x) : "v"(p) : "memory"); return x; }
template <int OFF> __device__ __forceinline__ unsigned gload_u16s(const void* sbase, unsigned voff) { unsigned x; asm volatile("global_load_ushort %0, %1, %2 offset:%3" : "=v"(x) : "v"(voff), "s"(sbase), "n"(OFF) : "memory"); return x; }
__device__ __forceinline__ float gload_f32s(const void* sbase, unsigned voff) { float x; asm volatile("global_load_dword %0, %1, %2" : "=v"(x) : "v"(voff), "s"(sbase) : "memory"); return x; }
__device__ __forceinline__ float gload_f32(const float* p) { float x; asm volatile("global_load_dword %0, %1, off" : "=v"(x) : "v"(p) : "memory"); return x; }
__device__ __forceinline__ void rwkv_chunk_blk(const P& p, int l, int d, int b, int hh, LAS unsigned char* lds, int wid, int lane) {
    static_assert(RN_ == 64 && RT == 16, "rwkv chunk geometry");
#define ZF ((LAS float*)lds)
#define ZT ((LAS bf16_t*)(lds + 16384))
#define RHS ((LAS float*)(lds + 34816))
#define LW ((LAS float*)(lds + 38912))
#define UT ((LAS bf16_t*)(lds + 43008))
#define SETB(s) (lds + 48128 + (s) * 29952)
#define AT(s) ((LAS bf16_t*)SETB(s))
#define RTm(s) (AT(s) + 16 * 72)
#define BH(s) (AT(s) + 32 * 72)
#define KH(s) (AT(s) + 48 * 72)
#define BHT(s) ((LAS bf16_t*)(SETB(s) + 9216))
#define KHT(s) (BHT(s) + 64 * 40)
#define VT(s) (BHT(s) + 128 * 40)
#define MAK(s) ((LAS bf16_t*)(SETB(s) + 24576))
#define MRB(s) (MAK(s) + 16 * 40)
#define MRK(s) (MAK(s) + 32 * 40)
#define MABF(s) ((LAS float*)(SETB(s) + 28416))
#define PL(s) ((LAS float*)(SETB(s) + 29440))
#define NR(s) ((LAS int*)(SETB(s) + 29696))
    const int tid = wid * 64 + lane, cj = hh * RN_ + lane;
    const float kkc = p.rwkv_k_k[(size_t)l * RW + cj], kac = p.rwkv_k_a[(size_t)l * RW + cj];
    const bf16_t* rkv = WSP(bf16_t, rkv); const float* gs = WSP(float, gs); const bf16_t* gsb = WSP(bf16_t, gsb); bf16_t* yr = (bf16_t*)WSP(float, yr) + (size_t)d * NTOK * RW;
    F4 za = (F4){0.f, 0.f, 0.f, 0.f}, zb = za;
    for (int i = tid; i < 2 * 64 * 72; i += 512) ZT[i] = 0;
    for (int i = tid; i < 64 * 40; i += 512) UT[i] = 0;
    for (int i = tid; i < 2 * 29952 / 2; i += 512) AT(0)[i] = 0;
    const int ntk = wid == 0 ? 0 : ((wid == 4 || wid == 5) ? 3 : 2);
#define TKI(tt) ((tt) < 2 ? 2 * wid + (tt) : wid - 4)
    unsigned rawu[3][4]; float rawf[3]; int rn[3];
    const unsigned vo2 = (unsigned)cj * 2u, vo4 = (unsigned)cj * 4u;
#define RC_LOAD(chunk) do { _Pragma("unroll") for (int tt = 0; tt < 3; ++tt) { const int n = __builtin_amdgcn_readfirstlane(row_of(b, seqpos(d, (chunk) * RT + (tt < ntk ? TKI(tt) : 0)))); rn[tt] = n;        \
        const bf16_t* rk = rkv + (size_t)n * 3 * RW; const float* gp = gs + (size_t)n * NGF + d * RW; const bf16_t* gb = gsb + (size_t)n * NGB + d * RW; \
        rawu[tt][0] = gload_u16s<0>(rk, vo2); rawu[tt][1] = gload_u16s<2 * RW>(rk, vo2); rawu[tt][2] = gload_u16s<4 * RW>(rk, vo2); rawf[tt] = gload_f32s(gp, vo4); rawu[tt][3] = gload_u16s<0>(gb, vo2); } } while (0)
    float vr[3], vk2[3], va[3], vb[3], vv[3], vlw[3];
#define RC_RETIRE() do { asm volatile("s_waitcnt vmcnt(0)" ::: "memory"); _Pragma("unroll") for (int tt = 0; tt < 3; ++tt) { asm volatile("" : "+v"(rawu[tt][0]), "+v"(rawu[tt][1]), "+v"(rawu[tt][2]), "+v"(rawu[tt][3]), "+v"(rawf[tt])); } } while (0)
#define RC_P0(s) do { \
        _Pragma("unroll") for (int tt = 0; tt < 3; ++tt) if (tt < ntk) { const float k = bf2f((bf16_t)rawu[tt][1]), a = bf2f((bf16_t)rawu[tt][3]), kkraw = k * kkc; const float kk = kkraw * __builtin_amdgcn_rsqf(WSUM(kkraw * kkraw) + 1e-12f); \
            vr[tt] = bf2f((bf16_t)rawu[tt][0]); vk2[tt] = k * (1.0f + (a - 1.0f) * kac); va[tt] = -kk; vb[tt] = kk * a; vv[tt] = bf2f((bf16_t)rawu[tt][2]); vlw[tt] = rawf[tt]; \
            LW[TKI(tt) * 64 + lane] = vlw[tt]; if (lane == 0) NR(s)[TKI(tt)] = rn[tt]; } } while (0)
#define RC_TOK(s, t_, lp_, tt) do { const int t = (t_); const float lp = (lp_); const float em = fexp(lp - vlw[tt]), ep = fexp(lp), en = fexp(-lp); \
            AT(s)[t * 72 + lane] = f2bf(va[tt] * em); RTm(s)[t * 72 + lane] = f2bf(vr[tt] * ep); const bf16_t bh = f2bf(vb[tt] * en), kh = f2bf(vk2[tt] * en); \
            BH(s)[t * 72 + lane] = bh; KH(s)[t * 72 + lane] = kh; BHT(s)[lane * 40 + t] = bh; KHT(s)[lane * 40 + t] = kh; VT(s)[lane * 40 + t] = f2bf(vv[tt]); \
            if (t == RT - 1) PL(s)[lane] = ep; } while (0)
#define RC_P0B(s) do { if (ntk) { float lpb = 0.f, lpc = 0.f; const float l0 = LW[lane]; \
            _Pragma("unroll") for (int q = 0; q < RT - 2; q += 2) { const float x0 = LW[q * 64 + lane], x1 = LW[(q + 1) * 64 + lane]; const bool on = q < 2 * wid; lpb += on ? x0 : 0.f; lpc += on ? x1 : 0.f; } \
            lpb += lpc; lpb += vlw[0]; RC_TOK(s, 2 * wid, lpb, 0); lpb += vlw[1]; RC_TOK(s, 2 * wid + 1, lpb, 1); \
            if (ntk == 3) { const float lp3 = (wid == 5 ? l0 : 0.f) + vlw[2]; RC_TOK(s, wid - 4, lp3, 2); } } } while (0)
#define RC_P1(s, w4) do { const LAS bf16_t* Aop = ((w4) < 2) ? AT(s) : RTm(s); const LAS bf16_t* Bop = ((w4) & 1) ? KH(s) : BH(s); \
            bmm<16, 16, 64, 1>(Aop, 72, Bop, 72, 0, lane, [&](int r0, int cc, const F4& acc) { \
                _Pragma("unroll") for (int j = 0; j < 4; ++j) { const int rr = r0 + j; const bool keep = ((w4) < 2) ? (cc < rr) : (cc <= rr); const float val = keep ? acc[j] : 0.f; \
                    if ((w4) == 0) MABF(s)[cc * 16 + rr] = val; else if ((w4) == 1) MAK(s)[rr * 40 + cc] = f2bf(val); else if ((w4) == 2) MRB(s)[rr * 40 + cc] = f2bf(val); else MRK(s)[rr * 40 + cc] = f2bf(val); } }); } while (0)
    constexpr int NCH = SPOS / RT;
    RC_LOAD(0);
    __syncthreads();
    RC_RETIRE(); RC_P0(0); BSYNC(); RC_LOAD(1); RC_P0B(0); BSYNC(); if (wid < 4) RC_P1(0, wid); BSYNC();
    F4 yacc = (F4){0.f, 0.f, 0.f, 0.f}; int yrow[4] = {0, 0, 0, 0}; int ycol = 0;
#define RC_YST() do { _Pragma("unroll") for (int j = 0; j < 4; ++j) yr[(size_t)yrow[j] * RW + ycol] = f2bf(yacc[j]); } while (0)
    for (int ch = 0; ch < NCH; ++ch) {
        int lnv = lane; asm volatile("" : "+v"(lnv)); const int lane = lnv;
        const int cs = ch & 1, ns = cs ^ 1; LAS bf16_t* ZTc = ZT + cs * 64 * 72; LAS bf16_t* ZTn = ZT + ns * 64 * 72; const bool more = ch + 1 < NCH;
        if (wid < 4) bmm3<16, 64, 64, 32, 0, 4>(AT(cs), 72, ZTc, 72, MAK(cs), 40, VT(cs), 40, AT(cs), 72, ZTc, 72, wid, lane, [&](int r0, int cc, const F4& acc) {
#pragma unroll
            for (int j = 0; j < 4; ++j) RHS[(r0 + j) * 64 + cc] = acc[j]; });
        RC_RETIRE();
        if (wid < 4 && ch > 0) RC_YST();
        if (more) RC_P0(ns);
        typedef float F2 __attribute__((ext_vector_type(2)));
        constexpr int MPRE = 6;
        F2 mm[RT - 1][RT / 2];
        if (wid == 0) { unsigned mtb = (unsigned)(size_t)MABF(cs); asm volatile("" : "+v"(mtb)); const LAS float* MT = (const LAS float*)(size_t)mtb;
#pragma unroll
            for (int s = 0; s < MPRE; ++s) {
#pragma unroll
                for (int i = (s + 1) >> 1; i < RT / 2; ++i) mm[s][i] = *(const LAS F2*)(MT + s * 16 + 2 * i); } }
        BSYNC();
        RC_LOAD(ch + 2 < NCH ? ch + 2 : NCH - 1);
        if (wid == 0) {
            __builtin_amdgcn_s_setprio(2);
            F2 acc2[RT / 2];
#pragma unroll
            for (int i = 0; i < RT / 2; ++i) { acc2[i][0] = RHS[(2 * i) * 64 + lane]; acc2[i][1] = RHS[(2 * i + 1) * 64 + lane]; }
#pragma unroll
            for (int s = 0; s < RT - 1; ++s) { const float u = acc2[s >> 1][s & 1]; const F2 uu = (F2){u, u};
                if (s == 2) { asm volatile("" ::: "memory"); unsigned mtb = (unsigned)(size_t)MABF(cs); asm volatile("" : "+v"(mtb)); const LAS float* MT = (const LAS float*)(size_t)mtb;
#pragma unroll
                    for (int s2 = MPRE; s2 < RT - 1; ++s2) {
#pragma unroll
                        for (int i = (s2 + 1) >> 1; i < RT / 2; ++i) mm[s2][i] = *(const LAS F2*)(MT + s2 * 16 + 2 * i); } }
#pragma unroll
                for (int i = (s + 1) >> 1; i < RT / 2; ++i) acc2[i] = __builtin_elementwise_fma(mm[s][i], uu, acc2[i]); }
#pragma unroll
            for (int i = 0; i < RT / 2; ++i) { UT[lane * 40 + 2 * i] = f2bf(acc2[i][0]); UT[lane * 40 + 2 * i + 1] = f2bf(acc2[i][1]); }
            __builtin_amdgcn_s_setprio(0); }
        if (more) RC_P0B(ns);
        BSYNC();
        if (wid < 4) bmm3<16, 64, 64, 32, 32, 4>(RTm(cs), 72, ZTc, 72, MRB(cs), 40, UT, 40, MRK(cs), 40, VT(cs), 40, wid, lane, [&](int r0, int cc, const F4& acc) {
#pragma unroll
            for (int j = 0; j < 4; ++j) yrow[j] = NR(cs)[r0 + j];
            yacc = acc; ycol = hh * RN_ + cc; });
        else if (more) RC_P1(ns, wid - 4);
        {
            const int r = lane & 15, q = lane >> 4, tn = wid & 3, cc = tn * 16 + r;
            typedef __bf16 bf2_t __attribute__((ext_vector_type(2))); typedef float F2s __attribute__((ext_vector_type(2)));
#pragma unroll
            for (int h = 0; h < 2; ++h) { const int tm = (wid >> 2) + 2 * h, r0 = tm * 16 + 4 * q; F4 acc = (F4){0.f, 0.f, 0.f, 0.f};
                acc = __builtin_amdgcn_mfma_f32_16x16x32_bf16(*(const LAS bf16x8*)(BHT(cs) + (tm * 16 + r) * 40 + 8 * q), *(const LAS bf16x8*)(UT + cc * 40 + 8 * q), acc, 0, 0, 0);
                acc = __builtin_amdgcn_mfma_f32_16x16x32_bf16(*(const LAS bf16x8*)(KHT(cs) + (tm * 16 + r) * 40 + 8 * q), *(const LAS bf16x8*)(VT(cs) + cc * 40 + 8 * q), acc, 0, 0, 0);
                const F4 pl = *(const LAS F4*)(PL(cs) + r0);
                const F4 zn = pl * ((h ? zb : za) + acc); if (h) zb = zn; else za = zn;
                const bf2_t p01 = __builtin_convertvector((F2s){zn[0], zn[1]}, bf2_t), p23 = __builtin_convertvector((F2s){zn[2], zn[3]}, bf2_t);
                u32x2_t w2; w2[0] = __builtin_bit_cast(unsigned, p01); w2[1] = __builtin_bit_cast(unsigned, p23);
                *(LAS u32x2_t*)(ZTn + cc * 72 + r0) = w2; } }
        BSYNC();
    }
    RC_RETIRE();
    if (wid < 4) RC_YST();
    __syncthreads();
#undef RC_YST
#undef RC_RETIRE
#undef RC_LOAD
#undef RC_P0
#undef RC_P0B
#undef RC_TOK
#undef TKI
#undef RC_P1
#undef ZF
#undef ZT
#undef RHS
#undef LW
#undef UT
#undef SETB
#undef AT
#undef RTm
#undef BH
#undef KH
#undef BHT
#undef KHT
#undef VT
#undef MAK
#undef MRB
#undef MRK
#undef MABF
#undef PL
#undef NR
}
__device__ __forceinline__ u32x2_t gload_x2(const void* p) { u32x2_t x; asm volatile("global_load_dwordx2 %0, %1, off" : "=v"(x) : "v"(p) : "memory"); return x; }
__device__ __forceinline__ u32x4_t gload_x4(const void* p) { u32x4_t x; asm volatile("global_load_dwordx4 %0, %1, off" : "=v"(x) : "v"(p) : "memory"); return x; }
template <int K1, int K2>
__device__ __forceinline__ F4 bmm2_tile(const LAS bf16_t* A1, int lda1, const LAS bf16_t* Bt1, int ldb1, const LAS bf16_t* A2, int lda2, const LAS bf16_t* Bt2, int ldb2, int tm, int tn, int lane) {
    const int r = lane & 15, q = lane >> 4; F4 acc = (F4){0.f, 0.f, 0.f, 0.f};
#pragma unroll
    for (int kk = 0; kk < K1 / 32; ++kk) acc = __builtin_amdgcn_mfma_f32_16x16x32_bf16(*(const LAS bf16x8*)(A1 + (tm * 16 + r) * lda1 + kk * 32 + 8 * q), *(const LAS bf16x8*)(Bt1 + (tn * 16 + r) * ldb1 + kk * 32 + 8 * q), acc, 0, 0, 0);
#pragma unroll
    for (int kk = 0; kk < K2 / 32; ++kk) acc = __builtin_amdgcn_mfma_f32_16x16x32_bf16(*(const LAS bf16x8*)(A2 + (tm * 16 + r) * lda2 + kk * 32 + 8 * q), *(const LAS bf16x8*)(Bt2 + (tn * 16 + r) * ldb2 + kk * 32 + 8 * q), acc, 0, 0, 0);
    return acc;
}
__device__ __forceinline__ void gla_chunk_blk(const P& p, int l, int d, int b, int hh, LAS unsigned char* lds, int wid, int lane) {
    static_assert(GK_ == 32 && GV_ == 64 && CH_ == 64, "gla chunk geometry");
    const int tid = wid * 64 + lane;
    LAS float* LA = (LAS float*)lds;
    LAS float* QR = (LAS float*)(lds + 8192);
    LAS float* KR = (LAS float*)(lds + 16384);
    LAS float* SF = (LAS float*)(lds + 24576);
    LAS bf16_t* QIN = (LAS bf16_t*)(lds + 32768);
    LAS bf16_t* KIN = (LAS bf16_t*)(lds + 32768 + 5120);
    LAS bf16_t* STT = (LAS bf16_t*)(lds + 32768 + 10240);
    LAS bf16_t* KSTT = (LAS bf16_t*)(lds + 32768 + 15360);
    LAS bf16_t* VT = (LAS bf16_t*)(lds + 32768 + 19968);
    LAS bf16_t* ATT = (LAS bf16_t*)(lds + 32768 + 29184);
    LAS int* NR = (LAS int*)(lds + 32768 + 38400);
    const bf16_t* proj = WSP(bf16_t, proj); const float* gs = WSP(float, gs); bf16_t* og = (bf16_t*)WSP(float, og) + (size_t)d * NTOK * GWD;
    for (int i = tid; i < 32 * 64; i += 512) SF[i] = 0.f;
    for (int i = tid; i < 64 * 40; i += 512) STT[i] = 0;
    const int t = tid >> 3, k4 = (tid & 7) * 4, v8 = (tid & 7) * 8;
    u32x2_t rq, rk; u32x4_t rv, rla; int rn_;
#define GC_LOAD(c_) do { rn_ = row_of(b, seqpos(d, (c_) * 64 + t)); const bf16_t* pr = proj + (size_t)rn_ * NINP + GBASE; \
        rq = gload_x2(pr + hh * GK_ + k4); rk = gload_x2(pr + GKD + hh * GK_ + k4); rv = gload_x4(pr + 2 * GKD + hh * GV_ + v8); rla = gload_x4(gs + (size_t)rn_ * NGF + 2 * RW + d * GKD + hh * GK_ + k4); } while (0)
#define GC_WAIT() do { asm volatile("s_waitcnt vmcnt(0)" ::: "memory"); asm volatile("" : "+v"(rq), "+v"(rk), "+v"(rv), "+v"(rla)); } while (0)
#define GC_PUT() do { _Pragma("unroll") for (int j = 0; j < 4; ++j) { const unsigned wq = rq[j >> 1], wk = rk[j >> 1]; const float qf = __builtin_bit_cast(float, (j & 1) ? (wq & 0xFFFF0000u) : (wq << 16)), kf = __builtin_bit_cast(float, (j & 1) ? (wk & 0xFFFF0000u) : (wk << 16)); \
            QR[t * 32 + k4 + j] = qf * 0.17677669529663687f; KR[t * 32 + k4 + j] = kf; } \
        *(LAS u32x4_t*)(LA + t * 32 + k4) = rla; \
        _Pragma("unroll") for (int j = 0; j < 8; ++j) { const unsigned wv_ = rv[j >> 1]; VT[(v8 + j) * 72 + t] = (bf16_t)((j & 1) ? (wv_ >> 16) : (wv_ & 0xFFFFu)); } if ((tid & 7) == 0) NR[t] = rn_; } while (0)
    F4 o0 = (F4){0.f, 0.f, 0.f, 0.f}, o1 = o0; int orow0[4] = {0, 0, 0, 0}, orow1[4] = {0, 0, 0, 0};
    const int ocol = hh * GV_ + (wid & 3) * 16 + (lane & 15);
#define GC_OST() do { _Pragma("unroll") for (int j = 0; j < 4; ++j) { og[(size_t)orow0[j] * GWD + ocol] = f2bf(o0[j]); og[(size_t)orow1[j] * GWD + ocol] = f2bf(o1[j]); } } while (0)
    GC_LOAD(0);
    __syncthreads();
#pragma unroll 1
    for (int c = 0; c < NPC; ++c) {
        GC_WAIT();
        if (c > 0) GC_OST();
        GC_PUT();
        BSYNC();
        GC_LOAD(c + 1 < NPC ? c + 1 : NPC - 1);
        if (wid == 0) { const int kc = lane & 31, t0 = (lane >> 5) * 32; float cs[32];
#pragma unroll
            for (int tt = 0; tt < 32; ++tt) cs[tt] = LA[(t0 + tt) * 32 + kc];
#pragma unroll
            for (int tt = 1; tt < 32; ++tt) cs[tt] += cs[tt - 1];
            const float up = __builtin_bit_cast(float, __builtin_amdgcn_ds_bpermute(((lane + 32) & 63) * 4, __builtin_bit_cast(int, cs[31]))); const float add = lane >= 32 ? up : 0.f;
#pragma unroll
            for (int tt = 0; tt < 32; ++tt) LA[(t0 + tt) * 32 + kc] = cs[tt] + add; }
        BSYNC();
#pragma unroll
        for (int j = 0; j < 4; ++j) { const float bb = LA[t * 32 + k4 + j], bl = LA[63 * 32 + k4 + j], qv = QR[t * 32 + k4 + j], kv = KR[t * 32 + k4 + j];
            QIN[t * 40 + k4 + j] = f2bf(qv * fexp(bb)); KIN[t * 40 + k4 + j] = f2bf(kv * fexp(-bb)); KSTT[(k4 + j) * 72 + t] = f2bf(kv * fexp(bl - bb)); }
        BSYNC();
        bmm<64, 64, 32, 8>(QIN, 40, KIN, 40, wid, lane, [&](int r0, int cc, const F4& acc) {
#pragma unroll
            for (int j = 0; j < 4; ++j) ATT[(r0 + j) * 72 + cc] = f2bf(cc <= r0 + j ? acc[j] : 0.f); });
        BSYNC();
        { const int tm0 = wid >> 2, tn = wid & 3, q4 = 4 * (lane >> 4);
          o0 = bmm2_tile<64, 32>(ATT, 72, VT, 72, QIN, 40, STT, 40, tm0, tn, lane); o1 = bmm2_tile<64, 32>(ATT, 72, VT, 72, QIN, 40, STT, 40, tm0 + 2, tn, lane);
#pragma unroll
          for (int j = 0; j < 4; ++j) { orow0[j] = NR[tm0 * 16 + q4 + j]; orow1[j] = NR[(tm0 + 2) * 16 + q4 + j]; } }
        BSYNC();
        bmm<32, 64, 64, 8>(KSTT, 72, VT, 72, wid, lane, [&](int r0, int cc, const F4& acc) {
#pragma unroll
            for (int j = 0; j < 4; ++j) { const float sn = fexp(LA[63 * 32 + r0 + j]) * SF[(r0 + j) * 64 + cc] + acc[j]; SF[(r0 + j) * 64 + cc] = sn; STT[cc * 40 + r0 + j] = f2bf(sn); } });
        BSYNC();
    }
    GC_WAIT();
    GC_OST();
#undef GC_PUT
#undef GC_LOAD
#undef GC_WAIT
#undef GC_OST
}
#endif

#ifndef CPU_TEST
__device__ __forceinline__ void cvt_job(LAS unsigned char* lds, int tid, const float* src, bf16_t* dst, int nb, size_t sbs, size_t dbs, int K, int Nsrc, int Ndst, int nvalid, int perm) {
    LAS unsigned short* tl = (LAS unsigned short*)lds;
    const int tK = K / 64, tN = Ndst / 64, per = tK * tN; const long total = (long)nb * per;
    for (long t = blockIdx.x; t < total; t += gridDim.x) {
        const int e = (int)(t / per), r = (int)(t % per), tn = r / tK, tk = r % tK, n0 = tn * 64, k0 = tk * 64;
        int sc0 = n0; if (perm) { const int j = n0 / 256, w = n0 % 256; sc0 = w < 128 ? 128 * j + w : FF_ + 128 * j + (w - 128); }
        const int nv = nvalid - n0;
        const float* s = src + (size_t)e * sbs + (size_t)(k0 + (tid >> 3)) * Nsrc + sc0 + (tid & 7) * 8; const int c8 = (tid & 7) * 8, kk = tid >> 3;
        float v[8];
        if (c8 + 8 <= nv) { const F4 a = *(const F4*)s, b = *(const F4*)(s + 4); v[0] = a[0]; v[1] = a[1]; v[2] = a[2]; v[3] = a[3]; v[4] = b[0]; v[5] = b[1]; v[6] = b[2]; v[7] = b[3]; }
        else {
#pragma unroll
            for (int j = 0; j < 8; ++j) v[j] = (c8 + j < nv) ? s[j] : 0.f; }
#pragma unroll
        for (int j = 0; j < 8; ++j) tl[(c8 + j) * 72 + kk] = f2bf(v[j]);
        __syncthreads();
        { const int n = tid >> 3, ks = (tid & 7) * 8; typedef unsigned u32x4_t __attribute__((ext_vector_type(4))); const u32x4_t w = *(const LAS u32x4_t*)(tl + n * 72 + ks); *(u32x4_t*)(dst + (size_t)e * dbs + (size_t)(n0 + n) * K + k0 + ks) = w; }
        __syncthreads();
    }
}
__device__ __forceinline__ void st_cvt_tiles(const P& p, int l, LAS unsigned char* lds, int tid) {
    cvt_job(lds, tid, p.w_in + (size_t)l * D_ * NIN, WSP(bf16_t, w_inT) + (size_t)l * NINP * D_, 1, 0, 0, D_, NIN, NINP, NIN, 0);
    cvt_job(lds, tid, p.w_out + (size_t)l * MIXW * D_, WSP(bf16_t, w_outT) + (size_t)l * D_ * MIXW, 1, 0, 0, MIXW, D_, D_, D_, 0);
    cvt_job(lds, tid, p.sh_w2 + (size_t)l * FF_ * D_, WSP(bf16_t, shw2T) + (size_t)l * D_ * FF_, 1, 0, 0, FF_, D_, D_, D_, 0);
    cvt_job(lds, tid, p.s5_glu_w + (size_t)l * SW * SW, WSP(bf16_t, gluT) + (size_t)l * SWP * SW, 1, 0, 0, SW, SW, SWP, SW, 0);
    cvt_job(lds, tid, p.router_w + (size_t)l * D_ * E_, WSP(bf16_t, rsT) + (size_t)l * NRS * D_, 1, 0, 0, D_, E_, EP, E_, 0);
    cvt_job(lds, tid, p.sh_w13 + (size_t)l * D_ * 2 * FF_, WSP(bf16_t, rsT) + (size_t)l * NRS * D_ + (size_t)EP * D_, 1, 0, 0, D_, 2 * FF_, 2 * FF_, 2 * FF_, 1);
    cvt_job(lds, tid, p.exp_w13 + (size_t)l * E_ * D_ * 2 * FF_, WSP(bf16_t, w13T) + (size_t)l * E_ * 2 * FF_ * D_, E_, (size_t)D_ * 2 * FF_, (size_t)2 * FF_ * D_, D_, 2 * FF_, 2 * FF_, 2 * FF_, 1);
    cvt_job(lds, tid, p.exp_w2 + (size_t)l * E_ * FF_ * D_, WSP(bf16_t, w2T) + (size_t)l * E_ * D_ * FF_, E_, (size_t)FF_ * D_, (size_t)D_ * FF_, FF_, D_, D_, D_, 0);
}
#endif

#ifndef CPU_TEST
__device__ __forceinline__ void st_prep1_blk(const P& p, int l, int wid, int lane, int wv, int nwv) {
    const bf16_t* proj = WSP(bf16_t, proj); bf16_t* rkv = WSP(bf16_t, rkv); bf16_t* as = WSP(bf16_t, asmall); bf16_t* U2 = WSP(bf16_t, U2);
    const float* taps = p.rwkv_conv + (size_t)l * 9 * RCOLS; constexpr int NG = RCOLS / 8, TPB = 512 / NG;
    const int tid = wid * 64 + lane;
    if (tid < TPB * NG) {
        const int cg = tid % NG, ts = tid / NG, ch = cg * 8; const int step = (int)gridDim.x * TPB;
        float w[9][8];
#pragma unroll
        for (int k = 0; k < 9; ++k) ld8f(taps + k * RCOLS + ch, w[k]);
#define P1_OUT(n_, acc) do { if (ch < 3 * RW) st8bf(rkv + (size_t)(n_) * 3 * RW + ch, acc); else { const int q0 = ch - 3 * RW; \
            if (q0 < 2 * RDR_) { _Pragma("unroll") for (int q = 0; q < 8; ++q) acc[q] = ftanh(acc[q]); } \
            else if (q0 >= 2 * RDR_ + 2 * RIR_) { _Pragma("unroll") for (int q = 0; q < 8; ++q) acc[q] = sigmoidf_(acc[q]); } \
            st8bf(as + (size_t)(n_) * KSM + q0, acc); } } while (0)
#define P1_FMA(acc, xv, k) do { _Pragma("unroll") for (int j_ = 0; j_ < 4; ++j_) { acc[2 * j_] += w[k][2 * j_] * __uint_as_float((xv)[j_] << 16); acc[2 * j_ + 1] += w[k][2 * j_ + 1] * __uint_as_float((xv)[j_] & 0xffff0000u); } } while (0)
        constexpr int NPT = 4; static_assert(GW_ % NPT == 0 && NLAT % NPT == 0, "token groups");
        for (int pi = (int)blockIdx.x * TPB + ts; pi < NLAT / NPT; pi += step) { const int n0 = NPT * pi, t_ = n0 % T_, gr = t_ / GW_, gc = t_ % GW_; const bf16_t* pb_ = proj + (size_t)n0 * NINP + ch;
            const bool rok0 = gr > 0, rok2 = gr < ROWS_ - 1, cokl = gc > 0, cokr = gc + NPT < GW_; U4 xw[3][NPT + 2];
#pragma unroll
            for (int a = 0; a < 3; ++a)
#pragma unroll
                for (int jw = 0; jw < NPT + 2; ++jw) { const bool ok = (a == 0 ? rok0 : a == 2 ? rok2 : true) && (jw == 0 ? cokl : jw == NPT + 1 ? cokr : true);
                    const int off_ = ok ? ((a - 1) * GW_ + (jw - 1)) * NINP : 0; const U4 v = *(const U4*)(pb_ + off_); xw[a][jw] = ok ? v : (U4){0u, 0u, 0u, 0u}; }
#pragma unroll
            for (int tk = 0; tk < NPT; ++tk) { float acc[8];
#pragma unroll
                for (int q = 0; q < 8; ++q) acc[q] = 0.f;
#pragma unroll
                for (int a = 0; a < 3; ++a)
#pragma unroll
                    for (int jj = 0; jj < 3; ++jj) P1_FMA(acc, xw[a][tk + jj], a * 3 + jj);
                P1_OUT(n0 + tk, acc); } }
        for (int n = NLAT + (int)blockIdx.x * TPB + ts; n < NTOK; n += step) { const int s_ = (n - NLAT) % CTX_; U4 xc[3];
#pragma unroll
            for (int j = 0; j < 3; ++j) { const int ss = s_ + j - 1; const bool ok = ss >= 0 && ss < CTX_; const int nn = ok ? n + j - 1 : n; const U4 v = *(const U4*)(proj + (size_t)nn * NINP + ch); xc[j] = ok ? v : (U4){0u, 0u, 0u, 0u}; }
            float acc[8];
#pragma unroll
            for (int q = 0; q < 8; ++q) acc[q] = 0.f;
#pragma unroll
            for (int jj = 0; jj < 3; ++jj) P1_FMA(acc, xc[jj], 3 + jj);
            P1_OUT(n, acc); }
#undef P1_FMA
#undef P1_OUT
    }
    GIDX;
    constexpr int NT8 = (KSM - OGL) / 8;
    for (long i = gid; i < (long)NTOK * NT8; i += gsz) { const int n = (int)(i / NT8), q = (int)(i % NT8) * 8;
        if (q < 2 * GGR_) cp8bf(as + (size_t)n * KSM + OGL + q, proj + (size_t)n * NINP + GBASE + 2 * GKD + 2 * GWD + q); else z8bf(as + (size_t)n * KSM + OGL + q); }
    for (long i = gid; i < (long)B_ * SPOS * (SW / 8); i += gsz) { const int c = (int)(i % (SW / 8)) * 8; const long r = i / (SW / 8); const int pos = (int)(r % SPOS), b = (int)(r / SPOS);
        const int g = c / SG_, cc = c % SG_, pc = pos / CH_, t = pos % CH_, m = b * NPC + pc;
        cp8bf(U2 + ((size_t)g * M5P + m) * KT5 + t * SG_ + cc, proj + (size_t)row_of(b, pos) * NINP + SBASE + c); }
}
#define DPP_MOVF(v, ctrl) __builtin_bit_cast(float, __builtin_amdgcn_update_dpp(0, __builtin_bit_cast(int, v), ctrl, 0xF, 0xF, true))
#define DPP_MOVI(v, ctrl) __builtin_amdgcn_update_dpp(0, v, ctrl, 0xF, 0xF, true)
__device__ __forceinline__ void st_topk_wave(const P& p, int l, int wv, int nwv, int lane, LAS unsigned char* lds) {
    LAS int* hist = (LAS int*)lds;
    { const int tid_ = (int)threadIdx.x; if (tid_ < E_) hist[tid_] = 0; }
    __syncthreads();
    static_assert(E_ == 256 && NGRP_ == 8 && TKG_ == 4 && TOPK_ == 8, "wave top-k is written for 256 experts in 8 groups");
    const int nrow = (l == L_ - 1) ? NLAT : NTOK; const float* lg = WSP(float, logits); const F4 rb = *(const F4*)(p.router_bias + (size_t)l * E_ + 4 * lane);
    for (int n = wv; n < nrow; n += nwv) {
        const F4 z = *(const F4*)(lg + (size_t)n * E_ + 4 * lane); float sg[4], sv[4];
#pragma unroll
        for (int j = 0; j < 4; ++j) { sg[j] = sigmoidf_(z[j]); sv[j] = sg[j] + rb[j]; }
        float m1 = fmaxf(fmaxf(sv[0], sv[1]), fmaxf(sv[2], sv[3])), m2;
        { float a = fmaxf(sv[0], sv[1]), b = fminf(sv[0], sv[1]), c = fmaxf(sv[2], sv[3]), d = fminf(sv[2], sv[3]); m2 = fmaxf(fminf(a, c), fmaxf(b, d)); }
        { float o1 = DPP_MOVF(m1, 0xB1), o2 = DPP_MOVF(m2, 0xB1); float n1 = fmaxf(m1, o1), n2 = fmaxf(fminf(m1, o1), fmaxf(m2, o2)); m1 = n1; m2 = n2;
          o1 = DPP_MOVF(m1, 0x4E); o2 = DPP_MOVF(m2, 0x4E); n1 = fmaxf(m1, o1); n2 = fmaxf(fminf(m1, o1), fmaxf(m2, o2)); m1 = n1; m2 = n2;
          o1 = DPP_MOVF(m1, 0x141); o2 = DPP_MOVF(m2, 0x141); n1 = fmaxf(m1, o1); n2 = fmaxf(fminf(m1, o1), fmaxf(m2, o2)); m1 = n1; m2 = n2; }
        const float gsc = m1 + m2; const int g = lane >> 3, gb = __builtin_bit_cast(int, gsc); int rank = 0;
#pragma unroll
        for (int g2 = 0; g2 < 8; ++g2) { const float o = __builtin_bit_cast(float, __builtin_amdgcn_readlane(gb, 8 * g2)); rank += (o > gsc || (o == gsc && g2 < g)) ? 1 : 0; }
        const bool sel = rank < TKG_;
        int ck[4];
#pragma unroll
        for (int j = 0; j < 4; ++j) ck[j] = (sel && sv[j] > 0.f) ? __builtin_bit_cast(int, sv[j]) : 0;
        float myw = 0.f; int mye = 0; float wsum = 0.f;
#pragma unroll
        for (int kk = 0; kk < TOPK_; ++kk) {
            int bk = ck[0] > ck[1] ? ck[0] : ck[1]; { const int b2 = ck[2] > ck[3] ? ck[2] : ck[3]; bk = bk > b2 ? bk : b2; }
            int mk = bk;
            { int o = DPP_MOVI(mk, 0xB1); mk = mk > o ? mk : o; o = DPP_MOVI(mk, 0x4E); mk = mk > o ? mk : o; o = DPP_MOVI(mk, 0x141); mk = mk > o ? mk : o; o = DPP_MOVI(mk, 0x140); mk = mk > o ? mk : o; }
            const int r0 = __builtin_amdgcn_readlane(mk, 0), r1 = __builtin_amdgcn_readlane(mk, 16), r2 = __builtin_amdgcn_readlane(mk, 32), r3 = __builtin_amdgcn_readlane(mk, 48);
            const int K = (r0 > r1 ? r0 : r1) > (r2 > r3 ? r2 : r3) ? (r0 > r1 ? r0 : r1) : (r2 > r3 ? r2 : r3);
            const unsigned long long ball = __ballot(bk == K); const int wl = __builtin_amdgcn_readfirstlane((int)__ffsll((long long)ball) - 1);
            int wj = 0; float sgw = 0.f;
            if (lane == wl) {
#pragma unroll
                for (int j = 3; j >= 0; --j) if (ck[j] == K) wj = j;
#pragma unroll
                for (int j = 0; j < 4; ++j) if (wj == j) { ck[j] = 0; sgw = sg[j]; } }
            const int wjb = __builtin_amdgcn_readlane(wj, wl); sgw = __builtin_bit_cast(float, __builtin_amdgcn_readlane(__builtin_bit_cast(int, sgw), wl)); wsum += sgw;
            if (lane == kk) { myw = sgw; mye = 4 * wl + wjb; }
        }
        if (lane < TOPK_) { WSP(int, eidx)[(size_t)n * TOPK_ + lane] = mye; WSP(float, ewt)[(size_t)n * TOPK_ + lane] = myw / wsum * 2.5f; __hip_atomic_fetch_add(hist + mye, 1, __ATOMIC_RELAXED, __HIP_MEMORY_SCOPE_WORKGROUP); }
    }
    __syncthreads();
    { const int tid_ = (int)threadIdx.x; if (tid_ < E_) { const int c = hist[tid_]; if (c > 0) atomicAdd(WSP(int, ecnt) + tid_, c); } }
    __syncthreads();
}
__device__ __forceinline__ void st_scatter_blk(const P& p, int l, LAS unsigned char* lds, int wid, int lane, int wv, int nwv) {
    LAS int* eo = (LAS int*)lds;
    if (wid == 0) {
        const int* ecnt = WSP(int, ecnt); int c4[4], t4[4], tsum = 0;
#pragma unroll
        for (int j = 0; j < 4; ++j) { c4[j] = ld_int(ecnt + 4 * lane + j); t4[j] = (c4[j] + 255) / 256; tsum += t4[j]; }
        int incl = tsum;
#pragma unroll
        for (int o = 1; o < 64; o <<= 1) { const int v = __shfl_up(incl, o); if (lane >= o) incl += v; }
        int tb = incl - tsum;
#pragma unroll
        for (int j = 0; j < 4; ++j) { eo[4 * lane + j] = tb * 256;
            if (blockIdx.x == 0) { WSP(int, eoff)[4 * lane + j] = tb * 256; for (int t = 0; t < t4[j]; ++t) { int* u = WSP(int, ulist) + (size_t)(tb + t) * 4; u[0] = (tb + t) * 256; u[1] = 4 * lane + j; u[2] = (c4[j] - 256 * t) < 256 ? (c4[j] - 256 * t) : 256; u[3] = 0; } }
            tb += t4[j]; }
        if (lane == 63) { eo[E_] = tb * 256; if (blockIdx.x == 0) { WSP(int, eoff)[E_] = tb * 256; WSP(int, nunits)[0] = tb; } }
    }
    __syncthreads();
    const long gid = (long)wv * 64 + lane, gsz = (long)nwv * 64; const int nrow = (l == L_ - 1) ? NLAT : NTOK; const int* ei = WSP(int, eidx); int* so = WSP(int, slot_of); int* st = WSP(int, slot_tok);
    LAS int* lc = eo + E_ + 1;
    constexpr int MAXI = 4; const long total = (long)nrow * TOPK_;
#pragma unroll 1
    for (long base = 0; base < total; base += (long)MAXI * gsz) {
        if ((int)threadIdx.x < E_) lc[threadIdx.x] = 0;
        __syncthreads();
        int ie[MAXI], ir[MAXI];
#pragma unroll
        for (int u = 0; u < MAXI; ++u) { const long i = base + gid + (long)u * gsz; ie[u] = -1; ir[u] = 0; if (i < total) { ie[u] = ei[i]; ir[u] = __hip_atomic_fetch_add(lc + ie[u], 1, __ATOMIC_RELAXED, __HIP_MEMORY_SCOPE_WORKGROUP); } }
        __syncthreads();
        if ((int)threadIdx.x < E_) { const int c = lc[threadIdx.x]; lc[threadIdx.x] = c > 0 ? atomicAdd(WSP(int, efill) + threadIdx.x, c) : 0; }
        __syncthreads();
#pragma unroll
        for (int u = 0; u < MAXI; ++u) { const long i = base + gid + (long)u * gsz; if (ie[u] >= 0) { const int s = eo[ie[u]] + lc[ie[u]] + ir[u]; so[i] = s; st[s] = (int)(i / TOPK_); } }
        __syncthreads();
    }
}
#endif

#ifndef CPU_TEST
__device__ __forceinline__ void st_post_wave(const P& p, int l, int wv, int nwv, int lane) {
    static_assert(RH_ == 6 && GH_ == 6 && RN_ == 64 && GV_ == 64, "post_wave geometry");
    bf16_t* ymix = WSP(bf16_t, ymix); const bf16_t* yr = (const bf16_t*)WSP(float, yr); const bf16_t* og = (const bf16_t*)WSP(float, og); const bf16_t* proj = WSP(bf16_t, proj); const bf16_t* gsb = WSP(bf16_t, gsb); const bf16_t* rkv = WSP(bf16_t, rkv);
    const int nrow = (l == L_ - 1) ? NLAT : NTOK; const int hq = lane >> 4, c4 = (lane & 15) * 4;
    for (int n = wv; n < nrow; n += nwv) {
        float o[3][4];
#pragma unroll
        for (int i = 0; i < 3; ++i) {
            const int hd = hq + 4 * i;
            if (hd < RH_) { const int c = hd * RN_ + c4; float r[4], k[4], v[4], a0[4], a1[4], g[4];
                ld4bf(rkv + (size_t)n * 3 * RW + c, r); ld4bf(rkv + (size_t)n * 3 * RW + RW + c, k); ld4bf(rkv + (size_t)n * 3 * RW + 2 * RW + c, v);
                ld4bf(gsb + (size_t)n * NGB + c, a0); ld4bf(gsb + (size_t)n * NGB + RW + c, a1); ld4bf(gsb + (size_t)n * NGB + 2 * RW + c, g);
                float y0[4], y1[4]; ld4bf(yr + (size_t)n * RW + c, y0); ld4bf(yr + ((size_t)NTOK + n) * RW + c, y1);
                const F4 ka = *(const F4*)(p.rwkv_k_a + (size_t)l * RW + c), rk = *(const F4*)(p.rwkv_r_k + (size_t)l * RW + c), lg = *(const F4*)(p.rwkv_ln_g + (size_t)l * RW + c), lb = *(const F4*)(p.rwkv_ln_b + (size_t)l * RW + c);
                float y[4], s = 0.f, bs = 0.f;
#pragma unroll
                for (int j = 0; j < 4; ++j) { y[j] = y0[j] + y1[j]; s += y[j]; const float k20 = k[j] * (1.0f + (a0[j] - 1.0f) * ka[j]), k21 = k[j] * (1.0f + (a1[j] - 1.0f) * ka[j]); bs += r[j] * (k20 + k21) * rk[j]; }
                s = dpp_sum16(s); bs = dpp_sum16(bs); const float mu = s * (1.0f / RN_); float qq = 0.f;
#pragma unroll
                for (int j = 0; j < 4; ++j) { const float dlt = y[j] - mu; qq += dlt * dlt; }
                qq = dpp_sum16(qq); const float rstd = 1.0f / sqrtf(qq * (1.0f / RN_) + GN_EPS);
#pragma unroll
                for (int j = 0; j < 4; ++j) o[i][j] = ((y[j] - mu) * rstd * lg[j] + lb[j] + bs * v[j]) * g[j];
            } else { const int h2 = hd - RH_, c = h2 * GV_ + c4; float gg[4];
                float o0[4], o1[4]; ld4bf(og + (size_t)n * GWD + c, o0); ld4bf(og + ((size_t)NTOK + n) * GWD + c, o1); ld4bf(proj + (size_t)n * NINP + GBASE + 2 * GKD + GWD + c, gg);
                const F4 ng = *(const F4*)(p.gla_norm_g + (size_t)l * GV_ + c4); float oo[4], qq = 0.f;
#pragma unroll
                for (int j = 0; j < 4; ++j) { oo[j] = o0[j] + o1[j]; qq += oo[j] * oo[j]; }
                qq = dpp_sum16(qq); const float rs = 1.0f / sqrtf(qq * (1.0f / GV_) + 1e-6f);
#pragma unroll
                for (int j = 0; j < 4; ++j) o[i][j] = oo[j] * rs * ng[j] * siluf_(gg[j]);
            }
        }
#pragma unroll
        for (int i = 0; i < 3; ++i) st4bf(ymix + (size_t)n * MIXW + (hq + 4 * i) * 64 + c4, o[i]);
    }
}
#endif

#ifndef CPU_TEST
__device__ __forceinline__ void st_modv_blk(const P& p, LAS unsigned char* lds, int tid) {
    static_assert(D_ == 1024 && B_ + 1 <= 17, "modv_blk geometry");
    LAS float* sc = (LAS float*)lds;
    LAS float* red = (LAS float*)(lds + 17 * 1024 * 4);
    const float* scg = WSP(float, silu_c); float* mv = WSP(float, modv);
    for (int i = tid; i < (B_ + 1) * D_; i += 512) sc[i] = scg[i];
    __syncthreads();
    const int cl = tid & 63, ks = tid >> 6;
    for (int task = blockIdx.x; task < L_ * 6 * D_ / 64; task += gridDim.x) {
        const int l = task / (6 * D_ / 64), col = (task % (6 * D_ / 64)) * 64 + cl;
        float acc[B_ + 1];
#pragma unroll
        for (int b = 0; b <= B_; ++b) acc[b] = 0.f;
        const float* w = p.w_mod + (size_t)l * D_ * 6 * D_ + col;
#pragma unroll 4
        for (int k = ks * 128; k < ks * 128 + 128; ++k) { const float wk = w[(size_t)k * 6 * D_];
#pragma unroll
            for (int b = 0; b <= B_; ++b) acc[b] += sc[b * D_ + k] * wk; }
#pragma unroll
        for (int b = 0; b <= B_; ++b) red[(ks * (B_ + 1) + b) * 64 + cl] = acc[b];
        __syncthreads();
        for (int i = tid; i < (B_ + 1) * 64; i += 512) { const int b = i >> 6, c2 = i & 63; float s = p.b_mod[(size_t)l * 6 * D_ + (task % (6 * D_ / 64)) * 64 + c2];
#pragma unroll
            for (int q = 0; q < 8; ++q) s += red[(q * (B_ + 1) + b) * 64 + c2];
            mv[((size_t)l * (B_ + 1) + b) * 6 * D_ + (task % (6 * D_ / 64)) * 64 + c2] = s; }
        __syncthreads();
    }
}
#endif

#ifdef CPU_TEST
#define GEMM_CALL(g, S, E) gemm_phase(g, S, E)
#define GEMM_CALL_G(g, S, E) gemm_phase(g, S, E)
#define SCHED_GC 1, 0
#define SYNC(k)
#define LOADP
#else
#define CAS __attribute__((address_space(4)))
#define LOADP const CAS P* _q = pk; asm volatile("" : "+s"(_q)); const P& p = *(const P*)_q; int lane = lane_id(); asm volatile("" : "+v"(lane)); \
    const int wv = blockIdx.x * 8 + wid, nwv = gridDim.x * 8; (void)lane; (void)wv; (void)nwv;
#define GEMM_CALL(g, S, E) gemm_phase<false>(lds, wid, g, S, E, &bar)
#define GEMM_CALL_G(g, S, E) gemm_phase<true>(lds, wid, g, S, E, &bar)
#define SCHED_GC (int)gridDim.x, sched_id((const unsigned*)(p.ws + WS.ctl), lds)
#define VC_WORD(x) (3584 + 64 * (x))
__device__ __forceinline__ int sched_id(const unsigned* ctl, LAS unsigned char* lds) {
    const unsigned G = gridDim.x; bool ok = (G % 8u) == 0u;
#pragma unroll
    for (int x = 0; x < 8; ++x) ok = ok && (__hip_atomic_load(ctl + VC_WORD(x), __ATOMIC_RELAXED, __HIP_MEMORY_SCOPE_AGENT) == G / 8u);
    const unsigned v = ((volatile LAS unsigned*)(lds + STAGE_BYTES))[2];
    return __builtin_amdgcn_readfirstlane(ok ? (int)v : (int)blockIdx.x);
}
#define SYNC(k) if (lo <= (k) && (k) + 1 < hi) xcd_barrier(bar);
#define XB_TMO      128
#define XB_XCNT(j)  (256  + 64 * (j))
#define XB_XSUB(j)  (1280 + 64 * (j))
#define XB_XGEN(j)  (2304 + 64 * (j))
#define XB_TOP      3328
#define XB_TOPGEN   3392
#define XCD_BAR_WORDS 3456
#define XB_SPIN_CAP (1u << 18)
__device__ __forceinline__ unsigned xb_ld(unsigned* p)              { return __hip_atomic_load(p, __ATOMIC_RELAXED, __HIP_MEMORY_SCOPE_AGENT); }
__device__ __forceinline__ unsigned xb_add(unsigned* p, unsigned v) { return __hip_atomic_fetch_add(p, v, __ATOMIC_RELAXED, __HIP_MEMORY_SCOPE_AGENT); }
__device__ __forceinline__ unsigned xb_xcc_id() { return (unsigned)__builtin_amdgcn_s_getreg((3 << 11) | 20) & 0xFu; }
#define XB_SPIN(cond, bar) do { unsigned _sp = 0; while (cond) { __builtin_amdgcn_s_sleep(1); \
    if ((++_sp & 255u) == 0u) { if (xb_ld(&(bar)[XB_TMO])) break; if (_sp > XB_SPIN_CAP) { atomicAdd(&(bar)[XB_TMO], 1u); break; } } } } while (0)
struct XcdBarrier { unsigned* bar; unsigned x; volatile LAS unsigned* st; int wid; };
__device__ __forceinline__ XcdBarrier xcd_barrier_post(unsigned* bar, volatile LAS unsigned* st) {
    XcdBarrier b; b.bar = bar; b.x = xb_xcc_id(); b.st = st; b.wid = 0;
    if (threadIdx.x == 0) (void)xb_add(&bar[XB_XCNT(b.x)], 1u);
    return b;
}
__device__ __forceinline__ void xcd_barrier_complete(unsigned* bar, unsigned x, unsigned& nloc, unsigned& nx) {
    const unsigned G = gridDim.x * gridDim.y * gridDim.z;
    unsigned sum, cnt, mine, sp = 0u;
    for (;;) {
        sum = 0u; cnt = 0u; mine = 0u;
#pragma unroll
        for (unsigned j = 0; j < 16; ++j) { const unsigned c = xb_ld(&bar[XB_XCNT(j)]); sum += c; cnt += (c > 0u) ? 1u : 0u; mine = (j == x) ? c : mine; }
        if (sum == G) break;
        __builtin_amdgcn_s_sleep(1);
        if ((++sp & 255u) == 0u) { if (xb_ld(&bar[XB_TMO])) break; if (sp > XB_SPIN_CAP) { atomicAdd(&bar[XB_TMO], 1u); break; } }
    }
    nloc = mine > 0u ? mine : 1u; nx = cnt > 0u ? cnt : 1u;
}
__device__ __forceinline__ void xcd_barrier(const XcdBarrier& b) {
    asm volatile("s_waitcnt vmcnt(0)" ::: "memory");
    __syncthreads();
    if (b.wid == 0 && lane_id() == 0) {
        unsigned* bar = b.bar;
        __builtin_amdgcn_s_waitcnt(0);
        unsigned nloc = b.st[0], nx = b.st[1];
        if (nloc == 0u) { xcd_barrier_complete(bar, b.x, nloc, nx); b.st[0] = nloc; b.st[1] = nx; }
        const unsigned old = xb_add(&bar[XB_XSUB(b.x)], 1u);
        const unsigned gen = old / nloc;
        if (old + 1u == (gen + 1u) * nloc) {
            __builtin_amdgcn_fence(__ATOMIC_RELEASE, "agent");
            asm volatile("s_waitcnt vmcnt(0)" ::: "memory");
            const unsigned og = xb_add(&bar[XB_TOP], 1u);
            const unsigned tg = og / nx;
            if (og + 1u == (tg + 1u) * nx) xb_add(&bar[XB_TOPGEN], 1u);
            else XB_SPIN(xb_ld(&bar[XB_TOPGEN]) == tg, bar);
            __builtin_amdgcn_fence(__ATOMIC_ACQUIRE, "agent");
            xb_add(&bar[XB_XGEN(b.x)], 1u);
            asm volatile("s_waitcnt vmcnt(0)" ::: "memory");
        } else {
            XB_SPIN(xb_ld(&bar[XB_XGEN(b.x)]) == gen, bar);
            __builtin_amdgcn_fence(__ATOMIC_ACQUIRE, "agent");
            asm volatile("s_waitcnt vmcnt(0)" ::: "memory");
        }
    }
    __syncthreads();
}
#endif

#define IN(k) (lo <= (k) && (k) < hi)
#ifndef PROBE_MASK
#define PROBE_MASK 0
#endif
#ifdef CPU_TEST
#define REP_BEGIN(k)
#define REP_END
#else
#define REP_BEGIN(k) for (int rep_ = 0; rep_ < (((PROBE_MASK) >> (k)) & 1) + 1; ++rep_) { if (rep_) xcd_barrier(bar);
#define REP_END }
#endif
#ifdef CPU_TEST
template <int lo, int hi, int l> static void run_layer(const P& p) { const int wv = 0, nwv = 1, lane = 0; (void)wv; (void)nwv; (void)lane;
#else
template <int lo, int hi, int l> __device__ __forceinline__ void run_layer(const CAS P* pk, LAS unsigned char* lds, const int wid, const XcdBarrier& bar) {
#endif

        const int pb = NPH_PRO + l * NPH_LAYER; const bool last = (l == L_ - 1); const int MR = last ? NLAT : NTOK;
        if (IN(pb + 0)) { REP_BEGIN(0) LOADP GemmArgs g{WSP(bf16_t, h), D_, nullptr, WSP(bf16_t, w_inT) + (size_t)l * NINP * D_, D_, D_}; StaticSched S; S.init(1, NTOK, NINP, 0, 0, SCHED_GC);
            EpiBf16Plain E{WSP(bf16_t, proj), NINP}; GEMM_CALL(g, S, E); REP_END } SYNC(pb + 0)
#ifdef CPU_TEST
        if (IN(pb + 1)) { REP_BEGIN(1) LOADP st_prep1(p, l, wv, nwv, lane); REP_END } SYNC(pb + 1)
#else
        if (IN(pb + 1)) { REP_BEGIN(1) LOADP st_prep1_blk(p, l, wid, lane, wv, nwv); REP_END } SYNC(pb + 1)
#endif
        if (IN(pb + 2)) { REP_BEGIN(2) LOADP
            { GemmArgs g{WSP(bf16_t, asmall), KSM, nullptr, WSP(bf16_t, wsmT) + (size_t)l * NSMP * KSM, KSM, KSM}; StaticSched S; S.init(1, NTOK, NSMP, 0, 0, SCHED_GC);
              EpiSmall E{WSP(float, gs), WSP(bf16_t, gsb), p.rwkv_w0 + (size_t)l * 2 * RW, p.rwkv_a0 + (size_t)l * 2 * RW, p.gla_a_bias + (size_t)l * 2 * GKD}; GEMM_CALL(g, S, E); }
            { GemmArgs g{WSP(bf16_t, U2), KT5, nullptr, WSP(bf16_t, s5Wa) + (size_t)l * SNG_ * N5AP * K5, K5, K5}; StaticSched S; S.init(SNG_, M5P, N5AP, M5P, N5AP, SCHED_GC);
              EpiF32Plain E{WSP(float, xl), N5AP, (size_t)M5P * N5AP}; GEMM_CALL(g, S, E); }
        REP_END } SYNC(pb + 2)
        if (IN(pb + 3)) { REP_BEGIN(3) LOADP
#ifdef CPU_TEST
            rwkv_scan_all(p, l); gla_scan_all(p, l);
#else
            { constexpr int NRS_ = 2 * B_ * RH_, NGS_ = 2 * B_ * GH_, NGG = (NGS_ + 2) / 3;
              for (int task = blockIdx.x; task < NRS_; task += gridDim.x) { const int hh = task % RH_, b = (task / RH_) % B_, d = task / (RH_ * B_); rwkv_chunk_blk(p, l, d, b, hh, lds, wid, lane); } }
            { LOADP constexpr int NRS_ = 2 * B_ * RH_, NGS_ = 2 * B_ * GH_, NGG = (NGS_ + 2) / 3;
              for (int task = (int)blockIdx.x + (((int)blockIdx.x < NRS_) ? (int)gridDim.x * ((NRS_ - 1 - (int)blockIdx.x) / (int)gridDim.x + 1) : 0); task < NRS_ + NGG; task += gridDim.x) {
                  for (int s3 = 0; s3 < 3; ++s3) { const int t2 = (task - NRS_) + NGG * s3; if (t2 < NGS_) { const int hh = t2 % GH_, b = (t2 / GH_) % B_, d = t2 / (GH_ * B_); gla_chunk_blk(p, l, d, b, hh, lds, wid, lane); } __syncthreads(); } } }
#endif
            st_s5carry(p, l, wv, nwv, lane); REP_END } SYNC(pb + 3)
        if (IN(pb + 4)) { REP_BEGIN(4) LOADP
            { GemmArgs g{WSP(bf16_t, U2), KT5, nullptr, WSP(bf16_t, s5Tb) + (size_t)l * SNG_ * K5 * KT5, KT5, KT5}; StaticSched S; S.init(SNG_, M5P, K5, M5P, K5, SCHED_GC);
              EpiS5b E{WSP(bf16_t, yc)}; GEMM_CALL(g, S, E); }
#ifdef CPU_TEST
            st_post(p, l, wv, nwv, lane);
#else
            st_post_wave(p, l, wv, nwv, lane);
#endif
            REP_END } SYNC(pb + 4)
        if (IN(pb + 5)) { REP_BEGIN(5) LOADP GemmArgs g{WSP(bf16_t, yc), SW, nullptr, WSP(bf16_t, gluT) + (size_t)l * SWP * SW, SW, SW}; StaticSched S; S.init(1, MR, SWP, 0, 0, SCHED_GC);
            EpiGlu E{WSP(bf16_t, ymix), WSP(bf16_t, yc), p.s5_glu_b + (size_t)l * SW}; GEMM_CALL(g, S, E); REP_END } SYNC(pb + 5)
        if (IN(pb + 6)) { REP_BEGIN(6) LOADP GemmArgs g{WSP(bf16_t, ymix), MIXW, nullptr, WSP(bf16_t, w_outT) + (size_t)l * D_ * MIXW, MIXW, MIXW}; StaticSched S; S.init(1, MR, D_, 0, 0, SCHED_GC);
            EpiBf16Plain E{WSP(bf16_t, yo), D_}; GEMM_CALL(g, S, E); REP_END } SYNC(pb + 6)
        if (IN(pb + 7)) { REP_BEGIN(7) LOADP st_ln1(p, l, wv, nwv, lane); REP_END } SYNC(pb + 7)
        if (IN(pb + 8)) { REP_BEGIN(8) LOADP GemmArgs g{WSP(bf16_t, h2), D_, nullptr, WSP(bf16_t, rsT) + (size_t)l * NRS * D_, D_, D_}; StaticSched S; S.init(1, MR, NRS, 0, 0, SCHED_GC);
            EpiRS E{WSP(float, logits), WSP(bf16_t, sact)}; GEMM_CALL(g, S, E); REP_END } SYNC(pb + 8)
        if (IN(pb + 9)) { REP_BEGIN(9) LOADP
#ifdef CPU_TEST
            st_topk(p, l, wv, nwv, lane);
#else
            st_topk_wave(p, l, wv, nwv, lane, lds);
#endif
            st_scatter0(p, l, wv, nwv, lane); REP_END } SYNC(pb + 9)
#ifdef CPU_TEST
        if (IN(pb + 10)) { LOADP st_offsets(p, l, wv, nwv, lane); }
        if (IN(pb + 11)) { LOADP st_scatter(p, l, wv, nwv, lane); }
#else
        if (IN(pb + 11)) { LOADP st_scatter_blk(p, l, lds, wid, lane, wv, nwv); } SYNC(pb + 11)
#endif
        if (IN(pb + 12)) { REP_BEGIN(12) LOADP
            { GemmArgs g{WSP(bf16_t, h2), D_, WSP(int, slot_tok), WSP(bf16_t, w13T) + (size_t)l * E_ * 2 * FF_ * D_, D_, D_}; ListSched S{WSP(int, ulist), WSP(int, nunits), 2 * FF_ / 256, 2 * FF_, SCHED_GC};
              EpiUp E{WSP(bf16_t, act)}; GEMM_CALL_G(g, S, E); }
            { GemmArgs g{WSP(bf16_t, sact), FF_, nullptr, WSP(bf16_t, shw2T) + (size_t)l * D_ * FF_, FF_, FF_}; StaticSched S; S.init(1, MR, D_, 0, 0, SCHED_GC);
              EpiBf16Plain E{WSP(bf16_t, Ysh), D_}; GEMM_CALL(g, S, E); }
        REP_END } SYNC(pb + 12)
        if (IN(pb + 13)) { REP_BEGIN(13) LOADP GemmArgs g{WSP(bf16_t, act), FF_, nullptr, WSP(bf16_t, w2T) + (size_t)l * E_ * D_ * FF_, FF_, FF_}; ListSched S{WSP(int, ulist), WSP(int, nunits), D_ / 256, D_, SCHED_GC};
            EpiDown E{WSP(bf16_t, Y)}; GEMM_CALL(g, S, E); REP_END } SYNC(pb + 13)
        if (IN(pb + 14)) { REP_BEGIN(14) LOADP st_ln2(p, l, wv, nwv, lane); REP_END } SYNC(pb + 14)
    }
#ifdef CPU_TEST
template <int lo, int hi> static void run_program(const P& p) { const int wv = 0, nwv = 1, lane = 0;
#else
template <int lo, int hi> __device__ __forceinline__ void run_program(const CAS P* pk, LAS unsigned char* lds, const int wid, const XcdBarrier& bar) {
#endif
    if (IN(0)) { { LOADP st_siluc(p, wv, nwv, lane); } { LOADP st_s5a(p, wv, nwv, lane); }
#ifdef CPU_TEST
        { LOADP st_cvt1(p, 0, wv, nwv, lane); } { LOADP st_cvt2(p, 0, wv, nwv, lane); } { LOADP st_cvt3(p, 0, wv, nwv, lane); } { LOADP st_cvt4(p, 0, wv, nwv, lane); }
        { LOADP st_cvt1(p, 1, wv, nwv, lane); } { LOADP st_cvt2(p, 1, wv, nwv, lane); } { LOADP st_cvt3(p, 1, wv, nwv, lane); } { LOADP st_cvt4(p, 1, wv, nwv, lane); }
#else
        { LOADP st_cvt_tiles(p, 0, lds, wid * 64 + lane); } { LOADP st_cvt_tiles(p, 1, lds, wid * 64 + lane); }
#endif
        { LOADP st_cvt5(p, 0, wv, nwv, lane); } { LOADP st_cvt5(p, 1, wv, nwv, lane); } } SYNC(0)
#ifdef CPU_TEST
    if (IN(1)) { { LOADP st_modv(p, wv, nwv, lane); } { LOADP st_s5b(p, wv, nwv, lane); } } SYNC(1)
#else
#ifndef PRO_PROBE
#define PRO_PROBE 0
#endif
    if (IN(1)) { { LOADP st_modv_blk(p, lds, wid * 64 + lane); } for (int rp_ = 0; rp_ < ((PRO_PROBE & 1) ? 2 : 1); ++rp_) { LOADP st_s5b(p, wv, nwv, lane); } } SYNC(1)
#endif
#ifdef CPU_TEST
    if (IN(2)) { { LOADP st_s5c(p, wv, nwv, lane); } { LOADP st_hmod(p, 0, wv, nwv, lane); } } SYNC(2)
#else
    if (IN(2)) { for (int rp_ = 0; rp_ < ((PRO_PROBE & 2) ? 2 : 1); ++rp_) { LOADP st_s5c(p, wv, nwv, lane); } for (int rp_ = 0; rp_ < ((PRO_PROBE & 4) ? 2 : 1); ++rp_) { LOADP st_hmod(p, 0, wv, nwv, lane); } } SYNC(2)
#endif
#ifdef CPU_TEST
    run_layer<lo, hi, 0>(p); run_layer<lo, hi, 1>(p);
#else
    run_layer<lo, hi, 0>(pk, lds, wid, bar); run_layer<lo, hi, 1>(pk, lds, wid, bar);
#endif
}
#undef IN
#ifndef CPU_TEST
constexpr int LDS_BYTES = STAGE_BYTES + 1024;
struct KArgs { P p; };
template <int LO, int HI> __global__ void __launch_bounds__(512, 2) fwd_kernel(KArgs a) {
    extern __shared__ __attribute__((aligned(16))) unsigned char lds_raw[];
    LAS unsigned char* lds = (LAS unsigned char*)lds_raw;
    volatile LAS unsigned* xbw = (volatile LAS unsigned*)(lds + STAGE_BYTES);
    const int wid = __builtin_amdgcn_readfirstlane(threadIdx.x >> 6);
    const CAS P* pk = (const CAS P*)__builtin_amdgcn_kernarg_segment_ptr();
    if (threadIdx.x < 4) xbw[threadIdx.x] = 0u;
    __syncthreads();
    if (threadIdx.x == 0) { const unsigned xcc = xb_xcc_id() & 7u; const unsigned rank = xb_add((unsigned*)(pk->ws + WS.ctl) + VC_WORD(xcc), 1u); xbw[2] = rank * 8u + xcc; }
    __syncthreads();
    XcdBarrier bar; bar.bar = (unsigned*)(pk->ws + WS.ctl); bar.x = 0; bar.st = xbw; bar.wid = wid;
    if (HI - LO > 1) { bar = xcd_barrier_post((unsigned*)(pk->ws + WS.ctl), xbw); bar.wid = wid; }
    run_program<LO, HI>(pk, lds, wid, bar);
}
template <int PH> static void launch_each(int grid, hipStream_t stream, const KArgs& a) {
    if constexpr (PH < NPH) {
        static bool attr = false;
        if (!attr) { (void)hipFuncSetAttribute((const void*)fwd_kernel<PH, PH + 1>, hipFuncAttributeMaxDynamicSharedMemorySize, LDS_BYTES); attr = true; }
        hipLaunchKernelGGL((fwd_kernel<PH, PH + 1>), dim3(grid), dim3(512), LDS_BYTES, stream, a);
        launch_each<PH + 1>(grid, stream, a);
    }
}
extern "C" void kernel_launch(void* const* d_in, const int* in_sizes, int n_in, void* d_out, int out_size, void* d_ws, size_t ws_size, hipStream_t stream) {
    static int grid = 0;
    if (grid == 0) {
        if (n_in != 42 || ws_size < WS.end) { fprintf(stderr, "kernel_launch: bad inputs (n_in %d, ws %zu, need %zu)\n", n_in, ws_size, (size_t)WS.end); grid = -1; return; }
        int dev = 0, cus = 0; (void)hipGetDevice(&dev); (void)hipDeviceGetAttribute(&cus, hipDeviceAttributeMultiprocessorCount, dev);
        grid = cus;
    }
    if (grid < 0) return;
    KArgs a{}; const float** pp = (const float**)&a.p;
    for (int i = 0; i < 42; ++i) pp[i] = (const float*)d_in[i];
    a.p.out = (float*)d_out; a.p.ws = (unsigned char*)d_ws;
    (void)hipMemsetAsync((char*)d_ws + WS.ctl, 0, 16384, stream);
#ifdef FUSED
    static bool attr = false;
    if (!attr) { (void)hipFuncSetAttribute((const void*)fwd_kernel<0, NPH>, hipFuncAttributeMaxDynamicSharedMemorySize, LDS_BYTES); attr = true; }
    hipLaunchKernelGGL((fwd_kernel<0, NPH>), dim3(grid), dim3(512), LDS_BYTES, stream, a);
#else
    launch_each<0>(grid, stream, a);
#endif
}
#else
static void cpu_forward(const P& p) { run_program<0, NPH>(p); }
#endif
```

```cpp
#ifndef CFG_SMALL
#define D_ 1024
#define B_ 16
#define T_ 2048
#define CTX_ 256
#define GW_ 64
#define RH_ 6
#define GH_ 6
#define SNG_ 16
#define E_ 256
#define TOPK_ 8
#define NGRP_ 8
#define TKG_ 4
#define FF_ 256
#else
#define D_ 256
#define B_ 2
#define T_ 256
#define CTX_ 128
#define GW_ 16
#define RH_ 2
#define GH_ 2
#define SNG_ 4
#define E_ 16
#define TOPK_ 4
#define NGRP_ 4
#define TKG_ 2
#define FF_ 128
#endif
#define L_ 2
#define RN_ 64
#define RDR_ 32
#define RIR_ 32
#define RGR_ 64
#define GK_ 32
#define GV_ 64
#define GGR_ 16
#define SG_ 16
#define SP_ 64
#define CH_ 64

constexpr int pad256(int x) { return (x + 255) / 256 * 256; }
constexpr int RW = RH_ * RN_, RCOLS = 3 * RW + 2 * RDR_ + 2 * RIR_ + RGR_;
constexpr int GKD = GH_ * GK_, GWD = GH_ * GV_, GCOLS = 2 * GKD + 2 * GWD + 2 * GGR_;
constexpr int SW = SG_ * SNG_, MIXW = RW + GWD + SW, NIN = RCOLS + GCOLS + SW, NINP = pad256(NIN);
constexpr int GBASE = RCOLS, SBASE = RCOLS + GCOLS;
constexpr int NLAT = B_ * T_, NCTX = B_ * CTX_, NTOK = NLAT + NCTX;
constexpr int SPOS = CTX_ + T_, NPC = SPOS / CH_, NPCC = CTX_ / CH_, M5 = B_ * NPC, M5P = pad256(M5);
constexpr int KSM = 256, OWD = 0, OAD = 2 * RDR_, OGD = OAD + 2 * RIR_, OGL = OGD + RGR_;
constexpr int NSM = 5 * RW + 2 * GKD, NSMP = pad256(NSM), NGF = 2 * RW + 2 * GKD, NGB = 3 * RW;
constexpr int K5 = CH_ * SG_, KT5 = K5 + 4 * SP_, N5A = 4 * SP_, N5AP = pad256(N5A);
constexpr int EP = pad256(E_), NRS = EP + 2 * FF_;
constexpr int SWP = pad256(SW);
constexpr int NSLOT = pad256(NTOK * TOPK_) + E_ * 256, MAXT = NSLOT / 256;
constexpr int ROWS_ = T_ / GW_;
constexpr float LN_EPS = 1e-6f, GN_EPS = 64e-5f;
static_assert(OGL + 2 * GGR_ <= KSM, "ksm");
static_assert(NTOK % 256 == 0 && NLAT % 256 == 0, "rows");
static_assert(FF_ % 128 == 0 && D_ % 256 == 0, "ff");

typedef unsigned short bf16_t;
#ifdef CPU_TEST
#include <cmath>
#include <cstring>
#include <cstdio>
#include <cstdlib>
#include <vector>
#define HD static inline
#define HDM inline
#define NL 1
static inline float WSUM(float v) { return v; }
struct F4 { float v[4]; float& operator[](int i) { return v[i]; } const float& operator[](int i) const { return v[i]; } };
#else
#include <hip/hip_runtime.h>
#define HD __device__ __forceinline__
#define HDM __device__ __forceinline__
#define NL 64
#define DPP_ADD(v, ctrl) v += __builtin_bit_cast(float, __builtin_amdgcn_update_dpp(0, __builtin_bit_cast(int, v), ctrl, 0xF, 0xF, true))
HD float WSUM(float v) {
    DPP_ADD(v, 0xB1); DPP_ADD(v, 0x4E); DPP_ADD(v, 0x141); DPP_ADD(v, 0x140);
    const int b = __builtin_bit_cast(int, v);
    const float s0 = __builtin_bit_cast(float, __builtin_amdgcn_readlane(b, 0)), s1 = __builtin_bit_cast(float, __builtin_amdgcn_readlane(b, 16)),
                s2 = __builtin_bit_cast(float, __builtin_amdgcn_readlane(b, 32)), s3 = __builtin_bit_cast(float, __builtin_amdgcn_readlane(b, 48));
    return (s0 + s1) + (s2 + s3);
}
typedef float F4 __attribute__((ext_vector_type(4)));
#endif

#ifdef CPU_TEST
HD bf16_t f2bf(float f) { unsigned u; memcpy(&u, &f, 4); u += 0x7FFFu + ((u >> 16) & 1u); return (bf16_t)(u >> 16); }
#else
HD bf16_t f2bf(float f) { return __builtin_bit_cast(unsigned short, (__bf16)f); }
#endif
HD float bf2f(bf16_t b) { unsigned u = ((unsigned)b) << 16; float f; memcpy(&f, &u, 4); return f; }
#ifdef CPU_TEST
HD float fexp(float x) { return expf(x); }
HD float flog(float x) { return logf(x); }
HD float frcp(float x) { return 1.0f / x; }
#else
HD float fexp(float x) { return __expf(x); }
HD float flog(float x) { return __logf(x); }
HD float frcp(float x) { return __builtin_amdgcn_rcpf(x); }
#endif
HD float sigmoidf_(float x) { return frcp(1.0f + fexp(-x)); }
HD float siluf_(float x) { return x * sigmoidf_(x); }
HD float softplusf_(float x) { return x > 20.f ? x : flog(1.0f + fexp(x)); }
HD float ftanh(float x) { const float e = fexp(2.0f * (x > 15.f ? 15.f : x)); return 1.0f - 2.0f * frcp(e + 1.0f); }
HD float geluf_(float x) { return 0.5f * x * (1.0f + ftanh(0.7978845608028654f * (x + 0.044715f * x * x * x))); }

HD int row_of(int b, int pos) { return pos < CTX_ ? NLAT + b * CTX_ + pos : b * T_ + (pos - CTX_); }
HD int bidx_of(int n) { return n < NLAT ? n / T_ : B_; }
HD int seqpos(int d, int i) { return d == 0 ? i : (i < CTX_ ? CTX_ - 1 - i : CTX_ + T_ - 1 - (i - CTX_)); }

constexpr size_t al256(size_t x) { return (x + 255) / 256 * 256; }
struct WSMap {
    size_t ctl, silu_c, modv, w_inT, w_outT, wsmT, rsT, w13T, w2T, shw2T, gluT, s5Wa, s5Tb, s5pw, s5bb, s5K;
    size_t h, ymix, yo, xcur, x1, h2, eidx, ewt, slot_of, ecnt, efill, eoff, nunits, ulist, slot_tok;
    size_t proj, rkv, asmall, gs, gsb, yr, og, U2, xl, yc;
    size_t logits, sact, act, Y, Ysh;
    size_t end;
};
constexpr WSMap make_wsmap() {
    WSMap m{}; size_t o = 0;
#define TAKE(f, bytes) m.f = o; o = al256(o + (size_t)(bytes));
    TAKE(ctl, 65536)
    TAKE(silu_c, (B_ + 1) * D_ * 4) TAKE(modv, (size_t)L_ * (B_ + 1) * 6 * D_ * 4)
    TAKE(w_inT, (size_t)L_ * NINP * D_ * 2) TAKE(w_outT, (size_t)L_ * D_ * MIXW * 2) TAKE(wsmT, (size_t)L_ * NSMP * KSM * 2)
    TAKE(rsT, (size_t)L_ * NRS * D_ * 2) TAKE(w13T, (size_t)L_ * E_ * 2 * FF_ * D_ * 2) TAKE(w2T, (size_t)L_ * E_ * D_ * FF_ * 2)
    TAKE(shw2T, (size_t)L_ * D_ * FF_ * 2) TAKE(gluT, (size_t)L_ * SWP * SW * 2)
    TAKE(s5Wa, (size_t)L_ * SNG_ * N5AP * K5 * 2) TAKE(s5Tb, (size_t)L_ * SNG_ * K5 * KT5 * 2)
    TAKE(s5pw, (size_t)L_ * 2 * SNG_ * SP_ * (CH_ + 1) * 2 * 4) TAKE(s5bb, (size_t)L_ * 2 * SNG_ * SP_ * SG_ * 2 * 4) TAKE(s5K, (size_t)L_ * 2 * SNG_ * CH_ * SG_ * SG_ * 4)
    TAKE(h, (size_t)NTOK * D_ * 2) TAKE(ymix, (size_t)NTOK * MIXW * 2) TAKE(yo, (size_t)NTOK * D_ * 2) TAKE(xcur, (size_t)NTOK * D_ * 2)
    TAKE(x1, (size_t)NTOK * D_ * 2) TAKE(h2, (size_t)NTOK * D_ * 2)
    TAKE(eidx, (size_t)NTOK * TOPK_ * 4) TAKE(ewt, (size_t)NTOK * TOPK_ * 4) TAKE(slot_of, (size_t)NTOK * TOPK_ * 4)
    TAKE(ecnt, E_ * 4) TAKE(efill, E_ * 4) TAKE(eoff, (E_ + 1) * 4) TAKE(nunits, 256) TAKE(ulist, (size_t)MAXT * 16) TAKE(slot_tok, (size_t)NSLOT * 4)
    const size_t regA = o;
    TAKE(proj, (size_t)NTOK * NINP * 2) TAKE(rkv, (size_t)NTOK * 3 * RW * 2) TAKE(asmall, (size_t)NTOK * KSM * 2) TAKE(gs, (size_t)NTOK * NGF * 4) TAKE(gsb, (size_t)NTOK * NGB * 2)
    TAKE(yr, (size_t)2 * NTOK * RW * 4) TAKE(og, (size_t)2 * NTOK * GWD * 4) TAKE(U2, (size_t)SNG_ * M5P * KT5 * 2) TAKE(xl, (size_t)SNG_ * M5P * N5AP * 4)
    TAKE(yc, (size_t)NTOK * SW * 2)
    const size_t endA = o; o = regA;
    TAKE(logits, (size_t)NTOK * E_ * 4) TAKE(sact, (size_t)NTOK * FF_ * 2) TAKE(act, (size_t)NSLOT * FF_ * 2) TAKE(Y, (size_t)NSLOT * D_ * 2) TAKE(Ysh, (size_t)NTOK * D_ * 2)
    m.end = o > endA ? o : endA;
#undef TAKE
    return m;
}
constexpr WSMap WS = make_wsmap();

struct P {
    const float *x, *c, *ctx, *c_ctx, *w_mod, *b_mod, *w_in, *rwkv_conv, *rwkv_w0, *rwkv_w_up, *rwkv_a0, *rwkv_a_up, *rwkv_g_up, *rwkv_k_k, *rwkv_k_a,
        *rwkv_r_k, *rwkv_ln_g, *rwkv_ln_b, *gla_a_up, *gla_a_bias, *gla_norm_g, *s5_lam_re, *s5_lam_im, *s5_log_dt, *s5_b_re, *s5_b_im, *s5_c_re, *s5_c_im,
        *s5_d, *s5_glu_w, *s5_glu_b, *w_out, *ln1_g, *ln1_b, *router_w, *router_bias, *exp_w13, *exp_w2, *sh_w13, *sh_w2, *ln2_g, *ln2_b;
    float* out; unsigned char* ws;
};
#define WSP(type, field) ((type*)(p.ws + WS.field))
#define GIDX long gid = (long)wv * NL + lane; const long gsz = (long)nwv * NL
#ifdef CPU_TEST
HD void ld8bf(const bf16_t* q, float* o) { for (int j = 0; j < 8; ++j) o[j] = bf2f(q[j]); }
HD void ld8f(const float* q, float* o) { for (int j = 0; j < 8; ++j) o[j] = q[j]; }
HD void st8f(float* q, const float* v) { for (int j = 0; j < 8; ++j) q[j] = v[j]; }
HD void st8bf(bf16_t* q, const float* v) { for (int j = 0; j < 8; ++j) q[j] = f2bf(v[j]); }
HD void cp8bf(bf16_t* q, const bf16_t* s) { for (int j = 0; j < 8; ++j) q[j] = s[j]; }
HD void z8bf(bf16_t* q) { for (int j = 0; j < 8; ++j) q[j] = 0; }
#else
typedef unsigned U4 __attribute__((ext_vector_type(4)));
HD void ld8bf(const bf16_t* q, float* o) { const U4 w = *(const U4*)q;
#pragma unroll
    for (int j = 0; j < 4; ++j) { o[2 * j] = __uint_as_float(w[j] << 16); o[2 * j + 1] = __uint_as_float(w[j] & 0xffff0000u); } }
HD void ld8f(const float* q, float* o) { const F4 a = *(const F4*)q, b = *(const F4*)(q + 4); o[0] = a[0]; o[1] = a[1]; o[2] = a[2]; o[3] = a[3]; o[4] = b[0]; o[5] = b[1]; o[6] = b[2]; o[7] = b[3]; }
HD void st8f(float* q, const float* v) { *(F4*)q = (F4){v[0], v[1], v[2], v[3]}; *(F4*)(q + 4) = (F4){v[4], v[5], v[6], v[7]}; }
HD void st8bf(bf16_t* q, const float* v) { U4 w;
#pragma unroll
    for (int j = 0; j < 4; ++j) w[j] = (unsigned)f2bf(v[2 * j]) | ((unsigned)f2bf(v[2 * j + 1]) << 16);
    *(U4*)q = w; }
HD void cp8bf(bf16_t* q, const bf16_t* s) { *(U4*)q = *(const U4*)s; }
HD void z8bf(bf16_t* q) { *(U4*)q = (U4){0u, 0u, 0u, 0u}; }
#endif

HD void st_siluc(const P& p, int wv, int nwv, int lane) {
    GIDX; float* sc = WSP(float, silu_c);
    for (long i = gid; i < (long)(B_ + 1) * D_; i += gsz) { const int b = (int)(i / D_), k = (int)(i % D_); const float v = b < B_ ? p.c[(size_t)b * D_ + k] : p.c_ctx[k]; sc[i] = siluf_(v); }
}
HD void st_modv(const P& p, int wv, int nwv, int lane) {
    GIDX; const float* sc = WSP(float, silu_c); float* mv = WSP(float, modv);
    for (long i = gid; i < (long)L_ * 6 * D_; i += gsz) {
        const int l = (int)(i / (6 * D_)), col = (int)(i % (6 * D_));
        float acc[B_ + 1];
#pragma unroll
        for (int b = 0; b <= B_; ++b) acc[b] = 0.f;
        const float* w = p.w_mod + (size_t)l * D_ * 6 * D_ + col;
        for (int k = 0; k < D_; ++k) { const float wk = w[(size_t)k * 6 * D_];
#pragma unroll
            for (int b = 0; b <= B_; ++b) acc[b] += sc[b * D_ + k] * wk; }
        const float bm = p.b_mod[(size_t)l * 6 * D_ + col];
#pragma unroll
        for (int b = 0; b <= B_; ++b) mv[((size_t)l * (B_ + 1) + b) * 6 * D_ + col] = acc[b] + bm;
    }
}
HD void cvt_T(bf16_t* dst, const float* src, int Ndst, int K, int Nsrc, int nvalid, int src_col0, long gid, long gsz) {
    for (long i = gid; i < (long)Ndst * K; i += gsz) { const int n = (int)(i % Ndst), k = (int)(i / Ndst);
        dst[(size_t)n * K + k] = n < nvalid ? f2bf(src[(size_t)k * Nsrc + src_col0 + n]) : (bf16_t)0; }
}
HD void st_cvt1(const P& p, int l, int wv, int nwv, int lane) {
    GIDX;
    cvt_T(WSP(bf16_t, w_inT) + (size_t)l * NINP * D_, p.w_in + (size_t)l * D_ * NIN, NINP, D_, NIN, NIN, 0, gid, gsz);
    cvt_T(WSP(bf16_t, w_outT) + (size_t)l * D_ * MIXW, p.w_out + (size_t)l * MIXW * D_, D_, MIXW, D_, D_, 0, gid, gsz);
    cvt_T(WSP(bf16_t, shw2T) + (size_t)l * D_ * FF_, p.sh_w2 + (size_t)l * FF_ * D_, D_, FF_, D_, D_, 0, gid, gsz);
    cvt_T(WSP(bf16_t, gluT) + (size_t)l * SWP * SW, p.s5_glu_w + (size_t)l * SW * SW, SWP, SW, SW, SW, 0, gid, gsz);
}
HD void st_cvt2(const P& p, int l, int wv, int nwv, int lane) {
    GIDX;
    bf16_t* rs = WSP(bf16_t, rsT) + (size_t)l * NRS * D_;
    cvt_T(rs, p.router_w + (size_t)l * D_ * E_, EP, D_, E_, E_, 0, gid, gsz);
    for (int j = 0; j < FF_ / 128; ++j) {
        cvt_T(rs + (size_t)(EP + 256 * j) * D_, p.sh_w13 + (size_t)l * D_ * 2 * FF_, 128, D_, 2 * FF_, 128, 128 * j, gid, gsz);
        cvt_T(rs + (size_t)(EP + 256 * j + 128) * D_, p.sh_w13 + (size_t)l * D_ * 2 * FF_, 128, D_, 2 * FF_, 128, FF_ + 128 * j, gid, gsz);
    }
}
HD void st_cvt3(const P& p, int l, int wv, int nwv, int lane) {
    GIDX;
    for (long i = gid; i < (long)E_ * 2 * FF_ * D_; i += gsz) {
        const int n = (int)(i % (2 * FF_)); const long r = i / (2 * FF_); const int k = (int)(r % D_), e = (int)(r / D_);
        const int j = n / 256, w = n % 256, srcc = w < 128 ? 128 * j + w : FF_ + 128 * j + (w - 128);
        WSP(bf16_t, w13T)[(((size_t)l * E_ + e) * 2 * FF_ + n) * D_ + k] = f2bf(p.exp_w13[(((size_t)l * E_ + e) * D_ + k) * 2 * FF_ + srcc]);
    }
}
HD void st_cvt4(const P& p, int l, int wv, int nwv, int lane) {
    GIDX;
    for (long i = gid; i < (long)E_ * D_ * FF_; i += gsz) {
        const int n = (int)(i % D_); const long r = i / D_; const int k = (int)(r % FF_), e = (int)(r / FF_);
        WSP(bf16_t, w2T)[(((size_t)l * E_ + e) * D_ + n) * FF_ + k] = f2bf(p.exp_w2[(((size_t)l * E_ + e) * FF_ + k) * D_ + n]);
    }
}
HD void st_cvt5(const P& p, int l, int wv, int nwv, int lane) {
    GIDX;
    bf16_t* ws = WSP(bf16_t, wsmT) + (size_t)l * NSMP * KSM;
    for (long i = gid; i < (long)NSMP * KSM; i += gsz) {
        const int n = (int)(i / KSM), k = (int)(i % KSM); float v = 0.f;
        if (n < 2 * RW) { const int d = n / RW, c = n % RW, r = k - (OWD + d * RDR_); if (r >= 0 && r < RDR_) v = p.rwkv_w_up[(((size_t)l * 2 + d) * RDR_ + r) * RW + c]; }
        else if (n < 4 * RW) { const int d = (n - 2 * RW) / RW, c = n % RW, r = k - (OAD + d * RIR_); if (r >= 0 && r < RIR_) v = p.rwkv_a_up[(((size_t)l * 2 + d) * RIR_ + r) * RW + c]; }
        else if (n < 5 * RW) { const int c = n - 4 * RW, r = k - OGD; if (r >= 0 && r < RGR_) v = p.rwkv_g_up[((size_t)l * RGR_ + r) * RW + c]; }
        else if (n < NSM) { const int q = n - 5 * RW, d = q / GKD, c = q % GKD, r = k - (OGL + d * GGR_); if (r >= 0 && r < GGR_) v = p.gla_a_up[(((size_t)l * 2 + d) * GGR_ + r) * GKD + c]; }
        ws[i] = f2bf(v);
    }
}
HD void st_s5a(const P& p, int wv, int nwv, int lane) {
    GIDX; float* pw = WSP(float, s5pw); float* bb = WSP(float, s5bb);
    for (long i = gid; i < (long)L_ * 2 * SNG_ * SP_ * (CH_ + 1); i += gsz) {
        const int tau = (int)(i % (CH_ + 1)); long r = i / (CH_ + 1); const int pp = (int)(r % SP_); r /= SP_; const int g = (int)(r % SNG_); r /= SNG_; const int d = (int)(r % 2), l = (int)(r / 2);
        const double dt = exp((double)p.s5_log_dt[((size_t)l * 2 + d) * SNG_ + g]);
        const double zr = (double)p.s5_lam_re[((size_t)l * 2 + d) * SP_ + pp] * dt, zi = (double)p.s5_lam_im[((size_t)l * 2 + d) * SP_ + pp] * dt;
        const double mag = exp(zr * tau);
        pw[i * 2] = (float)(mag * cos(zi * tau)); pw[i * 2 + 1] = (float)(mag * sin(zi * tau));
    }
    for (long i = gid; i < (long)L_ * 2 * SNG_ * SP_ * SG_; i += gsz) {
        const int c = (int)(i % SG_); long r = i / SG_; const int pp = (int)(r % SP_); r /= SP_; const int g = (int)(r % SNG_); r /= SNG_; const int d = (int)(r % 2), l = (int)(r / 2);
        const double dt = exp((double)p.s5_log_dt[((size_t)l * 2 + d) * SNG_ + g]);
        const double lr = p.s5_lam_re[((size_t)l * 2 + d) * SP_ + pp], li = p.s5_lam_im[((size_t)l * 2 + d) * SP_ + pp];
        const double zr = lr * dt, zi = li * dt, mag = exp(zr), ar = mag * cos(zi), ai = mag * sin(zi), den = lr * lr + li * li;
        const double fr = ((ar - 1) * lr + ai * li) / den, fi = (ai * lr - (ar - 1) * li) / den;
        const size_t bi = ((((size_t)l * 2 + d) * SNG_ + g) * SP_ + pp) * SG_ + c;
        const double br = p.s5_b_re[bi], bim = p.s5_b_im[bi];
        bb[i * 2] = (float)(fr * br - fi * bim); bb[i * 2 + 1] = (float)(fr * bim + fi * br);
    }
}
HD void st_s5b(const P& p, int wv, int nwv, int lane) {
    GIDX; const float* pw = WSP(float, s5pw); const float* bb = WSP(float, s5bb); float* K = WSP(float, s5K);
    for (long i = gid; i < (long)L_ * 2 * SNG_ * CH_ * SG_ * SG_; i += gsz) {
        const int c2 = (int)(i % SG_); long r = i / SG_; const int c = (int)(r % SG_); r /= SG_; const int tau = (int)(r % CH_); r /= CH_; const long ldg = r;
        float acc = 0.f;
        for (int pp = 0; pp < SP_; ++pp) {
            const float cr = p.s5_c_re[(ldg * SG_ + c) * SP_ + pp], ci = p.s5_c_im[(ldg * SG_ + c) * SP_ + pp];
            const float ar = pw[((ldg * SP_ + pp) * (CH_ + 1) + tau) * 2], ai = pw[((ldg * SP_ + pp) * (CH_ + 1) + tau) * 2 + 1];
            const float br = bb[((ldg * SP_ + pp) * SG_ + c2) * 2], bi = bb[((ldg * SP_ + pp) * SG_ + c2) * 2 + 1];
            const float er = cr * ar - ci * ai, ei = cr * ai + ci * ar;
            acc += er * br - ei * bi;
        }
        K[i] = acc;
    }
}
static_assert(SG_ == 16 && K5 % 8 == 0 && KT5 % 8 == 0 && SP_ % 8 == 0, "s5c item shape");
HD void st_s5c(const P& p, int wv, int nwv, int lane) {
    GIDX; const float* pw = WSP(float, s5pw); const float* bb = WSP(float, s5bb); const float* K = WSP(float, s5K);
    bf16_t* Tb = WSP(bf16_t, s5Tb); bf16_t* Wa = WSP(bf16_t, s5Wa);
    for (long i = gid; i < (long)L_ * SNG_ * K5 * (KT5 / 8); i += gsz) {
        const int k = (int)(i % (KT5 / 8)) * 8; long r = i / (KT5 / 8); const int n = (int)(r % K5); r /= K5; const int g = (int)(r % SNG_), l = (int)(r / SNG_);
        const int t = n / SG_, c = n % SG_; float v[8];
        const long ldg0 = ((long)l * 2 + 0) * SNG_ + g, ldg1 = ((long)l * 2 + 1) * SNG_ + g;
        if (k < K5) { const int s = k / SG_, c2 = k % SG_; const float m0 = s <= t ? 1.f : 0.f, m1 = s >= t ? 1.f : 0.f; const int t0 = s <= t ? t - s : 0, t1 = s >= t ? s - t : 0;
            float a[8], b[8]; ld8f(K + ((ldg0 * CH_ + t0) * SG_ + c) * SG_ + c2, a); ld8f(K + ((ldg1 * CH_ + t1) * SG_ + c) * SG_ + c2, b);
            const float dd = p.s5_d[(size_t)l * SW + g * SG_ + c];
#pragma unroll
            for (int j = 0; j < 8; ++j) v[j] = m0 * a[j] + m1 * b[j] + ((s == t && c == c2 + j) ? dd : 0.f);
        } else { const int q = k - K5, d = q / (2 * SP_), part = (q / SP_) & 1, pp0 = q % SP_; const long ldg = d ? ldg1 : ldg0; const int ex = d ? (CH_ - t) : (t + 1);
            float cr[8], ci[8]; ld8f(p.s5_c_re + (ldg * SG_ + c) * SP_ + pp0, cr); ld8f(p.s5_c_im + (ldg * SG_ + c) * SP_ + pp0, ci);
#pragma unroll
            for (int j = 0; j < 8; ++j) { const float ar = pw[((ldg * SP_ + pp0 + j) * (CH_ + 1) + ex) * 2], ai = pw[((ldg * SP_ + pp0 + j) * (CH_ + 1) + ex) * 2 + 1];
                v[j] = part == 0 ? (cr[j] * ar - ci[j] * ai) : -(cr[j] * ai + ci[j] * ar); } }
        st8bf(Tb + i * 8, v);
    }
    for (long i = gid; i < (long)L_ * SNG_ * N5AP * (K5 / 8); i += gsz) {
        const int k = (int)(i % (K5 / 8)) * 8; long r = i / (K5 / 8); const int n = (int)(r % N5AP); r /= N5AP; const int g = (int)(r % SNG_), l = (int)(r / SNG_);
        float v[8];
#pragma unroll
        for (int j = 0; j < 8; ++j) v[j] = 0.f;
        if (n < N5A) { const int d = n / (2 * SP_), part = (n / SP_) & 1, pp = n % SP_, s = k / SG_, c2 = k % SG_; const long ldg = ((long)l * 2 + d) * SNG_ + g; const int ex = d ? s : (CH_ - 1 - s);
            const float ar = pw[((ldg * SP_ + pp) * (CH_ + 1) + ex) * 2], ai = pw[((ldg * SP_ + pp) * (CH_ + 1) + ex) * 2 + 1];
            float b0[8], b1[8]; ld8f(bb + ((ldg * SP_ + pp) * SG_ + c2) * 2, b0); ld8f(bb + ((ldg * SP_ + pp) * SG_ + c2) * 2 + 8, b1);
#pragma unroll
            for (int j = 0; j < 8; ++j) { const float br = j < 4 ? b0[2 * j] : b1[2 * (j - 4)], bi = j < 4 ? b0[2 * j + 1] : b1[2 * (j - 4) + 1]; v[j] = part == 0 ? (ar * br - ai * bi) : (ar * bi + ai * br); } }
        st8bf(Wa + i * 8, v);
    }
}
HD const float* xsrc0(const P& p, int n) { return n < NLAT ? p.x + (size_t)n * D_ : p.ctx + (size_t)(n - NLAT) * D_; }
HD void ln_stats(const float* z, int lane, float& mu, float& rstd) {
    float s = 0.f; for (int k = lane; k < D_; k += NL) s += z[k]; s = WSUM(s); mu = s * (1.0f / D_);
    float q = 0.f; for (int k = lane; k < D_; k += NL) { const float d = z[k] - mu; q += d * d; } q = WSUM(q); rstd = 1.0f / sqrtf(q * (1.0f / D_) + LN_EPS);
}
constexpr int PERL = D_ / NL, NCHK = PERL / 4;
HD void row_stats(const float* xv, float& mu, float& rstd) {
    float s = 0.f;
#pragma unroll
    for (int i = 0; i < PERL; ++i) s += xv[i];
    s = WSUM(s); mu = s * (1.0f / D_); float q = 0.f;
#pragma unroll
    for (int i = 0; i < PERL; ++i) { const float d = xv[i] - mu; q += d * d; }
    q = WSUM(q); rstd = 1.0f / sqrtf(q * (1.0f / D_) + LN_EPS);
}
HD void row_ld(const float* z, int lane, float* xv) {
#pragma unroll
    for (int i = 0; i < NCHK; ++i) { const F4 v = *(const F4*)(z + 4 * lane + 4 * NL * i); xv[4 * i] = v[0]; xv[4 * i + 1] = v[1]; xv[4 * i + 2] = v[2]; xv[4 * i + 3] = v[3]; }
}
HD void st4bf(bf16_t* q, const float* v) {
#ifdef CPU_TEST
    for (int j = 0; j < 4; ++j) q[j] = f2bf(v[j]);
#else
    uint2 w; w.x = (unsigned)f2bf(v[0]) | ((unsigned)f2bf(v[1]) << 16); w.y = (unsigned)f2bf(v[2]) | ((unsigned)f2bf(v[3]) << 16); *(uint2*)q = w;
#endif
}
HD void ld4bf(const bf16_t* q, float* o) {
#ifdef CPU_TEST
    for (int j = 0; j < 4; ++j) o[j] = bf2f(q[j]);
#else
    const uint2 w = *(const uint2*)q; o[0] = __uint_as_float(w.x << 16); o[1] = __uint_as_float(w.x & 0xffff0000u); o[2] = __uint_as_float(w.y << 16); o[3] = __uint_as_float(w.y & 0xffff0000u);
#endif
}
HD void row_mod_store(const float* xv, const float* mv, int sh_off, int sc_off, bf16_t* hrow, int lane) {
    float mu, rstd; row_stats(xv, mu, rstd);
#pragma unroll
    for (int i = 0; i < NCHK; ++i) { const int k = 4 * lane + 4 * NL * i; const F4 sc = *(const F4*)(mv + sc_off + k), sh = *(const F4*)(mv + sh_off + k); float o[4];
#pragma unroll
        for (int j = 0; j < 4; ++j) o[j] = (xv[4 * i + j] - mu) * rstd * (1.0f + sc[j]) + sh[j];
        st4bf(hrow + k, o); }
}
HD void row_affine(float* xv, const float* g, const float* bb, int lane) {
    float mu, rstd; row_stats(xv, mu, rstd);
#pragma unroll
    for (int i = 0; i < NCHK; ++i) { const int k = 4 * lane + 4 * NL * i; const F4 gg = *(const F4*)(g + k), be = *(const F4*)(bb + k);
#pragma unroll
        for (int j = 0; j < 4; ++j) xv[4 * i + j] = (xv[4 * i + j] - mu) * rstd * gg[j] + be[j]; }
}
HD void row_ld_bf(const bf16_t* z, int lane, float* xv) {
#pragma unroll
    for (int i = 0; i < NCHK; ++i) ld4bf(z + 4 * lane + 4 * NL * i, xv + 4 * i);
}
HD void row_st_bf(bf16_t* z, int lane, const float* xv) {
#pragma unroll
    for (int i = 0; i < NCHK; ++i) st4bf(z + 4 * lane + 4 * NL * i, xv + 4 * i);
}
HD void row_ld_x(const P& p, int l, int n, int lane, float* xv) { if (l == 0) row_ld(xsrc0(p, n), lane, xv); else row_ld_bf(WSP(bf16_t, xcur) + (size_t)n * D_, lane, xv); }
HD void row_st(float* z, int lane, const float* xv) {
#pragma unroll
    for (int i = 0; i < NCHK; ++i) { F4 v; v[0] = xv[4 * i]; v[1] = xv[4 * i + 1]; v[2] = xv[4 * i + 2]; v[3] = xv[4 * i + 3]; *(F4*)(z + 4 * lane + 4 * NL * i) = v; }
}
HD void st_hmod(const P& p, int l, int wv, int nwv, int lane) {
    bf16_t* h = WSP(bf16_t, h);
    for (int n = wv; n < NTOK; n += nwv) {
        float xv[PERL]; row_ld_x(p, l, n, lane, xv);
        const float* mv = WSP(float, modv) + ((size_t)l * (B_ + 1) + bidx_of(n)) * 6 * D_;
        row_mod_store(xv, mv, 0, D_, h + (size_t)n * D_, lane);
    }
}
static_assert(RCOLS % 8 == 0 && RW % 8 == 0 && RDR_ % 4 == 0, "prep1 groups");
HD void st_prep1(const P& p, int l, int wv, int nwv, int lane) {
    GIDX; const bf16_t* proj = WSP(bf16_t, proj); bf16_t* rkv = WSP(bf16_t, rkv); bf16_t* as = WSP(bf16_t, asmall); bf16_t* U2 = WSP(bf16_t, U2);
    const float* taps = p.rwkv_conv + (size_t)l * 9 * RCOLS; constexpr int NG = RCOLS / 8;
    for (long i0 = gid; i0 < (long)NTOK * NG; i0 += 2 * gsz) {
#pragma unroll
      for (int u2 = 0; u2 < 2; ++u2) { const long i = i0 + u2 * gsz; if (i < (long)NTOK * NG) {
        const int n = (int)(i / NG), ch = (int)(i % NG) * 8; float acc[8];
#pragma unroll
        for (int j = 0; j < 8; ++j) acc[j] = 0.f;
        if (n < NLAT) { const int b = n / T_, t = n % T_, gr = t / GW_, gc = t % GW_;
#pragma unroll
            for (int a = 0; a < 3; ++a)
#pragma unroll
                for (int j = 0; j < 3; ++j) { const int rr = gr + a - 1, cc = gc + j - 1; const bool ok = rr >= 0 && rr < ROWS_ && cc >= 0 && cc < GW_;
                    const int nn = ok ? b * T_ + rr * GW_ + cc : n; float x[8], w[8]; ld8bf(proj + (size_t)nn * NINP + ch, x); ld8f(taps + (a * 3 + j) * RCOLS + ch, w); const float m = ok ? 1.f : 0.f;
#pragma unroll
                    for (int q = 0; q < 8; ++q) acc[q] += (w[q] * m) * x[q]; }
        } else { const int s = (n - NLAT) % CTX_;
#pragma unroll
            for (int j = 0; j < 3; ++j) { const int ss = s + j - 1; const bool ok = ss >= 0 && ss < CTX_; const int nn = ok ? n + j - 1 : n; float x[8], w[8]; ld8bf(proj + (size_t)nn * NINP + ch, x); ld8f(taps + (3 + j) * RCOLS + ch, w); const float m = ok ? 1.f : 0.f;
#pragma unroll
                for (int q = 0; q < 8; ++q) acc[q] += (w[q] * m) * x[q]; } }
        if (ch < 3 * RW) st8bf(rkv + (size_t)n * 3 * RW + ch, acc);
        else { const int q0 = ch - 3 * RW;
            if (q0 < 2 * RDR_) {
#pragma unroll
                for (int q = 0; q < 8; ++q) acc[q] = ftanh(acc[q]); }
            else if (q0 >= 2 * RDR_ + 2 * RIR_) {
#pragma unroll
                for (int q = 0; q < 8; ++q) acc[q] = sigmoidf_(acc[q]); }
            st8bf(as + (size_t)n * KSM + q0, acc); }
          } }
    }
    constexpr int NT8 = (KSM - OGL) / 8;
    for (long i = gid; i < (long)NTOK * NT8; i += gsz) { const int n = (int)(i / NT8), q = (int)(i % NT8) * 8;
        if (q < 2 * GGR_) cp8bf(as + (size_t)n * KSM + OGL + q, proj + (size_t)n * NINP + GBASE + 2 * GKD + 2 * GWD + q); else z8bf(as + (size_t)n * KSM + OGL + q); }
    for (long i = gid; i < (long)B_ * SPOS * (SW / 8); i += gsz) { const int c = (int)(i % (SW / 8)) * 8; const long r = i / (SW / 8); const int pos = (int)(r % SPOS), b = (int)(r / SPOS);
        const int g = c / SG_, cc = c % SG_, pc = pos / CH_, t = pos % CH_, m = b * NPC + pc;
        cp8bf(U2 + ((size_t)g * M5P + m) * KT5 + t * SG_ + cc, proj + (size_t)row_of(b, pos) * NINP + SBASE + c); }
}
HD void st_s5carry(const P& p, int l, int wv, int nwv, int lane) {
    GIDX; const float* xl = WSP(float, xl); bf16_t* U2 = WSP(bf16_t, U2); const float* pw = WSP(float, s5pw);
    for (long i = gid; i < (long)2 * B_ * SNG_ * SP_; i += gsz) {
        const int pp = (int)(i % SP_); long r = i / SP_; const int g = (int)(r % SNG_); r /= SNG_; const int b = (int)(r % B_), d = (int)(r / B_);
        const long ldg = ((long)l * 2 + d) * SNG_ + g; const float ar = pw[((ldg * SP_ + pp) * (CH_ + 1) + CH_) * 2], ai = pw[((ldg * SP_ + pp) * (CH_ + 1) + CH_) * 2 + 1];
        float xr = 0.f, xi = 0.f;
        for (int q = 0; q < NPC; ++q) {
            const int pc = d == 0 ? q : (q < NPCC ? NPCC - 1 - q : NPC - 1 - (q - NPCC)); const size_t m = (size_t)b * NPC + pc;
            bf16_t* x0 = U2 + ((size_t)g * M5P + m) * KT5 + K5 + d * 2 * SP_; x0[pp] = f2bf(xr); x0[SP_ + pp] = f2bf(xi);
            const float lr = xl[((size_t)g * M5P + m) * N5AP + d * 2 * SP_ + pp], li = xl[((size_t)g * M5P + m) * N5AP + d * 2 * SP_ + SP_ + pp];
            const float nr = ar * xr - ai * xi + lr, ni = ar * xi + ai * xr + li; xr = nr; xi = ni;
        }
    }
}
struct RV { float r, w, k2, a, b, v, kkraw; };
HD void rwkv_elem(const P& p, int l, int d, int n, int hh, int j, float kknorm_rs, RV& o) {
    const bf16_t* rkv = WSP(bf16_t, rkv) + (size_t)n * 3 * RW; const float* gs = WSP(float, gs) + (size_t)n * NGF; const bf16_t* gb = WSP(bf16_t, gsb) + (size_t)n * NGB; const int c = hh * RN_ + j;
    const float k = bf2f(rkv[RW + c]); o.kkraw = k * p.rwkv_k_k[(size_t)l * RW + c]; const float kk = o.kkraw * kknorm_rs;
    const float a = bf2f(gb[d * RW + c]); o.w = fexp(gs[d * RW + c]); o.k2 = k * (1.0f + (a - 1.0f) * p.rwkv_k_a[(size_t)l * RW + c]);
    o.a = -kk; o.b = kk * a; o.r = bf2f(rkv[c]); o.v = bf2f(rkv[2 * RW + c]);
}
HD void st_post(const P& p, int l, int wv, int nwv, int lane) {
    bf16_t* ymix = WSP(bf16_t, ymix); const float* yr = WSP(float, yr); const float* og = WSP(float, og); const bf16_t* proj = WSP(bf16_t, proj); const bf16_t* gsbb = WSP(bf16_t, gsb); const bf16_t* rkvb = WSP(bf16_t, rkv);
    const int nrow = (l == L_ - 1) ? NLAT : NTOK; constexpr int PJ = RN_ / NL;
    for (int n = wv; n < nrow; n += nwv) {
        const bf16_t* rk = rkvb + (size_t)n * 3 * RW; const bf16_t* gb = gsbb + (size_t)n * NGB;
        float r_[RH_][PJ], k_[RH_][PJ], v_[RH_][PJ], y_[RH_][PJ], a0_[RH_][PJ], a1_[RH_][PJ], g_[RH_][PJ], o_[GH_][PJ], gg_[GH_][PJ];
#pragma unroll
        for (int hh = 0; hh < RH_; ++hh)
#pragma unroll
            for (int q = 0; q < PJ; ++q) { const int c = hh * RN_ + lane + NL * q; r_[hh][q] = bf2f(rk[c]); k_[hh][q] = bf2f(rk[RW + c]); v_[hh][q] = bf2f(rk[2 * RW + c]);
                y_[hh][q] = yr[(size_t)n * RW + c] + yr[((size_t)NTOK + n) * RW + c]; a0_[hh][q] = bf2f(gb[c]); a1_[hh][q] = bf2f(gb[RW + c]); g_[hh][q] = bf2f(gb[2 * RW + c]); }
#pragma unroll
        for (int hh = 0; hh < GH_; ++hh)
#pragma unroll
            for (int q = 0; q < PJ; ++q) { const int c = hh * GV_ + lane + NL * q; o_[hh][q] = og[(size_t)n * GWD + c] + og[((size_t)NTOK + n) * GWD + c]; gg_[hh][q] = bf2f(proj[(size_t)n * NINP + GBASE + 2 * GKD + GWD + c]); }
#pragma unroll
        for (int hh = 0; hh < RH_; ++hh) {
            float s = 0.f, bs = 0.f;
#pragma unroll
            for (int q = 0; q < PJ; ++q) { const int c = hh * RN_ + lane + NL * q; const float ka = p.rwkv_k_a[(size_t)l * RW + c];
                const float k20 = k_[hh][q] * (1.0f + (a0_[hh][q] - 1.0f) * ka), k21 = k_[hh][q] * (1.0f + (a1_[hh][q] - 1.0f) * ka);
                s += y_[hh][q]; bs += r_[hh][q] * (k20 + k21) * p.rwkv_r_k[(size_t)l * RW + c]; }
            s = WSUM(s); bs = WSUM(bs); const float mu = s * (1.0f / RN_); float qq = 0.f;
#pragma unroll
            for (int q = 0; q < PJ; ++q) { const float d = y_[hh][q] - mu; qq += d * d; }
            qq = WSUM(qq); const float rstd = 1.0f / sqrtf(qq * (1.0f / RN_) + GN_EPS);
#pragma unroll
            for (int q = 0; q < PJ; ++q) { const int c = hh * RN_ + lane + NL * q; const float gn = (y_[hh][q] - mu) * rstd * p.rwkv_ln_g[(size_t)l * RW + c] + p.rwkv_ln_b[(size_t)l * RW + c];
                ymix[(size_t)n * MIXW + c] = f2bf((gn + bs * v_[hh][q]) * g_[hh][q]); }
        }
#pragma unroll
        for (int hh = 0; hh < GH_; ++hh) { float qq = 0.f;
#pragma unroll
            for (int q = 0; q < PJ; ++q) qq += o_[hh][q] * o_[hh][q];
            qq = WSUM(qq); const float rs = 1.0f / sqrtf(qq * (1.0f / GV_) + 1e-6f);
#pragma unroll
            for (int q = 0; q < PJ; ++q) { const int j = lane + NL * q; ymix[(size_t)n * MIXW + RW + hh * GV_ + j] = f2bf(o_[hh][q] * rs * p.gla_norm_g[(size_t)l * GV_ + j] * siluf_(gg_[hh][q])); }
        }
    }
}
HD void st_ln1(const P& p, int l, int wv, int nwv, int lane) {
    GIDX; const float alpha = sqrtf(2.0f);
    for (long i = gid; i < E_; i += gsz) { WSP(int, ecnt)[i] = 0; WSP(int, efill)[i] = 0; }
    const int nrow = (l == L_ - 1) ? NLAT : NTOK; bf16_t* x1 = WSP(bf16_t, x1); bf16_t* h2 = WSP(bf16_t, h2); const bf16_t* yo = WSP(bf16_t, yo);
    for (int n = wv; n < nrow; n += nwv) {
        const float* mv = WSP(float, modv) + ((size_t)l * (B_ + 1) + bidx_of(n)) * 6 * D_;
        float xv[PERL], yv[PERL]; row_ld_x(p, l, n, lane, xv); row_ld_bf(yo + (size_t)n * D_, lane, yv);
#pragma unroll
        for (int i = 0; i < NCHK; ++i) { const F4 g1 = *(const F4*)(mv + 2 * D_ + 4 * lane + 4 * NL * i);
#pragma unroll
            for (int j = 0; j < 4; ++j) xv[4 * i + j] = alpha * xv[4 * i + j] + g1[j] * yv[4 * i + j]; }
        row_affine(xv, p.ln1_g + (size_t)l * D_, p.ln1_b + (size_t)l * D_, lane);
        row_st_bf(x1 + (size_t)n * D_, lane, xv);
        row_mod_store(xv, mv, 3 * D_, 4 * D_, h2 + (size_t)n * D_, lane);
    }
}
HD void st_topk(const P& p, int l, int wv, int nwv, int lane) {
    GIDX; const int nrow = (l == L_ - 1) ? NLAT : NTOK; const float* lg = WSP(float, logits); constexpr int EG = E_ / NGRP_;
    for (long n = gid; n < nrow; n += gsz) {
        const float* z = lg + (size_t)n * E_; const float* rb = p.router_bias + (size_t)l * E_;
        float gsc[NGRP_];
#pragma unroll
        for (int g = 0; g < NGRP_; ++g) { float m1 = -1e30f, m2 = -1e30f;
            for (int e = 0; e < EG; ++e) { const float s = sigmoidf_(z[g * EG + e]) + rb[g * EG + e]; if (s > m1) { m2 = m1; m1 = s; } else if (s > m2) m2 = s; }
            gsc[g] = m1 + m2; }
        unsigned gmask = 0;
#pragma unroll
        for (int g = 0; g < NGRP_; ++g) { int rank = 0;
#pragma unroll
            for (int g2 = 0; g2 < NGRP_; ++g2) rank += (gsc[g2] > gsc[g] || (gsc[g2] == gsc[g] && g2 < g)) ? 1 : 0;
            if (rank < TKG_) gmask |= 1u << g; }
        float pv = 1e30f; int pi = -1; float wsum = 0.f; int* ei = WSP(int, eidx) + (size_t)n * TOPK_; float* ew = WSP(float, ewt) + (size_t)n * TOPK_;
        for (int kk = 0; kk < TOPK_; ++kk) { float bv = -1e30f; int bi = -1;
            for (int e = 0; e < E_; ++e) { if (!((gmask >> (e / EG)) & 1u)) continue; const float s = sigmoidf_(z[e]) + rb[e];
                const bool after = (s < pv) || (s == pv && e > pi); if (after && s > bv) { bv = s; bi = e; } }
            pv = bv; pi = bi; ei[kk] = bi; const float w = sigmoidf_(z[bi]); ew[kk] = w; wsum += w; }
        for (int kk = 0; kk < TOPK_; ++kk) ew[kk] = ew[kk] / wsum * 2.5f;
#ifdef CPU_TEST
        for (int kk = 0; kk < TOPK_; ++kk) WSP(int, ecnt)[ei[kk]]++;
#else
        for (int kk = 0; kk < TOPK_; ++kk) atomicAdd(WSP(int, ecnt) + ei[kk], 1);
#endif
    }
}
HD void st_offsets(const P& p, int l, int wv, int nwv, int lane) {
    if (wv != 0 || lane != 0) return;
    int* eoff = WSP(int, eoff); const int* ecnt = WSP(int, ecnt); int* ul = WSP(int, ulist); int o = 0, nu = 0;
    for (int e = 0; e < E_; ++e) { eoff[e] = o; const int nt = (ecnt[e] + 255) / 256;
        for (int t = 0; t < nt; ++t) { ul[nu * 4 + 0] = o + 256 * t; ul[nu * 4 + 1] = e; ul[nu * 4 + 2] = (ecnt[e] - 256 * t) < 256 ? (ecnt[e] - 256 * t) : 256; ul[nu * 4 + 3] = 0; ++nu; }
        o += nt * 256; }
    eoff[E_] = o; WSP(int, nunits)[0] = nu;
}
HD void st_scatter0(const P& p, int l, int wv, int nwv, int lane) { GIDX; int* st = WSP(int, slot_tok); for (long i = gid; i < NSLOT; i += gsz) st[i] = 0; }
HD void st_scatter(const P& p, int l, int wv, int nwv, int lane) {
    GIDX; const int nrow = (l == L_ - 1) ? NLAT : NTOK; const int* ei = WSP(int, eidx); const int* eoff = WSP(int, eoff); int* so = WSP(int, slot_of); int* st = WSP(int, slot_tok);
    for (long i = gid; i < (long)nrow * TOPK_; i += gsz) { const int e = ei[i];
#ifdef CPU_TEST
        const int r = WSP(int, efill)[e]++;
#else
        const int r = atomicAdd(WSP(int, efill) + e, 1);
#endif
        const int s = eoff[e] + r; so[i] = s; st[s] = (int)(i / TOPK_); }
}
HD void st_ln2(const P& p, int l, int wv, int nwv, int lane) {
    const float alpha = sqrtf(2.0f); const bool last = (l == L_ - 1); const int nrow = last ? NLAT : NTOK;
    const bf16_t* x1 = WSP(bf16_t, x1); const bf16_t* Y = WSP(bf16_t, Y); const bf16_t* Ysh = WSP(bf16_t, Ysh); const int* so = WSP(int, slot_of); const float* ew = WSP(float, ewt);
    for (int n = wv; n < nrow; n += nwv) {
        const float* mv = WSP(float, modv) + ((size_t)l * (B_ + 1) + bidx_of(n)) * 6 * D_;
        float xv[PERL], fv[PERL]; row_ld_bf(x1 + (size_t)n * D_, lane, xv);
#pragma unroll
        for (int i = 0; i < NCHK; ++i) ld4bf(Ysh + (size_t)n * D_ + 4 * lane + 4 * NL * i, fv + 4 * i);
#pragma unroll
        for (int kk = 0; kk < TOPK_; ++kk) { const float w = ew[(size_t)n * TOPK_ + kk]; const bf16_t* yr_ = Y + (size_t)so[(size_t)n * TOPK_ + kk] * D_;
#pragma unroll
            for (int i = 0; i < NCHK; ++i) { float t4[4]; ld4bf(yr_ + 4 * lane + 4 * NL * i, t4);
#pragma unroll
                for (int j = 0; j < 4; ++j) fv[4 * i + j] += w * t4[j]; } }
#pragma unroll
        for (int i = 0; i < NCHK; ++i) { const F4 g2 = *(const F4*)(mv + 5 * D_ + 4 * lane + 4 * NL * i);
#pragma unroll
            for (int j = 0; j < 4; ++j) xv[4 * i + j] = alpha * xv[4 * i + j] + g2[j] * fv[4 * i + j]; }
        row_affine(xv, p.ln2_g + (size_t)l * D_, p.ln2_b + (size_t)l * D_, lane);
        if (last) row_st(p.out + (size_t)n * D_, lane, xv);
        else { row_st_bf(WSP(bf16_t, xcur) + (size_t)n * D_, lane, xv);
            const float* mv2 = WSP(float, modv) + ((size_t)(l + 1) * (B_ + 1) + bidx_of(n)) * 6 * D_;
            row_mod_store(xv, mv2, 0, D_, WSP(bf16_t, h) + (size_t)n * D_, lane); }
    }
}
struct UnitInfo { int arow0, brow0, g, pm, pn, nv; };
struct GemmArgs { const bf16_t* A; int lda; const int* rowmap; const bf16_t* Bt; int ldb; int K; };

struct StaticSched {
    int nb, nM, nN, aM, bN, G, c;
    HDM void init(int nb_, int M, int N, int aM_, int bN_, int G_, int c_) { nb = nb_; nM = M / 256; nN = N / 256; aM = aM_; bN = bN_; G = G_; c = c_; }
    HDM int max_units() const { return (nb * nM * nN + G - 1) / G; }
    HDM bool next(int i, UnitInfo& u) const {
        const long L = (long)i * G + c; const int per = nM * nN; if (L >= (long)nb * per) return false;
        const int g = (int)(L / per); int wgid = (int)(L % per);
        { const int q = per / 8, r = per % 8, xcd = wgid % 8, off = wgid / 8; wgid = (xcd < r ? xcd * (q + 1) : r * (q + 1) + (xcd - r) * q) + off; }
        const int nig = 8 * nN, gid = wgid / nig, fm = gid * 8, gsz = (nM - fm) < 8 ? (nM - fm) : 8;
        u.pm = fm + ((wgid % nig) % gsz); u.pn = (wgid % nig) / gsz; u.g = g; u.arow0 = g * aM + 256 * u.pm; u.brow0 = g * bN + 256 * u.pn; u.nv = 256; return true;
    }
};
HD int ld_int(const int* q) {
#ifdef CPU_TEST
    return *q;
#else
    return __hip_atomic_load(q, __ATOMIC_RELAXED, __HIP_MEMORY_SCOPE_AGENT);
#endif
}
struct ListSched {
    const int* ulist; const int* nunits; int ntn, bN, G, c;
    HDM int max_units() const { return 0; }
    HDM bool next(int i, UnitInfo& u) const {
        const long L = (long)i * G + c; const int nt = ld_int(nunits); if (L >= (long)((nt + 7) / 8) * 8 * ntn) return false;
        const int r_ = (int)(L % (8 * ntn)); const int t = (r_ & 7) * ((nt + 7) / 8) + (int)(L / (8 * ntn)), pn = r_ >> 3; if (t >= nt) return false;
        const int s0 = ld_int(ulist + 4 * t), e = ld_int(ulist + 4 * t + 1);
        u.arow0 = s0; u.brow0 = e * bN + 256 * pn; u.g = e; u.pm = s0 / 256; u.pn = pn; u.nv = ld_int(ulist + 4 * t + 2); return true;
    }
};

#ifndef PROBE_EpiBf16Plain
#define PROBE_EpiBf16Plain false
#endif
#ifndef PROBE_EpiF32Plain
#define PROBE_EpiF32Plain false
#endif
#ifndef PROBE_EpiSmall
#define PROBE_EpiSmall false
#endif
#ifndef PROBE_EpiS5b
#define PROBE_EpiS5b false
#endif
#ifndef PROBE_EpiGlu
#define PROBE_EpiGlu false
#endif
#ifndef PROBE_EpiRS
#define PROBE_EpiRS false
#endif
#ifndef PROBE_EpiUp
#define PROBE_EpiUp false
#endif
#ifndef PROBE_EpiDown
#define PROBE_EpiDown false
#endif
HD void st4_bf16(bf16_t* q, const F4& v) {
#ifdef CPU_TEST
    for (int j = 0; j < 4; ++j) q[j] = f2bf(v[j]);
#else
    uint2 w; w.x = (unsigned)f2bf(v[0]) | ((unsigned)f2bf(v[1]) << 16); w.y = (unsigned)f2bf(v[2]) | ((unsigned)f2bf(v[3]) << 16); *(uint2*)q = w;
#endif
}
HD void st4_f32(float* q, const F4& v) {
#ifdef CPU_TEST
    for (int j = 0; j < 4; ++j) q[j] = v[j];
#else
    *(F4*)q = v;
#endif
}
HD void st8_bf16(bf16_t* q, const F4& lo, const F4& hi) {
#ifdef CPU_TEST
    for (int j = 0; j < 4; ++j) { q[j] = f2bf(lo[j]); q[4 + j] = f2bf(hi[j]); }
#else
    typedef unsigned U4e __attribute__((ext_vector_type(4))); U4e w;
    w[0] = (unsigned)f2bf(lo[0]) | ((unsigned)f2bf(lo[1]) << 16); w[1] = (unsigned)f2bf(lo[2]) | ((unsigned)f2bf(lo[3]) << 16);
    w[2] = (unsigned)f2bf(hi[0]) | ((unsigned)f2bf(hi[1]) << 16); w[3] = (unsigned)f2bf(hi[2]) | ((unsigned)f2bf(hi[3]) << 16); *(U4e*)q = w;
#endif
}
HD int perm32(int rho) { const int n = rho >> 4, i = rho & 15; return 8 * (i >> 2) + 4 * n + (i & 3); }
struct EpiBf16Plain { static constexpr bool PROBE = PROBE_EpiBf16Plain; bf16_t* O; int ldo; HDM void shift() { O += 800000000; }
    static constexpr bool PERM = true;
    HDM void st8(const UnitInfo& u, int r, int c, const F4& al, const F4& ah, const F4& bl, const F4& bh) const { bf16_t* q = O + (size_t)(256 * u.pm + r) * ldo + 256 * u.pn + c; st8_bf16(q, al, ah); st8_bf16(q + 128, bl, bh); } };
struct EpiF32Plain { static constexpr bool PROBE = PROBE_EpiF32Plain; static constexpr bool PERM = false; HDM void shift() {} float* O; int ldo; size_t gstride;
    HDM void st(const UnitInfo& u, int r, int c, const F4& v0, const F4& v1) const { float* q = O + (size_t)u.g * gstride + (size_t)(256 * u.pm + r) * ldo + 256 * u.pn + c; st4_f32(q, v0); st4_f32(q + 128, v1); } };
struct EpiSmall { static constexpr bool PROBE = PROBE_EpiSmall; static constexpr bool PERM = false; HDM void shift() {} float* gs; bf16_t* gsb; const float* w0; const float* a0; const float* ab;
    HDM void half(int n, int col, const F4& v) const {
        if (col >= NSM) return; F4 o;
        if (col < 2 * RW) { for (int j = 0; j < 4; ++j) { float w = w0[col + j] + v[j]; w = -softplusf_(-w) - 0.5f; o[j] = -fexp(w); } st4_f32(gs + (size_t)n * NGF + col, o); }
        else if (col < 4 * RW) { for (int j = 0; j < 4; ++j) o[j] = sigmoidf_(a0[col - 2 * RW + j] + v[j]); st4_bf16(gsb + (size_t)n * NGB + (col - 2 * RW), o); }
        else if (col < 5 * RW) st4_bf16(gsb + (size_t)n * NGB + 2 * RW + (col - 4 * RW), v);
        else { for (int j = 0; j < 4; ++j) o[j] = -softplusf_(-(v[j] + ab[col - 5 * RW + j])) * (1.0f / 16.0f); st4_f32(gs + (size_t)n * NGF + 2 * RW + (col - 5 * RW), o); }
    }
    HDM void st(const UnitInfo& u, int r, int c, const F4& v0, const F4& v1) const { const int n = 256 * u.pm + r, col = 256 * u.pn + c; half(n, col, v0); half(n, col + 128, v1); } };
struct EpiS5b { static constexpr bool PROBE = PROBE_EpiS5b; static constexpr bool PERM = true; HDM void shift() {} bf16_t* yc;
    HDM void half(const UnitInfo& u, int b, int pc, int col, const F4& lo, const F4& hi) const { const int t = col / SG_, cc = col % SG_; const int n = row_of(b, pc * CH_ + t);
        F4 ol, oh; for (int j = 0; j < 4; ++j) { ol[j] = geluf_(lo[j]); oh[j] = geluf_(hi[j]); } st8_bf16(yc + (size_t)n * SW + u.g * SG_ + cc, ol, oh); }
    HDM void st8(const UnitInfo& u, int r, int c, const F4& al, const F4& ah, const F4& bl, const F4& bh) const {
        const int m = 256 * u.pm + r; if (m >= M5) return; const int b = m / NPC, pc = m % NPC; half(u, b, pc, 256 * u.pn + c, al, ah); half(u, b, pc, 256 * u.pn + c + 128, bl, bh); } };
HD void ld4_bf16(const bf16_t* q, F4& o) {
#ifdef CPU_TEST
    for (int j = 0; j < 4; ++j) o[j] = bf2f(q[j]);
#else
    const uint2 w = *(const uint2*)q; o[0] = __uint_as_float(w.x << 16); o[1] = __uint_as_float(w.x & 0xffff0000u); o[2] = __uint_as_float(w.y << 16); o[3] = __uint_as_float(w.y & 0xffff0000u);
#endif
}
struct EpiGlu { static constexpr bool PROBE = PROBE_EpiGlu; static constexpr bool PERM = true; HDM void shift() {} bf16_t* ymix; const bf16_t* yc; const float* gb;
    HDM void half(int n, int col, const F4& lo, const F4& hi) const { if (col >= SW) return; F4 y0, y1, ol, oh; ld4_bf16(yc + (size_t)n * SW + col, y0); ld4_bf16(yc + (size_t)n * SW + col + 4, y1);
        for (int j = 0; j < 4; ++j) { ol[j] = y0[j] * sigmoidf_(lo[j] + gb[col + j]); oh[j] = y1[j] * sigmoidf_(hi[j] + gb[col + 4 + j]); } st8_bf16(ymix + (size_t)n * MIXW + RW + GWD + col, ol, oh); }
    HDM void st8(const UnitInfo& u, int r, int c, const F4& al, const F4& ah, const F4& bl, const F4& bh) const { const int n = 256 * u.pm + r, col = 256 * u.pn + c; half(n, col, al, ah); half(n, col + 128, bl, bh); } };
struct EpiRS { static constexpr bool PROBE = PROBE_EpiRS; static constexpr bool PERM = true; HDM void shift() {} float* logits; bf16_t* sact;
    HDM void st8(const UnitInfo& u, int r, int c, const F4& al, const F4& ah, const F4& bl, const F4& bh) const {
        const int n = 256 * u.pm + r;
        if (u.pn < EP / 256) { const int col = 256 * u.pn + c; if (col < E_) { st4_f32(logits + (size_t)n * E_ + col, al); st4_f32(logits + (size_t)n * E_ + col + 4, ah); } if (col + 128 < E_) { st4_f32(logits + (size_t)n * E_ + col + 128, bl); st4_f32(logits + (size_t)n * E_ + col + 132, bh); } }
        else { const int j = u.pn - EP / 256; F4 ol, oh; for (int q = 0; q < 4; ++q) { ol[q] = siluf_(al[q]) * bl[q]; oh[q] = siluf_(ah[q]) * bh[q]; } st8_bf16(sact + (size_t)n * FF_ + 128 * j + c, ol, oh); }
    } };
struct EpiUp { static constexpr bool PROBE = PROBE_EpiUp; static constexpr bool PERM = true; HDM void shift() {} bf16_t* act;
    HDM void st8(const UnitInfo& u, int r, int c, const F4& al, const F4& ah, const F4& bl, const F4& bh) const { if (r >= u.nv) return; F4 ol, oh; for (int q = 0; q < 4; ++q) { ol[q] = siluf_(al[q]) * bl[q]; oh[q] = siluf_(ah[q]) * bh[q]; } st8_bf16(act + (size_t)(u.arow0 + r) * FF_ + 128 * u.pn + c, ol, oh); } };
struct EpiDown { static constexpr bool PROBE = PROBE_EpiDown; static constexpr bool PERM = true; HDM void shift() {} bf16_t* Y;
    HDM void st8(const UnitInfo& u, int r, int c, const F4& al, const F4& ah, const F4& bl, const F4& bh) const { if (r >= u.nv) return; bf16_t* q = Y + (size_t)(u.arow0 + r) * D_ + 256 * u.pn + c; st8_bf16(q, al, ah); st8_bf16(q + 128, bl, bh); } };

#ifdef CPU_TEST
template <class Epi, class Sched> static void gemm_phase(const GemmArgs& g, const Sched& S, const Epi& E) {
    UnitInfo u; std::vector<float> arow(g.K);
    for (int i = 0; S.next(i, u); ++i)
        for (int r = 0; r < 256; ++r) {
            const int ar = g.rowmap ? g.rowmap[u.arow0 + r] : u.arow0 + r; const bf16_t* a = g.A + (size_t)ar * g.lda;
            for (int k = 0; k < g.K; ++k) arow[k] = bf2f(a[k]);
            float out[256];
            for (int c = 0; c < 256; ++c) { const bf16_t* b0 = g.Bt + (size_t)(u.brow0 + c) * g.ldb; float s0 = 0.f; for (int k = 0; k < g.K; ++k) s0 += arow[k] * bf2f(b0[k]); out[c] = s0; }
            if constexpr (Epi::PERM) { for (int c = 0; c < 128; c += 8) { F4 al, ah, bl, bh; for (int j = 0; j < 4; ++j) { al[j] = out[c + j]; ah[j] = out[c + 4 + j]; bl[j] = out[128 + c + j]; bh[j] = out[128 + c + 4 + j]; } E.st8(u, r, c, al, ah, bl, bh); } }
            else { for (int c = 0; c < 128; c += 4) { F4 v0, v1; for (int j = 0; j < 4; ++j) { v0[j] = out[c + j]; v1[j] = out[128 + c + j]; } E.st(u, r, c, v0, v1); } }
        }
}
#else
#define LAS __attribute__((address_space(3)))
typedef short bf16x8 __attribute__((ext_vector_type(8)));
constexpr int HTB = 128 * 64 * 2, STAGE_BYTES = 8 * HTB;
HD int lds_byte(int r, int c) { const int st = (r >> 4) * 2 + (c >> 5), rr = r & 15, cc = c & 31, ob = rr * 64 + cc * 2; return st * 1024 + (ob ^ (((ob >> 9) & 1) << 5)); }
HD void stage_rc(int b, int& R, int& C) { const int st = b / 1024, sb = b % 1024, swz = sb ^ (((sb >> 9) & 1) << 5); R = (st >> 1) * 16 + swz / 64; C = (st & 1) * 32 + (swz % 64) / 2; }

struct XcdBarrier; __device__ __forceinline__ void xcd_barrier(const XcdBarrier& b);
#ifndef GP_RS
#define GP_RS 0
#endif
HD int lane_id() { return (int)__builtin_amdgcn_mbcnt_hi(~0u, __builtin_amdgcn_mbcnt_lo(~0u, 0u)); }
template <bool GATHER, class Epi, class Sched>
__device__ __forceinline__ void gemm_phase(LAS unsigned char* lds, const int wid, const GemmArgs g, const Sched& S, const Epi& E, const XcdBarrier* pbar) {
    int lane = lane_id(); asm volatile("" : "+v"(lane)); const int tid = wid * 64 + lane;
    const int wr = wid >> 2, wc = wid & 3, fr = lane & 15, fq = lane >> 4;
    float zero_ = 0.f; asm volatile("" : "+v"(zero_));
    const int nt = g.K / 64;
    const unsigned ldsw = (unsigned)wid * 1024u;
    const int aoff = lds_byte(wr * 64 + fr, fq * 8), boff = lds_byte(wc * 32 + fr, fq * 8);
    const char* Ab = (const char*)g.A; const char* Bb = (const char*)g.Bt;
#define G_SA(b, h) (((b) * 2 + (h)) * HTB)
#define G_SB(b, h) ((4 + (b) * 2 + (h)) * HTB)
#define G_STAGE(bufoff, gbase, voff) do { _Pragma("unroll") for (int _i = 0; _i < 2; ++_i) \
        __builtin_amdgcn_global_load_lds((const unsigned*)((gbase) + (voff)[_i]), (LAS unsigned*)(lds + (bufoff) + ldsw + _i * 8192), 16, 0, 0); } while (0)
#define G_LDA(dst, b, h) do { _Pragma("unroll") for (int m = 0; m < 4; ++m) _Pragma("unroll") for (int k = 0; k < 2; ++k) dst[m][k] = *(const LAS bf16x8*)(lds + G_SA(b, h) + aoff + m * 2048 + k * 1024); } while (0)
#define G_LDB(dst, b, h) do { _Pragma("unroll") for (int n = 0; n < 2; ++n) _Pragma("unroll") for (int k = 0; k < 2; ++k) dst[n][k] = *(const LAS bf16x8*)(lds + G_SB(b, h) + boff + n * 2048 + k * 1024); } while (0)
#define G_MMA(ai, bj, At, Bt) do { __builtin_amdgcn_s_setprio(1); _Pragma("unroll") for (int m = 0; m < 4; ++m) _Pragma("unroll") for (int n = 0; n < 2; ++n) _Pragma("unroll") for (int k = 0; k < 2; ++k) \
        acc[ai][bj][m][n] = __builtin_amdgcn_mfma_f32_16x16x32_bf16(Bt[n][k], At[m][k], acc[ai][bj][m][n], 0, 0, 0); __builtin_amdgcn_s_setprio(0); } while (0)
#define G_WAIT_V(n) asm volatile("s_waitcnt vmcnt(" #n ")" ::: "memory")
#define G_WAIT_L(n) asm volatile("s_waitcnt lgkmcnt(" #n ")" ::: "memory")
#define G_BAR __builtin_amdgcn_s_barrier()
#define G_SCHED __builtin_amdgcn_sched_barrier(0)
    const unsigned hA = 128u * (unsigned)g.lda * 2u, hB = 128u * (unsigned)g.ldb * 2u;
#define G_SETOFF(u) do { int _t = lane_id(); asm volatile("" : "+v"(_t)); _t += wid * 64; _Pragma("unroll") for (int _i = 0; _i < 2; ++_i) { int _R, _C; stage_rc(_t * 16 + _i * 8192, _R, _C); \
        const int _Rb = Epi::PERM ? ((_R & ~31) + perm32(_R & 31)) : _R; OB[_i] = ((unsigned)((u).brow0 + _Rb) * (unsigned)g.ldb + (unsigned)_C) * 2u; \
        if (GATHER) { OA[0][_i] = ((unsigned)ld_int(g.rowmap + (u).arow0 + _R) * (unsigned)g.lda + (unsigned)_C) * 2u; OA[1][_i] = ((unsigned)ld_int(g.rowmap + (u).arow0 + 128 + _R) * (unsigned)g.lda + (unsigned)_C) * 2u; } \
        else { OA[0][_i] = ((unsigned)((u).arow0 + _R) * (unsigned)g.lda + (unsigned)_C) * 2u; } } } while (0)
#define G_STA(bufoff, h, kb) G_STAGE(bufoff, Ab + (kb) + (GATHER ? 0u : (h) * hA), OA[GATHER ? (h) : 0])
#define G_STB(bufoff, h, kb) G_STAGE(bufoff, Bb + (kb) + (h) * hB, OB)
#ifndef GP_K2
#define GP_K2 0
#endif
#ifndef GP_E2
#define GP_E2 0
#endif
    constexpr bool K2 = GP_K2 && Epi::PROBE, E2 = GP_E2 && Epi::PROBE;
    UnitInfo cur, nxt; int ui = 0;
    if (!S.next(0, cur)) return;
    F4 acc[2][2][4][2];
#pragma unroll
    for (int a = 0; a < 2; ++a)
#pragma unroll
        for (int b = 0; b < 2; ++b)
#pragma unroll
            for (int m = 0; m < 4; ++m)
#pragma unroll
                for (int n = 0; n < 2; ++n) acc[a][b][m][n] = (F4){zero_, zero_, zero_, zero_};
    bf16x8 At[4][2], B0[2][2], B1[2][2];
    unsigned OA[GATHER ? 2 : 1][2], OB[2];
    G_SETOFF(cur);
    G_STB(G_SB(0, 0), 0, 0); G_STA(G_SA(0, 0), 0, 0); G_STB(G_SB(0, 1), 1, 0); G_STA(G_SA(0, 1), 1, 0);
    if (wr == 1) G_BAR;
    G_WAIT_V(4); G_BAR;
    G_STB(G_SB(1, 0), 0, 128); G_STA(G_SA(1, 0), 0, 128); G_STB(G_SB(1, 1), 1, 128);
    G_WAIT_V(6); G_BAR;
    for (;;) {
        const bool has_next = K2 ? S.next((ui + 1) >> 1, nxt) : S.next(ui + 1, nxt);
#pragma unroll 1
        for (int t = 0; t < nt; t += 2) {
            const bool last = (t == nt - 2);
            G_LDB(B0, 0, 0); G_SCHED; G_LDA(At, 0, 0); G_STA(G_SA(1, 1), 1, (size_t)(t + 1) * 128);
            if (last && has_next) G_SETOFF(nxt);
            const size_t k2 = last ? 0 : (size_t)(t + 2) * 128, k3 = k2 + 128;
            G_WAIT_L(8); G_BAR; G_WAIT_L(0); G_MMA(0, 0, At, B0); G_BAR; G_SCHED;
            G_LDB(B1, 0, 1); G_STB(G_SB(0, 0), 0, k2);
            G_BAR; G_WAIT_L(0); G_MMA(0, 1, At, B1); G_BAR;
            G_LDA(At, 0, 1); G_STA(G_SA(0, 0), 0, k2);
            G_BAR; G_WAIT_L(0); G_MMA(1, 0, At, B0); G_BAR; G_SCHED;
            G_STB(G_SB(0, 1), 1, k2);
            G_WAIT_V(6); G_BAR; G_MMA(1, 1, At, B1); G_BAR;
            G_LDB(B0, 1, 0); G_SCHED; G_LDA(At, 1, 0); G_STA(G_SA(0, 1), 1, k2);
            G_WAIT_L(8); G_BAR; G_WAIT_L(0); G_MMA(0, 0, At, B0); G_BAR; G_SCHED;
            G_LDB(B1, 1, 1); G_STB(G_SB(1, 0), 0, k3);
            G_BAR; G_WAIT_L(0); G_MMA(0, 1, At, B1); G_BAR;
            G_LDA(At, 1, 1); G_STA(G_SA(1, 0), 0, k3);
            G_BAR; G_WAIT_L(0); G_MMA(1, 0, At, B0); G_BAR; G_SCHED;
            G_STB(G_SB(1, 1), 1, k3);
            G_WAIT_V(6); G_BAR; G_MMA(1, 1, At, B1); G_BAR;
        }
        if (!K2 || (ui & 1)) {
        if (wr == 0) G_BAR;
        int te = lane_id(); asm volatile("" : "+v"(te)); const int ewr = wid >> 2, ewc = wid & 3, efr = te & 15, efq = te >> 4;
#pragma unroll
        for (int ai = 0; ai < 2; ++ai)
#pragma unroll
            for (int m = 0; m < 4; ++m)
            { int rr = ai * 128 + ewr * 64 + m * 16 + efr; asm volatile("" : "+v"(rr) :: "memory"); const float sc_ = K2 ? 0.5f : 1.0f;
                if constexpr (Epi::PERM) { E.st8(cur, rr, ewc * 32 + 8 * efq, acc[ai][0][m][0] * sc_, acc[ai][0][m][1] * sc_, acc[ai][1][m][0] * sc_, acc[ai][1][m][1] * sc_); }
                else {
#pragma unroll
                    for (int n = 0; n < 2; ++n) { E.st(cur, rr, ewc * 32 + n * 16 + 4 * efq, acc[ai][0][m][n] * sc_, acc[ai][1][m][n] * sc_); asm volatile("" ::: "memory"); } } }
        }
        if (GP_RS && Epi::PROBE) xcd_barrier(*pbar);
        if (!has_next) break;
        if (!K2 || (ui & 1)) {
#pragma unroll
        for (int a = 0; a < 2; ++a)
#pragma unroll
            for (int b = 0; b < 2; ++b)
#pragma unroll
                for (int m = 0; m < 4; ++m)
#pragma unroll
                    for (int n = 0; n < 2; ++n) acc[a][b][m][n] = (F4){zero_, zero_, zero_, zero_};
        if (wr == 1) G_BAR;
        }
        cur = nxt; ++ui;
    }
    G_WAIT_V(0);
    if (K2 && !(ui & 1)) { if (wr == 0) G_BAR; }
    G_BAR;
    if (GP_RS && Epi::PROBE) { for (int r_ = ui + 1; r_ < S.max_units(); ++r_) xcd_barrier(*pbar); }
}
#endif
#ifndef MULTI_LAUNCH
#define FUSED 1
#endif
constexpr int NPH_PRO = 3, NPH_LAYER = 16, NPH = NPH_PRO + L_ * NPH_LAYER;

#ifdef CPU_TEST
static void rwkv_scan_all(const P& p, int l) {
    float* yr = WSP(float, yr);
    for (int d = 0; d < 2; ++d) for (int b = 0; b < B_; ++b) for (int hh = 0; hh < RH_; ++hh) {
        static float S[RN_][RN_]; memset(S, 0, sizeof(S));
        for (int idx = 0; idx < SPOS; ++idx) { const int n = row_of(b, seqpos(d, idx)); RV e[RN_]; float q = 0.f;
            for (int j = 0; j < RN_; ++j) { rwkv_elem(p, l, d, n, hh, j, 1.0f, e[j]); q += e[j].kkraw * e[j].kkraw; }
            const float rs = 1.0f / sqrtf(q + 1e-12f);
            for (int j = 0; j < RN_; ++j) { e[j].a *= rs; e[j].b *= rs; }
            for (int i = 0; i < RN_; ++i) { float sa = 0.f; for (int j = 0; j < RN_; ++j) sa += S[i][j] * e[j].a;
                float y = 0.f; for (int j = 0; j < RN_; ++j) { S[i][j] = S[i][j] * e[j].w + sa * e[j].b + e[i].v * e[j].k2; y += S[i][j] * e[j].r; }
                yr[((size_t)d * NTOK + n) * RW + hh * RN_ + i] = y; }
        }
    }
}
static void gla_scan_all(const P& p, int l) {
    float* og = WSP(float, og); const bf16_t* proj = WSP(bf16_t, proj); const float* gs = WSP(float, gs);
    for (int d = 0; d < 2; ++d) for (int b = 0; b < B_; ++b) for (int hh = 0; hh < GH_; ++hh) {
        static float S[GK_][GV_]; memset(S, 0, sizeof(S));
        for (int idx = 0; idx < SPOS; ++idx) { const int n = row_of(b, seqpos(d, idx)); const bf16_t* pr = proj + (size_t)n * NINP + GBASE;
            for (int j = 0; j < GV_; ++j) { const float v = bf2f(pr[2 * GKD + hh * GV_ + j]); float o = 0.f;
                for (int k = 0; k < GK_; ++k) { const float q = bf2f(pr[hh * GK_ + k]) * 0.17677669529663687f, kg = bf2f(pr[GKD + hh * GK_ + k]), al = fexp(gs[(size_t)n * NGF + 2 * RW + d * GKD + hh * GK_ + k]);
                    S[k][j] = S[k][j] * al + kg * v; o += q * S[k][j]; }
                og[((size_t)d * NTOK + n) * GWD + hh * GV_ + j] = o; }
        }
    }
}
#else
__device__ __forceinline__ float dpp_sum8(float v) {
    v += __builtin_bit_cast(float, __builtin_amdgcn_update_dpp(0, __builtin_bit_cast(int, v), 0xB1, 0xF, 0xF, true));
    v += __builtin_bit_cast(float, __builtin_amdgcn_update_dpp(0, __builtin_bit_cast(int, v), 0x4E, 0xF, 0xF, true));
    v += __builtin_bit_cast(float, __builtin_amdgcn_update_dpp(0, __builtin_bit_cast(int, v), 0x141, 0xF, 0xF, true));
    return v;
}
__device__ __forceinline__ float dpp_sum16(float v) {
    v = dpp_sum8(v);
    v += __builtin_bit_cast(float, __builtin_amdgcn_update_dpp(0, __builtin_bit_cast(int, v), 0x140, 0xF, 0xF, true));
    return v;
}
__device__ __forceinline__ float dpp_sum4(float v) {
    v += __builtin_bit_cast(float, __builtin_amdgcn_update_dpp(0, __builtin_bit_cast(int, v), 0xB1, 0xF, 0xF, true));
    v += __builtin_bit_cast(float, __builtin_amdgcn_update_dpp(0, __builtin_bit_cast(int, v), 0x4E, 0xF, 0xF, true));
    return v;
}
constexpr int RT = 16;
__device__ __forceinline__ void rwkv_seq_blk(const P& p, int l, int d, int b, int hh, LAS unsigned char* lds, int wid, int lane) {
    LAS float* stage = (LAS float*)lds;
    LAS float* ybuf = (LAS float*)(lds + 2 * RT * 6 * 64 * 4);
    const int r = lane >> 3, c = lane & 7, i = wid * 8 + r, cj = hh * RN_ + lane;
    const float kkc = p.rwkv_k_k[(size_t)l * RW + cj], kac = p.rwkv_k_a[(size_t)l * RW + cj];
    const bf16_t* rkv = WSP(bf16_t, rkv); const float* gs = WSP(float, gs); const bf16_t* gsb = WSP(bf16_t, gsb); float* yr = WSP(float, yr) + (size_t)d * NTOK * RW;
    float S[8];
#pragma unroll
    for (int q = 0; q < 8; ++q) S[q] = 0.f;
    float rawA[2][5], rawB[2][5];
#define RW_LOAD(chunk, raw) do { _Pragma("unroll") for (int tt = 0; tt < 2; ++tt) { const int n = __builtin_amdgcn_readfirstlane(row_of(b, seqpos(d, (chunk) * RT + 2 * wid + tt))); \
        const bf16_t* rk = rkv + (size_t)n * 3 * RW; \
        raw[tt][0] = bf2f(rk[cj]); raw[tt][1] = bf2f(rk[RW + cj]); raw[tt][2] = bf2f(rk[2 * RW + cj]); raw[tt][3] = gs[(size_t)n * NGF + d * RW + cj]; raw[tt][4] = bf2f(gsb[(size_t)n * NGB + d * RW + cj]); } } while (0)
#define RW_PUT(buf, raw) do { _Pragma("unroll") for (int tt = 0; tt < 2; ++tt) { const float k = raw[tt][1], a = raw[tt][4], kkraw = k * kkc; \
        const float kk = kkraw * (1.0f / sqrtf(WSUM(kkraw * kkraw) + 1e-12f)); LAS float* sv = stage + (((buf) * RT + 2 * wid + tt) * 6) * 64 + lane; \
        sv[0] = fexp(raw[tt][3]); sv[64] = k * (1.0f + (a - 1.0f) * kac); sv[128] = -kk; sv[192] = kk * a; sv[256] = raw[tt][0]; sv[320] = raw[tt][2]; } } while (0)
#define RW_YST(ch_, buf_) do { _Pragma("unroll") for (int tt = 0; tt < 2; ++tt) { const int n = __builtin_amdgcn_readfirstlane(row_of(b, seqpos(d, (ch_) * RT + 2 * wid + tt))); \
        const LAS float* yp = ybuf + (((buf_) * RT + 2 * wid + tt) * 64 + lane) * 8; const F4 ya = *(const LAS F4*)yp, yb = *(const LAS F4*)(yp + 4); \
        yr[(size_t)n * RW + cj] = ((ya[0] + ya[1]) + (ya[2] + ya[3])) + ((yb[0] + yb[1]) + (yb[2] + yb[3])); } } while (0)
    RW_LOAD(0, rawA); RW_PUT(0, rawA); RW_LOAD(1, rawB);
    __syncthreads();
    constexpr int NCH = SPOS / RT; static_assert(NCH % 2 == 0, "chunk pairs");
    for (int ch = 0; ch < NCH; ch += 2) {
        {
            constexpr int buf = 0;
            if (ch + 2 < NCH) RW_LOAD(ch + 2, rawA);
        { F4 cw0, cw1, ck0, ck1, ca0, ca1, cb0, cb1, cr0, cr1; float cvi;
#define RW_LDV(t_, W0, W1, K0, K1, A0, A1, B0, B1, R0, R1, VI) do { const LAS float* sv = stage + ((buf * RT + (t_)) * 6) * 64 + 8 * c; \
            W0 = *(const LAS F4*)(sv); W1 = *(const LAS F4*)(sv + 4); K0 = *(const LAS F4*)(sv + 64); K1 = *(const LAS F4*)(sv + 68); A0 = *(const LAS F4*)(sv + 128); A1 = *(const LAS F4*)(sv + 132); \
            B0 = *(const LAS F4*)(sv + 192); B1 = *(const LAS F4*)(sv + 196); R0 = *(const LAS F4*)(sv + 256); R1 = *(const LAS F4*)(sv + 260); VI = sv[320 - 8 * c + i]; } while (0)
          RW_LDV(0, cw0, cw1, ck0, ck1, ca0, ca1, cb0, cb1, cr0, cr1, cvi);
#pragma unroll
          for (int t = 0; t < RT; ++t) {
            F4 nw0 = cw0, nw1 = cw1, nk0 = ck0, nk1 = ck1, na0 = ca0, na1 = ca1, nb0 = cb0, nb1 = cb1, nr0 = cr0, nr1 = cr1; float nvi = cvi;
            if (t + 1 < RT) RW_LDV(t + 1, nw0, nw1, nk0, nk1, na0, na1, nb0, nb1, nr0, nr1, nvi);
            float sa = ((S[0] * ca0[0] + S[1] * ca0[1]) + (S[2] * ca0[2] + S[3] * ca0[3])) + ((S[4] * ca1[0] + S[5] * ca1[1]) + (S[6] * ca1[2] + S[7] * ca1[3]));
            sa = dpp_sum8(sa);
            float y0 = 0.f, y1 = 0.f;
#pragma unroll
            for (int q = 0; q < 4; ++q) { S[q] = S[q] * cw0[q] + (sa * cb0[q] + cvi * ck0[q]); y0 += S[q] * cr0[q]; S[4 + q] = S[4 + q] * cw1[q] + (sa * cb1[q] + cvi * ck1[q]); y1 += S[4 + q] * cr1[q]; }
            ybuf[((buf * RT + t) * 64 + i) * 8 + c] = y0 + y1;
            cw0 = nw0; cw1 = nw1; ck0 = nk0; ck1 = nk1; ca0 = na0; ca1 = na1; cb0 = nb0; cb1 = nb1; cr0 = nr0; cr1 = nr1; cvi = nvi;
          }
#undef RW_LDV
        }
            RW_PUT(1, rawB);
            __syncthreads();
            RW_YST(ch, 0);
        }
        {
            constexpr int buf = 1;
            if (ch + 3 < NCH) RW_LOAD(ch + 3, rawB);
        { F4 cw0, cw1, ck0, ck1, ca0, ca1, cb0, cb1, cr0, cr1; float cvi;
#define RW_LDV(t_, W0, W1, K0, K1, A0, A1, B0, B1, R0, R1, VI) do { const LAS float* sv = stage + ((buf * RT + (t_)) * 6) * 64 + 8 * c; \
            W0 = *(const LAS F4*)(sv); W1 = *(const LAS F4*)(sv + 4); K0 = *(const LAS F4*)(sv + 64); K1 = *(const LAS F4*)(sv + 68); A0 = *(const LAS F4*)(sv + 128); A1 = *(const LAS F4*)(sv + 132); \
            B0 = *(const LAS F4*)(sv + 192); B1 = *(const LAS F4*)(sv + 196); R0 = *(const LAS F4*)(sv + 256); R1 = *(const LAS F4*)(sv + 260); VI = sv[320 - 8 * c + i]; } while (0)
          RW_LDV(0, cw0, cw1, ck0, ck1, ca0, ca1, cb0, cb1, cr0, cr1, cvi);
#pragma unroll
          for (int t = 0; t < RT; ++t) {
            F4 nw0 = cw0, nw1 = cw1, nk0 = ck0, nk1 = ck1, na0 = ca0, na1 = ca1, nb0 = cb0, nb1 = cb1, nr0 = cr0, nr1 = cr1; float nvi = cvi;
            if (t + 1 < RT) RW_LDV(t + 1, nw0, nw1, nk0, nk1, na0, na1, nb0, nb1, nr0, nr1, nvi);
            float sa = ((S[0] * ca0[0] + S[1] * ca0[1]) + (S[2] * ca0[2] + S[3] * ca0[3])) + ((S[4] * ca1[0] + S[5] * ca1[1]) + (S[6] * ca1[2] + S[7] * ca1[3]));
            sa = dpp_sum8(sa);
            float y0 = 0.f, y1 = 0.f;
#pragma unroll
            for (int q = 0; q < 4; ++q) { S[q] = S[q] * cw0[q] + (sa * cb0[q] + cvi * ck0[q]); y0 += S[q] * cr0[q]; S[4 + q] = S[4 + q] * cw1[q] + (sa * cb1[q] + cvi * ck1[q]); y1 += S[4 + q] * cr1[q]; }
            ybuf[((buf * RT + t) * 64 + i) * 8 + c] = y0 + y1;
            cw0 = nw0; cw1 = nw1; ck0 = nk0; ck1 = nk1; ca0 = na0; ca1 = na1; cb0 = nb0; cb1 = nb1; cr0 = nr0; cr1 = nr1; cvi = nvi;
          }
#undef RW_LDV
        }
            if (ch + 2 < NCH) RW_PUT(0, rawA);
            __syncthreads();
            RW_YST(ch + 1, 1);
        }
    }
    __syncthreads();
#undef RW_YST
#undef RW_LOAD
#undef RW_PUT
}
__device__ __forceinline__ void gla_seq_wave(const P& p, int l, int d, int b, int hh, int hv, LAS float* st, int lane) {
    float S[2][8];
#pragma unroll
    for (int k = 0; k < 8; ++k) { S[0][k] = 0.f; S[1][k] = 0.f; }
    const int vp = lane >> 2, kg = lane & 3;
    float* og = WSP(float, og) + (size_t)d * NTOK * GWD; const bf16_t* proj = WSP(bf16_t, proj); const float* gs = WSP(float, gs);
    constexpr int SB = RT * 128;
    const int kh = lane >> 5, jj = lane & 31;
    float vec[24], vv[RT / 2];
#define GL_LOAD(chunk) do { _Pragma("unroll") for (int it = 0; it < 8; ++it) { const int n = row_of(b, seqpos(d, (chunk) * RT + 2 * it + kh)); const bf16_t* pr = proj + (size_t)n * NINP + GBASE + hh * GK_ + jj; \
        vec[3 * it] = bf2f(pr[0]) * 0.17677669529663687f; vec[3 * it + 1] = bf2f(pr[GKD]); vec[3 * it + 2] = gs[(size_t)n * NGF + 2 * RW + d * GKD + hh * GK_ + jj]; \
        vv[it] = bf2f(pr[2 * GKD - hh * GK_ + hh * GV_ + 32 * hv]); } } while (0)
#define GL_PUT(buf) do { _Pragma("unroll") for (int it = 0; it < 8; ++it) { LAS float* q = st + (buf) * SB + (2 * it + kh) * 128 + jj; q[0] = vec[3 * it]; q[32] = vec[3 * it + 1]; q[64] = fexp(vec[3 * it + 2]); q[96] = vv[it]; } } while (0)
#define WAVE_SYNC() do { __builtin_amdgcn_fence(__ATOMIC_RELEASE, "wavefront"); __builtin_amdgcn_wave_barrier(); __builtin_amdgcn_fence(__ATOMIC_ACQUIRE, "wavefront"); } while (0)
    GL_LOAD(0); GL_PUT(0); WAVE_SYNC();
    constexpr int NCH = SPOS / RT;
    for (int ch = 0; ch < NCH; ++ch) {
        const int buf = ch & 1;
        if (ch + 1 < NCH) GL_LOAD(ch + 1);
        { typedef float F2 __attribute__((ext_vector_type(2))); F4 cq[2], ck[2], ca[2]; F2 cv;
#define GL_LDV(t_, Q, K, A, V) do { const LAS float* sv = st + buf * SB + (t_) * 128 + 8 * kg; _Pragma("unroll") for (int k4 = 0; k4 < 2; ++k4) { Q[k4] = *(const LAS F4*)(sv + 4 * k4); K[k4] = *(const LAS F4*)(sv + 32 + 4 * k4); A[k4] = *(const LAS F4*)(sv + 64 + 4 * k4); } \
            V = *(const LAS F2*)(st + buf * SB + (t_) * 128 + 96 + 2 * vp); } while (0)
          GL_LDV(0, cq, ck, ca, cv);
#pragma unroll
          for (int t = 0; t < RT; ++t) {
            F4 nq[2], nk[2], na[2]; F2 nv = cv;
#pragma unroll
            for (int k4 = 0; k4 < 2; ++k4) { nq[k4] = cq[k4]; nk[k4] = ck[k4]; na[k4] = ca[k4]; }
            if (t + 1 < RT) GL_LDV(t + 1, nq, nk, na, nv);
            float o0 = 0.f, o1 = 0.f;
#pragma unroll
            for (int k4 = 0; k4 < 2; ++k4)
#pragma unroll
                for (int q = 0; q < 4; ++q) { S[0][4 * k4 + q] = S[0][4 * k4 + q] * ca[k4][q] + ck[k4][q] * cv[0]; o0 += cq[k4][q] * S[0][4 * k4 + q]; S[1][4 * k4 + q] = S[1][4 * k4 + q] * ca[k4][q] + ck[k4][q] * cv[1]; o1 += cq[k4][q] * S[1][4 * k4 + q]; }
            o0 = dpp_sum4(o0); o1 = dpp_sum4(o1);
            const int n = __builtin_amdgcn_readfirstlane(row_of(b, seqpos(d, ch * RT + t)));
            if (kg == 0) { F2 oo; oo[0] = o0; oo[1] = o1; *(F2*)(og + (size_t)n * GWD + hh * GV_ + 32 * hv + 2 * vp) = oo; }
#pragma unroll
            for (int k4 = 0; k4 < 2; ++k4) { cq[k4] = nq[k4]; ck[k4] = nk[k4]; ca[k4] = na[k4]; }
            cv = nv;
          }
#undef GL_LDV
        }
        if (ch + 1 < NCH) GL_PUT(buf ^ 1);
        WAVE_SYNC();
    }
#undef GL_LOAD
#undef GL_PUT
}
#define BSYNC() do { asm volatile("s_waitcnt lgkmcnt(0)" ::: "memory"); __builtin_amdgcn_s_barrier(); asm volatile("" ::: "memory"); } while (0)
template <int M, int N, int K, int NW, class F>
__device__ __forceinline__ void bmm(const LAS bf16_t* A, int lda, const LAS bf16_t* Bt, int ldb, int w, int lane, F f) {
    const int r = lane & 15, q = lane >> 4;
#pragma unroll 1
    for (int t = w; t < (M / 16) * (N / 16); t += NW) { const int tm = t / (N / 16), tn = t % (N / 16); F4 acc = (F4){0.f, 0.f, 0.f, 0.f};
#pragma unroll
        for (int kk = 0; kk < K / 32; ++kk) { const bf16x8 a = *(const LAS bf16x8*)(A + (tm * 16 + r) * lda + kk * 32 + 8 * q), bb = *(const LAS bf16x8*)(Bt + (tn * 16 + r) * ldb + kk * 32 + 8 * q);
            acc = __builtin_amdgcn_mfma_f32_16x16x32_bf16(a, bb, acc, 0, 0, 0); }
        f(tm * 16 + 4 * q, tn * 16 + r, acc); }
}
template <int M, int N, int K1, int K2, int NW, class F>
__device__ __forceinline__ void bmm2(const LAS bf16_t* A1, int lda1, const LAS bf16_t* Bt1, int ldb1, const LAS bf16_t* A2, int lda2, const LAS bf16_t* Bt2, int ldb2, int w, int lane, F f) {
    const int r = lane & 15, q = lane >> 4;
#pragma unroll 1
    for (int t = w; t < (M / 16) * (N / 16); t += NW) { const int tm = t / (N / 16), tn = t % (N / 16); F4 acc = (F4){0.f, 0.f, 0.f, 0.f};
#pragma unroll
        for (int kk = 0; kk < K1 / 32; ++kk) { const bf16x8 a = *(const LAS bf16x8*)(A1 + (tm * 16 + r) * lda1 + kk * 32 + 8 * q), bb = *(const LAS bf16x8*)(Bt1 + (tn * 16 + r) * ldb1 + kk * 32 + 8 * q);
            acc = __builtin_amdgcn_mfma_f32_16x16x32_bf16(a, bb, acc, 0, 0, 0); }
#pragma unroll
        for (int kk = 0; kk < K2 / 32; ++kk) { const bf16x8 a = *(const LAS bf16x8*)(A2 + (tm * 16 + r) * lda2 + kk * 32 + 8 * q), bb = *(const LAS bf16x8*)(Bt2 + (tn * 16 + r) * ldb2 + kk * 32 + 8 * q);
            acc = __builtin_amdgcn_mfma_f32_16x16x32_bf16(a, bb, acc, 0, 0, 0); }
        f(tm * 16 + 4 * q, tn * 16 + r, acc); }
}
template <int M, int N, int K1, int K2, int K3, int NW, class F>
__device__ __forceinline__ void bmm3(const LAS bf16_t* A1, int lda1, const LAS bf16_t* Bt1, int ldb1, const LAS bf16_t* A2, int lda2, const LAS bf16_t* Bt2, int ldb2,
                                     const LAS bf16_t* A3, int lda3, const LAS bf16_t* Bt3, int ldb3, int w, int lane, F f) {
    const int r = lane & 15, q = lane >> 4;
#pragma unroll 1
    for (int t = w; t < (M / 16) * (N / 16); t += NW) { const int tm = t / (N / 16), tn = t % (N / 16); F4 acc = (F4){0.f, 0.f, 0.f, 0.f};
#pragma unroll
        for (int kk = 0; kk < K1 / 32; ++kk) acc = __builtin_amdgcn_mfma_f32_16x16x32_bf16(*(const LAS bf16x8*)(A1 + (tm * 16 + r) * lda1 + kk * 32 + 8 * q), *(const LAS bf16x8*)(Bt1 + (tn * 16 + r) * ldb1 + kk * 32 + 8 * q), acc, 0, 0, 0);
#pragma unroll
        for (int kk = 0; kk < K2 / 32; ++kk) acc = __builtin_amdgcn_mfma_f32_16x16x32_bf16(*(const LAS bf16x8*)(A2 + (tm * 16 + r) * lda2 + kk * 32 + 8 * q), *(const LAS bf16x8*)(Bt2 + (tn * 16 + r) * ldb2 + kk * 32 + 8 * q), acc, 0, 0, 0);
#pragma unroll
        for (int kk = 0; kk < K3 / 32; ++kk) acc = __builtin_amdgcn_mfma_f32_16x16x32_bf16(*(const LAS bf16x8*)(A3 + (tm * 16 + r) * lda3 + kk * 32 + 8 * q), *(const LAS bf16x8*)(Bt3 + (tn * 16 + r) * ldb3 + kk * 32 + 8 * q), acc, 0, 0, 0);
        f(tm * 16 + 4 * q, tn * 16 + r, acc); }
}
typedef unsigned u32x2_t __attribute__((ext_vector_type(2)));
typedef unsigned u32x4_t __attribute__((ext_vector_type(4)));
__device__ __forceinline__ unsigned gload_u16(const bf16_t* p) { unsigned x; asm volatile("global_load_ushort %0, %1, off" : "=v"(x) : "v"(p) : "memory"); return x; }
template <int OFF> __device__ __forceinline__ unsigned gload_u16s(const void* sbase, unsigned voff) { unsigned x; asm volatile("global_load_ushort %0, %1, %2 offset:%3" : "=v"(x) : "v"(voff), "s"(sbase), "n"(OFF) : "memory"); return x; }
__device__ __forceinline__ float gload_f32s(const void* sbase, unsigned voff) { float x; asm volatile("global_load_dword %0, %1, %2" : "=v"(x) : "v"(voff), "s"(sbase) : "memory"); return x; }
__device__ __forceinline__ float gload_f32(const float* p) { float x; asm volatile("global_load_dword %0, %1, off" : "=v"(x) : "v"(p) : "memory"); return x; }
__device__ __forceinline__ void rwkv_chunk_blk(const P& p, int l, int d, int b, int hh, LAS unsigned char* lds, int wid, int lane) {
    static_assert(RN_ == 64 && RT == 16, "rwkv chunk geometry");
#define ZF ((LAS float*)lds)
#define ZT ((LAS bf16_t*)(lds + 16384))
#define RHS ((LAS float*)(lds + 34816))
#define LW ((LAS float*)(lds + 38912))
#define UT ((LAS bf16_t*)(lds + 43008))
#define SETB(s) (lds + 48128 + (s) * 29952)
#define AT(s) ((LAS bf16_t*)SETB(s))
#define RTm(s) (AT(s) + 16 * 72)
#define BH(s) (AT(s) + 32 * 72)
#define KH(s) (AT(s) + 48 * 72)
#define BHT(s) ((LAS bf16_t*)(SETB(s) + 9216))
#define KHT(s) (BHT(s) + 64 * 40)
#define VT(s) (BHT(s) + 128 * 40)
#define MAK(s) ((LAS bf16_t*)(SETB(s) + 24576))
#define MRB(s) (MAK(s) + 16 * 40)
#define MRK(s) (MAK(s) + 32 * 40)
#define MABF(s) ((LAS float*)(SETB(s) + 28416))
#define PL(s) ((LAS float*)(SETB(s) + 29440))
#define NR(s) ((LAS int*)(SETB(s) + 29696))
    const int tid = wid * 64 + lane, cj = hh * RN_ + lane;
    const float kkc = p.rwkv_k_k[(size_t)l * RW + cj], kac = p.rwkv_k_a[(size_t)l * RW + cj];
    const bf16_t* rkv = WSP(bf16_t, rkv); const float* gs = WSP(float, gs); const bf16_t* gsb = WSP(bf16_t, gsb); float* yr = WSP(float, yr) + (size_t)d * NTOK * RW;
    F4 za = (F4){0.f, 0.f, 0.f, 0.f}, zb = za;
    for (int i = tid; i < 2 * 64 * 72; i += 512) ZT[i] = 0;
    for (int i = tid; i < 64 * 40; i += 512) UT[i] = 0;
    for (int i = tid; i < 2 * 29952 / 2; i += 512) AT(0)[i] = 0;
    const int ntk = wid == 0 ? 0 : ((wid == 4 || wid == 5) ? 3 : 2);
#define TKI(tt) ((tt) < 2 ? 2 * wid + (tt) : wid - 4)
    unsigned rawu[3][4]; float rawf[3]; int rn[3];
    const unsigned vo2 = (unsigned)cj * 2u, vo4 = (unsigned)cj * 4u;
#define RC_LOAD(chunk) do { _Pragma("unroll") for (int tt = 0; tt < 3; ++tt) { const int n = __builtin_amdgcn_readfirstlane(row_of(b, seqpos(d, (chunk) * RT + (tt < ntk ? TKI(tt) : 0)))); rn[tt] = n;        \
        const bf16_t* rk = rkv + (size_t)n * 3 * RW; const float* gp = gs + (size_t)n * NGF + d * RW; const bf16_t* gb = gsb + (size_t)n * NGB + d * RW; \
        rawu[tt][0] = gload_u16s<0>(rk, vo2); rawu[tt][1] = gload_u16s<2 * RW>(rk, vo2); rawu[tt][2] = gload_u16s<4 * RW>(rk, vo2); rawf[tt] = gload_f32s(gp, vo4); rawu[tt][3] = gload_u16s<0>(gb, vo2); } } while (0)
    float vr[3], vk2[3], va[3], vb[3], vv[3], vlw[3];
#define RC_RETIRE() do { asm volatile("s_waitcnt vmcnt(0)" ::: "memory"); _Pragma("unroll") for (int tt = 0; tt < 3; ++tt) { asm volatile("" : "+v"(rawu[tt][0]), "+v"(rawu[tt][1]), "+v"(rawu[tt][2]), "+v"(rawu[tt][3]), "+v"(rawf[tt])); } } while (0)
#define RC_P0(s) do { \
        _Pragma("unroll") for (int tt = 0; tt < 3; ++tt) if (tt < ntk) { const float k = bf2f((bf16_t)rawu[tt][1]), a = bf2f((bf16_t)rawu[tt][3]), kkraw = k * kkc; const float kk = kkraw * __builtin_amdgcn_rsqf(WSUM(kkraw * kkraw) + 1e-12f); \
            vr[tt] = bf2f((bf16_t)rawu[tt][0]); vk2[tt] = k * (1.0f + (a - 1.0f) * kac); va[tt] = -kk; vb[tt] = kk * a; vv[tt] = bf2f((bf16_t)rawu[tt][2]); vlw[tt] = rawf[tt]; \
            LW[TKI(tt) * 64 + lane] = vlw[tt]; if (lane == 0) NR(s)[TKI(tt)] = rn[tt]; } } while (0)
#define RC_TOK(s, t_, lp_, tt) do { const int t = (t_); const float lp = (lp_); const float em = fexp(lp - vlw[tt]), ep = fexp(lp), en = fexp(-lp); \
            AT(s)[t * 72 + lane] = f2bf(va[tt] * em); RTm(s)[t * 72 + lane] = f2bf(vr[tt] * ep); const bf16_t bh = f2bf(vb[tt] * en), kh = f2bf(vk2[tt] * en); \
            BH(s)[t * 72 + lane] = bh; KH(s)[t * 72 + lane] = kh; BHT(s)[lane * 40 + t] = bh; KHT(s)[lane * 40 + t] = kh; VT(s)[lane * 40 + t] = f2bf(vv[tt]); \
            if (t == RT - 1) PL(s)[lane] = ep; } while (0)
#define RC_P0B(s) do { if (ntk) { float lpb = 0.f, lpc = 0.f; const float l0 = LW[lane]; \
            _Pragma("unroll") for (int q = 0; q < RT - 2; q += 2) { const float x0 = LW[q * 64 + lane], x1 = LW[(q + 1) * 64 + lane]; const bool on = q < 2 * wid; lpb += on ? x0 : 0.f; lpc += on ? x1 : 0.f; } \
            lpb += lpc; lpb += vlw[0]; RC_TOK(s, 2 * wid, lpb, 0); lpb += vlw[1]; RC_TOK(s, 2 * wid + 1, lpb, 1); \
            if (ntk == 3) { const float lp3 = (wid == 5 ? l0 : 0.f) + vlw[2]; RC_TOK(s, wid - 4, lp3, 2); } } } while (0)
#define RC_P1(s, w4) do { const LAS bf16_t* Aop = ((w4) < 2) ? AT(s) : RTm(s); const LAS bf16_t* Bop = ((w4) & 1) ? KH(s) : BH(s); \
            bmm<16, 16, 64, 1>(Aop, 72, Bop, 72, 0, lane, [&](int r0, int cc, const F4& acc) { \
                _Pragma("unroll") for (int j = 0; j < 4; ++j) { const int rr = r0 + j; const bool keep = ((w4) < 2) ? (cc < rr) : (cc <= rr); const float val = keep ? acc[j] : 0.f; \
                    if ((w4) == 0) MABF(s)[cc * 16 + rr] = val; else if ((w4) == 1) MAK(s)[rr * 40 + cc] = f2bf(val); else if ((w4) == 2) MRB(s)[rr * 40 + cc] = f2bf(val); else MRK(s)[rr * 40 + cc] = f2bf(val); } }); } while (0)
    constexpr int NCH = SPOS / RT;
    RC_LOAD(0);
    __syncthreads();
    RC_RETIRE(); RC_P0(0); BSYNC(); RC_LOAD(1); RC_P0B(0); BSYNC(); if (wid < 4) RC_P1(0, wid); BSYNC();
    F4 yacc = (F4){0.f, 0.f, 0.f, 0.f}; int yrow[4] = {0, 0, 0, 0}; int ycol = 0;
#define RC_YST() do { _Pragma("unroll") for (int j = 0; j < 4; ++j) yr[(size_t)yrow[j] * RW + ycol] = yacc[j]; } while (0)
    for (int ch = 0; ch < NCH; ++ch) {
        int lnv = lane; asm volatile("" : "+v"(lnv)); const int lane = lnv;
        const int cs = ch & 1, ns = cs ^ 1; LAS bf16_t* ZTc = ZT + cs * 64 * 72; LAS bf16_t* ZTn = ZT + ns * 64 * 72; const bool more = ch + 1 < NCH;
        if (wid < 4) bmm3<16, 64, 64, 32, 0, 4>(AT(cs), 72, ZTc, 72, MAK(cs), 40, VT(cs), 40, AT(cs), 72, ZTc, 72, wid, lane, [&](int r0, int cc, const F4& acc) {
#pragma unroll
            for (int j = 0; j < 4; ++j) RHS[(r0 + j) * 64 + cc] = acc[j]; });
        RC_RETIRE();
        if (wid < 4 && ch > 0) RC_YST();
        if (more) RC_P0(ns);
        typedef float F2 __attribute__((ext_vector_type(2)));
        constexpr int MPRE = 6;
        F2 mm[RT - 1][RT / 2];
        if (wid == 0) { unsigned mtb = (unsigned)(size_t)MABF(cs); asm volatile("" : "+v"(mtb)); const LAS float* MT = (const LAS float*)(size_t)mtb;
#pragma unroll
            for (int s = 0; s < MPRE; ++s) {
#pragma unroll
                for (int i = (s + 1) >> 1; i < RT / 2; ++i) mm[s][i] = *(const LAS F2*)(MT + s * 16 + 2 * i); } }
        BSYNC();
        RC_LOAD(ch + 2 < NCH ? ch + 2 : NCH - 1);
        if (wid == 0) {
            __builtin_amdgcn_s_setprio(2);
            F2 acc2[RT / 2];
#pragma unroll
            for (int i = 0; i < RT / 2; ++i) { acc2[i][0] = RHS[(2 * i) * 64 + lane]; acc2[i][1] = RHS[(2 * i + 1) * 64 + lane]; }
#pragma unroll
            for (int s = 0; s < RT - 1; ++s) { const float u = acc2[s >> 1][s & 1]; const F2 uu = (F2){u, u};
                if (s == 2) { asm volatile("" ::: "memory"); unsigned mtb = (unsigned)(size_t)MABF(cs); asm volatile("" : "+v"(mtb)); const LAS float* MT = (const LAS float*)(size_t)mtb;
#pragma unroll
                    for (int s2 = MPRE; s2 < RT - 1; ++s2) {
#pragma unroll
                        for (int i = (s2 + 1) >> 1; i < RT / 2; ++i) mm[s2][i] = *(const LAS F2*)(MT + s2 * 16 + 2 * i); } }
#pragma unroll
                for (int i = (s + 1) >> 1; i < RT / 2; ++i) acc2[i] = __builtin_elementwise_fma(mm[s][i], uu, acc2[i]); }
#pragma unroll
            for (int i = 0; i < RT / 2; ++i) { UT[lane * 40 + 2 * i] = f2bf(acc2[i][0]); UT[lane * 40 + 2 * i + 1] = f2bf(acc2[i][1]); }
            __builtin_amdgcn_s_setprio(0); }
        if (more) RC_P0B(ns);
        BSYNC();
        if (wid < 4) bmm3<16, 64, 64, 32, 32, 4>(RTm(cs), 72, ZTc, 72, MRB(cs), 40, UT, 40, MRK(cs), 40, VT(cs), 40, wid, lane, [&](int r0, int cc, const F4& acc) {
#pragma unroll
            for (int j = 0; j < 4; ++j) yrow[j] = NR(cs)[r0 + j];
            yacc = acc; ycol = hh * RN_ + cc; });
        else if (more) RC_P1(ns, wid - 4);
        {
            const int r = lane & 15, q = lane >> 4, tn = wid & 3, cc = tn * 16 + r;
            typedef __bf16 bf2_t __attribute__((ext_vector_type(2))); typedef float F2s __attribute__((ext_vector_type(2)));
#pragma unroll
            for (int h = 0; h < 2; ++h) { const int tm = (wid >> 2) + 2 * h, r0 = tm * 16 + 4 * q; F4 acc = (F4){0.f, 0.f, 0.f, 0.f};
                acc = __builtin_amdgcn_mfma_f32_16x16x32_bf16(*(const LAS bf16x8*)(BHT(cs) + (tm * 16 + r) * 40 + 8 * q), *(const LAS bf16x8*)(UT + cc * 40 + 8 * q), acc, 0, 0, 0);
                acc = __builtin_amdgcn_mfma_f32_16x16x32_bf16(*(const LAS bf16x8*)(KHT(cs) + (tm * 16 + r) * 40 + 8 * q), *(const LAS bf16x8*)(VT(cs) + cc * 40 + 8 * q), acc, 0, 0, 0);
                const F4 pl = *(const LAS F4*)(PL(cs) + r0);
                const F4 zn = pl * ((h ? zb : za) + acc); if (h) zb = zn; else za = zn;
                const bf2_t p01 = __builtin_convertvector((F2s){zn[0], zn[1]}, bf2_t), p23 = __builtin_convertvector((F2s){zn[2], zn[3]}, bf2_t);
                u32x2_t w2; w2[0] = __builtin_bit_cast(unsigned, p01); w2[1] = __builtin_bit_cast(unsigned, p23);
                *(LAS u32x2_t*)(ZTn + cc * 72 + r0) = w2; } }
        BSYNC();
    }
    RC_RETIRE();
    if (wid < 4) RC_YST();
    __syncthreads();
#undef RC_YST
#undef RC_RETIRE
#undef RC_LOAD
#undef RC_P0
#undef RC_P0B
#undef RC_TOK
#undef TKI
#undef RC_P1
#undef ZF
#undef ZT
#undef RHS
#undef LW
#undef UT
#undef SETB
#undef AT
#undef RTm
#undef BH
#undef KH
#undef BHT
#undef KHT
#undef VT
#undef MAK
#undef MRB
#undef MRK
#undef MABF
#undef PL
#undef NR
}
__device__ __forceinline__ u32x2_t gload_x2(const void* p) { u32x2_t x; asm volatile("global_load_dwordx2 %0, %1, off" : "=v"(x) : "v"(p) : "memory"); return x; }
__device__ __forceinline__ u32x4_t gload_x4(const void* p) { u32x4_t x; asm volatile("global_load_dwordx4 %0, %1, off" : "=v"(x) : "v"(p) : "memory"); return x; }
template <int K1, int K2>
__device__ __forceinline__ F4 bmm2_tile(const LAS bf16_t* A1, int lda1, const LAS bf16_t* Bt1, int ldb1, const LAS bf16_t* A2, int lda2, const LAS bf16_t* Bt2, int ldb2, int tm, int tn, int lane) {
    const int r = lane & 15, q = lane >> 4; F4 acc = (F4){0.f, 0.f, 0.f, 0.f};
#pragma unroll
    for (int kk = 0; kk < K1 / 32; ++kk) acc = __builtin_amdgcn_mfma_f32_16x16x32_bf16(*(const LAS bf16x8*)(A1 + (tm * 16 + r) * lda1 + kk * 32 + 8 * q), *(const LAS bf16x8*)(Bt1 + (tn * 16 + r) * ldb1 + kk * 32 + 8 * q), acc, 0, 0, 0);
#pragma unroll
    for (int kk = 0; kk < K2 / 32; ++kk) acc = __builtin_amdgcn_mfma_f32_16x16x32_bf16(*(const LAS bf16x8*)(A2 + (tm * 16 + r) * lda2 + kk * 32 + 8 * q), *(const LAS bf16x8*)(Bt2 + (tn * 16 + r) * ldb2 + kk * 32 + 8 * q), acc, 0, 0, 0);
    return acc;
}
__device__ __forceinline__ void gla_chunk_blk(const P& p, int l, int d, int b, int hh, LAS unsigned char* lds, int wid, int lane) {
    static_assert(GK_ == 32 && GV_ == 64 && CH_ == 64, "gla chunk geometry");
    const int tid = wid * 64 + lane;
    LAS float* LA = (LAS float*)lds;
    LAS float* QR = (LAS float*)(lds + 8192);
    LAS float* KR = (LAS float*)(lds + 16384);
    LAS float* SF = (LAS float*)(lds + 24576);
    LAS bf16_t* QIN = (LAS bf16_t*)(lds + 32768);
    LAS bf16_t* KIN = (LAS bf16_t*)(lds + 32768 + 5120);
    LAS bf16_t* STT = (LAS bf16_t*)(lds + 32768 + 10240);
    LAS bf16_t* KSTT = (LAS bf16_t*)(lds + 32768 + 15360);
    LAS bf16_t* VT = (LAS bf16_t*)(lds + 32768 + 19968);
    LAS bf16_t* ATT = (LAS bf16_t*)(lds + 32768 + 29184);
    LAS int* NR = (LAS int*)(lds + 32768 + 38400);
    const bf16_t* proj = WSP(bf16_t, proj); const float* gs = WSP(float, gs); float* og = WSP(float, og) + (size_t)d * NTOK * GWD;
    for (int i = tid; i < 32 * 64; i += 512) SF[i] = 0.f;
    for (int i = tid; i < 64 * 40; i += 512) STT[i] = 0;
    const int t = tid >> 3, k4 = (tid & 7) * 4, v8 = (tid & 7) * 8;
    u32x2_t rq, rk; u32x4_t rv, rla; int rn_;
#define GC_LOAD(c_) do { rn_ = row_of(b, seqpos(d, (c_) * 64 + t)); const bf16_t* pr = proj + (size_t)rn_ * NINP + GBASE; \
        rq = gload_x2(pr + hh * GK_ + k4); rk = gload_x2(pr + GKD + hh * GK_ + k4); rv = gload_x4(pr + 2 * GKD + hh * GV_ + v8); rla = gload_x4(gs + (size_t)rn_ * NGF + 2 * RW + d * GKD + hh * GK_ + k4); } while (0)
#define GC_WAIT() do { asm volatile("s_waitcnt vmcnt(0)" ::: "memory"); asm volatile("" : "+v"(rq), "+v"(rk), "+v"(rv), "+v"(rla)); } while (0)
#define GC_PUT() do { _Pragma("unroll") for (int j = 0; j < 4; ++j) { const unsigned wq = rq[j >> 1], wk = rk[j >> 1]; const float qf = __builtin_bit_cast(float, (j & 1) ? (wq & 0xFFFF0000u) : (wq << 16)), kf = __builtin_bit_cast(float, (j & 1) ? (wk & 0xFFFF0000u) : (wk << 16)); \
            QR[t * 32 + k4 + j] = qf * 0.17677669529663687f; KR[t * 32 + k4 + j] = kf; } \
        *(LAS u32x4_t*)(LA + t * 32 + k4) = rla; \
        _Pragma("unroll") for (int j = 0; j < 8; ++j) { const unsigned wv_ = rv[j >> 1]; VT[(v8 + j) * 72 + t] = (bf16_t)((j & 1) ? (wv_ >> 16) : (wv_ & 0xFFFFu)); } if ((tid & 7) == 0) NR[t] = rn_; } while (0)
    F4 o0 = (F4){0.f, 0.f, 0.f, 0.f}, o1 = o0; int orow0[4] = {0, 0, 0, 0}, orow1[4] = {0, 0, 0, 0};
    const int ocol = hh * GV_ + (wid & 3) * 16 + (lane & 15);
#define GC_OST() do { _Pragma("unroll") for (int j = 0; j < 4; ++j) { og[(size_t)orow0[j] * GWD + ocol] = o0[j]; og[(size_t)orow1[j] * GWD + ocol] = o1[j]; } } while (0)
    GC_LOAD(0);
    __syncthreads();
#pragma unroll 1
    for (int c = 0; c < NPC; ++c) {
        GC_WAIT();
        if (c > 0) GC_OST();
        GC_PUT();
        BSYNC();
        GC_LOAD(c + 1 < NPC ? c + 1 : NPC - 1);
        if (wid == 0) { const int kc = lane & 31, t0 = (lane >> 5) * 32; float cs[32];
#pragma unroll
            for (int tt = 0; tt < 32; ++tt) cs[tt] = LA[(t0 + tt) * 32 + kc];
#pragma unroll
            for (int tt = 1; tt < 32; ++tt) cs[tt] += cs[tt - 1];
            const float up = __builtin_bit_cast(float, __builtin_amdgcn_ds_bpermute(((lane + 32) & 63) * 4, __builtin_bit_cast(int, cs[31]))); const float add = lane >= 32 ? up : 0.f;
#pragma unroll
            for (int tt = 0; tt < 32; ++tt) LA[(t0 + tt) * 32 + kc] = cs[tt] + add; }
        BSYNC();
#pragma unroll
        for (int j = 0; j < 4; ++j) { const float bb = LA[t * 32 + k4 + j], bl = LA[63 * 32 + k4 + j], qv = QR[t * 32 + k4 + j], kv = KR[t * 32 + k4 + j];
            QIN[t * 40 + k4 + j] = f2bf(qv * fexp(bb)); KIN[t * 40 + k4 + j] = f2bf(kv * fexp(-bb)); KSTT[(k4 + j) * 72 + t] = f2bf(kv * fexp(bl - bb)); }
        BSYNC();
        bmm<64, 64, 32, 8>(QIN, 40, KIN, 40, wid, lane, [&](int r0, int cc, const F4& acc) {
#pragma unroll
            for (int j = 0; j < 4; ++j) ATT[(r0 + j) * 72 + cc] = f2bf(cc <= r0 + j ? acc[j] : 0.f); });
        BSYNC();
        { const int tm0 = wid >> 2, tn = wid & 3, q4 = 4 * (lane >> 4);
          o0 = bmm2_tile<64, 32>(ATT, 72, VT, 72, QIN, 40, STT, 40, tm0, tn, lane); o1 = bmm2_tile<64, 32>(ATT, 72, VT, 72, QIN, 40, STT, 40, tm0 + 2, tn, lane);
#pragma unroll
          for (int j = 0; j < 4; ++j) { orow0[j] = NR[tm0 * 16 + q4 + j]; orow1[j] = NR[(tm0 + 2) * 16 + q4 + j]; } }
        BSYNC();
        bmm<32, 64, 64, 8>(KSTT, 72, VT, 72, wid, lane, [&](int r0, int cc, const F4& acc) {
#pragma unroll
            for (int j = 0; j < 4; ++j) { const float sn = fexp(LA[63 * 32 + r0 + j]) * SF[(r0 + j) * 64 + cc] + acc[j]; SF[(r0 + j) * 64 + cc] = sn; STT[cc * 40 + r0 + j] = f2bf(sn); } });
        BSYNC();
    }
    GC_WAIT();
    GC_OST();
#undef GC_PUT
#undef GC_LOAD
#undef GC_WAIT
#undef GC_OST
}
#endif

#ifndef CPU_TEST
__device__ __forceinline__ void cvt_job(LAS unsigned char* lds, int tid, const float* src, bf16_t* dst, int nb, size_t sbs, size_t dbs, int K, int Nsrc, int Ndst, int nvalid, int perm) {
    LAS unsigned short* tl = (LAS unsigned short*)lds;
    const int tK = K / 64, tN = Ndst / 64, per = tK * tN; const long total = (long)nb * per;
    for (long t = blockIdx.x; t < total; t += gridDim.x) {
        const int e = (int)(t / per), r = (int)(t % per), tn = r / tK, tk = r % tK, n0 = tn * 64, k0 = tk * 64;
        int sc0 = n0; if (perm) { const int j = n0 / 256, w = n0 % 256; sc0 = w < 128 ? 128 * j + w : FF_ + 128 * j + (w - 128); }
        const int nv = nvalid - n0;
        const float* s = src + (size_t)e * sbs + (size_t)(k0 + (tid >> 3)) * Nsrc + sc0 + (tid & 7) * 8; const int c8 = (tid & 7) * 8, kk = tid >> 3;
        float v[8];
        if (c8 + 8 <= nv) { const F4 a = *(const F4*)s, b = *(const F4*)(s + 4); v[0] = a[0]; v[1] = a[1]; v[2] = a[2]; v[3] = a[3]; v[4] = b[0]; v[5] = b[1]; v[6] = b[2]; v[7] = b[3]; }
        else {
#pragma unroll
            for (int j = 0; j < 8; ++j) v[j] = (c8 + j < nv) ? s[j] : 0.f; }
#pragma unroll
        for (int j = 0; j < 8; ++j) tl[(c8 + j) * 72 + kk] = f2bf(v[j]);
        __syncthreads();
        { const int n = tid >> 3, ks = (tid & 7) * 8; typedef unsigned u32x4_t __attribute__((ext_vector_type(4))); const u32x4_t w = *(const LAS u32x4_t*)(tl + n * 72 + ks); *(u32x4_t*)(dst + (size_t)e * dbs + (size_t)(n0 + n) * K + k0 + ks) = w; }
        __syncthreads();
    }
}
__device__ __forceinline__ void st_cvt_tiles(const P& p, int l, LAS unsigned char* lds, int tid) {
    cvt_job(lds, tid, p.w_in + (size_t)l * D_ * NIN, WSP(bf16_t, w_inT) + (size_t)l * NINP * D_, 1, 0, 0, D_, NIN, NINP, NIN, 0);
    cvt_job(lds, tid, p.w_out + (size_t)l * MIXW * D_, WSP(bf16_t, w_outT) + (size_t)l * D_ * MIXW, 1, 0, 0, MIXW, D_, D_, D_, 0);
    cvt_job(lds, tid, p.sh_w2 + (size_t)l * FF_ * D_, WSP(bf16_t, shw2T) + (size_t)l * D_ * FF_, 1, 0, 0, FF_, D_, D_, D_, 0);
    cvt_job(lds, tid, p.s5_glu_w + (size_t)l * SW * SW, WSP(bf16_t, gluT) + (size_t)l * SWP * SW, 1, 0, 0, SW, SW, SWP, SW, 0);
    cvt_job(lds, tid, p.router_w + (size_t)l * D_ * E_, WSP(bf16_t, rsT) + (size_t)l * NRS * D_, 1, 0, 0, D_, E_, EP, E_, 0);
    cvt_job(lds, tid, p.sh_w13 + (size_t)l * D_ * 2 * FF_, WSP(bf16_t, rsT) + (size_t)l * NRS * D_ + (size_t)EP * D_, 1, 0, 0, D_, 2 * FF_, 2 * FF_, 2 * FF_, 1);
    cvt_job(lds, tid, p.exp_w13 + (size_t)l * E_ * D_ * 2 * FF_, WSP(bf16_t, w13T) + (size_t)l * E_ * 2 * FF_ * D_, E_, (size_t)D_ * 2 * FF_, (size_t)2 * FF_ * D_, D_, 2 * FF_, 2 * FF_, 2 * FF_, 1);
    cvt_job(lds, tid, p.exp_w2 + (size_t)l * E_ * FF_ * D_, WSP(bf16_t, w2T) + (size_t)l * E_ * D_ * FF_, E_, (size_t)FF_ * D_, (size_t)D_ * FF_, FF_, D_, D_, D_, 0);
}
#endif

#ifndef CPU_TEST
__device__ __forceinline__ void st_prep1_blk(const P& p, int l, int wid, int lane, int wv, int nwv) {
    const bf16_t* proj = WSP(bf16_t, proj); bf16_t* rkv = WSP(bf16_t, rkv); bf16_t* as = WSP(bf16_t, asmall); bf16_t* U2 = WSP(bf16_t, U2);
    const float* taps = p.rwkv_conv + (size_t)l * 9 * RCOLS; constexpr int NG = RCOLS / 8, TPB = 512 / NG;
    const int tid = wid * 64 + lane;
    if (tid < TPB * NG) {
        const int cg = tid % NG, ts = tid / NG, ch = cg * 8; const int step = (int)gridDim.x * TPB;
        float w[9][8];
#pragma unroll
        for (int k = 0; k < 9; ++k) ld8f(taps + k * RCOLS + ch, w[k]);
#define P1_OUT(n_, acc) do { if (ch < 3 * RW) st8bf(rkv + (size_t)(n_) * 3 * RW + ch, acc); else { const int q0 = ch - 3 * RW; \
            if (q0 < 2 * RDR_) { _Pragma("unroll") for (int q = 0; q < 8; ++q) acc[q] = ftanh(acc[q]); } \
            else if (q0 >= 2 * RDR_ + 2 * RIR_) { _Pragma("unroll") for (int q = 0; q < 8; ++q) acc[q] = sigmoidf_(acc[q]); } \
            st8bf(as + (size_t)(n_) * KSM + q0, acc); } } while (0)
#define P1_FMA(acc, xv, k) do { _Pragma("unroll") for (int j_ = 0; j_ < 4; ++j_) { acc[2 * j_] += w[k][2 * j_] * __uint_as_float((xv)[j_] << 16); acc[2 * j_ + 1] += w[k][2 * j_ + 1] * __uint_as_float((xv)[j_] & 0xffff0000u); } } while (0)
        constexpr int NPT = 4; static_assert(GW_ % NPT == 0 && NLAT % NPT == 0, "token groups");
        for (int pi = (int)blockIdx.x * TPB + ts; pi < NLAT / NPT; pi += step) { const int n0 = NPT * pi, t_ = n0 % T_, gr = t_ / GW_, gc = t_ % GW_; const bf16_t* pb_ = proj + (size_t)n0 * NINP + ch;
            const bool rok0 = gr > 0, rok2 = gr < ROWS_ - 1, cokl = gc > 0, cokr = gc + NPT < GW_; U4 xw[3][NPT + 2];
#pragma unroll
            for (int a = 0; a < 3; ++a)
#pragma unroll
                for (int jw = 0; jw < NPT + 2; ++jw) { const bool ok = (a == 0 ? rok0 : a == 2 ? rok2 : true) && (jw == 0 ? cokl : jw == NPT + 1 ? cokr : true);
                    const int off_ = ok ? ((a - 1) * GW_ + (jw - 1)) * NINP : 0; const U4 v = *(const U4*)(pb_ + off_); xw[a][jw] = ok ? v : (U4){0u, 0u, 0u, 0u}; }
#pragma unroll
            for (int tk = 0; tk < NPT; ++tk) { float acc[8];
#pragma unroll
                for (int q = 0; q < 8; ++q) acc[q] = 0.f;
#pragma unroll
                for (int a = 0; a < 3; ++a)
#pragma unroll
                    for (int jj = 0; jj < 3; ++jj) P1_FMA(acc, xw[a][tk + jj], a * 3 + jj);
                P1_OUT(n0 + tk, acc); } }
        for (int n = NLAT + (int)blockIdx.x * TPB + ts; n < NTOK; n += step) { const int s_ = (n - NLAT) % CTX_; U4 xc[3];
#pragma unroll
            for (int j = 0; j < 3; ++j) { const int ss = s_ + j - 1; const bool ok = ss >= 0 && ss < CTX_; const int nn = ok ? n + j - 1 : n; const U4 v = *(const U4*)(proj + (size_t)nn * NINP + ch); xc[j] = ok ? v : (U4){0u, 0u, 0u, 0u}; }
            float acc[8];
#pragma unroll
            for (int q = 0; q < 8; ++q) acc[q] = 0.f;
#pragma unroll
            for (int jj = 0; jj < 3; ++jj) P1_FMA(acc, xc[jj], 3 + jj);
            P1_OUT(n, acc); }
#undef P1_FMA
#undef P1_OUT
    }
    GIDX;
    constexpr int NT8 = (KSM - OGL) / 8;
    for (long i = gid; i < (long)NTOK * NT8; i += gsz) { const int n = (int)(i / NT8), q = (int)(i % NT8) * 8;
        if (q < 2 * GGR_) cp8bf(as + (size_t)n * KSM + OGL + q, proj + (size_t)n * NINP + GBASE + 2 * GKD + 2 * GWD + q); else z8bf(as + (size_t)n * KSM + OGL + q); }
    for (long i = gid; i < (long)B_ * SPOS * (SW / 8); i += gsz) { const int c = (int)(i % (SW / 8)) * 8; const long r = i / (SW / 8); const int pos = (int)(r % SPOS), b = (int)(r / SPOS);
        const int g = c / SG_, cc = c % SG_, pc = pos / CH_, t = pos % CH_, m = b * NPC + pc;
        cp8bf(U2 + ((size_t)g * M5P + m) * KT5 + t * SG_ + cc, proj + (size_t)row_of(b, pos) * NINP + SBASE + c); }
}
#define DPP_MOVF(v, ctrl) __builtin_bit_cast(float, __builtin_amdgcn_update_dpp(0, __builtin_bit_cast(int, v), ctrl, 0xF, 0xF, true))
#define DPP_MOVI(v, ctrl) __builtin_amdgcn_update_dpp(0, v, ctrl, 0xF, 0xF, true)
__device__ __forceinline__ void st_topk_wave(const P& p, int l, int wv, int nwv, int lane, LAS unsigned char* lds) {
    LAS int* hist = (LAS int*)lds;
    { const int tid_ = (int)threadIdx.x; if (tid_ < E_) hist[tid_] = 0; }
    __syncthreads();
    static_assert(E_ == 256 && NGRP_ == 8 && TKG_ == 4 && TOPK_ == 8, "wave top-k is written for 256 experts in 8 groups");
    const int nrow = (l == L_ - 1) ? NLAT : NTOK; const float* lg = WSP(float, logits); const F4 rb = *(const F4*)(p.router_bias + (size_t)l * E_ + 4 * lane);
    for (int n = wv; n < nrow; n += nwv) {
        const F4 z = *(const F4*)(lg + (size_t)n * E_ + 4 * lane); float sg[4], sv[4];
#pragma unroll
        for (int j = 0; j < 4; ++j) { sg[j] = sigmoidf_(z[j]); sv[j] = sg[j] + rb[j]; }
        float m1 = fmaxf(fmaxf(sv[0], sv[1]), fmaxf(sv[2], sv[3])), m2;
        { float a = fmaxf(sv[0], sv[1]), b = fminf(sv[0], sv[1]), c = fmaxf(sv[2], sv[3]), d = fminf(sv[2], sv[3]); m2 = fmaxf(fminf(a, c), fmaxf(b, d)); }
        { float o1 = DPP_MOVF(m1, 0xB1), o2 = DPP_MOVF(m2, 0xB1); float n1 = fmaxf(m1, o1), n2 = fmaxf(fminf(m1, o1), fmaxf(m2, o2)); m1 = n1; m2 = n2;
          o1 = DPP_MOVF(m1, 0x4E); o2 = DPP_MOVF(m2, 0x4E); n1 = fmaxf(m1, o1); n2 = fmaxf(fminf(m1, o1), fmaxf(m2, o2)); m1 = n1; m2 = n2;
          o1 = DPP_MOVF(m1, 0x141); o2 = DPP_MOVF(m2, 0x141); n1 = fmaxf(m1, o1); n2 = fmaxf(fminf(m1, o1), fmaxf(m2, o2)); m1 = n1; m2 = n2; }
        const float gsc = m1 + m2; const int g = lane >> 3, gb = __builtin_bit_cast(int, gsc); int rank = 0;
#pragma unroll
        for (int g2 = 0; g2 < 8; ++g2) { const float o = __builtin_bit_cast(float, __builtin_amdgcn_readlane(gb, 8 * g2)); rank += (o > gsc || (o == gsc && g2 < g)) ? 1 : 0; }
        const bool sel = rank < TKG_;
        int ck[4];
#pragma unroll
        for (int j = 0; j < 4; ++j) ck[j] = (sel && sv[j] > 0.f) ? __builtin_bit_cast(int, sv[j]) : 0;
        float myw = 0.f; int mye = 0; float wsum = 0.f;
#pragma unroll
        for (int kk = 0; kk < TOPK_; ++kk) {
            int bk = ck[0] > ck[1] ? ck[0] : ck[1]; { const int b2 = ck[2] > ck[3] ? ck[2] : ck[3]; bk = bk > b2 ? bk : b2; }
            int mk = bk;
            { int o = DPP_MOVI(mk, 0xB1); mk = mk > o ? mk : o; o = DPP_MOVI(mk, 0x4E); mk = mk > o ? mk : o; o = DPP_MOVI(mk, 0x141); mk = mk > o ? mk : o; o = DPP_MOVI(mk, 0x140); mk = mk > o ? mk : o; }
            const int r0 = __builtin_amdgcn_readlane(mk, 0), r1 = __builtin_amdgcn_readlane(mk, 16), r2 = __builtin_amdgcn_readlane(mk, 32), r3 = __builtin_amdgcn_readlane(mk, 48);
            const int K = (r0 > r1 ? r0 : r1) > (r2 > r3 ? r2 : r3) ? (r0 > r1 ? r0 : r1) : (r2 > r3 ? r2 : r3);
            const unsigned long long ball = __ballot(bk == K); const int wl = __builtin_amdgcn_readfirstlane((int)__ffsll((long long)ball) - 1);
            int wj = 0; float sgw = 0.f;
            if (lane == wl) {
#pragma unroll
                for (int j = 3; j >= 0; --j) if (ck[j] == K) wj = j;
#pragma unroll
                for (int j = 0; j < 4; ++j) if (wj == j) { ck[j] = 0; sgw = sg[j]; } }
            const int wjb = __builtin_amdgcn_readlane(wj, wl); sgw = __builtin_bit_cast(float, __builtin_amdgcn_readlane(__builtin_bit_cast(int, sgw), wl)); wsum += sgw;
            if (lane == kk) { myw = sgw; mye = 4 * wl + wjb; }
        }
        if (lane < TOPK_) { WSP(int, eidx)[(size_t)n * TOPK_ + lane] = mye; WSP(float, ewt)[(size_t)n * TOPK_ + lane] = myw / wsum * 2.5f; __hip_atomic_fetch_add(hist + mye, 1, __ATOMIC_RELAXED, __HIP_MEMORY_SCOPE_WORKGROUP); }
    }
    __syncthreads();
    { const int tid_ = (int)threadIdx.x; if (tid_ < E_) { const int c = hist[tid_]; if (c > 0) atomicAdd(WSP(int, ecnt) + tid_, c); } }
    __syncthreads();
}
__device__ __forceinline__ void st_scatter_blk(const P& p, int l, LAS unsigned char* lds, int wid, int lane, int wv, int nwv) {
    LAS int* eo = (LAS int*)lds;
    if (wid == 0) {
        const int* ecnt = WSP(int, ecnt); int c4[4], t4[4], tsum = 0;
#pragma unroll
        for (int j = 0; j < 4; ++j) { c4[j] = ld_int(ecnt + 4 * lane + j); t4[j] = (c4[j] + 255) / 256; tsum += t4[j]; }
        int incl = tsum;
#pragma unroll
        for (int o = 1; o < 64; o <<= 1) { const int v = __shfl_up(incl, o); if (lane >= o) incl += v; }
        int tb = incl - tsum;
#pragma unroll
        for (int j = 0; j < 4; ++j) { eo[4 * lane + j] = tb * 256;
            if (blockIdx.x == 0) { WSP(int, eoff)[4 * lane + j] = tb * 256; for (int t = 0; t < t4[j]; ++t) { int* u = WSP(int, ulist) + (size_t)(tb + t) * 4; u[0] = (tb + t) * 256; u[1] = 4 * lane + j; u[2] = (c4[j] - 256 * t) < 256 ? (c4[j] - 256 * t) : 256; u[3] = 0; } }
            tb += t4[j]; }
        if (lane == 63) { eo[E_] = tb * 256; if (blockIdx.x == 0) { WSP(int, eoff)[E_] = tb * 256; WSP(int, nunits)[0] = tb; } }
    }
    __syncthreads();
    const long gid = (long)wv * 64 + lane, gsz = (long)nwv * 64; const int nrow = (l == L_ - 1) ? NLAT : NTOK; const int* ei = WSP(int, eidx); int* so = WSP(int, slot_of); int* st = WSP(int, slot_tok);
    LAS int* lc = eo + E_ + 1;
    constexpr int MAXI = 4; const long total = (long)nrow * TOPK_;
#pragma unroll 1
    for (long base = 0; base < total; base += (long)MAXI * gsz) {
        if ((int)threadIdx.x < E_) lc[threadIdx.x] = 0;
        __syncthreads();
        int ie[MAXI], ir[MAXI];
#pragma unroll
        for (int u = 0; u < MAXI; ++u) { const long i = base + gid + (long)u * gsz; ie[u] = -1; ir[u] = 0; if (i < total) { ie[u] = ei[i]; ir[u] = __hip_atomic_fetch_add(lc + ie[u], 1, __ATOMIC_RELAXED, __HIP_MEMORY_SCOPE_WORKGROUP); } }
        __syncthreads();
        if ((int)threadIdx.x < E_) { const int c = lc[threadIdx.x]; lc[threadIdx.x] = c > 0 ? atomicAdd(WSP(int, efill) + threadIdx.x, c) : 0; }
        __syncthreads();
#pragma unroll
        for (int u = 0; u < MAXI; ++u) { const long i = base + gid + (long)u * gsz; if (ie[u] >= 0) { const int s = eo[ie[u]] + lc[ie[u]] + ir[u]; so[i] = s; st[s] = (int)(i / TOPK_); } }
        __syncthreads();
    }
}
#endif

#ifndef CPU_TEST
__device__ __forceinline__ void st_post_wave(const P& p, int l, int wv, int nwv, int lane) {
    static_assert(RH_ == 6 && GH_ == 6 && RN_ == 64 && GV_ == 64, "post_wave geometry");
    bf16_t* ymix = WSP(bf16_t, ymix); const float* yr = WSP(float, yr); const float* og = WSP(float, og); const bf16_t* proj = WSP(bf16_t, proj); const bf16_t* gsb = WSP(bf16_t, gsb); const bf16_t* rkv = WSP(bf16_t, rkv);
    static_assert(NLAT % 2 == 0 && NTOK % 2 == 0, "token pairs");
    const int nrow = (l == L_ - 1) ? NLAT : NTOK; const int hq = (lane >> 4) & 1, c4 = (lane & 15) * 4;
    for (int n0 = 2 * wv; n0 < nrow; n0 += 2 * nwv) { const int n = n0 + (lane >> 5);
        float o[6][4];
#pragma unroll
        for (int i = 0; i < 6; ++i) {
            const int hd = hq + 2 * i;
            if (i < 3) { const int c = hd * RN_ + c4; float r[4], k[4], v[4], a0[4], a1[4], g[4];
                ld4bf(rkv + (size_t)n * 3 * RW + c, r); ld4bf(rkv + (size_t)n * 3 * RW + RW + c, k); ld4bf(rkv + (size_t)n * 3 * RW + 2 * RW + c, v);
                ld4bf(gsb + (size_t)n * NGB + c, a0); ld4bf(gsb + (size_t)n * NGB + RW + c, a1); ld4bf(gsb + (size_t)n * NGB + 2 * RW + c, g);
                const F4 y0 = *(const F4*)(yr + (size_t)n * RW + c), y1 = *(const F4*)(yr + ((size_t)NTOK + n) * RW + c);
                const F4 ka = *(const F4*)(p.rwkv_k_a + (size_t)l * RW + c), rk = *(const F4*)(p.rwkv_r_k + (size_t)l * RW + c), lg = *(const F4*)(p.rwkv_ln_g + (size_t)l * RW + c), lb = *(const F4*)(p.rwkv_ln_b + (size_t)l * RW + c);
                float y[4], s = 0.f, bs = 0.f;
#pragma unroll
                for (int j = 0; j < 4; ++j) { y[j] = y0[j] + y1[j]; s += y[j]; const float k20 = k[j] * (1.0f + (a0[j] - 1.0f) * ka[j]), k21 = k[j] * (1.0f + (a1[j] - 1.0f) * ka[j]); bs += r[j] * (k20 + k21) * rk[j]; }
                s = dpp_sum16(s); bs = dpp_sum16(bs); const float mu = s * (1.0f / RN_); float qq = 0.f;
#pragma unroll
                for (int j = 0; j < 4; ++j) { const float dlt = y[j] - mu; qq += dlt * dlt; }
                qq = dpp_sum16(qq); const float rstd = 1.0f / sqrtf(qq * (1.0f / RN_) + GN_EPS);
#pragma unroll
                for (int j = 0; j < 4; ++j) o[i][j] = ((y[j] - mu) * rstd * lg[j] + lb[j] + bs * v[j]) * g[j];
            } else { const int h2 = hd - RH_, c = h2 * GV_ + c4; float gg[4];
                const F4 o0 = *(const F4*)(og + (size_t)n * GWD + c), o1 = *(const F4*)(og + ((size_t)NTOK + n) * GWD + c); ld4bf(proj + (size_t)n * NINP + GBASE + 2 * GKD + GWD + c, gg);
                const F4 ng = *(const F4*)(p.gla_norm_g + (size_t)l * GV_ + c4); float oo[4], qq = 0.f;
#pragma unroll
                for (int j = 0; j < 4; ++j) { oo[j] = o0[j] + o1[j]; qq += oo[j] * oo[j]; }
                qq = dpp_sum16(qq); const float rs = 1.0f / sqrtf(qq * (1.0f / GV_) + 1e-6f);
#pragma unroll
                for (int j = 0; j < 4; ++j) o[i][j] = oo[j] * rs * ng[j] * siluf_(gg[j]);
            }
        }
#pragma unroll
        for (int i = 0; i < 6; ++i) st4bf(ymix + (size_t)n * MIXW + (hq + 2 * i) * 64 + c4, o[i]);
    }
}
#endif

#ifndef CPU_TEST
__device__ __forceinline__ void st_modv_blk(const P& p, LAS unsigned char* lds, int tid) {
    static_assert(D_ == 1024 && B_ + 1 <= 17, "modv_blk geometry");
    LAS float* sc = (LAS float*)lds;
    LAS float* red = (LAS float*)(lds + 17 * 1024 * 4);
    const float* scg = WSP(float, silu_c); float* mv = WSP(float, modv);
    for (int i = tid; i < (B_ + 1) * D_; i += 512) sc[i] = scg[i];
    __syncthreads();
    const int cl = tid & 63, ks = tid >> 6;
    for (int task = blockIdx.x; task < L_ * 6 * D_ / 64; task += gridDim.x) {
        const int l = task / (6 * D_ / 64), col = (task % (6 * D_ / 64)) * 64 + cl;
        float acc[B_ + 1];
#pragma unroll
        for (int b = 0; b <= B_; ++b) acc[b] = 0.f;
        const float* w = p.w_mod + (size_t)l * D_ * 6 * D_ + col;
#pragma unroll 4
        for (int k = ks * 128; k < ks * 128 + 128; ++k) { const float wk = w[(size_t)k * 6 * D_];
#pragma unroll
            for (int b = 0; b <= B_; ++b) acc[b] += sc[b * D_ + k] * wk; }
#pragma unroll
        for (int b = 0; b <= B_; ++b) red[(ks * (B_ + 1) + b) * 64 + cl] = acc[b];
        __syncthreads();
        for (int i = tid; i < (B_ + 1) * 64; i += 512) { const int b = i >> 6, c2 = i & 63; float s = p.b_mod[(size_t)l * 6 * D_ + (task % (6 * D_ / 64)) * 64 + c2];
#pragma unroll
            for (int q = 0; q < 8; ++q) s += red[(q * (B_ + 1) + b) * 64 + c2];
            mv[((size_t)l * (B_ + 1) + b) * 6 * D_ + (task % (6 * D_ / 64)) * 64 + c2] = s; }
        __syncthreads();
    }
}
#endif

#ifdef CPU_TEST
#define GEMM_CALL(g, S, E) gemm_phase(g, S, E)
#define GEMM_CALL_G(g, S, E) gemm_phase(g, S, E)
#define SCHED_GC 1, 0
#define SYNC(k)
#define LOADP
#else
#define CAS __attribute__((address_space(4)))
#define LOADP const CAS P* _q = pk; asm volatile("" : "+s"(_q)); const P& p = *(const P*)_q; int lane = lane_id(); asm volatile("" : "+v"(lane)); \
    const int wv = blockIdx.x * 8 + wid, nwv = gridDim.x * 8; (void)lane; (void)wv; (void)nwv;
#define GEMM_CALL(g, S, E) gemm_phase<false>(lds, wid, g, S, E, &bar)
#define GEMM_CALL_G(g, S, E) gemm_phase<true>(lds, wid, g, S, E, &bar)
#define SCHED_GC (int)gridDim.x, sched_id((const unsigned*)(p.ws + WS.ctl), lds)
#define VC_WORD(x) (3584 + 64 * (x))
__device__ __forceinline__ int sched_id(const unsigned* ctl, LAS unsigned char* lds) {
    const unsigned G = gridDim.x; bool ok = (G % 8u) == 0u;
#pragma unroll
    for (int x = 0; x < 8; ++x) ok = ok && (__hip_atomic_load(ctl + VC_WORD(x), __ATOMIC_RELAXED, __HIP_MEMORY_SCOPE_AGENT) == G / 8u);
    const unsigned v = ((volatile LAS unsigned*)(lds + STAGE_BYTES))[2];
    return __builtin_amdgcn_readfirstlane(ok ? (int)v : (int)blockIdx.x);
}
#define SYNC(k) if (lo <= (k) && (k) + 1 < hi) xcd_barrier(bar);
#define XB_TMO      128
#define XB_XCNT(j)  (256  + 64 * (j))
#define XB_XSUB(j)  (1280 + 64 * (j))
#define XB_XGEN(j)  (2304 + 64 * (j))
#define XB_TOP      3328
#define XB_TOPGEN   3392
#define XCD_BAR_WORDS 3456
#define XB_SPIN_CAP (1u << 18)
__device__ __forceinline__ unsigned xb_ld(unsigned* p)              { return __hip_atomic_load(p, __ATOMIC_RELAXED, __HIP_MEMORY_SCOPE_AGENT); }
__device__ __forceinline__ unsigned xb_add(unsigned* p, unsigned v) { return __hip_atomic_fetch_add(p, v, __ATOMIC_RELAXED, __HIP_MEMORY_SCOPE_AGENT); }
__device__ __forceinline__ unsigned xb_xcc_id() { return (unsigned)__builtin_amdgcn_s_getreg((3 << 11) | 20) & 0xFu; }
#define XB_SPIN(cond, bar) do { unsigned _sp = 0; while (cond) { __builtin_amdgcn_s_sleep(1); \
    if ((++_sp & 255u) == 0u) { if (xb_ld(&(bar)[XB_TMO])) break; if (_sp > XB_SPIN_CAP) { atomicAdd(&(bar)[XB_TMO], 1u); break; } } } } while (0)
struct XcdBarrier { unsigned* bar; unsigned x; volatile LAS unsigned* st; int wid; };
__device__ __forceinline__ XcdBarrier xcd_barrier_post(unsigned* bar, volatile LAS unsigned* st) {
    XcdBarrier b; b.bar = bar; b.x = xb_xcc_id(); b.st = st; b.wid = 0;
    if (threadIdx.x == 0) (void)xb_add(&bar[XB_XCNT(b.x)], 1u);
    return b;
}
__device__ __forceinline__ void xcd_barrier_complete(unsigned* bar, unsigned x, unsigned& nloc, unsigned& nx) {
    const unsigned G = gridDim.x * gridDim.y * gridDim.z;
    unsigned sum, cnt, mine, sp = 0u;
    for (;;) {
        sum = 0u; cnt = 0u; mine = 0u;
#pragma unroll
        for (unsigned j = 0; j < 16; ++j) { const unsigned c = xb_ld(&bar[XB_XCNT(j)]); sum += c; cnt += (c > 0u) ? 1u : 0u; mine = (j == x) ? c : mine; }
        if (sum == G) break;
        __builtin_amdgcn_s_sleep(1);
        if ((++sp & 255u) == 0u) { if (xb_ld(&bar[XB_TMO])) break; if (sp > XB_SPIN_CAP) { atomicAdd(&bar[XB_TMO], 1u); break; } }
    }
    nloc = mine > 0u ? mine : 1u; nx = cnt > 0u ? cnt : 1u;
}
__device__ __forceinline__ void xcd_barrier(const XcdBarrier& b) {
    asm volatile("s_waitcnt vmcnt(0)" ::: "memory");
    __syncthreads();
    if (b.wid == 0 && lane_id() == 0) {
        unsigned* bar = b.bar;
        __builtin_amdgcn_s_waitcnt(0);
        unsigned nloc = b.st[0], nx = b.st[1];
        if (nloc == 0u) { xcd_barrier_complete(bar, b.x, nloc, nx); b.st[0] = nloc; b.st[1] = nx; }
        const unsigned old = xb_add(&bar[XB_XSUB(b.x)], 1u);
        const unsigned gen = old / nloc;
        if (old + 1u == (gen + 1u) * nloc) {
            __builtin_amdgcn_fence(__ATOMIC_RELEASE, "agent");
            asm volatile("s_waitcnt vmcnt(0)" ::: "memory");
            const unsigned og = xb_add(&bar[XB_TOP], 1u);
            const unsigned tg = og / nx;
            if (og + 1u == (tg + 1u) * nx) xb_add(&bar[XB_TOPGEN], 1u);
            else XB_SPIN(xb_ld(&bar[XB_TOPGEN]) == tg, bar);
            __builtin_amdgcn_fence(__ATOMIC_ACQUIRE, "agent");
            xb_add(&bar[XB_XGEN(b.x)], 1u);
            asm volatile("s_waitcnt vmcnt(0)" ::: "memory");
        } else {
            XB_SPIN(xb_ld(&bar[XB_XGEN(b.x)]) == gen, bar);
            __builtin_amdgcn_fence(__ATOMIC_ACQUIRE, "agent");
            asm volatile("s_waitcnt vmcnt(0)" ::: "memory");
        }
    }
    __syncthreads();
}
#endif

#define IN(k) (lo <= (k) && (k) < hi)
#ifndef PROBE_MASK
#define PROBE_MASK 0
#endif
#ifdef CPU_TEST
#define REP_BEGIN(k)
#define REP_END
#else
#define REP_BEGIN(k) for (int rep_ = 0; rep_ < (((PROBE_MASK) >> (k)) & 1) + 1; ++rep_) { if (rep_) xcd_barrier(bar);
#define REP_END }
#endif
#ifdef CPU_TEST
template <int lo, int hi, int l> static void run_layer(const P& p) { const int wv = 0, nwv = 1, lane = 0; (void)wv; (void)nwv; (void)lane;
#else
template <int lo, int hi, int l> __device__ __forceinline__ void run_layer(const CAS P* pk, LAS unsigned char* lds, const int wid, const XcdBarrier& bar) {
#endif

        const int pb = NPH_PRO + l * NPH_LAYER; const bool last = (l == L_ - 1); const int MR = last ? NLAT : NTOK;
        if (IN(pb + 0)) { REP_BEGIN(0) LOADP GemmArgs g{WSP(bf16_t, h), D_, nullptr, WSP(bf16_t, w_inT) + (size_t)l * NINP * D_, D_, D_}; StaticSched S; S.init(1, NTOK, NINP, 0, 0, SCHED_GC);
            EpiBf16Plain E{WSP(bf16_t, proj), NINP}; GEMM_CALL(g, S, E); REP_END } SYNC(pb + 0)
#ifdef CPU_TEST
        if (IN(pb + 1)) { REP_BEGIN(1) LOADP st_prep1(p, l, wv, nwv, lane); REP_END } SYNC(pb + 1)
#else
        if (IN(pb + 1)) { REP_BEGIN(1) LOADP st_prep1_blk(p, l, wid, lane, wv, nwv); REP_END } SYNC(pb + 1)
#endif
        if (IN(pb + 2)) { REP_BEGIN(2) LOADP
            { GemmArgs g{WSP(bf16_t, asmall), KSM, nullptr, WSP(bf16_t, wsmT) + (size_t)l * NSMP * KSM, KSM, KSM}; StaticSched S; S.init(1, NTOK, NSMP, 0, 0, SCHED_GC);
              EpiSmall E{WSP(float, gs), WSP(bf16_t, gsb), p.rwkv_w0 + (size_t)l * 2 * RW, p.rwkv_a0 + (size_t)l * 2 * RW, p.gla_a_bias + (size_t)l * 2 * GKD}; GEMM_CALL(g, S, E); }
            { GemmArgs g{WSP(bf16_t, U2), KT5, nullptr, WSP(bf16_t, s5Wa) + (size_t)l * SNG_ * N5AP * K5, K5, K5}; StaticSched S; S.init(SNG_, M5P, N5AP, M5P, N5AP, SCHED_GC);
              EpiF32Plain E{WSP(float, xl), N5AP, (size_t)M5P * N5AP}; GEMM_CALL(g, S, E); }
        REP_END } SYNC(pb + 2)
        if (IN(pb + 3)) { REP_BEGIN(3) LOADP
#ifdef CPU_TEST
            rwkv_scan_all(p, l); gla_scan_all(p, l);
#else
            { constexpr int NRS_ = 2 * B_ * RH_, NGS_ = 2 * B_ * GH_, NGG = (NGS_ + 2) / 3;
              for (int task = blockIdx.x; task < NRS_; task += gridDim.x) { const int hh = task % RH_, b = (task / RH_) % B_, d = task / (RH_ * B_); rwkv_chunk_blk(p, l, d, b, hh, lds, wid, lane); } }
            { LOADP constexpr int NRS_ = 2 * B_ * RH_, NGS_ = 2 * B_ * GH_, NGG = (NGS_ + 2) / 3;
              for (int task = (int)blockIdx.x + (((int)blockIdx.x < NRS_) ? (int)gridDim.x * ((NRS_ - 1 - (int)blockIdx.x) / (int)gridDim.x + 1) : 0); task < NRS_ + NGG; task += gridDim.x) {
                  for (int s3 = 0; s3 < 3; ++s3) { const int t2 = (task - NRS_) + NGG * s3; if (t2 < NGS_) { const int hh = t2 % GH_, b = (t2 / GH_) % B_, d = t2 / (GH_ * B_); gla_chunk_blk(p, l, d, b, hh, lds, wid, lane); } __syncthreads(); } } }
#endif
            st_s5carry(p, l, wv, nwv, lane); REP_END } SYNC(pb + 3)
        if (IN(pb + 4)) { REP_BEGIN(4) LOADP
            { GemmArgs g{WSP(bf16_t, U2), KT5, nullptr, WSP(bf16_t, s5Tb) + (size_t)l * SNG_ * K5 * KT5, KT5, KT5}; StaticSched S; S.init(SNG_, M5P, K5, M5P, K5, SCHED_GC);
              EpiS5b E{WSP(bf16_t, yc)}; GEMM_CALL(g, S, E); }
#ifdef CPU_TEST
            st_post(p, l, wv, nwv, lane);
#else
            st_post_wave(p, l, wv, nwv, lane);
#endif
            REP_END } SYNC(pb + 4)
        if (IN(pb + 5)) { REP_BEGIN(5) LOADP GemmArgs g{WSP(bf16_t, yc), SW, nullptr, WSP(bf16_t, gluT) + (size_t)l * SWP * SW, SW, SW}; StaticSched S; S.init(1, MR, SWP, 0, 0, SCHED_GC);
            EpiGlu E{WSP(bf16_t, ymix), WSP(bf16_t, yc), p.s5_glu_b + (size_t)l * SW}; GEMM_CALL(g, S, E); REP_END } SYNC(pb + 5)
        if (IN(pb + 6)) { REP_BEGIN(6) LOADP GemmArgs g{WSP(bf16_t, ymix), MIXW, nullptr, WSP(bf16_t, w_outT) + (size_t)l * D_ * MIXW, MIXW, MIXW}; StaticSched S; S.init(1, MR, D_, 0, 0, SCHED_GC);
            EpiBf16Plain E{WSP(bf16_t, yo), D_}; GEMM_CALL(g, S, E); REP_END } SYNC(pb + 6)
        if (IN(pb + 7)) { REP_BEGIN(7) LOADP st_ln1(p, l, wv, nwv, lane); REP_END } SYNC(pb + 7)
        if (IN(pb + 8)) { REP_BEGIN(8) LOADP GemmArgs g{WSP(bf16_t, h2), D_, nullptr, WSP(bf16_t, rsT) + (size_t)l * NRS * D_, D_, D_}; StaticSched S; S.init(1, MR, NRS, 0, 0, SCHED_GC);
            EpiRS E{WSP(float, logits), WSP(bf16_t, sact)}; GEMM_CALL(g, S, E); REP_END } SYNC(pb + 8)
        if (IN(pb + 9)) { REP_BEGIN(9) LOADP
#ifdef CPU_TEST
            st_topk(p, l, wv, nwv, lane);
#else
            st_topk_wave(p, l, wv, nwv, lane, lds);
#endif
            st_scatter0(p, l, wv, nwv, lane); REP_END } SYNC(pb + 9)
#ifdef CPU_TEST
        if (IN(pb + 10)) { LOADP st_offsets(p, l, wv, nwv, lane); }
        if (IN(pb + 11)) { LOADP st_scatter(p, l, wv, nwv, lane); }
#else
        if (IN(pb + 11)) { LOADP st_scatter_blk(p, l, lds, wid, lane, wv, nwv); } SYNC(pb + 11)
#endif
        if (IN(pb + 12)) { REP_BEGIN(12) LOADP
            { GemmArgs g{WSP(bf16_t, h2), D_, WSP(int, slot_tok), WSP(bf16_t, w13T) + (size_t)l * E_ * 2 * FF_ * D_, D_, D_}; ListSched S{WSP(int, ulist), WSP(int, nunits), 2 * FF_ / 256, 2 * FF_, SCHED_GC};
              EpiUp E{WSP(bf16_t, act)}; GEMM_CALL_G(g, S, E); }
            { GemmArgs g{WSP(bf16_t, sact), FF_, nullptr, WSP(bf16_t, shw2T) + (size_t)l * D_ * FF_, FF_, FF_}; StaticSched S; S.init(1, MR, D_, 0, 0, SCHED_GC);
              EpiBf16Plain E{WSP(bf16_t, Ysh), D_}; GEMM_CALL(g, S, E); }
        REP_END } SYNC(pb + 12)
        if (IN(pb + 13)) { REP_BEGIN(13) LOADP GemmArgs g{WSP(bf16_t, act), FF_, nullptr, WSP(bf16_t, w2T) + (size_t)l * E_ * D_ * FF_, FF_, FF_}; ListSched S{WSP(int, ulist), WSP(int, nunits), D_ / 256, D_, SCHED_GC};
            EpiDown E{WSP(bf16_t, Y)}; GEMM_CALL(g, S, E); REP_END } SYNC(pb + 13)
        if (IN(pb + 14)) { REP_BEGIN(14) LOADP st_ln2(p, l, wv, nwv, lane); REP_END } SYNC(pb + 14)
    }
#ifdef CPU_TEST
template <int lo, int hi> static void run_program(const P& p) { const int wv = 0, nwv = 1, lane = 0;
#else
template <int lo, int hi> __device__ __forceinline__ void run_program(const CAS P* pk, LAS unsigned char* lds, const int wid, const XcdBarrier& bar) {
#endif
    if (IN(0)) { { LOADP st_siluc(p, wv, nwv, lane); } { LOADP st_s5a(p, wv, nwv, lane); }
#ifdef CPU_TEST
        { LOADP st_cvt1(p, 0, wv, nwv, lane); } { LOADP st_cvt2(p, 0, wv, nwv, lane); } { LOADP st_cvt3(p, 0, wv, nwv, lane); } { LOADP st_cvt4(p, 0, wv, nwv, lane); }
        { LOADP st_cvt1(p, 1, wv, nwv, lane); } { LOADP st_cvt2(p, 1, wv, nwv, lane); } { LOADP st_cvt3(p, 1, wv, nwv, lane); } { LOADP st_cvt4(p, 1, wv, nwv, lane); }
#else
        { LOADP st_cvt_tiles(p, 0, lds, wid * 64 + lane); } { LOADP st_cvt_tiles(p, 1, lds, wid * 64 + lane); }
#endif
        { LOADP st_cvt5(p, 0, wv, nwv, lane); } { LOADP st_cvt5(p, 1, wv, nwv, lane); } } SYNC(0)
#ifdef CPU_TEST
    if (IN(1)) { { LOADP st_modv(p, wv, nwv, lane); } { LOADP st_s5b(p, wv, nwv, lane); } } SYNC(1)
#else
#ifndef PRO_PROBE
#define PRO_PROBE 0
#endif
    if (IN(1)) { { LOADP st_modv_blk(p, lds, wid * 64 + lane); } for (int rp_ = 0; rp_ < ((PRO_PROBE & 1) ? 2 : 1); ++rp_) { LOADP st_s5b(p, wv, nwv, lane); } } SYNC(1)
#endif
#ifdef CPU_TEST
    if (IN(2)) { { LOADP st_s5c(p, wv, nwv, lane); } { LOADP st_hmod(p, 0, wv, nwv, lane); } } SYNC(2)
#else
    if (IN(2)) { for (int rp_ = 0; rp_ < ((PRO_PROBE & 2) ? 2 : 1); ++rp_) { LOADP st_s5c(p, wv, nwv, lane); } for (int rp_ = 0; rp_ < ((PRO_PROBE & 4) ? 2 : 1); ++rp_) { LOADP st_hmod(p, 0, wv, nwv, lane); } } SYNC(2)
#endif
#ifdef CPU_TEST
    run_layer<lo, hi, 0>(p); run_layer<lo, hi, 1>(p);
#else
    run_layer<lo, hi, 0>(pk, lds, wid, bar); run_layer<lo, hi, 1>(pk, lds, wid, bar);
#endif
}
#undef IN
#ifndef CPU_TEST
constexpr int LDS_BYTES = STAGE_BYTES + 1024;
struct KArgs { P p; };
template <int LO, int HI> __global__ void __launch_bounds__(512, 2) fwd_kernel(KArgs a) {
    extern __shared__ __attribute__((aligned(16))) unsigned char lds_raw[];
    LAS unsigned char* lds = (LAS unsigned char*)lds_raw;
    volatile LAS unsigned* xbw = (volatile LAS unsigned*)(lds + STAGE_BYTES);
    const int wid = __builtin_amdgcn_readfirstlane(threadIdx.x >> 6);
    const CAS P* pk = (const CAS P*)__builtin_amdgcn_kernarg_segment_ptr();
    if (threadIdx.x < 4) xbw[threadIdx.x] = 0u;
    __syncthreads();
    if (threadIdx.x == 0) { const unsigned xcc = xb_xcc_id() & 7u; const unsigned rank = xb_add((unsigned*)(pk->ws + WS.ctl) + VC_WORD(xcc), 1u); xbw[2] = rank * 8u + xcc; }
    __syncthreads();
    XcdBarrier bar; bar.bar = (unsigned*)(pk->ws + WS.ctl); bar.x = 0; bar.st = xbw; bar.wid = wid;
    if (HI - LO > 1) { bar = xcd_barrier_post((unsigned*)(pk->ws + WS.ctl), xbw); bar.wid = wid; }
    run_program<LO, HI>(pk, lds, wid, bar);
}
template <int PH> static void launch_each(int grid, hipStream_t stream, const KArgs& a) {
    if constexpr (PH < NPH) {
        static bool attr = false;
        if (!attr) { (void)hipFuncSetAttribute((const void*)fwd_kernel<PH, PH + 1>, hipFuncAttributeMaxDynamicSharedMemorySize, LDS_BYTES); attr = true; }
        hipLaunchKernelGGL((fwd_kernel<PH, PH + 1>), dim3(grid), dim3(512), LDS_BYTES, stream, a);
        launch_each<PH + 1>(grid, stream, a);
    }
}
extern "C" void kernel_launch(void* const* d_in, const int* in_sizes, int n_in, void* d_out, int out_size, void* d_ws, size_t ws_size, hipStream_t stream) {
    static int grid = 0;
    if (grid == 0) {
        if (n_in != 42 || ws_size < WS.end) { fprintf(stderr, "kernel_launch: bad inputs (n_in %d, ws %zu, need %zu)\n", n_in, ws_size, (size_t)WS.end); grid = -1; return; }
        int dev = 0, cus = 0; (void)hipGetDevice(&dev); (void)hipDeviceGetAttribute(&cus, hipDeviceAttributeMultiprocessorCount, dev);
        grid = cus;
    }
    if (grid < 0) return;
    KArgs a{}; const float** pp = (const float**)&a.p;
    for (int i = 0; i < 42; ++i) pp[i] = (const float*)d_in[i];
    a.p.out = (float*)d_out; a.p.ws = (unsigned char*)d_ws;
    (void)hipMemsetAsync((char*)d_ws + WS.ctl, 0, 16384, stream);
#ifdef FUSED
    static bool attr = false;
    if (!attr) { (void)hipFuncSetAttribute((const void*)fwd_kernel<0, NPH>, hipFuncAttributeMaxDynamicSharedMemorySize, LDS_BYTES); attr = true; }
    hipLaunchKernelGGL((fwd_kernel<0, NPH>), dim3(grid), dim3(512), LDS_BYTES, stream, a);
#else
    launch_each<0>(grid, stream, a);
#endif
}
#else
static void cpu_forward(const P& p) { run_program<0, NPH>(p); }
#endif
```

```cpp
#ifndef CFG_SMALL
#define D_ 1024
#define B_ 16
#define T_ 2048
#define CTX_ 256
#define GW_ 64
#define RH_ 6
#define GH_ 6
#define SNG_ 16
#define E_ 256
#define TOPK_ 8
#define NGRP_ 8
#define TKG_ 4
#define FF_ 256
#else
#define D_ 256
#define B_ 2
#define T_ 256
#define CTX_ 128
#define GW_ 16
#define RH_ 2
#define GH_ 2
#define SNG_ 4
#define E_ 16
#define TOPK_ 4
#define NGRP_ 4
#define TKG_ 2
#define FF_ 128
#endif
#define L_ 2
#define RN_ 64
#define RDR_ 32
#define RIR_ 32
#define RGR_ 64
#define GK_ 32
#define GV_ 64
#define GGR_ 16
#define SG_ 16
#define SP_ 64
#define CH_ 64

constexpr int pad256(int x) { return (x + 255) / 256 * 256; }
constexpr int RW = RH_ * RN_, RCOLS = 3 * RW + 2 * RDR_ + 2 * RIR_ + RGR_;
constexpr int GKD = GH_ * GK_, GWD = GH_ * GV_, GCOLS = 2 * GKD + 2 * GWD + 2 * GGR_;
constexpr int SW = SG_ * SNG_, MIXW = RW + GWD + SW, NIN = RCOLS + GCOLS + SW, NINP = pad256(NIN);
constexpr int GBASE = RCOLS, SBASE = RCOLS + GCOLS;
constexpr int NLAT = B_ * T_, NCTX = B_ * CTX_, NTOK = NLAT + NCTX;
constexpr int SPOS = CTX_ + T_, NPC = SPOS / CH_, NPCC = CTX_ / CH_, M5 = B_ * NPC, M5P = pad256(M5);
constexpr int KSM = 256, OWD = 0, OAD = 2 * RDR_, OGD = OAD + 2 * RIR_, OGL = OGD + RGR_;
constexpr int NSM = 5 * RW + 2 * GKD, NSMP = pad256(NSM), NGF = 2 * RW + 2 * GKD, NGB = 3 * RW;
constexpr int K5 = CH_ * SG_, KT5 = K5 + 4 * SP_, N5A = 4 * SP_, N5AP = pad256(N5A);
constexpr int EP = pad256(E_), NRS = EP + 2 * FF_;
constexpr int SWP = pad256(SW);
constexpr int NSLOT = pad256(NTOK * TOPK_) + E_ * 256, MAXT = NSLOT / 256;
constexpr int ROWS_ = T_ / GW_;
constexpr float LN_EPS = 1e-6f, GN_EPS = 64e-5f;
static_assert(OGL + 2 * GGR_ <= KSM, "ksm");
static_assert(NTOK % 256 == 0 && NLAT % 256 == 0, "rows");
static_assert(FF_ % 128 == 0 && D_ % 256 == 0, "ff");

typedef unsigned short bf16_t;
#ifdef CPU_TEST
#include <cmath>
#include <cstring>
#include <cstdio>
#include <cstdlib>
#include <vector>
#define HD static inline
#define HDM inline
#define NL 1
static inline float WSUM(float v) { return v; }
struct F4 { float v[4]; float& operator[](int i) { return v[i]; } const float& operator[](int i) const { return v[i]; } };
#else
#include <hip/hip_runtime.h>
#define HD __device__ __forceinline__
#define HDM __device__ __forceinline__
#define NL 64
#define DPP_ADD(v, ctrl) v += __builtin_bit_cast(float, __builtin_amdgcn_update_dpp(0, __builtin_bit_cast(int, v), ctrl, 0xF, 0xF, true))
HD float WSUM(float v) {
    DPP_ADD(v, 0xB1); DPP_ADD(v, 0x4E); DPP_ADD(v, 0x141); DPP_ADD(v, 0x140);
    const int b = __builtin_bit_cast(int, v);
    const float s0 = __builtin_bit_cast(float, __builtin_amdgcn_readlane(b, 0)), s1 = __builtin_bit_cast(float, __builtin_amdgcn_readlane(b, 16)),
                s2 = __builtin_bit_cast(float, __builtin_amdgcn_readlane(b, 32)), s3 = __builtin_bit_cast(float, __builtin_amdgcn_readlane(b, 48));
    return (s0 + s1) + (s2 + s3);
}
typedef float F4 __attribute__((ext_vector_type(4)));
#endif

#ifdef CPU_TEST
HD bf16_t f2bf(float f) { unsigned u; memcpy(&u, &f, 4); u += 0x7FFFu + ((u >> 16) & 1u); return (bf16_t)(u >> 16); }
#else
HD bf16_t f2bf(float f) { return __builtin_bit_cast(unsigned short, (__bf16)f); }
#endif
HD float bf2f(bf16_t b) { unsigned u = ((unsigned)b) << 16; float f; memcpy(&f, &u, 4); return f; }
#ifdef CPU_TEST
HD float fexp(float x) { return expf(x); }
HD float flog(float x) { return logf(x); }
HD float frcp(float x) { return 1.0f / x; }
#else
HD float fexp(float x) { return __expf(x); }
HD float flog(float x) { return __logf(x); }
HD float frcp(float x) { return __builtin_amdgcn_rcpf(x); }
#endif
HD float sigmoidf_(float x) { return frcp(1.0f + fexp(-x)); }
HD float siluf_(float x) { return x * sigmoidf_(x); }
HD float softplusf_(float x) { return x > 20.f ? x : flog(1.0f + fexp(x)); }
HD float ftanh(float x) { const float e = fexp(2.0f * (x > 15.f ? 15.f : x)); return 1.0f - 2.0f * frcp(e + 1.0f); }
HD float geluf_(float x) { return 0.5f * x * (1.0f + ftanh(0.7978845608028654f * (x + 0.044715f * x * x * x))); }

HD int row_of(int b, int pos) { return pos < CTX_ ? NLAT + b * CTX_ + pos : b * T_ + (pos - CTX_); }
HD int bidx_of(int n) { return n < NLAT ? n / T_ : B_; }
HD int seqpos(int d, int i) { return d == 0 ? i : (i < CTX_ ? CTX_ - 1 - i : CTX_ + T_ - 1 - (i - CTX_)); }

constexpr size_t al256(size_t x) { return (x + 255) / 256 * 256; }
struct WSMap {
    size_t ctl, silu_c, modv, w_inT, w_outT, wsmT, rsT, w13T, w2T, shw2T, gluT, s5Wa, s5Tb, s5pw, s5bb, s5K;
    size_t h, ymix, yo, xcur, x1, h2, eidx, ewt, slot_of, ecnt, efill, eoff, nunits, ulist, slot_tok;
    size_t proj, rkv, asmall, gs, gsb, yr, og, U2, xl, yc;
    size_t logits, sact, act, Y, Ysh;
    size_t end;
};
constexpr WSMap make_wsmap() {
    WSMap m{}; size_t o = 0;
#define TAKE(f, bytes) m.f = o; o = al256(o + (size_t)(bytes));
    TAKE(ctl, 65536)
    TAKE(silu_c, (B_ + 1) * D_ * 4) TAKE(modv, (size_t)L_ * (B_ + 1) * 6 * D_ * 4)
    TAKE(w_inT, (size_t)L_ * NINP * D_ * 2) TAKE(w_outT, (size_t)L_ * D_ * MIXW * 2) TAKE(wsmT, (size_t)L_ * NSMP * KSM * 2)
    TAKE(rsT, (size_t)L_ * NRS * D_ * 2) TAKE(w13T, (size_t)L_ * E_ * 2 * FF_ * D_ * 2) TAKE(w2T, (size_t)L_ * E_ * D_ * FF_ * 2)
    TAKE(shw2T, (size_t)L_ * D_ * FF_ * 2) TAKE(gluT, (size_t)L_ * SWP * SW * 2)
    TAKE(s5Wa, (size_t)L_ * SNG_ * N5AP * K5 * 2) TAKE(s5Tb, (size_t)L_ * SNG_ * K5 * KT5 * 2)
    TAKE(s5pw, (size_t)L_ * 2 * SNG_ * SP_ * (CH_ + 1) * 2 * 4) TAKE(s5bb, (size_t)L_ * 2 * SNG_ * SP_ * SG_ * 2 * 4) TAKE(s5K, (size_t)L_ * 2 * SNG_ * CH_ * SG_ * SG_ * 4)
    TAKE(h, (size_t)NTOK * D_ * 2) TAKE(ymix, (size_t)NTOK * MIXW * 2) TAKE(yo, (size_t)NTOK * D_ * 2) TAKE(xcur, (size_t)NTOK * D_ * 2)
    TAKE(x1, (size_t)NTOK * D_ * 2) TAKE(h2, (size_t)NTOK * D_ * 2)
    TAKE(eidx, (size_t)NTOK * TOPK_ * 4) TAKE(ewt, (size_t)NTOK * TOPK_ * 4) TAKE(slot_of, (size_t)NTOK * TOPK_ * 4)
    TAKE(ecnt, E_ * 4) TAKE(efill, E_ * 4) TAKE(eoff, (E_ + 1) * 4) TAKE(nunits, 256) TAKE(ulist, (size_t)MAXT * 16) TAKE(slot_tok, (size_t)NSLOT * 4)
    const size_t regA = o;
    TAKE(proj, (size_t)NTOK * NINP * 2) TAKE(rkv, (size_t)NTOK * 3 * RW * 2) TAKE(asmall, (size_t)NTOK * KSM * 2) TAKE(gs, (size_t)NTOK * NGF * 4) TAKE(gsb, (size_t)NTOK * NGB * 2)
    TAKE(yr, (size_t)2 * NTOK * RW * 4) TAKE(og, (size_t)2 * NTOK * GWD * 4) TAKE(U2, (size_t)SNG_ * M5P * KT5 * 2) TAKE(xl, (size_t)SNG_ * M5P * N5AP * 4)
    TAKE(yc, (size_t)NTOK * SW * 2)
    const size_t endA = o; o = regA;
    TAKE(logits, (size_t)NTOK * E_ * 4) TAKE(sact, (size_t)NTOK * FF_ * 2) TAKE(act, (size_t)NSLOT * FF_ * 2) TAKE(Y, (size_t)NSLOT * D_ * 2) TAKE(Ysh, (size_t)NTOK * D_ * 2)
    m.end = o > endA ? o : endA;
#undef TAKE
    return m;
}
constexpr WSMap WS = make_wsmap();

struct P {
    const float *x, *c, *ctx, *c_ctx, *w_mod, *b_mod, *w_in, *rwkv_conv, *rwkv_w0, *rwkv_w_up, *rwkv_a0, *rwkv_a_up, *rwkv_g_up, *rwkv_k_k, *rwkv_k_a,
        *rwkv_r_k, *rwkv_ln_g, *rwkv_ln_b, *gla_a_up, *gla_a_bias, *gla_norm_g, *s5_lam_re, *s5_lam_im, *s5_log_dt, *s5_b_re, *s5_b_im, *s5_c_re, *s5_c_im,
        *s5_d, *s5_glu_w, *s5_glu_b, *w_out, *ln1_g, *ln1_b, *router_w, *router_bias, *exp_w13, *exp_w2, *sh_w13, *sh_w2, *ln2_g, *ln2_b;
    float* out; unsigned char* ws;
};
#define WSP(type, field) ((type*)(p.ws + WS.field))
#define GIDX long gid = (long)wv * NL + lane; const long gsz = (long)nwv * NL
#ifdef CPU_TEST
HD void ld8bf(const bf16_t* q, float* o) { for (int j = 0; j < 8; ++j) o[j] = bf2f(q[j]); }
HD void ld8f(const float* q, float* o) { for (int j = 0; j < 8; ++j) o[j] = q[j]; }
HD void st8f(float* q, const float* v) { for (int j = 0; j < 8; ++j) q[j] = v[j]; }
HD void st8bf(bf16_t* q, const float* v) { for (int j = 0; j < 8; ++j) q[j] = f2bf(v[j]); }
HD void cp8bf(bf16_t* q, const bf16_t* s) { for (int j = 0; j < 8; ++j) q[j] = s[j]; }
HD void z8bf(bf16_t* q) { for (int j = 0; j < 8; ++j) q[j] = 0; }
#else
typedef unsigned U4 __attribute__((ext_vector_type(4)));
HD void ld8bf(const bf16_t* q, float* o) { const U4 w = *(const U4*)q;
#pragma unroll
    for (int j = 0; j < 4; ++j) { o[2 * j] = __uint_as_float(w[j] << 16); o[2 * j + 1] = __uint_as_float(w[j] & 0xffff0000u); } }
HD void ld8f(const float* q, float* o) { const F4 a = *(const F4*)q, b = *(const F4*)(q + 4); o[0] = a[0]; o[1] = a[1]; o[2] = a[2]; o[3] = a[3]; o[4] = b[0]; o[5] = b[1]; o[6] = b[2]; o[7] = b[3]; }
HD void st8f(float* q, const float* v) { *(F4*)q = (F4){v[0], v[1], v[2], v[3]}; *(F4*)(q + 4) = (F4){v[4], v[5], v[6], v[7]}; }
HD void st8bf(bf16_t* q, const float* v) { U4 w;
#pragma unroll
    for (int j = 0; j < 4; ++j) w[j] = (unsigned)f2bf(v[2 * j]) | ((unsigned)f2bf(v[2 * j + 1]) << 16);
    *(U4*)q = w; }
HD void cp8bf(bf16_t* q, const bf16_t* s) { *(U4*)q = *(const U4*)s; }
HD void z8bf(bf16_t* q) { *(U4*)q = (U4){0u, 0u, 0u, 0u}; }
#endif

HD void st_siluc(const P& p, int wv, int nwv, int lane) {
    GIDX; float* sc = WSP(float, silu_c);
    for (long i = gid; i < (long)(B_ + 1) * D_; i += gsz) { const int b = (int)(i / D_), k = (int)(i % D_); const float v = b < B_ ? p.c[(size_t)b * D_ + k] : p.c_ctx[k]; sc[i] = siluf_(v); }
}
HD void st_modv(const P& p, int wv, int nwv, int lane) {
    GIDX; const float* sc = WSP(float, silu_c); float* mv = WSP(float, modv);
    for (long i = gid; i < (long)L_ * 6 * D_; i += gsz) {
        const int l = (int)(i / (6 * D_)), col = (int)(i % (6 * D_));
        float acc[B_ + 1];
#pragma unroll
        for (int b = 0; b <= B_; ++b) acc[b] = 0.f;
        const float* w = p.w_mod + (size_t)l * D_ * 6 * D_ + col;
        for (int k = 0; k < D_; ++k) { const float wk = w[(size_t)k * 6 * D_];
#pragma unroll
            for (int b = 0; b <= B_; ++b) acc[b] += sc[b * D_ + k] * wk; }
        const float bm = p.b_mod[(size_t)l * 6 * D_ + col];
#pragma unroll
        for (int b = 0; b <= B_; ++b) mv[((size_t)l * (B_ + 1) + b) * 6 * D_ + col] = acc[b] + bm;
    }
}
HD void cvt_T(bf16_t* dst, const float* src, int Ndst, int K, int Nsrc, int nvalid, int src_col0, long gid, long gsz) {
    for (long i = gid; i < (long)Ndst * K; i += gsz) { const int n = (int)(i % Ndst), k = (int)(i / Ndst);
        dst[(size_t)n * K + k] = n < nvalid ? f2bf(src[(size_t)k * Nsrc + src_col0 + n]) : (bf16_t)0; }
}
HD void st_cvt1(const P& p, int l, int wv, int nwv, int lane) {
    GIDX;
    cvt_T(WSP(bf16_t, w_inT) + (size_t)l * NINP * D_, p.w_in + (size_t)l * D_ * NIN, NINP, D_, NIN, NIN, 0, gid, gsz);
    cvt_T(WSP(bf16_t, w_outT) + (size_t)l * D_ * MIXW, p.w_out + (size_t)l * MIXW * D_, D_, MIXW, D_, D_, 0, gid, gsz);
    cvt_T(WSP(bf16_t, shw2T) + (size_t)l * D_ * FF_, p.sh_w2 + (size_t)l * FF_ * D_, D_, FF_, D_, D_, 0, gid, gsz);
    cvt_T(WSP(bf16_t, gluT) + (size_t)l * SWP * SW, p.s5_glu_w + (size_t)l * SW * SW, SWP, SW, SW, SW, 0, gid, gsz);
}
HD void st_cvt2(const P& p, int l, int wv, int nwv, int lane) {
    GIDX;
    bf16_t* rs = WSP(bf16_t, rsT) + (size_t)l * NRS * D_;
    cvt_T(rs, p.router_w + (size_t)l * D_ * E_, EP, D_, E_, E_, 0, gid, gsz);
    for (int j = 0; j < FF_ / 128; ++j) {
        cvt_T(rs + (size_t)(EP + 256 * j) * D_, p.sh_w13 + (size_t)l * D_ * 2 * FF_, 128, D_, 2 * FF_, 128, 128 * j, gid, gsz);
        cvt_T(rs + (size_t)(EP + 256 * j + 128) * D_, p.sh_w13 + (size_t)l * D_ * 2 * FF_, 128, D_, 2 * FF_, 128, FF_ + 128 * j, gid, gsz);
    }
}
HD void st_cvt3(const P& p, int l, int wv, int nwv, int lane) {
    GIDX;
    for (long i = gid; i < (long)E_ * 2 * FF_ * D_; i += gsz) {
        const int n = (int)(i % (2 * FF_)); const long r = i / (2 * FF_); const int k = (int)(r % D_), e = (int)(r / D_);
        const int j = n / 256, w = n % 256, srcc = w < 128 ? 128 * j + w : FF_ + 128 * j + (w - 128);
        WSP(bf16_t, w13T)[(((size_t)l * E_ + e) * 2 * FF_ + n) * D_ + k] = f2bf(p.exp_w13[(((size_t)l * E_ + e) * D_ + k) * 2 * FF_ + srcc]);
    }
}
HD void st_cvt4(const P& p, int l, int wv, int nwv, int lane) {
    GIDX;
    for (long i = gid; i < (long)E_ * D_ * FF_; i += gsz) {
        const int n = (int)(i % D_); const long r = i / D_; const int k = (int)(r % FF_), e = (int)(r / FF_);
        WSP(bf16_t, w2T)[(((size_t)l * E_ + e) * D_ + n) * FF_ + k] = f2bf(p.exp_w2[(((size_t)l * E_ + e) * FF_ + k) * D_ + n]);
    }
}
HD void st_cvt5(const P& p, int l, int wv, int nwv, int lane) {
    GIDX;
    bf16_t* ws = WSP(bf16_t, wsmT) + (size_t)l * NSMP * KSM;
    for (long i = gid; i < (long)NSMP * KSM; i += gsz) {
        const int n = (int)(i / KSM), k = (int)(i % KSM); float v = 0.f;
        if (n < 2 * RW) { const int d = n / RW, c = n % RW, r = k - (OWD + d * RDR_); if (r >= 0 && r < RDR_) v = p.rwkv_w_up[(((size_t)l * 2 + d) * RDR_ + r) * RW + c]; }
        else if (n < 4 * RW) { const int d = (n - 2 * RW) / RW, c = n % RW, r = k - (OAD + d * RIR_); if (r >= 0 && r < RIR_) v = p.rwkv_a_up[(((size_t)l * 2 + d) * RIR_ + r) * RW + c]; }
        else if (n < 5 * RW) { const int c = n - 4 * RW, r = k - OGD; if (r >= 0 && r < RGR_) v = p.rwkv_g_up[((size_t)l * RGR_ + r) * RW + c]; }
        else if (n < NSM) { const int q = n - 5 * RW, d = q / GKD, c = q % GKD, r = k - (OGL + d * GGR_); if (r >= 0 && r < GGR_) v = p.gla_a_up[(((size_t)l * 2 + d) * GGR_ + r) * GKD + c]; }
        ws[i] = f2bf(v);
    }
}
HD void st_s5a(const P& p, int wv, int nwv, int lane) {
    GIDX; float* pw = WSP(float, s5pw); float* bb = WSP(float, s5bb);
    for (long i = gid; i < (long)L_ * 2 * SNG_ * SP_ * (CH_ + 1); i += gsz) {
        const int tau = (int)(i % (CH_ + 1)); long r = i / (CH_ + 1); const int pp = (int)(r % SP_); r /= SP_; const int g = (int)(r % SNG_); r /= SNG_; const int d = (int)(r % 2), l = (int)(r / 2);
        const double dt = exp((double)p.s5_log_dt[((size_t)l * 2 + d) * SNG_ + g]);
        const double zr = (double)p.s5_lam_re[((size_t)l * 2 + d) * SP_ + pp] * dt, zi = (double)p.s5_lam_im[((size_t)l * 2 + d) * SP_ + pp] * dt;
        const double mag = exp(zr * tau);
        pw[i * 2] = (float)(mag * cos(zi * tau)); pw[i * 2 + 1] = (float)(mag * sin(zi * tau));
    }
    for (long i = gid; i < (long)L_ * 2 * SNG_ * SP_ * SG_; i += gsz) {
        const int c = (int)(i % SG_); long r = i / SG_; const int pp = (int)(r % SP_); r /= SP_; const int g = (int)(r % SNG_); r /= SNG_; const int d = (int)(r % 2), l = (int)(r / 2);
        const double dt = exp((double)p.s5_log_dt[((size_t)l * 2 + d) * SNG_ + g]);
        const double lr = p.s5_lam_re[((size_t)l * 2 + d) * SP_ + pp], li = p.s5_lam_im[((size_t)l * 2 + d) * SP_ + pp];
        const double zr = lr * dt, zi = li * dt, mag = exp(zr), ar = mag * cos(zi), ai = mag * sin(zi), den = lr * lr + li * li;
        const double fr = ((ar - 1) * lr + ai * li) / den, fi = (ai * lr - (ar - 1) * li) / den;
        const size_t bi = ((((size_t)l * 2 + d) * SNG_ + g) * SP_ + pp) * SG_ + c;
        const double br = p.s5_b_re[bi], bim = p.s5_b_im[bi];
        bb[i * 2] = (float)(fr * br - fi * bim); bb[i * 2 + 1] = (float)(fr * bim + fi * br);
    }
}
HD void st_s5b(const P& p, int wv, int nwv, int lane) {
    GIDX; const float* pw = WSP(float, s5pw); const float* bb = WSP(float, s5bb); float* K = WSP(float, s5K);
    for (long i = gid; i < (long)L_ * 2 * SNG_ * CH_ * SG_ * SG_; i += gsz) {
        const int c2 = (int)(i % SG_); long r = i / SG_; const int c = (int)(r % SG_); r /= SG_; const int tau = (int)(r % CH_); r /= CH_; const long ldg = r;
        float acc = 0.f;
        for (int pp = 0; pp < SP_; ++pp) {
            const float cr = p.s5_c_re[(ldg * SG_ + c) * SP_ + pp], ci = p.s5_c_im[(ldg * SG_ + c) * SP_ + pp];
            const float ar = pw[((ldg * SP_ + pp) * (CH_ + 1) + tau) * 2], ai = pw[((ldg * SP_ + pp) * (CH_ + 1) + tau) * 2 + 1];
            const float br = bb[((ldg * SP_ + pp) * SG_ + c2) * 2], bi = bb[((ldg * SP_ + pp) * SG_ + c2) * 2 + 1];
            const float er = cr * ar - ci * ai, ei = cr * ai + ci * ar;
            acc += er * br - ei * bi;
        }
        K[i] = acc;
    }
}
static_assert(SG_ == 16 && K5 % 8 == 0 && KT5 % 8 == 0 && SP_ % 8 == 0, "s5c item shape");
HD void st_s5c(const P& p, int wv, int nwv, int lane) {
    GIDX; const float* pw = WSP(float, s5pw); const float* bb = WSP(float, s5bb); const float* K = WSP(float, s5K);
    bf16_t* Tb = WSP(bf16_t, s5Tb); bf16_t* Wa = WSP(bf16_t, s5Wa);
    for (long i = gid; i < (long)L_ * SNG_ * K5 * (KT5 / 8); i += gsz) {
        const int k = (int)(i % (KT5 / 8)) * 8; long r = i / (KT5 / 8); const int n = (int)(r % K5); r /= K5; const int g = (int)(r % SNG_), l = (int)(r / SNG_);
        const int t = n / SG_, c = n % SG_; float v[8];
        const long ldg0 = ((long)l * 2 + 0) * SNG_ + g, ldg1 = ((long)l * 2 + 1) * SNG_ + g;
        if (k < K5) { const int s = k / SG_, c2 = k % SG_; const float m0 = s <= t ? 1.f : 0.f, m1 = s >= t ? 1.f : 0.f; const int t0 = s <= t ? t - s : 0, t1 = s >= t ? s - t : 0;
            float a[8], b[8]; ld8f(K + ((ldg0 * CH_ + t0) * SG_ + c) * SG_ + c2, a); ld8f(K + ((ldg1 * CH_ + t1) * SG_ + c) * SG_ + c2, b);
            const float dd = p.s5_d[(size_t)l * SW + g * SG_ + c];
#pragma unroll
            for (int j = 0; j < 8; ++j) v[j] = m0 * a[j] + m1 * b[j] + ((s == t && c == c2 + j) ? dd : 0.f);
        } else { const int q = k - K5, d = q / (2 * SP_), part = (q / SP_) & 1, pp0 = q % SP_; const long ldg = d ? ldg1 : ldg0; const int ex = d ? (CH_ - t) : (t + 1);
            float cr[8], ci[8]; ld8f(p.s5_c_re + (ldg * SG_ + c) * SP_ + pp0, cr); ld8f(p.s5_c_im + (ldg * SG_ + c) * SP_ + pp0, ci);
#pragma unroll
            for (int j = 0; j < 8; ++j) { const float ar = pw[((ldg * SP_ + pp0 + j) * (CH_ + 1) + ex) * 2], ai = pw[((ldg * SP_ + pp0 + j) * (CH_ + 1) + ex) * 2 + 1];
                v[j] = part == 0 ? (cr[j] * ar - ci[j] * ai) : -(cr[j] * ai + ci[j] * ar); } }
        st8bf(Tb + i * 8, v);
    }
    for (long i = gid; i < (long)L_ * SNG_ * N5AP * (K5 / 8); i += gsz) {
        const int k = (int)(i % (K5 / 8)) * 8; long r = i / (K5 / 8); const int n = (int)(r % N5AP); r /= N5AP; const int g = (int)(r % SNG_), l = (int)(r / SNG_);
        float v[8];
#pragma unroll
        for (int j = 0; j < 8; ++j) v[j] = 0.f;
        if (n < N5A) { const int d = n / (2 * SP_), part = (n / SP_) & 1, pp = n % SP_, s = k / SG_, c2 = k % SG_; const long ldg = ((long)l * 2 + d) * SNG_ + g; const int ex = d ? s : (CH_ - 1 - s);
            const float ar = pw[((ldg * SP_ + pp) * (CH_ + 1) + ex) * 2], ai = pw[((ldg * SP_ + pp) * (CH_ + 1) + ex) * 2 + 1];
            float b0[8], b1[8]; ld8f(bb + ((ldg * SP_ + pp) * SG_ + c2) * 2, b0); ld8f(bb + ((ldg * SP_ + pp) * SG_ + c2) * 2 + 8, b1);
#pragma unroll
            for (int j = 0; j < 8; ++j) { const float br = j < 4 ? b0[2 * j] : b1[2 * (j - 4)], bi = j < 4 ? b0[2 * j + 1] : b1[2 * (j - 4) + 1]; v[j] = part == 0 ? (ar * br - ai * bi) : (ar * bi + ai * br); } }
        st8bf(Wa + i * 8, v);
    }
}
HD const float* xsrc0(const P& p, int n) { return n < NLAT ? p.x + (size_t)n * D_ : p.ctx + (size_t)(n - NLAT) * D_; }
HD void ln_stats(const float* z, int lane, float& mu, float& rstd) {
    float s = 0.f; for (int k = lane; k < D_; k += NL) s += z[k]; s = WSUM(s); mu = s * (1.0f / D_);
    float q = 0.f; for (int k = lane; k < D_; k += NL) { const float d = z[k] - mu; q += d * d; } q = WSUM(q); rstd = 1.0f / sqrtf(q * (1.0f / D_) + LN_EPS);
}
constexpr int PERL = D_ / NL, NCHK = PERL / 4;
HD void row_stats(const float* xv, float& mu, float& rstd) {
    float s = 0.f;
#pragma unroll
    for (int i = 0; i < PERL; ++i) s += xv[i];
    s = WSUM(s); mu = s * (1.0f / D_); float q = 0.f;
#pragma unroll
    for (int i = 0; i < PERL; ++i) { const float d = xv[i] - mu; q += d * d; }
    q = WSUM(q); rstd = 1.0f / sqrtf(q * (1.0f / D_) + LN_EPS);
}
HD void row_ld(const float* z, int lane, float* xv) {
#pragma unroll
    for (int i = 0; i < NCHK; ++i) { const F4 v = *(const F4*)(z + 4 * lane + 4 * NL * i); xv[4 * i] = v[0]; xv[4 * i + 1] = v[1]; xv[4 * i + 2] = v[2]; xv[4 * i + 3] = v[3]; }
}
HD void st4bf(bf16_t* q, const float* v) {
#ifdef CPU_TEST
    for (int j = 0; j < 4; ++j) q[j] = f2bf(v[j]);
#else
    uint2 w; w.x = (unsigned)f2bf(v[0]) | ((unsigned)f2bf(v[1]) << 16); w.y = (unsigned)f2bf(v[2]) | ((unsigned)f2bf(v[3]) << 16); *(uint2*)q = w;
#endif
}
HD void ld4bf(const bf16_t* q, float* o) {
#ifdef CPU_TEST
    for (int j = 0; j < 4; ++j) o[j] = bf2f(q[j]);
#else
    const uint2 w = *(const uint2*)q; o[0] = __uint_as_float(w.x << 16); o[1] = __uint_as_float(w.x & 0xffff0000u); o[2] = __uint_as_float(w.y << 16); o[3] = __uint_as_float(w.y & 0xffff0000u);
#endif
}
HD void row_mod_store(const float* xv, const float* mv, int sh_off, int sc_off, bf16_t* hrow, int lane) {
    float mu, rstd; row_stats(xv, mu, rstd);
#pragma unroll
    for (int i = 0; i < NCHK; ++i) { const int k = 4 * lane + 4 * NL * i; const F4 sc = *(const F4*)(mv + sc_off + k), sh = *(const F4*)(mv + sh_off + k); float o[4];
#pragma unroll
        for (int j = 0; j < 4; ++j) o[j] = (xv[4 * i + j] - mu) * rstd * (1.0f + sc[j]) + sh[j];
        st4bf(hrow + k, o); }
}
HD void row_affine(float* xv, const float* g, const float* bb, int lane) {
    float mu, rstd; row_stats(xv, mu, rstd);
#pragma unroll
    for (int i = 0; i < NCHK; ++i) { const int k = 4 * lane + 4 * NL * i; const F4 gg = *(const F4*)(g + k), be = *(const F4*)(bb + k);
#pragma unroll
        for (int j = 0; j < 4; ++j) xv[4 * i + j] = (xv[4 * i + j] - mu) * rstd * gg[j] + be[j]; }
}
HD void row_ld_bf(const bf16_t* z, int lane, float* xv) {
#pragma unroll
    for (int i = 0; i < NCHK; ++i) ld4bf(z + 4 * lane + 4 * NL * i, xv + 4 * i);
}
HD void row_st_bf(bf16_t* z, int lane, const float* xv) {
#pragma unroll
    for (int i = 0; i < NCHK; ++i) st4bf(z + 4 * lane + 4 * NL * i, xv + 4 * i);
}
HD void row_ld_x(const P& p, int l, int n, int lane, float* xv) { if (l == 0) row_ld(xsrc0(p, n), lane, xv); else row_ld_bf(WSP(bf16_t, xcur) + (size_t)n * D_, lane, xv); }
HD void row_st(float* z, int lane, const float* xv) {
#pragma unroll
    for (int i = 0; i < NCHK; ++i) { F4 v; v[0] = xv[4 * i]; v[1] = xv[4 * i + 1]; v[2] = xv[4 * i + 2]; v[3] = xv[4 * i + 3]; *(F4*)(z + 4 * lane + 4 * NL * i) = v; }
}
HD void st_hmod(const P& p, int l, int wv, int nwv, int lane) {
    bf16_t* h = WSP(bf16_t, h);
    for (int n = wv; n < NTOK; n += nwv) {
        float xv[PERL]; row_ld_x(p, l, n, lane, xv);
        const float* mv = WSP(float, modv) + ((size_t)l * (B_ + 1) + bidx_of(n)) * 6 * D_;
        row_mod_store(xv, mv, 0, D_, h + (size_t)n * D_, lane);
    }
}
static_assert(RCOLS % 8 == 0 && RW % 8 == 0 && RDR_ % 4 == 0, "prep1 groups");
HD void st_prep1(const P& p, int l, int wv, int nwv, int lane) {
    GIDX; const bf16_t* proj = WSP(bf16_t, proj); bf16_t* rkv = WSP(bf16_t, rkv); bf16_t* as = WSP(bf16_t, asmall); bf16_t* U2 = WSP(bf16_t, U2);
    const float* taps = p.rwkv_conv + (size_t)l * 9 * RCOLS; constexpr int NG = RCOLS / 8;
    for (long i0 = gid; i0 < (long)NTOK * NG; i0 += 2 * gsz) {
#pragma unroll
      for (int u2 = 0; u2 < 2; ++u2) { const long i = i0 + u2 * gsz; if (i < (long)NTOK * NG) {
        const int n = (int)(i / NG), ch = (int)(i % NG) * 8; float acc[8];
#pragma unroll
        for (int j = 0; j < 8; ++j) acc[j] = 0.f;
        if (n < NLAT) { const int b = n / T_, t = n % T_, gr = t / GW_, gc = t % GW_;
#pragma unroll
            for (int a = 0; a < 3; ++a)
#pragma unroll
                for (int j = 0; j < 3; ++j) { const int rr = gr + a - 1, cc = gc + j - 1; const bool ok = rr >= 0 && rr < ROWS_ && cc >= 0 && cc < GW_;
                    const int nn = ok ? b * T_ + rr * GW_ + cc : n; float x[8], w[8]; ld8bf(proj + (size_t)nn * NINP + ch, x); ld8f(taps + (a * 3 + j) * RCOLS + ch, w); const float m = ok ? 1.f : 0.f;
#pragma unroll
                    for (int q = 0; q < 8; ++q) acc[q] += (w[q] * m) * x[q]; }
        } else { const int s = (n - NLAT) % CTX_;
#pragma unroll
            for (int j = 0; j < 3; ++j) { const int ss = s + j - 1; const bool ok = ss >= 0 && ss < CTX_; const int nn = ok ? n + j - 1 : n; float x[8], w[8]; ld8bf(proj + (size_t)nn * NINP + ch, x); ld8f(taps + (3 + j) * RCOLS + ch, w); const float m = ok ? 1.f : 0.f;
#pragma unroll
                for (int q = 0; q < 8; ++q) acc[q] += (w[q] * m) * x[q]; } }
        if (ch < 3 * RW) st8bf(rkv + (size_t)n * 3 * RW + ch, acc);
        else { const int q0 = ch - 3 * RW;
            if (q0 < 2 * RDR_) {
#pragma unroll
                for (int q = 0; q < 8; ++q) acc[q] = ftanh(acc[q]); }
            else if (q0 >= 2 * RDR_ + 2 * RIR_) {
#pragma unroll
                for (int q = 0; q < 8; ++q) acc[q] = sigmoidf_(acc[q]); }
            st8bf(as + (size_t)n * KSM + q0, acc); }
          } }
    }
    constexpr int NT8 = (KSM - OGL) / 8;
    for (long i = gid; i < (long)NTOK * NT8; i += gsz) { const int n = (int)(i / NT8), q = (int)(i % NT8) * 8;
        if (q < 2 * GGR_) cp8bf(as + (size_t)n * KSM + OGL + q, proj + (size_t)n * NINP + GBASE + 2 * GKD + 2 * GWD + q); else z8bf(as + (size_t)n * KSM + OGL + q); }
    for (long i = gid; i < (long)B_ * SPOS * (SW / 8); i += gsz) { const int c = (int)(i % (SW / 8)) * 8; const long r = i / (SW / 8); const int pos = (int)(r % SPOS), b = (int)(r / SPOS);
        const int g = c / SG_, cc = c % SG_, pc = pos / CH_, t = pos % CH_, m = b * NPC + pc;
        cp8bf(U2 + ((size_t)g * M5P + m) * KT5 + t * SG_ + cc, proj + (size_t)row_of(b, pos) * NINP + SBASE + c); }
}
HD void st_s5carry(const P& p, int l, int wv, int nwv, int lane) {
    GIDX; const float* xl = WSP(float, xl); bf16_t* U2 = WSP(bf16_t, U2); const float* pw = WSP(float, s5pw);
    for (long i = gid; i < (long)2 * B_ * SNG_ * SP_; i += gsz) {
        const int pp = (int)(i % SP_); long r = i / SP_; const int g = (int)(r % SNG_); r /= SNG_; const int b = (int)(r % B_), d = (int)(r / B_);
        const long ldg = ((long)l * 2 + d) * SNG_ + g; const float ar = pw[((ldg * SP_ + pp) * (CH_ + 1) + CH_) * 2], ai = pw[((ldg * SP_ + pp) * (CH_ + 1) + CH_) * 2 + 1];
        float xr = 0.f, xi = 0.f;
        for (int q = 0; q < NPC; ++q) {
            const int pc = d == 0 ? q : (q < NPCC ? NPCC - 1 - q : NPC - 1 - (q - NPCC)); const size_t m = (size_t)b * NPC + pc;
            bf16_t* x0 = U2 + ((size_t)g * M5P + m) * KT5 + K5 + d * 2 * SP_; x0[pp] = f2bf(xr); x0[SP_ + pp] = f2bf(xi);
            const float lr = xl[((size_t)g * M5P + m) * N5AP + d * 2 * SP_ + pp], li = xl[((size_t)g * M5P + m) * N5AP + d * 2 * SP_ + SP_ + pp];
            const float nr = ar * xr - ai * xi + lr, ni = ar * xi + ai * xr + li; xr = nr; xi = ni;
        }
    }
}
struct RV { float r, w, k2, a, b, v, kkraw; };
HD void rwkv_elem(const P& p, int l, int d, int n, int hh, int j, float kknorm_rs, RV& o) {
    const bf16_t* rkv = WSP(bf16_t, rkv) + (size_t)n * 3 * RW; const float* gs = WSP(float, gs) + (size_t)n * NGF; const bf16_t* gb = WSP(bf16_t, gsb) + (size_t)n * NGB; const int c = hh * RN_ + j;
    const float k = bf2f(rkv[RW + c]); o.kkraw = k * p.rwkv_k_k[(size_t)l * RW + c]; const float kk = o.kkraw * kknorm_rs;
    const float a = bf2f(gb[d * RW + c]); o.w = fexp(gs[d * RW + c]); o.k2 = k * (1.0f + (a - 1.0f) * p.rwkv_k_a[(size_t)l * RW + c]);
    o.a = -kk; o.b = kk * a; o.r = bf2f(rkv[c]); o.v = bf2f(rkv[2 * RW + c]);
}
HD void st_post(const P& p, int l, int wv, int nwv, int lane) {
    bf16_t* ymix = WSP(bf16_t, ymix); const float* yr = WSP(float, yr); const float* og = WSP(float, og); const bf16_t* proj = WSP(bf16_t, proj); const bf16_t* gsbb = WSP(bf16_t, gsb); const bf16_t* rkvb = WSP(bf16_t, rkv);
    const int nrow = (l == L_ - 1) ? NLAT : NTOK; constexpr int PJ = RN_ / NL;
    for (int n = wv; n < nrow; n += nwv) {
        const bf16_t* rk = rkvb + (size_t)n * 3 * RW; const bf16_t* gb = gsbb + (size_t)n * NGB;
        float r_[RH_][PJ], k_[RH_][PJ], v_[RH_][PJ], y_[RH_][PJ], a0_[RH_][PJ], a1_[RH_][PJ], g_[RH_][PJ], o_[GH_][PJ], gg_[GH_][PJ];
#pragma unroll
        for (int hh = 0; hh < RH_; ++hh)
#pragma unroll
            for (int q = 0; q < PJ; ++q) { const int c = hh * RN_ + lane + NL * q; r_[hh][q] = bf2f(rk[c]); k_[hh][q] = bf2f(rk[RW + c]); v_[hh][q] = bf2f(rk[2 * RW + c]);
                y_[hh][q] = yr[(size_t)n * RW + c] + yr[((size_t)NTOK + n) * RW + c]; a0_[hh][q] = bf2f(gb[c]); a1_[hh][q] = bf2f(gb[RW + c]); g_[hh][q] = bf2f(gb[2 * RW + c]); }
#pragma unroll
        for (int hh = 0; hh < GH_; ++hh)
#pragma unroll
            for (int q = 0; q < PJ; ++q) { const int c = hh * GV_ + lane + NL * q; o_[hh][q] = og[(size_t)n * GWD + c] + og[((size_t)NTOK + n) * GWD + c]; gg_[hh][q] = bf2f(proj[(size_t)n * NINP + GBASE + 2 * GKD + GWD + c]); }
#pragma unroll
        for (int hh = 0; hh < RH_; ++hh) {
            float s = 0.f, bs = 0.f;
#pragma unroll
            for (int q = 0; q < PJ; ++q) { const int c = hh * RN_ + lane + NL * q; const float ka = p.rwkv_k_a[(size_t)l * RW + c];
                const float k20 = k_[hh][q] * (1.0f + (a0_[hh][q] - 1.0f) * ka), k21 = k_[hh][q] * (1.0f + (a1_[hh][q] - 1.0f) * ka);
                s += y_[hh][q]; bs += r_[hh][q] * (k20 + k21) * p.rwkv_r_k[(size_t)l * RW + c]; }
            s = WSUM(s); bs = WSUM(bs); const float mu = s * (1.0f / RN_); float qq = 0.f;
#pragma unroll
            for (int q = 0; q < PJ; ++q) { const float d = y_[hh][q] - mu; qq += d * d; }
            qq = WSUM(qq); const float rstd = 1.0f / sqrtf(qq * (1.0f / RN_) + GN_EPS);
#pragma unroll
            for (int q = 0; q < PJ; ++q) { const int c = hh * RN_ + lane + NL * q; const float gn = (y_[hh][q] - mu) * rstd * p.rwkv_ln_g[(size_t)l * RW + c] + p.rwkv_ln_b[(size_t)l * RW + c];
                ymix[(size_t)n * MIXW + c] = f2bf((gn + bs * v_[hh][q]) * g_[hh][q]); }
        }
#pragma unroll
        for (int hh = 0; hh < GH_; ++hh) { float qq = 0.f;
#pragma unroll
            for (int q = 0; q < PJ; ++q) qq += o_[hh][q] * o_[hh][q];
            qq = WSUM(qq); const float rs = 1.0f / sqrtf(qq * (1.0f / GV_) + 1e-6f);
#pragma unroll
            for (int q = 0; q < PJ; ++q) { const int j = lane + NL * q; ymix[(size_t)n * MIXW + RW + hh * GV_ + j] = f2bf(o_[hh][q] * rs * p.gla_norm_g[(size_t)l * GV_ + j] * siluf_(gg_[hh][q])); }
        }
    }
}
HD void st_ln1(const P& p, int l, int wv, int nwv, int lane) {
    GIDX; const float alpha = sqrtf(2.0f);
    for (long i = gid; i < E_; i += gsz) { WSP(int, ecnt)[i] = 0; WSP(int, efill)[i] = 0; }
    const int nrow = (l == L_ - 1) ? NLAT : NTOK; bf16_t* x1 = WSP(bf16_t, x1); bf16_t* h2 = WSP(bf16_t, h2); const bf16_t* yo = WSP(bf16_t, yo);
    for (int n = wv; n < nrow; n += nwv) {
        const float* mv = WSP(float, modv) + ((size_t)l * (B_ + 1) + bidx_of(n)) * 6 * D_;
        float xv[PERL], yv[PERL]; row_ld_x(p, l, n, lane, xv); row_ld_bf(yo + (size_t)n * D_, lane, yv);
#pragma unroll
        for (int i = 0; i < NCHK; ++i) { const F4 g1 = *(const F4*)(mv + 2 * D_ + 4 * lane + 4 * NL * i);
#pragma unroll
            for (int j = 0; j < 4; ++j) xv[4 * i + j] = alpha * xv[4 * i + j] + g1[j] * yv[4 * i + j]; }
        row_affine(xv, p.ln1_g + (size_t)l * D_, p.ln1_b + (size_t)l * D_, lane);
        row_st_bf(x1 + (size_t)n * D_, lane, xv);
        row_mod_store(xv, mv, 3 * D_, 4 * D_, h2 + (size_t)n * D_, lane);
    }
}
HD void st_topk(const P& p, int l, int wv, int nwv, int lane) {
    GIDX; const int nrow = (l == L_ - 1) ? NLAT : NTOK; const float* lg = WSP(float, logits); constexpr int EG = E_ / NGRP_;
    for (long n = gid; n < nrow; n += gsz) {
        const float* z = lg + (size_t)n * E_; const float* rb = p.router_bias + (size_t)l * E_;
        float gsc[NGRP_];
#pragma unroll
        for (int g = 0; g < NGRP_; ++g) { float m1 = -1e30f, m2 = -1e30f;
            for (int e = 0; e < EG; ++e) { const float s = sigmoidf_(z[g * EG + e]) + rb[g * EG + e]; if (s > m1) { m2 = m1; m1 = s; } else if (s > m2) m2 = s; }
            gsc[g] = m1 + m2; }
        unsigned gmask = 0;
#pragma unroll
        for (int g = 0; g < NGRP_; ++g) { int rank = 0;
#pragma unroll
            for (int g2 = 0; g2 < NGRP_; ++g2) rank += (gsc[g2] > gsc[g] || (gsc[g2] == gsc[g] && g2 < g)) ? 1 : 0;
            if (rank < TKG_) gmask |= 1u << g; }
        float pv = 1e30f; int pi = -1; float wsum = 0.f; int* ei = WSP(int, eidx) + (size_t)n * TOPK_; float* ew = WSP(float, ewt) + (size_t)n * TOPK_;
        for (int kk = 0; kk < TOPK_; ++kk) { float bv = -1e30f; int bi = -1;
            for (int e = 0; e < E_; ++e) { if (!((gmask >> (e / EG)) & 1u)) continue; const float s = sigmoidf_(z[e]) + rb[e];
                const bool after = (s < pv) || (s == pv && e > pi); if (after && s > bv) { bv = s; bi = e; } }
            pv = bv; pi = bi; ei[kk] = bi; const float w = sigmoidf_(z[bi]); ew[kk] = w; wsum += w; }
        for (int kk = 0; kk < TOPK_; ++kk) ew[kk] = ew[kk] / wsum * 2.5f;
#ifdef CPU_TEST
        for (int kk = 0; kk < TOPK_; ++kk) WSP(int, ecnt)[ei[kk]]++;
#else
        for (int kk = 0; kk < TOPK_; ++kk) atomicAdd(WSP(int, ecnt) + ei[kk], 1);
#endif
    }
}
HD void st_offsets(const P& p, int l, int wv, int nwv, int lane) {
    if (wv != 0 || lane != 0) return;
    int* eoff = WSP(int, eoff); const int* ecnt = WSP(int, ecnt); int* ul = WSP(int, ulist); int o = 0, nu = 0;
    for (int e = 0; e < E_; ++e) { eoff[e] = o; const int nt = (ecnt[e] + 255) / 256;
        for (int t = 0; t < nt; ++t) { ul[nu * 4 + 0] = o + 256 * t; ul[nu * 4 + 1] = e; ul[nu * 4 + 2] = (ecnt[e] - 256 * t) < 256 ? (ecnt[e] - 256 * t) : 256; ul[nu * 4 + 3] = 0; ++nu; }
        o += nt * 256; }
    eoff[E_] = o; WSP(int, nunits)[0] = nu;
}
HD void st_scatter0(const P& p, int l, int wv, int nwv, int lane) { GIDX; int* st = WSP(int, slot_tok); for (long i = gid; i < NSLOT; i += gsz) st[i] = 0; }
HD void st_scatter(const P& p, int l, int wv, int nwv, int lane) {
    GIDX; const int nrow = (l == L_ - 1) ? NLAT : NTOK; const int* ei = WSP(int, eidx); const int* eoff = WSP(int, eoff); int* so = WSP(int, slot_of); int* st = WSP(int, slot_tok);
    for (long i = gid; i < (long)nrow * TOPK_; i += gsz) { const int e = ei[i];
#ifdef CPU_TEST
        const int r = WSP(int, efill)[e]++;
#else
        const int r = atomicAdd(WSP(int, efill) + e, 1);
#endif
        const int s = eoff[e] + r; so[i] = s; st[s] = (int)(i / TOPK_); }
}
HD void st_ln2(const P& p, int l, int wv, int nwv, int lane) {
    const float alpha = sqrtf(2.0f); const bool last = (l == L_ - 1); const int nrow = last ? NLAT : NTOK;
    const bf16_t* x1 = WSP(bf16_t, x1); const bf16_t* Y = WSP(bf16_t, Y); const bf16_t* Ysh = WSP(bf16_t, Ysh); const int* so = WSP(int, slot_of); const float* ew = WSP(float, ewt);
    for (int n = wv; n < nrow; n += nwv) {
        const float* mv = WSP(float, modv) + ((size_t)l * (B_ + 1) + bidx_of(n)) * 6 * D_;
        float xv[PERL], fv[PERL]; row_ld_bf(x1 + (size_t)n * D_, lane, xv);
#pragma unroll
        for (int i = 0; i < NCHK; ++i) ld4bf(Ysh + (size_t)n * D_ + 4 * lane + 4 * NL * i, fv + 4 * i);
#pragma unroll
        for (int kk = 0; kk < TOPK_; ++kk) { const float w = ew[(size_t)n * TOPK_ + kk]; const bf16_t* yr_ = Y + (size_t)so[(size_t)n * TOPK_ + kk] * D_;
#pragma unroll
            for (int i = 0; i < NCHK; ++i) { float t4[4]; ld4bf(yr_ + 4 * lane + 4 * NL * i, t4);
#pragma unroll
                for (int j = 0; j < 4; ++j) fv[4 * i + j] += w * t4[j]; } }
#pragma unroll
        for (int i = 0; i < NCHK; ++i) { const F4 g2 = *(const F4*)(mv + 5 * D_ + 4 * lane + 4 * NL * i);
#pragma unroll
            for (int j = 0; j < 4; ++j) xv[4 * i + j] = alpha * xv[4 * i + j] + g2[j] * fv[4 * i + j]; }
        row_affine(xv, p.ln2_g + (size_t)l * D_, p.ln2_b + (size_t)l * D_, lane);
        if (last) row_st(p.out + (size_t)n * D_, lane, xv);
        else { row_st_bf(WSP(bf16_t, xcur) + (size_t)n * D_, lane, xv);
            const float* mv2 = WSP(float, modv) + ((size_t)(l + 1) * (B_ + 1) + bidx_of(n)) * 6 * D_;
            row_mod_store(xv, mv2, 0, D_, WSP(bf16_t, h) + (size_t)n * D_, lane); }
    }
}
struct UnitInfo { int arow0, brow0, g, pm, pn, nv; };
struct GemmArgs { const bf16_t* A; int lda; const int* rowmap; const bf16_t* Bt; int ldb; int K; };

struct StaticSched {
    int nb, nM, nN, aM, bN, G, c;
    HDM void init(int nb_, int M, int N, int aM_, int bN_, int G_, int c_) { nb = nb_; nM = M / 256; nN = N / 256; aM = aM_; bN = bN_; G = G_; c = c_; }
    HDM int max_units() const { return (nb * nM * nN + G - 1) / G; }
    HDM bool next(int i, UnitInfo& u) const {
        const long L = (long)i * G + c; const int per = nM * nN; if (L >= (long)nb * per) return false;
        const int g = (int)(L / per); int wgid = (int)(L % per);
        { const int q = per / 8, r = per % 8, xcd = wgid % 8, off = wgid / 8; wgid = (xcd < r ? xcd * (q + 1) : r * (q + 1) + (xcd - r) * q) + off; }
        const int nig = 8 * nN, gid = wgid / nig, fm = gid * 8, gsz = (nM - fm) < 8 ? (nM - fm) : 8;
        u.pm = fm + ((wgid % nig) % gsz); u.pn = (wgid % nig) / gsz; u.g = g; u.arow0 = g * aM + 256 * u.pm; u.brow0 = g * bN + 256 * u.pn; u.nv = 256; return true;
    }
};
HD int ld_int(const int* q) {
#ifdef CPU_TEST
    return *q;
#else
    return __hip_atomic_load(q, __ATOMIC_RELAXED, __HIP_MEMORY_SCOPE_AGENT);
#endif
}
struct ListSched {
    const int* ulist; const int* nunits; int ntn, bN, G, c;
    HDM int max_units() const { return 0; }
    HDM bool next(int i, UnitInfo& u) const {
        const long L = (long)i * G + c; const int nt = ld_int(nunits); if (L >= (long)((nt + 7) / 8) * 8 * ntn) return false;
        const int r_ = (int)(L % (8 * ntn)); const int t = (r_ & 7) * ((nt + 7) / 8) + (int)(L / (8 * ntn)), pn = r_ >> 3; if (t >= nt) return false;
        const int s0 = ld_int(ulist + 4 * t), e = ld_int(ulist + 4 * t + 1);
        u.arow0 = s0; u.brow0 = e * bN + 256 * pn; u.g = e; u.pm = s0 / 256; u.pn = pn; u.nv = ld_int(ulist + 4 * t + 2); return true;
    }
};

#ifndef PROBE_EpiBf16Plain
#define PROBE_EpiBf16Plain false
#endif
#ifndef PROBE_EpiF32Plain
#define PROBE_EpiF32Plain false
#endif
#ifndef PROBE_EpiSmall
#define PROBE_EpiSmall false
#endif
#ifndef PROBE_EpiS5b
#define PROBE_EpiS5b false
#endif
#ifndef PROBE_EpiGlu
#define PROBE_EpiGlu false
#endif
#ifndef PROBE_EpiRS
#define PROBE_EpiRS false
#endif
#ifndef PROBE_EpiUp
#define PROBE_EpiUp false
#endif
#ifndef PROBE_EpiDown
#define PROBE_EpiDown false
#endif
HD void st4_bf16(bf16_t* q, const F4& v) {
#ifdef CPU_TEST
    for (int j = 0; j < 4; ++j) q[j] = f2bf(v[j]);
#else
    uint2 w; w.x = (unsigned)f2bf(v[0]) | ((unsigned)f2bf(v[1]) << 16); w.y = (unsigned)f2bf(v[2]) | ((unsigned)f2bf(v[3]) << 16); *(uint2*)q = w;
#endif
}
HD void st4_f32(float* q, const F4& v) {
#ifdef CPU_TEST
    for (int j = 0; j < 4; ++j) q[j] = v[j];
#else
    *(F4*)q = v;
#endif
}
HD void st8_bf16(bf16_t* q, const F4& lo, const F4& hi) {
#ifdef CPU_TEST
    for (int j = 0; j < 4; ++j) { q[j] = f2bf(lo[j]); q[4 + j] = f2bf(hi[j]); }
#else
    typedef unsigned U4e __attribute__((ext_vector_type(4))); U4e w;
    w[0] = (unsigned)f2bf(lo[0]) | ((unsigned)f2bf(lo[1]) << 16); w[1] = (unsigned)f2bf(lo[2]) | ((unsigned)f2bf(lo[3]) << 16);
    w[2] = (unsigned)f2bf(hi[0]) | ((unsigned)f2bf(hi[1]) << 16); w[3] = (unsigned)f2bf(hi[2]) | ((unsigned)f2bf(hi[3]) << 16); *(U4e*)q = w;
#endif
}
HD int perm32(int rho) { const int n = rho >> 4, i = rho & 15; return 8 * (i >> 2) + 4 * n + (i & 3); }
struct EpiBf16Plain { static constexpr bool PROBE = PROBE_EpiBf16Plain; bf16_t* O; int ldo; HDM void shift() { O += 800000000; }
    static constexpr bool PERM = true;
    HDM void st8(const UnitInfo& u, int r, int c, const F4& al, const F4& ah, const F4& bl, const F4& bh) const { bf16_t* q = O + (size_t)(256 * u.pm + r) * ldo + 256 * u.pn + c; st8_bf16(q, al, ah); st8_bf16(q + 128, bl, bh); } };
struct EpiF32Plain { static constexpr bool PROBE = PROBE_EpiF32Plain; static constexpr bool PERM = false; HDM void shift() {} float* O; int ldo; size_t gstride;
    HDM void st(const UnitInfo& u, int r, int c, const F4& v0, const F4& v1) const { float* q = O + (size_t)u.g * gstride + (size_t)(256 * u.pm + r) * ldo + 256 * u.pn + c; st4_f32(q, v0); st4_f32(q + 128, v1); } };
struct EpiSmall { static constexpr bool PROBE = PROBE_EpiSmall; static constexpr bool PERM = false; HDM void shift() {} float* gs; bf16_t* gsb; const float* w0; const float* a0; const float* ab;
    HDM void half(int n, int col, const F4& v) const {
        if (col >= NSM) return; F4 o;
        if (col < 2 * RW) { for (int j = 0; j < 4; ++j) { float w = w0[col + j] + v[j]; w = -softplusf_(-w) - 0.5f; o[j] = -fexp(w); } st4_f32(gs + (size_t)n * NGF + col, o); }
        else if (col < 4 * RW) { for (int j = 0; j < 4; ++j) o[j] = sigmoidf_(a0[col - 2 * RW + j] + v[j]); st4_bf16(gsb + (size_t)n * NGB + (col - 2 * RW), o); }
        else if (col < 5 * RW) st4_bf16(gsb + (size_t)n * NGB + 2 * RW + (col - 4 * RW), v);
        else { for (int j = 0; j < 4; ++j) o[j] = -softplusf_(-(v[j] + ab[col - 5 * RW + j])) * (1.0f / 16.0f); st4_f32(gs + (size_t)n * NGF + 2 * RW + (col - 5 * RW), o); }
    }
    HDM void st(const UnitInfo& u, int r, int c, const F4& v0, const F4& v1) const { const int n = 256 * u.pm + r, col = 256 * u.pn + c; half(n, col, v0); half(n, col + 128, v1); } };
struct EpiS5b { static constexpr bool PROBE = PROBE_EpiS5b; static constexpr bool PERM = true; HDM void shift() {} bf16_t* yc;
    HDM void half(const UnitInfo& u, int b, int pc, int col, const F4& lo, const F4& hi) const { const int t = col / SG_, cc = col % SG_; const int n = row_of(b, pc * CH_ + t);
        F4 ol, oh; for (int j = 0; j < 4; ++j) { ol[j] = geluf_(lo[j]); oh[j] = geluf_(hi[j]); } st8_bf16(yc + (size_t)n * SW + u.g * SG_ + cc, ol, oh); }
    HDM void st8(const UnitInfo& u, int r, int c, const F4& al, const F4& ah, const F4& bl, const F4& bh) const {
        const int m = 256 * u.pm + r; if (m >= M5) return; const int b = m / NPC, pc = m % NPC; half(u, b, pc, 256 * u.pn + c, al, ah); half(u, b, pc, 256 * u.pn + c + 128, bl, bh); } };
HD void ld4_bf16(const bf16_t* q, F4& o) {
#ifdef CPU_TEST
    for (int j = 0; j < 4; ++j) o[j] = bf2f(q[j]);
#else
    const uint2 w = *(const uint2*)q; o[0] = __uint_as_float(w.x << 16); o[1] = __uint_as_float(w.x & 0xffff0000u); o[2] = __uint_as_float(w.y << 16); o[3] = __uint_as_float(w.y & 0xffff0000u);
#endif
}
struct EpiGlu { static constexpr bool PROBE = PROBE_EpiGlu; static constexpr bool PERM = true; HDM void shift() {} bf16_t* ymix; const bf16_t* yc; const float* gb;
    HDM void half(int n, int col, const F4& lo, const F4& hi) const { if (col >= SW) return; F4 y0, y1, ol, oh; ld4_bf16(yc + (size_t)n * SW + col, y0); ld4_bf16(yc + (size_t)n * SW + col + 4, y1);
        for (int j = 0; j < 4; ++j) { ol[j] = y0[j] * sigmoidf_(lo[j] + gb[col + j]); oh[j] = y1[j] * sigmoidf_(hi[j] + gb[col + 4 + j]); } st8_bf16(ymix + (size_t)n * MIXW + RW + GWD + col, ol, oh); }
    HDM void st8(const UnitInfo& u, int r, int c, const F4& al, const F4& ah, const F4& bl, const F4& bh) const { const int n = 256 * u.pm + r, col = 256 * u.pn + c; half(n, col, al, ah); half(n, col + 128, bl, bh); } };
struct EpiRS { static constexpr bool PROBE = PROBE_EpiRS; static constexpr bool PERM = true; HDM void shift() {} float* logits; bf16_t* sact;
    HDM void st8(const UnitInfo& u, int r, int c, const F4& al, const F4& ah, const F4& bl, const F4& bh) const {
        const int n = 256 * u.pm + r;
        if (u.pn < EP / 256) { const int col = 256 * u.pn + c; if (col < E_) { st4_f32(logits + (size_t)n * E_ + col, al); st4_f32(logits + (size_t)n * E_ + col + 4, ah); } if (col + 128 < E_) { st4_f32(logits + (size_t)n * E_ + col + 128, bl); st4_f32(logits + (size_t)n * E_ + col + 132, bh); } }
        else { const int j = u.pn - EP / 256; F4 ol, oh; for (int q = 0; q < 4; ++q) { ol[q] = siluf_(al[q]) * bl[q]; oh[q] = siluf_(ah[q]) * bh[q]; } st8_bf16(sact + (size_t)n * FF_ + 128 * j + c, ol, oh); }
    } };
struct EpiUp { static constexpr bool PROBE = PROBE_EpiUp; static constexpr bool PERM = true; HDM void shift() {} bf16_t* act;
    HDM void st8(const UnitInfo& u, int r, int c, const F4& al, const F4& ah, const F4& bl, const F4& bh) const { if (r >= u.nv) return; F4 ol, oh; for (int q = 0; q < 4; ++q) { ol[q] = siluf_(al[q]) * bl[q]; oh[q] = siluf_(ah[q]) * bh[q]; } st8_bf16(act + (size_t)(u.arow0 + r) * FF_ + 128 * u.pn + c, ol, oh); } };
struct EpiDown { static constexpr bool PROBE = PROBE_EpiDown; static constexpr bool PERM = true; HDM void shift() {} bf16_t* Y;
    HDM void st8(const UnitInfo& u, int r, int c, const F4& al, const F4& ah, const F4& bl, const F4& bh) const { if (r >= u.nv) return; bf16_t* q = Y + (size_t)(u.arow0 + r) * D_ + 256 * u.pn + c; st8_bf16(q, al, ah); st8_bf16(q + 128, bl, bh); } };

#ifdef CPU_TEST
template <class Epi, class Sched> static void gemm_phase(const GemmArgs& g, const Sched& S, const Epi& E) {
    UnitInfo u; std::vector<float> arow(g.K);
    for (int i = 0; S.next(i, u); ++i)
        for (int r = 0; r < 256; ++r) {
            const int ar = g.rowmap ? g.rowmap[u.arow0 + r] : u.arow0 + r; const bf16_t* a = g.A + (size_t)ar * g.lda;
            for (int k = 0; k < g.K; ++k) arow[k] = bf2f(a[k]);
            float out[256];
            for (int c = 0; c < 256; ++c) { const bf16_t* b0 = g.Bt + (size_t)(u.brow0 + c) * g.ldb; float s0 = 0.f; for (int k = 0; k < g.K; ++k) s0 += arow[k] * bf2f(b0[k]); out[c] = s0; }
            if constexpr (Epi::PERM) { for (int c = 0; c < 128; c += 8) { F4 al, ah, bl, bh; for (int j = 0; j < 4; ++j) { al[j] = out[c + j]; ah[j] = out[c + 4 + j]; bl[j] = out[128 + c + j]; bh[j] = out[128 + c + 4 + j]; } E.st8(u, r, c, al, ah, bl, bh); } }
            else { for (int c = 0; c < 128; c += 4) { F4 v0, v1; for (int j = 0; j < 4; ++j) { v0[j] = out[c + j]; v1[j] = out[128 + c + j]; } E.st(u, r, c, v0, v1); } }
        }
}
#else
#define LAS __attribute__((address_space(3)))
typedef short bf16x8 __attribute__((ext_vector_type(8)));
constexpr int HTB = 128 * 64 * 2, STAGE_BYTES = 8 * HTB;
HD int lds_byte(int r, int c) { const int st = (r >> 4) * 2 + (c >> 5), rr = r & 15, cc = c & 31, ob = rr * 64 + cc * 2; return st * 1024 + (ob ^ (((ob >> 9) & 1) << 5)); }
HD void stage_rc(int b, int& R, int& C) { const int st = b / 1024, sb = b % 1024, swz = sb ^ (((sb >> 9) & 1) << 5); R = (st >> 1) * 16 + swz / 64; C = (st & 1) * 32 + (swz % 64) / 2; }

struct XcdBarrier; __device__ __forceinline__ void xcd_barrier(const XcdBarrier& b);
#ifndef GP_RS
#define GP_RS 0
#endif
HD int lane_id() { return (int)__builtin_amdgcn_mbcnt_hi(~0u, __builtin_amdgcn_mbcnt_lo(~0u, 0u)); }
template <bool GATHER, class Epi, class Sched>
__device__ __forceinline__ void gemm_phase(LAS unsigned char* lds, const int wid, const GemmArgs g, const Sched& S, const Epi& E, const XcdBarrier* pbar) {
    int lane = lane_id(); asm volatile("" : "+v"(lane)); const int tid = wid * 64 + lane;
    const int wr = wid >> 2, wc = wid & 3, fr = lane & 15, fq = lane >> 4;
    float zero_ = 0.f; asm volatile("" : "+v"(zero_));
    const int nt = g.K / 64;
    const unsigned ldsw = (unsigned)wid * 1024u;
    const int aoff = lds_byte(wr * 64 + fr, fq * 8), boff = lds_byte(wc * 32 + fr, fq * 8);
    const char* Ab = (const char*)g.A; const char* Bb = (const char*)g.Bt;
#define G_SA(b, h) (((b) * 2 + (h)) * HTB)
#define G_SB(b, h) ((4 + (b) * 2 + (h)) * HTB)
#define G_STAGE(bufoff, gbase, voff) do { _Pragma("unroll") for (int _i = 0; _i < 2; ++_i) \
        __builtin_amdgcn_global_load_lds((const unsigned*)((gbase) + (voff)[_i]), (LAS unsigned*)(lds + (bufoff) + ldsw + _i * 8192), 16, 0, 0); } while (0)
#define G_LDA(dst, b, h) do { _Pragma("unroll") for (int m = 0; m < 4; ++m) _Pragma("unroll") for (int k = 0; k < 2; ++k) dst[m][k] = *(const LAS bf16x8*)(lds + G_SA(b, h) + aoff + m * 2048 + k * 1024); } while (0)
#define G_LDB(dst, b, h) do { _Pragma("unroll") for (int n = 0; n < 2; ++n) _Pragma("unroll") for (int k = 0; k < 2; ++k) dst[n][k] = *(const LAS bf16x8*)(lds + G_SB(b, h) + boff + n * 2048 + k * 1024); } while (0)
#define G_MMA(ai, bj, At, Bt) do { __builtin_amdgcn_s_setprio(1); _Pragma("unroll") for (int m = 0; m < 4; ++m) _Pragma("unroll") for (int n = 0; n < 2; ++n) _Pragma("unroll") for (int k = 0; k < 2; ++k) \
        acc[ai][bj][m][n] = __builtin_amdgcn_mfma_f32_16x16x32_bf16(Bt[n][k], At[m][k], acc[ai][bj][m][n], 0, 0, 0); __builtin_amdgcn_s_setprio(0); } while (0)
#define G_WAIT_V(n) asm volatile("s_waitcnt vmcnt(" #n ")" ::: "memory")
#define G_WAIT_L(n) asm volatile("s_waitcnt lgkmcnt(" #n ")" ::: "memory")
#define G_BAR __builtin_amdgcn_s_barrier()
#define G_SCHED __builtin_amdgcn_sched_barrier(0)
    const unsigned hA = 128u * (unsigned)g.lda * 2u, hB = 128u * (unsigned)g.ldb * 2u;
#define G_SETOFF(u) do { int _t = lane_id(); asm volatile("" : "+v"(_t)); _t += wid * 64; _Pragma("unroll") for (int _i = 0; _i < 2; ++_i) { int _R, _C; stage_rc(_t * 16 + _i * 8192, _R, _C); \
        const int _Rb = Epi::PERM ? ((_R & ~31) + perm32(_R & 31)) : _R; OB[_i] = ((unsigned)((u).brow0 + _Rb) * (unsigned)g.ldb + (unsigned)_C) * 2u; \
        if (GATHER) { OA[0][_i] = ((unsigned)ld_int(g.rowmap + (u).arow0 + _R) * (unsigned)g.lda + (unsigned)_C) * 2u; OA[1][_i] = ((unsigned)ld_int(g.rowmap + (u).arow0 + 128 + _R) * (unsigned)g.lda + (unsigned)_C) * 2u; } \
        else { OA[0][_i] = ((unsigned)((u).arow0 + _R) * (unsigned)g.lda + (unsigned)_C) * 2u; } } } while (0)
#define G_STA(bufoff, h, kb) G_STAGE(bufoff, Ab + (kb) + (GATHER ? 0u : (h) * hA), OA[GATHER ? (h) : 0])
#define G_STB(bufoff, h, kb) G_STAGE(bufoff, Bb + (kb) + (h) * hB, OB)
#ifndef GP_K2
#define GP_K2 0
#endif
#ifndef GP_E2
#define GP_E2 0
#endif
    constexpr bool K2 = GP_K2 && Epi::PROBE, E2 = GP_E2 && Epi::PROBE;
    UnitInfo cur, nxt; int ui = 0;
    if (!S.next(0, cur)) return;
    F4 acc[2][2][4][2];
#pragma unroll
    for (int a = 0; a < 2; ++a)
#pragma unroll
        for (int b = 0; b < 2; ++b)
#pragma unroll
            for (int m = 0; m < 4; ++m)
#pragma unroll
                for (int n = 0; n < 2; ++n) acc[a][b][m][n] = (F4){zero_, zero_, zero_, zero_};
    bf16x8 At[4][2], B0[2][2], B1[2][2];
    unsigned OA[GATHER ? 2 : 1][2], OB[2];
    G_SETOFF(cur);
    G_STB(G_SB(0, 0), 0, 0); G_STA(G_SA(0, 0), 0, 0); G_STB(G_SB(0, 1), 1, 0); G_STA(G_SA(0, 1), 1, 0);
    if (wr == 1) G_BAR;
    G_WAIT_V(4); G_BAR;
    G_STB(G_SB(1, 0), 0, 128); G_STA(G_SA(1, 0), 0, 128); G_STB(G_SB(1, 1), 1, 128);
    G_WAIT_V(6); G_BAR;
    for (;;) {
        const bool has_next = K2 ? S.next((ui + 1) >> 1, nxt) : S.next(ui + 1, nxt);
#pragma unroll 1
        for (int t = 0; t < nt; t += 2) {
            const bool last = (t == nt - 2);
            G_LDB(B0, 0, 0); G_SCHED; G_LDA(At, 0, 0); G_STA(G_SA(1, 1), 1, (size_t)(t + 1) * 128);
            if (last && has_next) G_SETOFF(nxt);
            const size_t k2 = last ? 0 : (size_t)(t + 2) * 128, k3 = k2 + 128;
            G_WAIT_L(8); G_BAR; G_WAIT_L(0); G_MMA(0, 0, At, B0); G_BAR; G_SCHED;
            G_LDB(B1, 0, 1); G_STB(G_SB(0, 0), 0, k2);
            G_BAR; G_WAIT_L(0); G_MMA(0, 1, At, B1); G_BAR;
            G_LDA(At, 0, 1); G_STA(G_SA(0, 0), 0, k2);
            G_BAR; G_WAIT_L(0); G_MMA(1, 0, At, B0); G_BAR; G_SCHED;
            G_STB(G_SB(0, 1), 1, k2);
            G_WAIT_V(6); G_BAR; G_MMA(1, 1, At, B1); G_BAR;
            G_LDB(B0, 1, 0); G_SCHED; G_LDA(At, 1, 0); G_STA(G_SA(0, 1), 1, k2);
            G_WAIT_L(8); G_BAR; G_WAIT_L(0); G_MMA(0, 0, At, B0); G_BAR; G_SCHED;
            G_LDB(B1, 1, 1); G_STB(G_SB(1, 0), 0, k3);
            G_BAR; G_WAIT_L(0); G_MMA(0, 1, At, B1); G_BAR;
            G_LDA(At, 1, 1); G_STA(G_SA(1, 0), 0, k3);
            G_BAR; G_WAIT_L(0); G_MMA(1, 0, At, B0); G_BAR; G_SCHED;
            G_STB(G_SB(1, 1), 1, k3);
            G_WAIT_V(6); G_BAR; G_MMA(1, 1, At, B1); G_BAR;
        }
        if (!K2 || (ui & 1)) {
        if (wr == 0) G_BAR;
        int te = lane_id(); asm volatile("" : "+v"(te)); const int ewr = wid >> 2, ewc = wid & 3, efr = te & 15, efq = te >> 4;
#pragma unroll
        for (int ai = 0; ai < 2; ++ai)
#pragma unroll
            for (int m = 0; m < 4; ++m)
            { int rr = ai * 128 + ewr * 64 + m * 16 + efr; asm volatile("" : "+v"(rr) :: "memory"); const float sc_ = K2 ? 0.5f : 1.0f;
                if constexpr (Epi::PERM) { E.st8(cur, rr, ewc * 32 + 8 * efq, acc[ai][0][m][0] * sc_, acc[ai][0][m][1] * sc_, acc[ai][1][m][0] * sc_, acc[ai][1][m][1] * sc_); }
                else {
#pragma unroll
                    for (int n = 0; n < 2; ++n) { E.st(cur, rr, ewc * 32 + n * 16 + 4 * efq, acc[ai][0][m][n] * sc_, acc[ai][1][m][n] * sc_); asm volatile("" ::: "memory"); } } }
        }
        if (GP_RS && Epi::PROBE) xcd_barrier(*pbar);
        if (!has_next) break;
        if (!K2 || (ui & 1)) {
#pragma unroll
        for (int a = 0; a < 2; ++a)
#pragma unroll
            for (int b = 0; b < 2; ++b)
#pragma unroll
                for (int m = 0; m < 4; ++m)
#pragma unroll
                    for (int n = 0; n < 2; ++n) acc[a][b][m][n] = (F4){zero_, zero_, zero_, zero_};
        if (wr == 1) G_BAR;
        }
        cur = nxt; ++ui;
    }
    G_WAIT_V(0);
    if (K2 && !(ui & 1)) { if (wr == 0) G_BAR; }
    G_BAR;
    if (GP_RS && Epi::PROBE) { for (int r_ = ui + 1; r_ < S.max_units(); ++r_) xcd_barrier(*pbar); }
}
#endif
#ifndef MULTI_LAUNCH
#define FUSED 1
#endif
constexpr int NPH_PRO = 3, NPH_LAYER = 16, NPH = NPH_PRO + L_ * NPH_LAYER;

#ifdef CPU_TEST
static void rwkv_scan_all(const P& p, int l) {
    float* yr = WSP(float, yr);
    for (int d = 0; d < 2; ++d) for (int b = 0; b < B_; ++b) for (int hh = 0; hh < RH_; ++hh) {
        static float S[RN_][RN_]; memset(S, 0, sizeof(S));
        for (int idx = 0; idx < SPOS; ++idx) { const int n = row_of(b, seqpos(d, idx)); RV e[RN_]; float q = 0.f;
            for (int j = 0; j < RN_; ++j) { rwkv_elem(p, l, d, n, hh, j, 1.0f, e[j]); q += e[j].kkraw * e[j].kkraw; }
            const float rs = 1.0f / sqrtf(q + 1e-12f);
            for (int j = 0; j < RN_; ++j) { e[j].a *= rs; e[j].b *= rs; }
            for (int i = 0; i < RN_; ++i) { float sa = 0.f; for (int j = 0; j < RN_; ++j) sa += S[i][j] * e[j].a;
                float y = 0.f; for (int j = 0; j < RN_; ++j) { S[i][j] = S[i][j] * e[j].w + sa * e[j].b + e[i].v * e[j].k2; y += S[i][j] * e[j].r; }
                yr[((size_t)d * NTOK + n) * RW + hh * RN_ + i] = y; }
        }
    }
}
static void gla_scan_all(const P& p, int l) {
    float* og = WSP(float, og); const bf16_t* proj = WSP(bf16_t, proj); const float* gs = WSP(float, gs);
    for (int d = 0; d < 2; ++d) for (int b = 0; b < B_; ++b) for (int hh = 0; hh < GH_; ++hh) {
        static float S[GK_][GV_]; memset(S, 0, sizeof(S));
        for (int idx = 0; idx < SPOS; ++idx) { const int n = row_of(b, seqpos(d, idx)); const bf16_t* pr = proj + (size_t)n * NINP + GBASE;
            for (int j = 0; j < GV_; ++j) { const float v = bf2f(pr[2 * GKD + hh * GV_ + j]); float o = 0.f;
                for (int k = 0; k < GK_; ++k) { const float q = bf2f(pr[hh * GK_ + k]) * 0.17677669529663687f, kg = bf2f(pr[GKD + hh * GK_ + k]), al = fexp(gs[(size_t)n * NGF + 2 * RW + d * GKD + hh * GK_ + k]);
                    S[k][j] = S[k][j] * al + kg * v; o += q * S[k][j]; }
                og[((size_t)d * NTOK + n) * GWD + hh * GV_ + j] = o; }
        }
    }
}
#else
__device__ __forceinline__ float dpp_sum8(float v) {
    v += __builtin_bit_cast(float, __builtin_amdgcn_update_dpp(0, __builtin_bit_cast(int, v), 0xB1, 0xF, 0xF, true));
    v += __builtin_bit_cast(float, __builtin_amdgcn_update_dpp(0, __builtin_bit_cast(int, v), 0x4E, 0xF, 0xF, true));
    v += __builtin_bit_cast(float, __builtin_amdgcn_update_dpp(0, __builtin_bit_cast(int, v), 0x141, 0xF, 0xF, true));
    return v;
}
__device__ __forceinline__ float dpp_sum16(float v) {
    v = dpp_sum8(v);
    v += __builtin_bit_cast(float, __builtin_amdgcn_update_dpp(0, __builtin_bit_cast(int, v), 0x140, 0xF, 0xF, true));
    return v;
}
__device__ __forceinline__ float dpp_sum4(float v) {
    v += __builtin_bit_cast(float, __builtin_amdgcn_update_dpp(0, __builtin_bit_cast(int, v), 0xB1, 0xF, 0xF, true));
    v += __builtin_bit_cast(float, __builtin_amdgcn_update_dpp(0, __builtin_bit_cast(int, v), 0x4E, 0xF, 0xF, true));
    return v;
}
constexpr int RT = 16;
__device__ __forceinline__ void rwkv_seq_blk(const P& p, int l, int d, int b, int hh, LAS unsigned char* lds, int wid, int lane) {
    LAS float* stage = (LAS float*)lds;
    LAS float* ybuf = (LAS float*)(lds + 2 * RT * 6 * 64 * 4);
    const int r = lane >> 3, c = lane & 7, i = wid * 8 + r, cj = hh * RN_ + lane;
    const float kkc = p.rwkv_k_k[(size_t)l * RW + cj], kac = p.rwkv_k_a[(size_t)l * RW + cj];
    const bf16_t* rkv = WSP(bf16_t, rkv); const float* gs = WSP(float, gs); const bf16_t* gsb = WSP(bf16_t, gsb); float* yr = WSP(float, yr) + (size_t)d * NTOK * RW;
    float S[8];
#pragma unroll
    for (int q = 0; q < 8; ++q) S[q] = 0.f;
    float rawA[2][5], rawB[2][5];
#define RW_LOAD(chunk, raw) do { _Pragma("unroll") for (int tt = 0; tt < 2; ++tt) { const int n = __builtin_amdgcn_readfirstlane(row_of(b, seqpos(d, (chunk) * RT + 2 * wid + tt))); \
        const bf16_t* rk = rkv + (size_t)n * 3 * RW; \
        raw[tt][0] = bf2f(rk[cj]); raw[tt][1] = bf2f(rk[RW + cj]); raw[tt][2] = bf2f(rk[2 * RW + cj]); raw[tt][3] = gs[(size_t)n * NGF + d * RW + cj]; raw[tt][4] = bf2f(gsb[(size_t)n * NGB + d * RW + cj]); } } while (0)
#define RW_PUT(buf, raw) do { _Pragma("unroll") for (int tt = 0; tt < 2; ++tt) { const float k = raw[tt][1], a = raw[tt][4], kkraw = k * kkc; \
        const float kk = kkraw * (1.0f / sqrtf(WSUM(kkraw * kkraw) + 1e-12f)); LAS float* sv = stage + (((buf) * RT + 2 * wid + tt) * 6) * 64 + lane; \
        sv[0] = fexp(raw[tt][3]); sv[64] = k * (1.0f + (a - 1.0f) * kac); sv[128] = -kk; sv[192] = kk * a; sv[256] = raw[tt][0]; sv[320] = raw[tt][2]; } } while (0)
#define RW_YST(ch_, buf_) do { _Pragma("unroll") for (int tt = 0; tt < 2; ++tt) { const int n = __builtin_amdgcn_readfirstlane(row_of(b, seqpos(d, (ch_) * RT + 2 * wid + tt))); \
        const LAS float* yp = ybuf + (((buf_) * RT + 2 * wid + tt) * 64 + lane) * 8; const F4 ya = *(const LAS F4*)yp, yb = *(const LAS F4*)(yp + 4); \
        yr[(size_t)n * RW + cj] = ((ya[0] + ya[1]) + (ya[2] + ya[3])) + ((yb[0] + yb[1]) + (yb[2] + yb[3])); } } while (0)
    RW_LOAD(0, rawA); RW_PUT(0, rawA); RW_LOAD(1, rawB);
    __syncthreads();
    constexpr int NCH = SPOS / RT; static_assert(NCH % 2 == 0, "chunk pairs");
    for (int ch = 0; ch < NCH; ch += 2) {
        {
            constexpr int buf = 0;
            if (ch + 2 < NCH) RW_LOAD(ch + 2, rawA);
        { F4 cw0, cw1, ck0, ck1, ca0, ca1, cb0, cb1, cr0, cr1; float cvi;
#define RW_LDV(t_, W0, W1, K0, K1, A0, A1, B0, B1, R0, R1, VI) do { const LAS float* sv = stage + ((buf * RT + (t_)) * 6) * 64 + 8 * c; \
            W0 = *(const LAS F4*)(sv); W1 = *(const LAS F4*)(sv + 4); K0 = *(const LAS F4*)(sv + 64); K1 = *(const LAS F4*)(sv + 68); A0 = *(const LAS F4*)(sv + 128); A1 = *(const LAS F4*)(sv + 132); \
            B0 = *(const LAS F4*)(sv + 192); B1 = *(const LAS F4*)(sv + 196); R0 = *(const LAS F4*)(sv + 256); R1 = *(const LAS F4*)(sv + 260); VI = sv[320 - 8 * c + i]; } while (0)
          RW_LDV(0, cw0, cw1, ck0, ck1, ca0, ca1, cb0, cb1, cr0, cr1, cvi);
#pragma unroll
          for (int t = 0; t < RT; ++t) {
            F4 nw0 = cw0, nw1 = cw1, nk0 = ck0, nk1 = ck1, na0 = ca0, na1 = ca1, nb0 = cb0, nb1 = cb1, nr0 = cr0, nr1 = cr1; float nvi = cvi;
            if (t + 1 < RT) RW_LDV(t + 1, nw0, nw1, nk0, nk1, na0, na1, nb0, nb1, nr0, nr1, nvi);
            float sa = ((S[0] * ca0[0] + S[1] * ca0[1]) + (S[2] * ca0[2] + S[3] * ca0[3])) + ((S[4] * ca1[0] + S[5] * ca1[1]) + (S[6] * ca1[2] + S[7] * ca1[3]));
            sa = dpp_sum8(sa);
            float y0 = 0.f, y1 = 0.f;
#pragma unroll
            for (int q = 0; q < 4; ++q) { S[q] = S[q] * cw0[q] + (sa * cb0[q] + cvi * ck0[q]); y0 += S[q] * cr0[q]; S[4 + q] = S[4 + q] * cw1[q] + (sa * cb1[q] + cvi * ck1[q]); y1 += S[4 + q] * cr1[q]; }
            ybuf[((buf * RT + t) * 64 + i) * 8 + c] = y0 + y1;
            cw0 = nw0; cw1 = nw1; ck0 = nk0; ck1 = nk1; ca0 = na0; ca1 = na1; cb0 = nb0; cb1 = nb1; cr0 = nr0; cr1 = nr1; cvi = nvi;
          }
#undef RW_LDV
        }
            RW_PUT(1, rawB);
            __syncthreads();
            RW_YST(ch, 0);
        }
        {
            constexpr int buf = 1;
            if (ch + 3 < NCH) RW_LOAD(ch + 3, rawB);
        { F4 cw0, cw1, ck0, ck1, ca0, ca1, cb0, cb1, cr0, cr1; float cvi;
#define RW_LDV(t_, W0, W1, K0, K1, A0, A1, B0, B1, R0, R1, VI) do { const LAS float* sv = stage + ((buf * RT + (t_)) * 6) * 64 + 8 * c; \
            W0 = *(const LAS F4*)(sv); W1 = *(const LAS F4*)(sv + 4); K0 = *(const LAS F4*)(sv + 64); K1 = *(const LAS F4*)(sv + 68); A0 = *(const LAS F4*)(sv + 128); A1 = *(const LAS F4*)(sv + 132); \
            B0 = *(const LAS F4*)(sv + 192); B1 = *(const LAS F4*)(sv + 196); R0 = *(const LAS F4*)(sv + 256); R1 = *(const LAS F4*)(sv + 260); VI = sv[320 - 8 * c + i]; } while (0)
          RW_LDV(0, cw0, cw1, ck0, ck1, ca0, ca1, cb0, cb1, cr0, cr1, cvi);
#pragma unroll
          for (int t = 0; t < RT; ++t) {
            F4 nw0 = cw0, nw1 = cw1, nk0 = ck0, nk1 = ck1, na0 = ca0, na1 = ca1, nb0 = cb0, nb1 = cb1, nr0 = cr0, nr1 = cr1; float nvi = cvi;
            if (t + 1 < RT) RW_LDV(t + 1, nw0, nw1, nk0, nk1, na0, na1, nb0, nb1, nr0, nr1, nvi);
            float sa = ((S[0] * ca0[0] + S[1] * ca0[1]) + (S[2] * ca0[2] + S[3] * ca0[3])) + ((S[4] * ca1[0] + S[5] * ca1[1]) + (S[6] * ca1[2] + S[7] * ca1[3]));
            sa = dpp_sum8(sa);
            float y0 = 0.f, y1 = 0.f;
#pragma unroll
            for (int q = 0; q < 4; ++q) { S[q] = S[q] * cw0[q] + (sa * cb0[q] + cvi * ck0[q]); y0 += S[q] * cr0[q]; S[4 + q] = S[4 + q] * cw1[q] + (sa * cb1[q] + cvi * ck1[q]); y1 += S[4 + q] * cr1[q]; }
            ybuf[((buf * RT + t) * 64 + i) * 8 + c] = y0 + y1;
            cw0 = nw0; cw1 = nw1; ck0 = nk0; ck1 = nk1; ca0 = na0; ca1 = na1; cb0 = nb0; cb1 = nb1; cr0 = nr0; cr1 = nr1; cvi = nvi;
          }
#undef RW_LDV
        }
            if (ch + 2 < NCH) RW_PUT(0, rawA);
            __syncthreads();
            RW_YST(ch + 1, 1);
        }
    }
    __syncthreads();
#undef RW_YST
#undef RW_LOAD
#undef RW_PUT
}
__device__ __forceinline__ void gla_seq_wave(const P& p, int l, int d, int b, int hh, int hv, LAS float* st, int lane) {
    float S[2][8];
#pragma unroll
    for (int k = 0; k < 8; ++k) { S[0][k] = 0.f; S[1][k] = 0.f; }
    const int vp = lane >> 2, kg = lane & 3;
    float* og = WSP(float, og) + (size_t)d * NTOK * GWD; const bf16_t* proj = WSP(bf16_t, proj); const float* gs = WSP(float, gs);
    constexpr int SB = RT * 128;
    const int kh = lane >> 5, jj = lane & 31;
    float vec[24], vv[RT / 2];
#define GL_LOAD(chunk) do { _Pragma("unroll") for (int it = 0; it < 8; ++it) { const int n = row_of(b, seqpos(d, (chunk) * RT + 2 * it + kh)); const bf16_t* pr = proj + (size_t)n * NINP + GBASE + hh * GK_ + jj; \
        vec[3 * it] = bf2f(pr[0]) * 0.17677669529663687f; vec[3 * it + 1] = bf2f(pr[GKD]); vec[3 * it + 2] = gs[(size_t)n * NGF + 2 * RW + d * GKD + hh * GK_ + jj]; \
        vv[it] = bf2f(pr[2 * GKD - hh * GK_ + hh * GV_ + 32 * hv]); } } while (0)
#define GL_PUT(buf) do { _Pragma("unroll") for (int it = 0; it < 8; ++it) { LAS float* q = st + (buf) * SB + (2 * it + kh) * 128 + jj; q[0] = vec[3 * it]; q[32] = vec[3 * it + 1]; q[64] = fexp(vec[3 * it + 2]); q[96] = vv[it]; } } while (0)
#define WAVE_SYNC() do { __builtin_amdgcn_fence(__ATOMIC_RELEASE, "wavefront"); __builtin_amdgcn_wave_barrier(); __builtin_amdgcn_fence(__ATOMIC_ACQUIRE, "wavefront"); } while (0)
    GL_LOAD(0); GL_PUT(0); WAVE_SYNC();
    constexpr int NCH = SPOS / RT;
    for (int ch = 0; ch < NCH; ++ch) {
        const int buf = ch & 1;
        if (ch + 1 < NCH) GL_LOAD(ch + 1);
        { typedef float F2 __attribute__((ext_vector_type(2))); F4 cq[2], ck[2], ca[2]; F2 cv;
#define GL_LDV(t_, Q, K, A, V) do { const LAS float* sv = st + buf * SB + (t_) * 128 + 8 * kg; _Pragma("unroll") for (int k4 = 0; k4 < 2; ++k4) { Q[k4] = *(const LAS F4*)(sv + 4 * k4); K[k4] = *(const LAS F4*)(sv + 32 + 4 * k4); A[k4] = *(const LAS F4*)(sv + 64 + 4 * k4); } \
            V = *(const LAS F2*)(st + buf * SB + (t_) * 128 + 96 + 2 * vp); } while (0)
          GL_LDV(0, cq, ck, ca, cv);
#pragma unroll
          for (int t = 0; t < RT; ++t) {
            F4 nq[2], nk[2], na[2]; F2 nv = cv;
#pragma unroll
            for (int k4 = 0; k4 < 2; ++k4) { nq[k4] = cq[k4]; nk[k4] = ck[k4]; na[k4] = ca[k4]; }
            if (t + 1 < RT) GL_LDV(t + 1, nq, nk, na, nv);
            float o0 = 0.f, o1 = 0.f;
#pragma unroll
            for (int k4 = 0; k4 < 2; ++k4)
#pragma unroll
                for (int q = 0; q < 4; ++q) { S[0][4 * k4 + q] = S[0][4 * k4 + q] * ca[k4][q] + ck[k4][q] * cv[0]; o0 += cq[k4][q] * S[0][4 * k4 + q]; S[1][4 * k4 + q] = S[1][4 * k4 + q] * ca[k4][q] + ck[k4][q] * cv[1]; o1 += cq[k4][q] * S[1][4 * k4 + q]; }
            o0 = dpp_sum4(o0); o1 = dpp_sum4(o1);
            const int n = __builtin_amdgcn_readfirstlane(row_of(b, seqpos(d, ch * RT + t)));
            if (kg == 0) { F2 oo; oo[0] = o0; oo[1] = o1; *(F2*)(og + (size_t)n * GWD + hh * GV_ + 32 * hv + 2 * vp) = oo; }
#pragma unroll
            for (int k4 = 0; k4 < 2; ++k4) { cq[k4] = nq[k4]; ck[k4] = nk[k4]; ca[k4] = na[k4]; }
            cv = nv;
          }
#undef GL_LDV
        }
        if (ch + 1 < NCH) GL_PUT(buf ^ 1);
        WAVE_SYNC();
    }
#undef GL_LOAD
#undef GL_PUT
}
#define BSYNC() do { asm volatile("s_waitcnt lgkmcnt(0)" ::: "memory"); __builtin_amdgcn_s_barrier(); asm volatile("" ::: "memory"); } while (0)
template <int M, int N, int K, int NW, class F>
__device__ __forceinline__ void bmm(const LAS bf16_t* A, int lda, const LAS bf16_t* Bt, int ldb, int w, int lane, F f) {
    const int r = lane & 15, q = lane >> 4;
#pragma unroll 1
    for (int t = w; t < (M / 16) * (N / 16); t += NW) { const int tm = t / (N / 16), tn = t % (N / 16); F4 acc = (F4){0.f, 0.f, 0.f, 0.f};
#pragma unroll
        for (int kk = 0; kk < K / 32; ++kk) { const bf16x8 a = *(const LAS bf16x8*)(A + (tm * 16 + r) * lda + kk * 32 + 8 * q), bb = *(const LAS bf16x8*)(Bt + (tn * 16 + r) * ldb + kk * 32 + 8 * q);
            acc = __builtin_amdgcn_mfma_f32_16x16x32_bf16(a, bb, acc, 0, 0, 0); }
        f(tm * 16 + 4 * q, tn * 16 + r, acc); }
}
template <int M, int N, int K1, int K2, int NW, class F>
__device__ __forceinline__ void bmm2(const LAS bf16_t* A1, int lda1, const LAS bf16_t* Bt1, int ldb1, const LAS bf16_t* A2, int lda2, const LAS bf16_t* Bt2, int ldb2, int w, int lane, F f) {
    const int r = lane & 15, q = lane >> 4;
#pragma unroll 1
    for (int t = w; t < (M / 16) * (N / 16); t += NW) { const int tm = t / (N / 16), tn = t % (N / 16); F4 acc = (F4){0.f, 0.f, 0.f, 0.f};
#pragma unroll
        for (int kk = 0; kk < K1 / 32; ++kk) { const bf16x8 a = *(const LAS bf16x8*)(A1 + (tm * 16 + r) * lda1 + kk * 32 + 8 * q), bb = *(const LAS bf16x8*)(Bt1 + (tn * 16 + r) * ldb1 + kk * 32 + 8 * q);
            acc = __builtin_amdgcn_mfma_f32_16x16x32_bf16(a, bb, acc, 0, 0, 0); }
#pragma unroll
        for (int kk = 0; kk < K2 / 32; ++kk) { const bf16x8 a = *(const LAS bf16x8*)(A2 + (tm * 16 + r) * lda2 + kk * 32 + 8 * q), bb = *(const LAS bf16x8*)(Bt2 + (tn * 16 + r) * ldb2 + kk * 32 + 8 * q);
            acc = __builtin_amdgcn_mfma_f32_16x16x32_bf16(a, bb, acc, 0, 0, 0); }
        f(tm * 16 + 4 * q, tn * 16 + r, acc); }
}
template <int M, int N, int K1, int K2, int K3, int NW, class F>
__device__ __forceinline__ void bmm3(const LAS bf16_t* A1, int lda1, const LAS bf16_t* Bt1, int ldb1, const LAS bf16_t* A2, int lda2, const LAS bf16_t* Bt2, int ldb2,
                                     const LAS bf16_t* A3, int lda3, const LAS bf16_t* Bt3, int ldb3, int w, int lane, F f) {
    const int r = lane & 15, q = lane >> 4;
#pragma unroll 1
    for (int t = w; t < (M / 16) * (N / 16); t += NW) { const int tm = t / (N / 16), tn = t % (N / 16); F4 acc = (F4){0.f, 0.f, 0.f, 0.f};
#pragma unroll
        for (int kk = 0; kk < K1 / 32; ++kk) acc = __builtin_amdgcn_mfma_f32_16x16x32_bf16(*(const LAS bf16x8*)(A1 + (tm * 16 + r) * lda1 + kk * 32 + 8 * q), *(const LAS bf16x8*)(Bt1 + (tn * 16 + r) * ldb1 + kk * 32 + 8 * q), acc, 0, 0, 0);
#pragma unroll
        for (int kk = 0; kk < K2 / 32; ++kk) acc = __builtin_amdgcn_mfma_f32_16x16x32_bf16(*(const LAS bf16x8*)(A2 + (tm * 16 + r) * lda2 + kk * 32 + 8 * q), *(const LAS bf16x8*)(Bt2 + (tn * 16 + r) * ldb2 + kk * 32 + 8 * q), acc, 0, 0, 0);
#pragma unroll
        for (int kk = 0; kk < K3 / 32; ++kk) acc = __builtin_amdgcn_mfma_f32_16x16x32_bf16(*(const LAS bf16x8*)(A3 + (tm * 16 + r) * lda3 + kk * 32 + 8 * q), *(const LAS bf16x8*)(Bt3 + (tn * 16 + r) * ldb3 + kk * 32 + 8 * q), acc, 0, 0, 0);
        f(tm * 16 + 4 * q, tn * 16 + r, acc); }
}
typedef unsigned u32x2_t __attribute__((ext_vector_type(2)));
typedef unsigned u32x4_t __attribute__((ext_vector_type(4)));
__device__ __forceinline__ unsigned gload_u16(const bf16_t* p) { unsigned x; asm volatile("global_load_ushort %0, %1, off" : "=v"(x) : "v"(p) : "memory"); return x; }
template <int OFF> __device__ __forceinline__ unsigned gload_u16s(const void* sbase, unsigned voff) { unsigned x; asm volatile("global_load_ushort %0, %1, %2 offset:%3" : "=v"(x) : "v"(voff), "s"(sbase), "n"(OFF) : "memory"); return x; }
__device__ __forceinline__ float gload_f32s(const void* sbase, unsigned voff) { float x; asm volatile("global_load_dword %0, %1, %2" : "=v"(x) : "v"(voff), "s"(sbase) : "memory"); return x; }
__device__ __forceinline__ float gload_f32(const float* p) { float x; asm volatile("global_load_dword %0, %1, off" : "=v"(x) : "v"(p) : "memory"); return x; }
__device__ __forceinline__ void rwkv_chunk_blk(const P& p, int l, int d, int b, int hh, LAS unsigned char* lds, int wid, int lane) {
    static_assert(RN_ == 64 && RT == 16, "rwkv chunk geometry");
#define ZF ((LAS float*)lds)
#define ZT ((LAS bf16_t*)(lds + 16384))
#define RHS ((LAS float*)(lds + 34816))
#define LW ((LAS float*)(lds + 38912))
#define UT ((LAS bf16_t*)(lds + 43008))
#define SETB(s) (lds + 48128 + (s) * 29952)
#define AT(s) ((LAS bf16_t*)SETB(s))
#define RTm(s) (AT(s) + 16 * 72)
#define BH(s) (AT(s) + 32 * 72)
#define KH(s) (AT(s) + 48 * 72)
#define BHT(s) ((LAS bf16_t*)(SETB(s) + 9216))
#define KHT(s) (BHT(s) + 64 * 40)
#define VT(s) (BHT(s) + 128 * 40)
#define MAK(s) ((LAS bf16_t*)(SETB(s) + 24576))
#define MRB(s) (MAK(s) + 16 * 40)
#define MRK(s) (MAK(s) + 32 * 40)
#define MABF(s) ((LAS float*)(SETB(s) + 28416))
#define PL(s) ((LAS float*)(SETB(s) + 29440))
#define NR(s) ((LAS int*)(SETB(s) + 29696))
    const int tid = wid * 64 + lane, cj = hh * RN_ + lane;
    const float kkc = p.rwkv_k_k[(size_t)l * RW + cj], kac = p.rwkv_k_a[(size_t)l * RW + cj];
    const bf16_t* rkv = WSP(bf16_t, rkv); const float* gs = WSP(float, gs); const bf16_t* gsb = WSP(bf16_t, gsb); float* yr = WSP(float, yr) + (size_t)d * NTOK * RW;
    F4 za = (F4){0.f, 0.f, 0.f, 0.f}, zb = za;
    for (int i = tid; i < 2 * 64 * 72; i += 512) ZT[i] = 0;
    for (int i = tid; i < 64 * 40; i += 512) UT[i] = 0;
    for (int i = tid; i < 2 * 29952 / 2; i += 512) AT(0)[i] = 0;
    const int ntk = wid == 0 ? 0 : ((wid == 4 || wid == 5) ? 3 : 2);
#define TKI(tt) ((tt) < 2 ? 2 * wid + (tt) : wid - 4)
    unsigned rawu[3][4]; float rawf[3]; int rn[3];
    const unsigned vo2 = (unsigned)cj * 2u, vo4 = (unsigned)cj * 4u;
#define RC_LOAD(chunk) do { _Pragma("unroll") for (int tt = 0; tt < 3; ++tt) { const int n = __builtin_amdgcn_readfirstlane(row_of(b, seqpos(d, (chunk) * RT + (tt < ntk ? TKI(tt) : 0)))); rn[tt] = n;        \
        const bf16_t* rk = rkv + (size_t)n * 3 * RW; const float* gp = gs + (size_t)n * NGF + d * RW; const bf16_t* gb = gsb + (size_t)n * NGB + d * RW; \
        rawu[tt][0] = gload_u16s<0>(rk, vo2); rawu[tt][1] = gload_u16s<2 * RW>(rk, vo2); rawu[tt][2] = gload_u16s<4 * RW>(rk, vo2); rawf[tt] = gload_f32s(gp, vo4); rawu[tt][3] = gload_u16s<0>(gb, vo2); } } while (0)
    float vr[3], vk2[3], va[3], vb[3], vv[3], vlw[3];
#define RC_RETIRE() do { asm volatile("s_waitcnt vmcnt(0)" ::: "memory"); _Pragma("unroll") for (int tt = 0; tt < 3; ++tt) { asm volatile("" : "+v"(rawu[tt][0]), "+v"(rawu[tt][1]), "+v"(rawu[tt][2]), "+v"(rawu[tt][3]), "+v"(rawf[tt])); } } while (0)
#define RC_P0(s) do { \
        _Pragma("unroll") for (int tt = 0; tt < 3; ++tt) if (tt < ntk) { const float k = bf2f((bf16_t)rawu[tt][1]), a = bf2f((bf16_t)rawu[tt][3]), kkraw = k * kkc; const float kk = kkraw * __builtin_amdgcn_rsqf(WSUM(kkraw * kkraw) + 1e-12f); \
            vr[tt] = bf2f((bf16_t)rawu[tt][0]); vk2[tt] = k * (1.0f + (a - 1.0f) * kac); va[tt] = -kk; vb[tt] = kk * a; vv[tt] = bf2f((bf16_t)rawu[tt][2]); vlw[tt] = rawf[tt]; \
            LW[TKI(tt) * 64 + lane] = vlw[tt]; if (lane == 0) NR(s)[TKI(tt)] = rn[tt]; } } while (0)
#define RC_TOK(s, t_, lp_, tt) do { const int t = (t_); const float lp = (lp_); const float em = fexp(lp - vlw[tt]), ep = fexp(lp), en = fexp(-lp); \
            AT(s)[t * 72 + lane] = f2bf(va[tt] * em); RTm(s)[t * 72 + lane] = f2bf(vr[tt] * ep); const bf16_t bh = f2bf(vb[tt] * en), kh = f2bf(vk2[tt] * en); \
            BH(s)[t * 72 + lane] = bh; KH(s)[t * 72 + lane] = kh; BHT(s)[lane * 40 + t] = bh; KHT(s)[lane * 40 + t] = kh; VT(s)[lane * 40 + t] = f2bf(vv[tt]); \
            if (t == RT - 1) PL(s)[lane] = ep; } while (0)
#define RC_P0B(s) do { if (ntk) { float lpb = 0.f, lpc = 0.f; const float l0 = LW[lane]; \
            _Pragma("unroll") for (int q = 0; q < RT - 2; q += 2) { const float x0 = LW[q * 64 + lane], x1 = LW[(q + 1) * 64 + lane]; const bool on = q < 2 * wid; lpb += on ? x0 : 0.f; lpc += on ? x1 : 0.f; } \
            lpb += lpc; lpb += vlw[0]; RC_TOK(s, 2 * wid, lpb, 0); lpb += vlw[1]; RC_TOK(s, 2 * wid + 1, lpb, 1); \
            if (ntk == 3) { const float lp3 = (wid == 5 ? l0 : 0.f) + vlw[2]; RC_TOK(s, wid - 4, lp3, 2); } } } while (0)
#define RC_P1(s, w4) do { const LAS bf16_t* Aop = ((w4) < 2) ? AT(s) : RTm(s); const LAS bf16_t* Bop = ((w4) & 1) ? KH(s) : BH(s); \
            bmm<16, 16, 64, 1>(Aop, 72, Bop, 72, 0, lane, [&](int r0, int cc, const F4& acc) { \
                _Pragma("unroll") for (int j = 0; j < 4; ++j) { const int rr = r0 + j; const bool keep = ((w4) < 2) ? (cc < rr) : (cc <= rr); const float val = keep ? acc[j] : 0.f; \
                    if ((w4) == 0) MABF(s)[cc * 16 + rr] = val; else if ((w4) == 1) MAK(s)[rr * 40 + cc] = f2bf(val); else if ((w4) == 2) MRB(s)[rr * 40 + cc] = f2bf(val); else MRK(s)[rr * 40 + cc] = f2bf(val); } }); } while (0)
    constexpr int NCH = SPOS / RT;
    RC_LOAD(0);
    __syncthreads();
    RC_RETIRE(); RC_P0(0); BSYNC(); RC_LOAD(1); RC_P0B(0); BSYNC(); if (wid < 4) RC_P1(0, wid); BSYNC();
    F4 yacc = (F4){0.f, 0.f, 0.f, 0.f}; int yrow[4] = {0, 0, 0, 0}; int ycol = 0;
#define RC_YST() do { _Pragma("unroll") for (int j = 0; j < 4; ++j) yr[(size_t)yrow[j] * RW + ycol] = yacc[j]; } while (0)
    for (int ch = 0; ch < NCH; ++ch) {
        int lnv = lane; asm volatile("" : "+v"(lnv)); const int lane = lnv;
        const int cs = ch & 1, ns = cs ^ 1; LAS bf16_t* ZTc = ZT + cs * 64 * 72; LAS bf16_t* ZTn = ZT + ns * 64 * 72; const bool more = ch + 1 < NCH;
        if (wid < 4) bmm3<16, 64, 64, 32, 0, 4>(AT(cs), 72, ZTc, 72, MAK(cs), 40, VT(cs), 40, AT(cs), 72, ZTc, 72, wid, lane, [&](int r0, int cc, const F4& acc) {
#pragma unroll
            for (int j = 0; j < 4; ++j) RHS[(r0 + j) * 64 + cc] = acc[j]; });
        RC_RETIRE();
        if (wid < 4 && ch > 0) RC_YST();
        if (more) RC_P0(ns);
        typedef float F2 __attribute__((ext_vector_type(2)));
        constexpr int MPRE = 6;
        F2 mm[RT - 1][RT / 2];
        if (wid == 0) { unsigned mtb = (unsigned)(size_t)MABF(cs); asm volatile("" : "+v"(mtb)); const LAS float* MT = (const LAS float*)(size_t)mtb;
#pragma unroll
            for (int s = 0; s < MPRE; ++s) {
#pragma unroll
                for (int i = (s + 1) >> 1; i < RT / 2; ++i) mm[s][i] = *(const LAS F2*)(MT + s * 16 + 2 * i); } }
        BSYNC();
        RC_LOAD(ch + 2 < NCH ? ch + 2 : NCH - 1);
        if (wid == 0) {
            __builtin_amdgcn_s_setprio(2);
            F2 acc2[RT / 2];
#pragma unroll
            for (int i = 0; i < RT / 2; ++i) { acc2[i][0] = RHS[(2 * i) * 64 + lane]; acc2[i][1] = RHS[(2 * i + 1) * 64 + lane]; }
#pragma unroll
            for (int s = 0; s < RT - 1; ++s) { const float u = acc2[s >> 1][s & 1]; const F2 uu = (F2){u, u};
                if (s == 2) { asm volatile("" ::: "memory"); unsigned mtb = (unsigned)(size_t)MABF(cs); asm volatile("" : "+v"(mtb)); const LAS float* MT = (const LAS float*)(size_t)mtb;
#pragma unroll
                    for (int s2 = MPRE; s2 < RT - 1; ++s2) {
#pragma unroll
                        for (int i = (s2 + 1) >> 1; i < RT / 2; ++i) mm[s2][i] = *(const LAS F2*)(MT + s2 * 16 + 2 * i); } }
#pragma unroll
                for (int i = (s + 1) >> 1; i < RT / 2; ++i) acc2[i] = __builtin_elementwise_fma(mm[s][i], uu, acc2[i]); }
#pragma unroll
            for (int i = 0; i < RT / 2; ++i) { UT[lane * 40 + 2 * i] = f2bf(acc2[i][0]); UT[lane * 40 + 2 * i + 1] = f2bf(acc2[i][1]); }
            __builtin_amdgcn_s_setprio(0); }
        if (more) RC_P0B(ns);
        BSYNC();
        if (wid < 4) bmm3<16, 64, 64, 32, 32, 4>(RTm(cs), 72, ZTc, 72, MRB(cs), 40, UT, 40, MRK(cs), 40, VT(cs), 40, wid, lane, [&](int r0, int cc, const F4& acc) {
#pragma unroll
            for (int j = 0; j < 4; ++j) yrow[j] = NR(cs)[r0 + j];
            yacc = acc; ycol = hh * RN_ + cc; });
        else if (more) RC_P1(ns, wid - 4);
        {
            const int r = lane & 15, q = lane >> 4, tn = wid & 3, cc = tn * 16 + r;
            typedef __bf16 bf2_t __attribute__((ext_vector_type(2))); typedef float F2s __attribute__((ext_vector_type(2)));
#pragma unroll
            for (int h = 0; h < 2; ++h) { const int tm = (wid >> 2) + 2 * h, r0 = tm * 16 + 4 * q; F4 acc = (F4){0.f, 0.f, 0.f, 0.f};
                acc = __builtin_amdgcn_mfma_f32_16x16x32_bf16(*(const LAS bf16x8*)(BHT(cs) + (tm * 16 + r) * 40 + 8 * q), *(const LAS bf16x8*)(UT + cc * 40 + 8 * q), acc, 0, 0, 0);
                acc = __builtin_amdgcn_mfma_f32_16x16x32_bf16(*(const LAS bf16x8*)(KHT(cs) + (tm * 16 + r) * 40 + 8 * q), *(const LAS bf16x8*)(VT(cs) + cc * 40 + 8 * q), acc, 0, 0, 0);
                const F4 pl = *(const LAS F4*)(PL(cs) + r0);
                const F4 zn = pl * ((h ? zb : za) + acc); if (h) zb = zn; else za = zn;
                const bf2_t p01 = __builtin_convertvector((F2s){zn[0], zn[1]}, bf2_t), p23 = __builtin_convertvector((F2s){zn[2], zn[3]}, bf2_t);
                u32x2_t w2; w2[0] = __builtin_bit_cast(unsigned, p01); w2[1] = __builtin_bit_cast(unsigned, p23);
                *(LAS u32x2_t*)(ZTn + cc * 72 + r0) = w2; } }
        BSYNC();
    }
    RC_RETIRE();
    if (wid < 4) RC_YST();
    __syncthreads();
#undef RC_YST
#undef RC_RETIRE
#undef RC_LOAD
#undef RC_P0
#undef RC_P0B
#undef RC_TOK
#undef TKI
#undef RC_P1
#undef ZF
#undef ZT
#undef RHS
#undef LW
#undef UT
#undef SETB
#undef AT
#undef RTm
#undef BH
#undef KH
#undef BHT
#undef KHT
#undef VT
#undef MAK
#undef MRB
#undef MRK
#undef MABF
#undef PL
#undef NR
}
__device__ __forceinline__ u32x2_t gload_x2(const void* p) { u32x2_t x; asm volatile("global_load_dwordx2 %0, %1, off" : "=v"(x) : "v"(p) : "memory"); return x; }
__device__ __forceinline__ u32x4_t gload_x4(const void* p) { u32x4_t x; asm volatile("global_load_dwordx4 %0, %1, off" : "=v"(x) : "v"(p) : "memory"); return x; }
template <int K1, int K2>
__device__ __forceinline__ F4 bmm2_tile(const LAS bf16_t* A1, int lda1, const LAS bf16_t* Bt1, int ldb1, const LAS bf16_t* A2, int lda2, const LAS bf16_t* Bt2, int ldb2, int tm, int tn, int lane) {
    const int r = lane & 15, q = lane >> 4; F4 acc = (F4){0.f, 0.f, 0.f, 0.f};
#pragma unroll
    for (int kk = 0; kk < K1 / 32; ++kk) acc = __builtin_amdgcn_mfma_f32_16x16x32_bf16(*(const LAS bf16x8*)(A1 + (tm * 16 + r) * lda1 + kk * 32 + 8 * q), *(const LAS bf16x8*)(Bt1 + (tn * 16 + r) * ldb1 + kk * 32 + 8 * q), acc, 0, 0, 0);
#pragma unroll
    for (int kk = 0; kk < K2 / 32; ++kk) acc = __builtin_amdgcn_mfma_f32_16x16x32_bf16(*(const LAS bf16x8*)(A2 + (tm * 16 + r) * lda2 + kk * 32 + 8 * q), *(const LAS bf16x8*)(Bt2 + (tn * 16 + r) * ldb2 + kk * 32 + 8 * q), acc, 0, 0, 0);
    return acc;
}
__device__ __forceinline__ void gla_chunk_blk(const P& p, int l, int d, int b, int hh, LAS unsigned char* lds, int wid, int lane) {
    static_assert(GK_ == 32 && GV_ == 64 && CH_ == 64, "gla chunk geometry");
    const int tid = wid * 64 + lane;
    LAS float* LA = (LAS float*)lds;
    LAS float* QR = (LAS float*)(lds + 8192);
    LAS float* KR = (LAS float*)(lds + 16384);
    LAS float* SF = (LAS float*)(lds + 24576);
    LAS bf16_t* QIN = (LAS bf16_t*)(lds + 32768);
    LAS bf16_t* KIN = (LAS bf16_t*)(lds + 32768 + 5120);
    LAS bf16_t* STT = (LAS bf16_t*)(lds + 32768 + 10240);
    LAS bf16_t* KSTT = (LAS bf16_t*)(lds + 32768 + 15360);
    LAS bf16_t* VT = (LAS bf16_t*)(lds + 32768 + 19968);
    LAS bf16_t* ATT = (LAS bf16_t*)(lds + 32768 + 29184);
    LAS int* NR = (LAS int*)(lds + 32768 + 38400);
    const bf16_t* proj = WSP(bf16_t, proj); const float* gs = WSP(float, gs); float* og = WSP(float, og) + (size_t)d * NTOK * GWD;
    for (int i = tid; i < 32 * 64; i += 512) SF[i] = 0.f;
    for (int i = tid; i < 64 * 40; i += 512) STT[i] = 0;
    const int t = tid >> 3, k4 = (tid & 7) * 4, v8 = (tid & 7) * 8;
    u32x2_t rq, rk; u32x4_t rv, rla; int rn_;
#define GC_LOAD(c_) do { rn_ = row_of(b, seqpos(d, (c_) * 64 + t)); const bf16_t* pr = proj + (size_t)rn_ * NINP + GBASE; \
        rq = gload_x2(pr + hh * GK_ + k4); rk = gload_x2(pr + GKD + hh * GK_ + k4); rv = gload_x4(pr + 2 * GKD + hh * GV_ + v8); rla = gload_x4(gs + (size_t)rn_ * NGF + 2 * RW + d * GKD + hh * GK_ + k4); } while (0)
#define GC_WAIT() do { asm volatile("s_waitcnt vmcnt(0)" ::: "memory"); asm volatile("" : "+v"(rq), "+v"(rk), "+v"(rv), "+v"(rla)); } while (0)
#define GC_PUT() do { _Pragma("unroll") for (int j = 0; j < 4; ++j) { const unsigned wq = rq[j >> 1], wk = rk[j >> 1]; const float qf = __builtin_bit_cast(float, (j & 1) ? (wq & 0xFFFF0000u) : (wq << 16)), kf = __builtin_bit_cast(float, (j & 1) ? (wk & 0xFFFF0000u) : (wk << 16)); \
            QR[t * 32 + k4 + j] = qf * 0.17677669529663687f; KR[t * 32 + k4 + j] = kf; } \
        *(LAS u32x4_t*)(LA + t * 32 + k4) = rla; \
        _Pragma("unroll") for (int j = 0; j < 8; ++j) { const unsigned wv_ = rv[j >> 1]; VT[(v8 + j) * 72 + t] = (bf16_t)((j & 1) ? (wv_ >> 16) : (wv_ & 0xFFFFu)); } if ((tid & 7) == 0) NR[t] = rn_; } while (0)
    F4 o0 = (F4){0.f, 0.f, 0.f, 0.f}, o1 = o0; int orow0[4] = {0, 0, 0, 0}, orow1[4] = {0, 0, 0, 0};
    const int ocol = hh * GV_ + (wid & 3) * 16 + (lane & 15);
#define GC_OST() do { _Pragma("unroll") for (int j = 0; j < 4; ++j) { og[(size_t)orow0[j] * GWD + ocol] = o0[j]; og[(size_t)orow1[j] * GWD + ocol] = o1[j]; } } while (0)
    GC_LOAD(0);
    __syncthreads();
#pragma unroll 1
    for (int c = 0; c < NPC; ++c) {
        GC_WAIT();
        if (c > 0) GC_OST();
        GC_PUT();
        BSYNC();
        GC_LOAD(c + 1 < NPC ? c + 1 : NPC - 1);
        if (wid == 0) { const int kc = lane & 31, t0 = (lane >> 5) * 32; float cs[32];
#pragma unroll
            for (int tt = 0; tt < 32; ++tt) cs[tt] = LA[(t0 + tt) * 32 + kc];
#pragma unroll
            for (int tt = 1; tt < 32; ++tt) cs[tt] += cs[tt - 1];
            const float up = __builtin_bit_cast(float, __builtin_amdgcn_ds_bpermute(((lane + 32) & 63) * 4, __builtin_bit_cast(int, cs[31]))); const float add = lane >= 32 ? up : 0.f;
#pragma unroll
            for (int tt = 0; tt < 32; ++tt) LA[(t0 + tt) * 32 + kc] = cs[tt] + add; }
        BSYNC();
#pragma unroll
        for (int j = 0; j < 4; ++j) { const float bb = LA[t * 32 + k4 + j], bl = LA[63 * 32 + k4 + j], qv = QR[t * 32 + k4 + j], kv = KR[t * 32 + k4 + j];
            QIN[t * 40 + k4 + j] = f2bf(qv * fexp(bb)); KIN[t * 40 + k4 + j] = f2bf(kv * fexp(-bb)); KSTT[(k4 + j) * 72 + t] = f2bf(kv * fexp(bl - bb)); }
        BSYNC();
        bmm<64, 64, 32, 8>(QIN, 40, KIN, 40, wid, lane, [&](int r0, int cc, const F4& acc) {
#pragma unroll
            for (int j = 0; j < 4; ++j) ATT[(r0 + j) * 72 + cc] = f2bf(cc <= r0 + j ? acc[j] : 0.f); });
        BSYNC();
        { const int tm0 = wid >> 2, tn = wid & 3, q4 = 4 * (lane >> 4);
          o0 = bmm2_tile<64, 32>(ATT, 72, VT, 72, QIN, 40, STT, 40, tm0, tn, lane); o1 = bmm2_tile<64, 32>(ATT, 72, VT, 72, QIN, 40, STT, 40, tm0 + 2, tn, lane);
#pragma unroll
          for (int j = 0; j < 4; ++j) { orow0[j] = NR[tm0 * 16 + q4 + j]; orow1[j] = NR[(tm0 + 2) * 16 + q4 + j]; } }
        BSYNC();
        bmm<32, 64, 64, 8>(KSTT, 72, VT, 72, wid, lane, [&](int r0, int cc, const F4& acc) {
#pragma unroll
            for (int j = 0; j < 4; ++j) { const float sn = fexp(LA[63 * 32 + r0 + j]) * SF[(r0 + j) * 64 + cc] + acc[j]; SF[(r0 + j) * 64 + cc] = sn; STT[cc * 40 + r0 + j] = f2bf(sn); } });
        BSYNC();
    }
    GC_WAIT();
    GC_OST();
#undef GC_PUT
#undef GC_LOAD
#undef GC_WAIT
#undef GC_OST
}
#endif

#ifndef CPU_TEST
__device__ __forceinline__ void cvt_job(LAS unsigned char* lds, int tid, const float* src, bf16_t* dst, int nb, size_t sbs, size_t dbs, int K, int Nsrc, int Ndst, int nvalid, int perm) {
    LAS unsigned short* tl = (LAS unsigned short*)lds;
    const int tK = K / 64, tN = Ndst / 64, per = tK * tN; const long total = (long)nb * per;
    for (long t = blockIdx.x; t < total; t += gridDim.x) {
        const int e = (int)(t / per), r = (int)(t % per), tn = r / tK, tk = r % tK, n0 = tn * 64, k0 = tk * 64;
        int sc0 = n0; if (perm) { const int j = n0 / 256, w = n0 % 256; sc0 = w < 128 ? 128 * j + w : FF_ + 128 * j + (w - 128); }
        const int nv = nvalid - n0;
        const float* s = src + (size_t)e * sbs + (size_t)(k0 + (tid >> 3)) * Nsrc + sc0 + (tid & 7) * 8; const int c8 = (tid & 7) * 8, kk = tid >> 3;
        float v[8];
        if (c8 + 8 <= nv) { const F4 a = *(const F4*)s, b = *(const F4*)(s + 4); v[0] = a[0]; v[1] = a[1]; v[2] = a[2]; v[3] = a[3]; v[4] = b[0]; v[5] = b[1]; v[6] = b[2]; v[7] = b[3]; }
        else {
#pragma unroll
            for (int j = 0; j < 8; ++j) v[j] = (c8 + j < nv) ? s[j] : 0.f; }
#pragma unroll
        for (int j = 0; j < 8; ++j) tl[(c8 + j) * 72 + kk] = f2bf(v[j]);
        __syncthreads();
        { const int n = tid >> 3, ks = (tid & 7) * 8; typedef unsigned u32x4_t __attribute__((ext_vector_type(4))); const u32x4_t w = *(const LAS u32x4_t*)(tl + n * 72 + ks); *(u32x4_t*)(dst + (size_t)e * dbs + (size_t)(n0 + n) * K + k0 + ks) = w; }
        __syncthreads();
    }
}
__device__ __forceinline__ void st_cvt_tiles(const P& p, int l, LAS unsigned char* lds, int tid) {
    cvt_job(lds, tid, p.w_in + (size_t)l * D_ * NIN, WSP(bf16_t, w_inT) + (size_t)l * NINP * D_, 1, 0, 0, D_, NIN, NINP, NIN, 0);
    cvt_job(lds, tid, p.w_out + (size_t)l * MIXW * D_, WSP(bf16_t, w_outT) + (size_t)l * D_ * MIXW, 1, 0, 0, MIXW, D_, D_, D_, 0);
    cvt_job(lds, tid, p.sh_w2 + (size_t)l * FF_ * D_, WSP(bf16_t, shw2T) + (size_t)l * D_ * FF_, 1, 0, 0, FF_, D_, D_, D_, 0);
    cvt_job(lds, tid, p.s5_glu_w + (size_t)l * SW * SW, WSP(bf16_t, gluT) + (size_t)l * SWP * SW, 1, 0, 0, SW, SW, SWP, SW, 0);
    cvt_job(lds, tid, p.router_w + (size_t)l * D_ * E_, WSP(bf16_t, rsT) + (size_t)l * NRS * D_, 1, 0, 0, D_, E_, EP, E_, 0);
    cvt_job(lds, tid, p.sh_w13 + (size_t)l * D_ * 2 * FF_, WSP(bf16_t, rsT) + (size_t)l * NRS * D_ + (size_t)EP * D_, 1, 0, 0, D_, 2 * FF_, 2 * FF_, 2 * FF_, 1);
    cvt_job(lds, tid, p.exp_w13 + (size_t)l * E_ * D_ * 2 * FF_, WSP(bf16_t, w13T) + (size_t)l * E_ * 2 * FF_ * D_, E_, (size_t)D_ * 2 * FF_, (size_t)2 * FF_ * D_, D_, 2 * FF_, 2 * FF_, 2 * FF_, 1);
    cvt_job(lds, tid, p.exp_w2 + (size_t)l * E_ * FF_ * D_, WSP(bf16_t, w2T) + (size_t)l * E_ * D_ * FF_, E_, (size_t)FF_ * D_, (size_t)D_ * FF_, FF_, D_, D_, D_, 0);
}
#endif

#ifndef CPU_TEST
__device__ __forceinline__ void st_prep1_blk(const P& p, int l, int wid, int lane, int wv, int nwv) {
    const bf16_t* proj = WSP(bf16_t, proj); bf16_t* rkv = WSP(bf16_t, rkv); bf16_t* as = WSP(bf16_t, asmall); bf16_t* U2 = WSP(bf16_t, U2);
    const float* taps = p.rwkv_conv + (size_t)l * 9 * RCOLS; constexpr int NG = RCOLS / 8, TPB = 512 / NG;
    const int tid = wid * 64 + lane;
    if (tid < TPB * NG) {
        const int cg = tid % NG, ts = tid / NG, ch = cg * 8; const int step = (int)gridDim.x * TPB;
        float w[9][8];
#pragma unroll
        for (int k = 0; k < 9; ++k) ld8f(taps + k * RCOLS + ch, w[k]);
#define P1_OUT(n_, acc) do { if (ch < 3 * RW) st8bf(rkv + (size_t)(n_) * 3 * RW + ch, acc); else { const int q0 = ch - 3 * RW; \
            if (q0 < 2 * RDR_) { _Pragma("unroll") for (int q = 0; q < 8; ++q) acc[q] = ftanh(acc[q]); } \
            else if (q0 >= 2 * RDR_ + 2 * RIR_) { _Pragma("unroll") for (int q = 0; q < 8; ++q) acc[q] = sigmoidf_(acc[q]); } \
            st8bf(as + (size_t)(n_) * KSM + q0, acc); } } while (0)
#define P1_FMA(acc, xv, k) do { _Pragma("unroll") for (int j_ = 0; j_ < 4; ++j_) { acc[2 * j_] += w[k][2 * j_] * __uint_as_float((xv)[j_] << 16); acc[2 * j_ + 1] += w[k][2 * j_ + 1] * __uint_as_float((xv)[j_] & 0xffff0000u); } } while (0)
        constexpr int NPT = 4; static_assert(GW_ % NPT == 0 && NLAT % NPT == 0, "token groups");
        for (int pi = (int)blockIdx.x * TPB + ts; pi < NLAT / NPT; pi += step) { const int n0 = NPT * pi, t_ = n0 % T_, gr = t_ / GW_, gc = t_ % GW_; const bf16_t* pb_ = proj + (size_t)n0 * NINP + ch;
            const bool rok0 = gr > 0, rok2 = gr < ROWS_ - 1, cokl = gc > 0, cokr = gc + NPT < GW_; U4 xw[3][NPT + 2];
#pragma unroll
            for (int a = 0; a < 3; ++a)
#pragma unroll
                for (int jw = 0; jw < NPT + 2; ++jw) { const bool ok = (a == 0 ? rok0 : a == 2 ? rok2 : true) && (jw == 0 ? cokl : jw == NPT + 1 ? cokr : true);
                    const int off_ = ok ? ((a - 1) * GW_ + (jw - 1)) * NINP : 0; const U4 v = *(const U4*)(pb_ + off_); xw[a][jw] = ok ? v : (U4){0u, 0u, 0u, 0u}; }
#pragma unroll
            for (int tk = 0; tk < NPT; ++tk) { float acc[8];
#pragma unroll
                for (int q = 0; q < 8; ++q) acc[q] = 0.f;
#pragma unroll
                for (int a = 0; a < 3; ++a)
#pragma unroll
                    for (int jj = 0; jj < 3; ++jj) P1_FMA(acc, xw[a][tk + jj], a * 3 + jj);
                P1_OUT(n0 + tk, acc); } }
        for (int n = NLAT + (int)blockIdx.x * TPB + ts; n < NTOK; n += step) { const int s_ = (n - NLAT) % CTX_; U4 xc[3];
#pragma unroll
            for (int j = 0; j < 3; ++j) { const int ss = s_ + j - 1; const bool ok = ss >= 0 && ss < CTX_; const int nn = ok ? n + j - 1 : n; const U4 v = *(const U4*)(proj + (size_t)nn * NINP + ch); xc[j] = ok ? v : (U4){0u, 0u, 0u, 0u}; }
            float acc[8];
#pragma unroll
            for (int q = 0; q < 8; ++q) acc[q] = 0.f;
#pragma unroll
            for (int jj = 0; jj < 3; ++jj) P1_FMA(acc, xc[jj], 3 + jj);
            P1_OUT(n, acc); }
#undef P1_FMA
#undef P1_OUT
    }
    GIDX;
    constexpr int NT8 = (KSM - OGL) / 8;
    for (long i = gid; i < (long)NTOK * NT8; i += gsz) { const int n = (int)(i / NT8), q = (int)(i % NT8) * 8;
        if (q < 2 * GGR_) cp8bf(as + (size_t)n * KSM + OGL + q, proj + (size_t)n * NINP + GBASE + 2 * GKD + 2 * GWD + q); else z8bf(as + (size_t)n * KSM + OGL + q); }
    for (long i = gid; i < (long)B_ * SPOS * (SW / 8); i += gsz) { const int c = (int)(i % (SW / 8)) * 8; const long r = i / (SW / 8); const int pos = (int)(r % SPOS), b = (int)(r / SPOS);
        const int g = c / SG_, cc = c % SG_, pc = pos / CH_, t = pos % CH_, m = b * NPC + pc;
        cp8bf(U2 + ((size_t)g * M5P + m) * KT5 + t * SG_ + cc, proj + (size_t)row_of(b, pos) * NINP + SBASE + c); }
}
#define DPP_MOVF(v, ctrl) __builtin_bit_cast(float, __builtin_amdgcn_update_dpp(0, __builtin_bit_cast(int, v), ctrl, 0xF, 0xF, true))
#define DPP_MOVI(v, ctrl) __builtin_amdgcn_update_dpp(0, v, ctrl, 0xF, 0xF, true)
__device__ __forceinline__ void st_topk_wave(const P& p, int l, int wv, int nwv, int lane, LAS unsigned char* lds) {
    LAS int* hist = (LAS int*)lds;
    { const int tid_ = (int)threadIdx.x; if (tid_ < E_) hist[tid_] = 0; }
    __syncthreads();
    static_assert(E_ == 256 && NGRP_ == 8 && TKG_ == 4 && TOPK_ == 8, "wave top-k is written for 256 experts in 8 groups");
    const int nrow = (l == L_ - 1) ? NLAT : NTOK; const float* lg = WSP(float, logits); const F4 rb = *(const F4*)(p.router_bias + (size_t)l * E_ + 4 * lane);
    for (int n = wv; n < nrow; n += nwv) {
        const F4 z = *(const F4*)(lg + (size_t)n * E_ + 4 * lane); float sg[4], sv[4];
#pragma unroll
        for (int j = 0; j < 4; ++j) { sg[j] = sigmoidf_(z[j]); sv[j] = sg[j] + rb[j]; }
        float m1 = fmaxf(fmaxf(sv[0], sv[1]), fmaxf(sv[2], sv[3])), m2;
        { float a = fmaxf(sv[0], sv[1]), b = fminf(sv[0], sv[1]), c = fmaxf(sv[2], sv[3]), d = fminf(sv[2], sv[3]); m2 = fmaxf(fminf(a, c), fmaxf(b, d)); }
        { float o1 = DPP_MOVF(m1, 0xB1), o2 = DPP_MOVF(m2, 0xB1); float n1 = fmaxf(m1, o1), n2 = fmaxf(fminf(m1, o1), fmaxf(m2, o2)); m1 = n1; m2 = n2;
          o1 = DPP_MOVF(m1, 0x4E); o2 = DPP_MOVF(m2, 0x4E); n1 = fmaxf(m1, o1); n2 = fmaxf(fminf(m1, o1), fmaxf(m2, o2)); m1 = n1; m2 = n2;
          o1 = DPP_MOVF(m1, 0x141); o2 = DPP_MOVF(m2, 0x141); n1 = fmaxf(m1, o1); n2 = fmaxf(fminf(m1, o1), fmaxf(m2, o2)); m1 = n1; m2 = n2; }
        const float gsc = m1 + m2; const int g = lane >> 3, gb = __builtin_bit_cast(int, gsc); int rank = 0;
#pragma unroll
        for (int g2 = 0; g2 < 8; ++g2) { const float o = __builtin_bit_cast(float, __builtin_amdgcn_readlane(gb, 8 * g2)); rank += (o > gsc || (o == gsc && g2 < g)) ? 1 : 0; }
        const bool sel = rank < TKG_;
        int ck[4];
#pragma unroll
        for (int j = 0; j < 4; ++j) ck[j] = (sel && sv[j] > 0.f) ? __builtin_bit_cast(int, sv[j]) : 0;
        float myw = 0.f; int mye = 0; float wsum = 0.f;
#pragma unroll
        for (int kk = 0; kk < TOPK_; ++kk) {
            int bk = ck[0] > ck[1] ? ck[0] : ck[1]; { const int b2 = ck[2] > ck[3] ? ck[2] : ck[3]; bk = bk > b2 ? bk : b2; }
            int mk = bk;
            { int o = DPP_MOVI(mk, 0xB1); mk = mk > o ? mk : o; o = DPP_MOVI(mk, 0x4E); mk = mk > o ? mk : o; o = DPP_MOVI(mk, 0x141); mk = mk > o ? mk : o; o = DPP_MOVI(mk, 0x140); mk = mk > o ? mk : o; }
            const int r0 = __builtin_amdgcn_readlane(mk, 0), r1 = __builtin_amdgcn_readlane(mk, 16), r2 = __builtin_amdgcn_readlane(mk, 32), r3 = __builtin_amdgcn_readlane(mk, 48);
            const int K = (r0 > r1 ? r0 : r1) > (r2 > r3 ? r2 : r3) ? (r0 > r1 ? r0 : r1) : (r2 > r3 ? r2 : r3);
            const unsigned long long ball = __ballot(bk == K); const int wl = __builtin_amdgcn_readfirstlane((int)__ffsll((long long)ball) - 1);
            int wj = 0; float sgw = 0.f;
            if (lane == wl) {
#pragma unroll
                for (int j = 3; j >= 0; --j) if (ck[j] == K) wj = j;
#pragma unroll
                for (int j = 0; j < 4; ++j) if (wj == j) { ck[j] = 0; sgw = sg[j]; } }
            const int wjb = __builtin_amdgcn_readlane(wj, wl); sgw = __builtin_bit_cast(float, __builtin_amdgcn_readlane(__builtin_bit_cast(int, sgw), wl)); wsum += sgw;
            if (lane == kk) { myw = sgw; mye = 4 * wl + wjb; }
        }
        if (lane < TOPK_) { WSP(int, eidx)[(size_t)n * TOPK_ + lane] = mye; WSP(float, ewt)[(size_t)n * TOPK_ + lane] = myw / wsum * 2.5f; __hip_atomic_fetch_add(hist + mye, 1, __ATOMIC_RELAXED, __HIP_MEMORY_SCOPE_WORKGROUP); }
    }
    __syncthreads();
    { const int tid_ = (int)threadIdx.x; if (tid_ < E_) { const int c = hist[tid_]; if (c > 0) atomicAdd(WSP(int, ecnt) + tid_, c); } }
    __syncthreads();
}
__device__ __forceinline__ void st_scatter_blk(const P& p, int l, LAS unsigned char* lds, int wid, int lane, int wv, int nwv) {
    LAS int* eo = (LAS int*)lds;
    if (wid == 0) {
        const int* ecnt = WSP(int, ecnt); int c4[4], t4[4], tsum = 0;
#pragma unroll
        for (int j = 0; j < 4; ++j) { c4[j] = ld_int(ecnt + 4 * lane + j); t4[j] = (c4[j] + 255) / 256; tsum += t4[j]; }
        int incl = tsum;
#pragma unroll
        for (int o = 1; o < 64; o <<= 1) { const int v = __shfl_up(incl, o); if (lane >= o) incl += v; }
        int tb = incl - tsum;
#pragma unroll
        for (int j = 0; j < 4; ++j) { eo[4 * lane + j] = tb * 256;
            if (blockIdx.x == 0) { WSP(int, eoff)[4 * lane + j] = tb * 256; for (int t = 0; t < t4[j]; ++t) { int* u = WSP(int, ulist) + (size_t)(tb + t) * 4; u[0] = (tb + t) * 256; u[1] = 4 * lane + j; u[2] = (c4[j] - 256 * t) < 256 ? (c4[j] - 256 * t) : 256; u[3] = 0; } }
            tb += t4[j]; }
        if (lane == 63) { eo[E_] = tb * 256; if (blockIdx.x == 0) { WSP(int, eoff)[E_] = tb * 256; WSP(int, nunits)[0] = tb; } }
    }
    __syncthreads();
    const long gid = (long)wv * 64 + lane, gsz = (long)nwv * 64; const int nrow = (l == L_ - 1) ? NLAT : NTOK; const int* ei = WSP(int, eidx); int* so = WSP(int, slot_of); int* st = WSP(int, slot_tok);
    LAS int* lc = eo + E_ + 1;
    constexpr int MAXI = 4; const long total = (long)nrow * TOPK_;
#pragma unroll 1
    for (long base = 0; base < total; base += (long)MAXI * gsz) {
        if ((int)threadIdx.x < E_) lc[threadIdx.x] = 0;
        __syncthreads();
        int ie[MAXI], ir[MAXI];
#pragma unroll
        for (int u = 0; u < MAXI; ++u) { const long i = base + gid + (long)u * gsz; ie[u] = -1; ir[u] = 0; if (i < total) { ie[u] = ei[i]; ir[u] = __hip_atomic_fetch_add(lc + ie[u], 1, __ATOMIC_RELAXED, __HIP_MEMORY_SCOPE_WORKGROUP); } }
        __syncthreads();
        if ((int)threadIdx.x < E_) { const int c = lc[threadIdx.x]; lc[threadIdx.x] = c > 0 ? atomicAdd(WSP(int, efill) + threadIdx.x, c) : 0; }
        __syncthreads();
#pragma unroll
        for (int u = 0; u < MAXI; ++u) { const long i = base + gid + (long)u * gsz; if (ie[u] >= 0) { const int s = eo[ie[u]] + lc[ie[u]] + ir[u]; so[i] = s; st[s] = (int)(i / TOPK_); } }
        __syncthreads();
    }
}
#endif

#ifndef CPU_TEST
__device__ __forceinline__ void st_post_wave(const P& p, int l, int wv, int nwv, int lane) {
    static_assert(RH_ == 6 && GH_ == 6 && RN_ == 64 && GV_ == 64, "post_wave geometry");
    bf16_t* ymix = WSP(bf16_t, ymix); const float* yr = WSP(float, yr); const float* og = WSP(float, og); const bf16_t* proj = WSP(bf16_t, proj); const bf16_t* gsb = WSP(bf16_t, gsb); const bf16_t* rkv = WSP(bf16_t, rkv);
    static_assert(NLAT % 2 == 0 && NTOK % 2 == 0, "token pairs");
    const int nrow = (l == L_ - 1) ? NLAT : NTOK; const int hq = (lane >> 4) & 1, c4 = (lane & 15) * 4;
    for (int n0 = 2 * wv; n0 < nrow; n0 += 2 * nwv) { const int n = n0 + (lane >> 5);
        float o[6][4];
#pragma unroll
        for (int i = 0; i < 6; ++i) {
            const int hd = hq + 2 * i;
            if (i < 3) { const int c = hd * RN_ + c4; float r[4], k[4], v[4], a0[4], a1[4], g[4];
                ld4bf(rkv + (size_t)n * 3 * RW + c, r); ld4bf(rkv + (size_t)n * 3 * RW + RW + c, k); ld4bf(rkv + (size_t)n * 3 * RW + 2 * RW + c, v);
                ld4bf(gsb + (size_t)n * NGB + c, a0); ld4bf(gsb + (size_t)n * NGB + RW + c, a1); ld4bf(gsb + (size_t)n * NGB + 2 * RW + c, g);
                const F4 y0 = *(const F4*)(yr + (size_t)n * RW + c), y1 = *(const F4*)(yr + ((size_t)NTOK + n) * RW + c);
                const F4 ka = *(const F4*)(p.rwkv_k_a + (size_t)l * RW + c), rk = *(const F4*)(p.rwkv_r_k + (size_t)l * RW + c), lg = *(const F4*)(p.rwkv_ln_g + (size_t)l * RW + c), lb = *(const F4*)(p.rwkv_ln_b + (size_t)l * RW + c);
                float y[4], s = 0.f, bs = 0.f;
#pragma unroll
                for (int j = 0; j < 4; ++j) { y[j] = y0[j] + y1[j]; s += y[j]; const float k20 = k[j] * (1.0f + (a0[j] - 1.0f) * ka[j]), k21 = k[j] * (1.0f + (a1[j] - 1.0f) * ka[j]); bs += r[j] * (k20 + k21) * rk[j]; }
                s = dpp_sum16(s); bs = dpp_sum16(bs); const float mu = s * (1.0f / RN_); float qq = 0.f;
#pragma unroll
                for (int j = 0; j < 4; ++j) { const float dlt = y[j] - mu; qq += dlt * dlt; }
                qq = dpp_sum16(qq); const float rstd = __builtin_amdgcn_rsqf(qq * (1.0f / RN_) + GN_EPS);
#pragma unroll
                for (int j = 0; j < 4; ++j) o[i][j] = ((y[j] - mu) * rstd * lg[j] + lb[j] + bs * v[j]) * g[j];
            } else { const int h2 = hd - RH_, c = h2 * GV_ + c4; float gg[4];
                const F4 o0 = *(const F4*)(og + (size_t)n * GWD + c), o1 = *(const F4*)(og + ((size_t)NTOK + n) * GWD + c); ld4bf(proj + (size_t)n * NINP + GBASE + 2 * GKD + GWD + c, gg);
                const F4 ng = *(const F4*)(p.gla_norm_g + (size_t)l * GV_ + c4); float oo[4], qq = 0.f;
#pragma unroll
                for (int j = 0; j < 4; ++j) { oo[j] = o0[j] + o1[j]; qq += oo[j] * oo[j]; }
                qq = dpp_sum16(qq); const float rs = __builtin_amdgcn_rsqf(qq * (1.0f / GV_) + 1e-6f);
#pragma unroll
                for (int j = 0; j < 4; ++j) o[i][j] = oo[j] * rs * ng[j] * siluf_(gg[j]);
            }
        }
#pragma unroll
        for (int i = 0; i < 6; ++i) st4bf(ymix + (size_t)n * MIXW + (hq + 2 * i) * 64 + c4, o[i]);
    }
}
#endif

#ifndef CPU_TEST
__device__ __forceinline__ void st_modv_blk(const P& p, LAS unsigned char* lds, int tid) {
    static_assert(D_ == 1024 && B_ + 1 <= 17, "modv_blk geometry");
    LAS float* sc = (LAS float*)lds;
    LAS float* red = (LAS float*)(lds + 17 * 1024 * 4);
    const float* scg = WSP(float, silu_c); float* mv = WSP(float, modv);
    for (int i = tid; i < (B_ + 1) * D_; i += 512) sc[i] = scg[i];
    __syncthreads();
    const int cl = tid & 63, ks = tid >> 6;
    for (int task = blockIdx.x; task < L_ * 6 * D_ / 64; task += gridDim.x) {
        const int l = task / (6 * D_ / 64), col = (task % (6 * D_ / 64)) * 64 + cl;
        float acc[B_ + 1];
#pragma unroll
        for (int b = 0; b <= B_; ++b) acc[b] = 0.f;
        const float* w = p.w_mod + (size_t)l * D_ * 6 * D_ + col;
#pragma unroll 4
        for (int k = ks * 128; k < ks * 128 + 128; ++k) { const float wk = w[(size_t)k * 6 * D_];
#pragma unroll
            for (int b = 0; b <= B_; ++b) acc[b] += sc[b * D_ + k] * wk; }
#pragma unroll
        for (int b = 0; b <= B_; ++b) red[(ks * (B_ + 1) + b) * 64 + cl] = acc[b];
        __syncthreads();
        for (int i = tid; i < (B_ + 1) * 64; i += 512) { const int b = i >> 6, c2 = i & 63; float s = p.b_mod[(size_t)l * 6 * D_ + (task % (6 * D_ / 64)) * 64 + c2];
#pragma unroll
            for (int q = 0; q < 8; ++q) s += red[(q * (B_ + 1) + b) * 64 + c2];
            mv[((size_t)l * (B_ + 1) + b) * 6 * D_ + (task % (6 * D_ / 64)) * 64 + c2] = s; }
        __syncthreads();
    }
}
#endif

#ifdef CPU_TEST
#define GEMM_CALL(g, S, E) gemm_phase(g, S, E)
#define GEMM_CALL_G(g, S, E) gemm_phase(g, S, E)
#define SCHED_GC 1, 0
#define SYNC(k)
#define LOADP
#else
#define CAS __attribute__((address_space(4)))
#define LOADP const CAS P* _q = pk; asm volatile("" : "+s"(_q)); const P& p = *(const P*)_q; int lane = lane_id(); asm volatile("" : "+v"(lane)); \
    const int wv = blockIdx.x * 8 + wid, nwv = gridDim.x * 8; (void)lane; (void)wv; (void)nwv;
#define GEMM_CALL(g, S, E) gemm_phase<false>(lds, wid, g, S, E, &bar)
#define GEMM_CALL_G(g, S, E) gemm_phase<true>(lds, wid, g, S, E, &bar)
#define SCHED_GC (int)gridDim.x, sched_id((const unsigned*)(p.ws + WS.ctl), lds)
#define VC_WORD(x) (3584 + 64 * (x))
__device__ __forceinline__ int sched_id(const unsigned* ctl, LAS unsigned char* lds) {
    const unsigned G = gridDim.x; bool ok = (G % 8u) == 0u;
#pragma unroll
    for (int x = 0; x < 8; ++x) ok = ok && (__hip_atomic_load(ctl + VC_WORD(x), __ATOMIC_RELAXED, __HIP_MEMORY_SCOPE_AGENT) == G / 8u);
    const unsigned v = ((volatile LAS unsigned*)(lds + STAGE_BYTES))[2];
    return __builtin_amdgcn_readfirstlane(ok ? (int)v : (int)blockIdx.x);
}
#define SYNC(k) if (lo <= (k) && (k) + 1 < hi) xcd_barrier(bar);
#define XB_TMO      128
#define XB_XCNT(j)  (256  + 64 * (j))
#define XB_XSUB(j)  (1280 + 64 * (j))
#define XB_XGEN(j)  (2304 + 64 * (j))
#define XB_TOP      3328
#define XB_TOPGEN   3392
#define XCD_BAR_WORDS 3456
#define XB_SPIN_CAP (1u << 18)
__device__ __forceinline__ unsigned xb_ld(unsigned* p)              { return __hip_atomic_load(p, __ATOMIC_RELAXED, __HIP_MEMORY_SCOPE_AGENT); }
__device__ __forceinline__ unsigned xb_add(unsigned* p, unsigned v) { return __hip_atomic_fetch_add(p, v, __ATOMIC_RELAXED, __HIP_MEMORY_SCOPE_AGENT); }
__device__ __forceinline__ unsigned xb_xcc_id() { return (unsigned)__builtin_amdgcn_s_getreg((3 << 11) | 20) & 0xFu; }
#define XB_SPIN(cond, bar) do { unsigned _sp = 0; while (cond) { __builtin_amdgcn_s_sleep(1); \
    if ((++_sp & 255u) == 0u) { if (xb_ld(&(bar)[XB_TMO])) break; if (_sp > XB_SPIN_CAP) { atomicAdd(&(bar)[XB_TMO], 1u); break; } } } } while (0)
struct XcdBarrier { unsigned* bar; unsigned x; volatile LAS unsigned* st; int wid; };
__device__ __forceinline__ XcdBarrier xcd_barrier_post(unsigned* bar, volatile LAS unsigned* st) {
    XcdBarrier b; b.bar = bar; b.x = xb_xcc_id(); b.st = st; b.wid = 0;
    if (threadIdx.x == 0) (void)xb_add(&bar[XB_XCNT(b.x)], 1u);
    return b;
}
__device__ __forceinline__ void xcd_barrier_complete(unsigned* bar, unsigned x, unsigned& nloc, unsigned& nx) {
    const unsigned G = gridDim.x * gridDim.y * gridDim.z;
    unsigned sum, cnt, mine, sp = 0u;
    for (;;) {
        sum = 0u; cnt = 0u; mine = 0u;
#pragma unroll
        for (unsigned j = 0; j < 16; ++j) { const unsigned c = xb_ld(&bar[XB_XCNT(j)]); sum += c; cnt += (c > 0u) ? 1u : 0u; mine = (j == x) ? c : mine; }
        if (sum == G) break;
        __builtin_amdgcn_s_sleep(1);
        if ((++sp & 255u) == 0u) { if (xb_ld(&bar[XB_TMO])) break; if (sp > XB_SPIN_CAP) { atomicAdd(&bar[XB_TMO], 1u); break; } }
    }
    nloc = mine > 0u ? mine : 1u; nx = cnt > 0u ? cnt : 1u;
}
__device__ __forceinline__ void xcd_barrier(const XcdBarrier& b) {
    asm volatile("s_waitcnt vmcnt(0)" ::: "memory");
    __syncthreads();
    if (b.wid == 0 && lane_id() == 0) {
        unsigned* bar = b.bar;
        __builtin_amdgcn_s_waitcnt(0);
        unsigned nloc = b.st[0], nx = b.st[1];
        if (nloc == 0u) { xcd_barrier_complete(bar, b.x, nloc, nx); b.st[0] = nloc; b.st[1] = nx; }
        const unsigned old = xb_add(&bar[XB_XSUB(b.x)], 1u);
        const unsigned gen = old / nloc;
        if (old + 1u == (gen + 1u) * nloc) {
            __builtin_amdgcn_fence(__ATOMIC_RELEASE, "agent");
            asm volatile("s_waitcnt vmcnt(0)" ::: "memory");
            const unsigned og = xb_add(&bar[XB_TOP], 1u);
            const unsigned tg = og / nx;
            if (og + 1u == (tg + 1u) * nx) xb_add(&bar[XB_TOPGEN], 1u);
            else XB_SPIN(xb_ld(&bar[XB_TOPGEN]) == tg, bar);
            __builtin_amdgcn_fence(__ATOMIC_ACQUIRE, "agent");
            xb_add(&bar[XB_XGEN(b.x)], 1u);
            asm volatile("s_waitcnt vmcnt(0)" ::: "memory");
        } else {
            XB_SPIN(xb_ld(&bar[XB_XGEN(b.x)]) == gen, bar);
            __builtin_amdgcn_fence(__ATOMIC_ACQUIRE, "agent");
            asm volatile("s_waitcnt vmcnt(0)" ::: "memory");
        }
    }
    __syncthreads();
}
#endif

#define IN(k) (lo <= (k) && (k) < hi)
#ifndef PROBE_MASK
#define PROBE_MASK 0
#endif
#ifdef CPU_TEST
#define REP_BEGIN(k)
#define REP_END
#else
#define REP_BEGIN(k) for (int rep_ = 0; rep_ < (((PROBE_MASK) >> (k)) & 1) + 1; ++rep_) { if (rep_) xcd_barrier(bar);
#define REP_END }
#endif
#ifdef CPU_TEST
template <int lo, int hi, int l> static void run_layer(const P& p) { const int wv = 0, nwv = 1, lane = 0; (void)wv; (void)nwv; (void)lane;
#else
template <int lo, int hi, int l> __device__ __forceinline__ void run_layer(const CAS P* pk, LAS unsigned char* lds, const int wid, const XcdBarrier& bar) {
#endif

        const int pb = NPH_PRO + l * NPH_LAYER; const bool last = (l == L_ - 1); const int MR = last ? NLAT : NTOK;
        if (IN(pb + 0)) { REP_BEGIN(0) LOADP GemmArgs g{WSP(bf16_t, h), D_, nullptr, WSP(bf16_t, w_inT) + (size_t)l * NINP * D_, D_, D_}; StaticSched S; S.init(1, NTOK, NINP, 0, 0, SCHED_GC);
            EpiBf16Plain E{WSP(bf16_t, proj), NINP}; GEMM_CALL(g, S, E); REP_END } SYNC(pb + 0)
#ifdef CPU_TEST
        if (IN(pb + 1)) { REP_BEGIN(1) LOADP st_prep1(p, l, wv, nwv, lane); REP_END } SYNC(pb + 1)
#else
        if (IN(pb + 1)) { REP_BEGIN(1) LOADP st_prep1_blk(p, l, wid, lane, wv, nwv); REP_END } SYNC(pb + 1)
#endif
        if (IN(pb + 2)) { REP_BEGIN(2) LOADP
            { GemmArgs g{WSP(bf16_t, asmall), KSM, nullptr, WSP(bf16_t, wsmT) + (size_t)l * NSMP * KSM, KSM, KSM}; StaticSched S; S.init(1, NTOK, NSMP, 0, 0, SCHED_GC);
              EpiSmall E{WSP(float, gs), WSP(bf16_t, gsb), p.rwkv_w0 + (size_t)l * 2 * RW, p.rwkv_a0 + (size_t)l * 2 * RW, p.gla_a_bias + (size_t)l * 2 * GKD}; GEMM_CALL(g, S, E); }
            { GemmArgs g{WSP(bf16_t, U2), KT5, nullptr, WSP(bf16_t, s5Wa) + (size_t)l * SNG_ * N5AP * K5, K5, K5}; StaticSched S; S.init(SNG_, M5P, N5AP, M5P, N5AP, SCHED_GC);
              EpiF32Plain E{WSP(float, xl), N5AP, (size_t)M5P * N5AP}; GEMM_CALL(g, S, E); }
        REP_END } SYNC(pb + 2)
        if (IN(pb + 3)) { REP_BEGIN(3) LOADP
#ifdef CPU_TEST
            rwkv_scan_all(p, l); gla_scan_all(p, l);
#else
            { constexpr int NRS_ = 2 * B_ * RH_, NGS_ = 2 * B_ * GH_, NGG = (NGS_ + 2) / 3;
              for (int task = blockIdx.x; task < NRS_; task += gridDim.x) { const int hh = task % RH_, b = (task / RH_) % B_, d = task / (RH_ * B_); rwkv_chunk_blk(p, l, d, b, hh, lds, wid, lane); } }
            { LOADP constexpr int NRS_ = 2 * B_ * RH_, NGS_ = 2 * B_ * GH_, NGG = (NGS_ + 2) / 3;
              for (int task = (int)blockIdx.x + (((int)blockIdx.x < NRS_) ? (int)gridDim.x * ((NRS_ - 1 - (int)blockIdx.x) / (int)gridDim.x + 1) : 0); task < NRS_ + NGG; task += gridDim.x) {
                  for (int s3 = 0; s3 < 3; ++s3) { const int t2 = (task - NRS_) + NGG * s3; if (t2 < NGS_) { const int hh = t2 % GH_, b = (t2 / GH_) % B_, d = t2 / (GH_ * B_); gla_chunk_blk(p, l, d, b, hh, lds, wid, lane); } __syncthreads(); } } }
#endif
            st_s5carry(p, l, wv, nwv, lane); REP_END } SYNC(pb + 3)
        if (IN(pb + 4)) { REP_BEGIN(4) LOADP
            { GemmArgs g{WSP(bf16_t, U2), KT5, nullptr, WSP(bf16_t, s5Tb) + (size_t)l * SNG_ * K5 * KT5, KT5, KT5}; StaticSched S; S.init(SNG_, M5P, K5, M5P, K5, SCHED_GC);
              EpiS5b E{WSP(bf16_t, yc)}; GEMM_CALL(g, S, E); }
#ifdef CPU_TEST
            st_post(p, l, wv, nwv, lane);
#else
            st_post_wave(p, l, wv, nwv, lane);
#endif
            REP_END } SYNC(pb + 4)
        if (IN(pb + 5)) { REP_BEGIN(5) LOADP GemmArgs g{WSP(bf16_t, yc), SW, nullptr, WSP(bf16_t, gluT) + (size_t)l * SWP * SW, SW, SW}; StaticSched S; S.init(1, MR, SWP, 0, 0, SCHED_GC);
            EpiGlu E{WSP(bf16_t, ymix), WSP(bf16_t, yc), p.s5_glu_b + (size_t)l * SW}; GEMM_CALL(g, S, E); REP_END } SYNC(pb + 5)
        if (IN(pb + 6)) { REP_BEGIN(6) LOADP GemmArgs g{WSP(bf16_t, ymix), MIXW, nullptr, WSP(bf16_t, w_outT) + (size_t)l * D_ * MIXW, MIXW, MIXW}; StaticSched S; S.init(1, MR, D_, 0, 0, SCHED_GC);
            EpiBf16Plain E{WSP(bf16_t, yo), D_}; GEMM_CALL(g, S, E); REP_END } SYNC(pb + 6)
        if (IN(pb + 7)) { REP_BEGIN(7) LOADP st_ln1(p, l, wv, nwv, lane); REP_END } SYNC(pb + 7)
        if (IN(pb + 8)) { REP_BEGIN(8) LOADP GemmArgs g{WSP(bf16_t, h2), D_, nullptr, WSP(bf16_t, rsT) + (size_t)l * NRS * D_, D_, D_}; StaticSched S; S.init(1, MR, NRS, 0, 0, SCHED_GC);
            EpiRS E{WSP(float, logits), WSP(bf16_t, sact)}; GEMM_CALL(g, S, E); REP_END } SYNC(pb + 8)
        if (IN(pb + 9)) { REP_BEGIN(9) LOADP
#ifdef CPU_TEST
            st_topk(p, l, wv, nwv, lane);
#else
            st_topk_wave(p, l, wv, nwv, lane, lds);
#endif
            st_scatter0(p, l, wv, nwv, lane); REP_END } SYNC(pb + 9)
#ifdef CPU_TEST
        if (IN(pb + 10)) { LOADP st_offsets(p, l, wv, nwv, lane); }
        if (IN(pb + 11)) { LOADP st_scatter(p, l, wv, nwv, lane); }
#else
        if (IN(pb + 11)) { LOADP st_scatter_blk(p, l, lds, wid, lane, wv, nwv); } SYNC(pb + 11)
#endif
        if (IN(pb + 12)) { REP_BEGIN(12) LOADP
            { GemmArgs g{WSP(bf16_t, h2), D_, WSP(int, slot_tok), WSP(bf16_t, w13T) + (size_t)l * E_ * 2 * FF_ * D_, D_, D_}; ListSched S{WSP(int, ulist), WSP(int, nunits), 2 * FF_ / 256, 2 * FF_, SCHED_GC};
              EpiUp E{WSP(bf16_t, act)}; GEMM_CALL_G(g, S, E); }
            { GemmArgs g{WSP(bf16_t, sact), FF_, nullptr, WSP(bf16_t, shw2T) + (size_t)l * D_ * FF_, FF_, FF_}; StaticSched S; S.init(1, MR, D_, 0, 0, SCHED_GC);
              EpiBf16Plain E{WSP(bf16_t, Ysh), D_}; GEMM_CALL(g, S, E); }
        REP_END } SYNC(pb + 12)
        if (IN(pb + 13)) { REP_BEGIN(13) LOADP GemmArgs g{WSP(bf16_t, act), FF_, nullptr, WSP(bf16_t, w2T) + (size_t)l * E_ * D_ * FF_, FF_, FF_}; ListSched S{WSP(int, ulist), WSP(int, nunits), D_ / 256, D_, SCHED_GC};
            EpiDown E{WSP(bf16_t, Y)}; GEMM_CALL(g, S, E); REP_END } SYNC(pb + 13)
        if (IN(pb + 14)) { REP_BEGIN(14) LOADP st_ln2(p, l, wv, nwv, lane); REP_END } SYNC(pb + 14)
    }
#ifdef CPU_TEST
template <int lo, int hi> static void run_program(const P& p) { const int wv = 0, nwv = 1, lane = 0;
#else
template <int lo, int hi> __device__ __forceinline__ void run_program(const CAS P* pk, LAS unsigned char* lds, const int wid, const XcdBarrier& bar) {
#endif
    if (IN(0)) { { LOADP st_siluc(p, wv, nwv, lane); } { LOADP st_s5a(p, wv, nwv, lane); }
#ifdef CPU_TEST
        { LOADP st_cvt1(p, 0, wv, nwv, lane); } { LOADP st_cvt2(p, 0, wv, nwv, lane); } { LOADP st_cvt3(p, 0, wv, nwv, lane); } { LOADP st_cvt4(p, 0, wv, nwv, lane); }
        { LOADP st_cvt1(p, 1, wv, nwv, lane); } { LOADP st_cvt2(p, 1, wv, nwv, lane); } { LOADP st_cvt3(p, 1, wv, nwv, lane); } { LOADP st_cvt4(p, 1, wv, nwv, lane); }
#else
        { LOADP st_cvt_tiles(p, 0, lds, wid * 64 + lane); } { LOADP st_cvt_tiles(p, 1, lds, wid * 64 + lane); }
#endif
        { LOADP st_cvt5(p, 0, wv, nwv, lane); } { LOADP st_cvt5(p, 1, wv, nwv, lane); } } SYNC(0)
#ifdef CPU_TEST
    if (IN(1)) { { LOADP st_modv(p, wv, nwv, lane); } { LOADP st_s5b(p, wv, nwv, lane); } } SYNC(1)
#else
#ifndef PRO_PROBE
#define PRO_PROBE 0
#endif
    if (IN(1)) { { LOADP st_modv_blk(p, lds, wid * 64 + lane); } for (int rp_ = 0; rp_ < ((PRO_PROBE & 1) ? 2 : 1); ++rp_) { LOADP st_s5b(p, wv, nwv, lane); } } SYNC(1)
#endif
#ifdef CPU_TEST
    if (IN(2)) { { LOADP st_s5c(p, wv, nwv, lane); } { LOADP st_hmod(p, 0, wv, nwv, lane); } } SYNC(2)
#else
    if (IN(2)) { for (int rp_ = 0; rp_ < ((PRO_PROBE & 2) ? 2 : 1); ++rp_) { LOADP st_s5c(p, wv, nwv, lane); } for (int rp_ = 0; rp_ < ((PRO_PROBE & 4) ? 2 : 1); ++rp_) { LOADP st_hmod(p, 0, wv, nwv, lane); } } SYNC(2)
#endif
#ifdef CPU_TEST
    run_layer<lo, hi, 0>(p); run_layer<lo, hi, 1>(p);
#else
    run_layer<lo, hi, 0>(pk, lds, wid, bar); run_layer<lo, hi, 1>(pk, lds, wid, bar);
#endif
}
#undef IN
#ifndef CPU_TEST
constexpr int LDS_BYTES = STAGE_BYTES + 1024;
struct KArgs { P p; };
template <int LO, int HI> __global__ void __launch_bounds__(512, 2) fwd_kernel(KArgs a) {
    extern __shared__ __attribute__((aligned(16))) unsigned char lds_raw[];
    LAS unsigned char* lds = (LAS unsigned char*)lds_raw;
    volatile LAS unsigned* xbw = (volatile LAS unsigned*)(lds + STAGE_BYTES);
    const int wid = __builtin_amdgcn_readfirstlane(threadIdx.x >> 6);
    const CAS P* pk = (const CAS P*)__builtin_amdgcn_kernarg_segment_ptr();
    if (threadIdx.x < 4) xbw[threadIdx.x] = 0u;
    __syncthreads();
    if (threadIdx.x == 0) { const unsigned xcc = xb_xcc_id() & 7u; const unsigned rank = xb_add((unsigned*)(pk->ws + WS.ctl) + VC_WORD(xcc), 1u); xbw[2] = rank * 8u + xcc; }
    __syncthreads();
    XcdBarrier bar; bar.bar = (unsigned*)(pk->ws + WS.ctl); bar.x = 0; bar.st = xbw; bar.wid = wid;
    if (HI - LO > 1) { bar = xcd_barrier_post((unsigned*)(pk->ws + WS.ctl), xbw); bar.wid = wid; }
    run_program<LO, HI>(pk, lds, wid, bar);
}
template <int PH> static void launch_each(int grid, hipStream_t stream, const KArgs& a) {
    if constexpr (PH < NPH) {
        static bool attr = false;
        if (!attr) { (void)hipFuncSetAttribute((const void*)fwd_kernel<PH, PH + 1>, hipFuncAttributeMaxDynamicSharedMemorySize, LDS_BYTES); attr = true; }
        hipLaunchKernelGGL((fwd_kernel<PH, PH + 1>), dim3(grid), dim3(512), LDS_BYTES, stream, a);
        launch_each<PH + 1>(grid, stream, a);
    }
}
extern "C" void kernel_launch(void* const* d_in, const int* in_sizes, int n_in, void* d_out, int out_size, void* d_ws, size_t ws_size, hipStream_t stream) {
    static int grid = 0;
    if (grid == 0) {
        if (n_in != 42 || ws_size < WS.end) { fprintf(stderr, "kernel_launch: bad inputs (n_in %d, ws %zu, need %zu)\n", n_in, ws_size, (size_t)WS.end); grid = -1; return; }
        int dev = 0, cus = 0; (void)hipGetDevice(&dev); (void)hipDeviceGetAttribute(&cus, hipDeviceAttributeMultiprocessorCount, dev);
        grid = cus;
    }
    if (grid < 0) return;
    KArgs a{}; const float** pp = (const float**)&a.p;
    for (int i = 0; i < 42; ++i) pp[i] = (const float*)d_in[i];
    a.p.out = (float*)d_out; a.p.ws = (unsigned char*)d_ws;
    (void)hipMemsetAsync((char*)d_ws + WS.ctl, 0, 16384, stream);
#ifdef FUSED
    static bool attr = false;
    if (!attr) { (void)hipFuncSetAttribute((const void*)fwd_kernel<0, NPH>, hipFuncAttributeMaxDynamicSharedMemorySize, LDS_BYTES); attr = true; }
    hipLaunchKernelGGL((fwd_kernel<0, NPH>), dim3(grid), dim3(512), LDS_BYTES, stream, a);
#else
    launch_each<0>(grid, stream, a);
#endif
}
#else
static void cpu_forward(const P& p) { run_program<0, NPH>(p); }
#endif
```

```cpp
#ifndef CFG_SMALL
#define D_ 1024
#define B_ 16
#define T_ 2048
#define CTX_ 256
#define GW_ 64
#define RH_ 6
#define GH_ 6
#define SNG_ 16
#define E_ 256
#define TOPK_ 8
#define NGRP_ 8
#define TKG_ 4
#define FF_ 256
#else
#define D_ 256
#define B_ 2
#define T_ 256
#define CTX_ 128
#define GW_ 16
#define RH_ 2
#define GH_ 2
#define SNG_ 4
#define E_ 16
#define TOPK_ 4
#define NGRP_ 4
#define TKG_ 2
#define FF_ 128
#endif
#define L_ 2
#define RN_ 64
#define RDR_ 32
#define RIR_ 32
#define RGR_ 64
#define GK_ 32
#define GV_ 64
#define GGR_ 16
#define SG_ 16
#define SP_ 64
#define CH_ 64

constexpr int pad256(int x) { return (x + 255) / 256 * 256; }
constexpr int RW = RH_ * RN_, RCOLS = 3 * RW + 2 * RDR_ + 2 * RIR_ + RGR_;
constexpr int GKD = GH_ * GK_, GWD = GH_ * GV_, GCOLS = 2 * GKD + 2 * GWD + 2 * GGR_;
constexpr int SW = SG_ * SNG_, MIXW = RW + GWD + SW, NIN = RCOLS + GCOLS + SW, NINP = pad256(NIN);
constexpr int GBASE = RCOLS, SBASE = RCOLS + GCOLS;
constexpr int NLAT = B_ * T_, NCTX = B_ * CTX_, NTOK = NLAT + NCTX;
constexpr int SPOS = CTX_ + T_, NPC = SPOS / CH_, NPCC = CTX_ / CH_, M5 = B_ * NPC, M5P = pad256(M5);
constexpr int KSM = 256, OWD = 0, OAD = 2 * RDR_, OGD = OAD + 2 * RIR_, OGL = OGD + RGR_;
constexpr int NSM = 5 * RW + 2 * GKD, NSMP = pad256(NSM), NGF = 2 * RW + 2 * GKD, NGB = 3 * RW;
constexpr int K5 = CH_ * SG_, KT5 = K5 + 4 * SP_, N5A = 4 * SP_, N5AP = pad256(N5A);
constexpr int EP = pad256(E_), NRS = EP + 2 * FF_;
constexpr int SWP = pad256(SW);
constexpr int NSLOT = pad256(NTOK * TOPK_) + E_ * 256, MAXT = NSLOT / 256;
constexpr int ROWS_ = T_ / GW_;
constexpr float LN_EPS = 1e-6f, GN_EPS = 64e-5f;
static_assert(OGL + 2 * GGR_ <= KSM, "ksm");
static_assert(NTOK % 256 == 0 && NLAT % 256 == 0, "rows");
static_assert(FF_ % 128 == 0 && D_ % 256 == 0, "ff");

typedef unsigned short bf16_t;
#ifdef CPU_TEST
#include <cmath>
#include <cstring>
#include <cstdio>
#include <cstdlib>
#include <vector>
#define HD static inline
#define HDM inline
#define NL 1
static inline float WSUM(float v) { return v; }
struct F4 { float v[4]; float& operator[](int i) { return v[i]; } const float& operator[](int i) const { return v[i]; } };
#else
#include <hip/hip_runtime.h>
#define HD __device__ __forceinline__
#define HDM __device__ __forceinline__
#define NL 64
#define DPP_ADD(v, ctrl) v += __builtin_bit_cast(float, __builtin_amdgcn_update_dpp(0, __builtin_bit_cast(int, v), ctrl, 0xF, 0xF, true))
HD float WSUM(float v) {
    DPP_ADD(v, 0xB1); DPP_ADD(v, 0x4E); DPP_ADD(v, 0x141); DPP_ADD(v, 0x140);
    const int b = __builtin_bit_cast(int, v);
    const float s0 = __builtin_bit_cast(float, __builtin_amdgcn_readlane(b, 0)), s1 = __builtin_bit_cast(float, __builtin_amdgcn_readlane(b, 16)),
                s2 = __builtin_bit_cast(float, __builtin_amdgcn_readlane(b, 32)), s3 = __builtin_bit_cast(float, __builtin_amdgcn_readlane(b, 48));
    return (s0 + s1) + (s2 + s3);
}
typedef float F4 __attribute__((ext_vector_type(4)));
#endif

#ifdef CPU_TEST
HD bf16_t f2bf(float f) { unsigned u; memcpy(&u, &f, 4); u += 0x7FFFu + ((u >> 16) & 1u); return (bf16_t)(u >> 16); }
#else
HD bf16_t f2bf(float f) { return __builtin_bit_cast(unsigned short, (__bf16)f); }
#endif
HD float bf2f(bf16_t b) { unsigned u = ((unsigned)b) << 16; float f; memcpy(&f, &u, 4); return f; }
#ifdef CPU_TEST
HD float fexp(float x) { return expf(x); }
HD float flog(float x) { return logf(x); }
HD float frcp(float x) { return 1.0f / x; }
HD float frsq(float x) { return 1.0f / sqrtf(x); }
#else
HD float fexp(float x) { return __expf(x); }
HD float flog(float x) { return __logf(x); }
HD float frcp(float x) { return __builtin_amdgcn_rcpf(x); }
HD float frsq(float x) { return __builtin_amdgcn_rsqf(x); }
#endif
HD float sigmoidf_(float x) { return frcp(1.0f + fexp(-x)); }
HD float siluf_(float x) { return x * sigmoidf_(x); }
HD float softplusf_(float x) { return x > 20.f ? x : flog(1.0f + fexp(x)); }
HD float ftanh(float x) { const float e = fexp(2.0f * (x > 15.f ? 15.f : x)); return 1.0f - 2.0f * frcp(e + 1.0f); }
HD float geluf_(float x) { return 0.5f * x * (1.0f + ftanh(0.7978845608028654f * (x + 0.044715f * x * x * x))); }

HD int row_of(int b, int pos) { return pos < CTX_ ? NLAT + b * CTX_ + pos : b * T_ + (pos - CTX_); }
HD int bidx_of(int n) { return n < NLAT ? n / T_ : B_; }
HD int seqpos(int d, int i) { return d == 0 ? i : (i < CTX_ ? CTX_ - 1 - i : CTX_ + T_ - 1 - (i - CTX_)); }

constexpr size_t al256(size_t x) { return (x + 255) / 256 * 256; }
struct WSMap {
    size_t ctl, silu_c, modv, w_inT, w_outT, wsmT, rsT, w13T, w2T, shw2T, gluT, s5Wa, s5Tb, s5pw, s5bb, s5K;
    size_t h, ymix, yo, xcur, x1, h2, eidx, ewt, slot_of, ecnt, efill, eoff, nunits, ulist, slot_tok;
    size_t proj, rkv, asmall, gs, gsb, yr, og, U2, xl, yc;
    size_t logits, sact, act, Y, Ysh;
    size_t end;
};
constexpr WSMap make_wsmap() {
    WSMap m{}; size_t o = 0;
#define TAKE(f, bytes) m.f = o; o = al256(o + (size_t)(bytes));
    TAKE(ctl, 65536)
    TAKE(silu_c, (B_ + 1) * D_ * 4) TAKE(modv, (size_t)L_ * (B_ + 1) * 6 * D_ * 4)
    TAKE(w_inT, (size_t)L_ * NINP * D_ * 2) TAKE(w_outT, (size_t)L_ * D_ * MIXW * 2) TAKE(wsmT, (size_t)L_ * NSMP * KSM * 2)
    TAKE(rsT, (size_t)L_ * NRS * D_ * 2) TAKE(w13T, (size_t)L_ * E_ * 2 * FF_ * D_ * 2) TAKE(w2T, (size_t)L_ * E_ * D_ * FF_ * 2)
    TAKE(shw2T, (size_t)L_ * D_ * FF_ * 2) TAKE(gluT, (size_t)L_ * SWP * SW * 2)
    TAKE(s5Wa, (size_t)L_ * SNG_ * N5AP * K5 * 2) TAKE(s5Tb, (size_t)L_ * SNG_ * K5 * KT5 * 2)
    TAKE(s5pw, (size_t)L_ * 2 * SNG_ * SP_ * (CH_ + 1) * 2 * 4) TAKE(s5bb, (size_t)L_ * 2 * SNG_ * SP_ * SG_ * 2 * 4) TAKE(s5K, (size_t)L_ * 2 * SNG_ * CH_ * SG_ * SG_ * 4)
    TAKE(h, (size_t)NTOK * D_ * 2) TAKE(ymix, (size_t)NTOK * MIXW * 2) TAKE(yo, (size_t)NTOK * D_ * 2) TAKE(xcur, (size_t)NTOK * D_ * 2)
    TAKE(x1, (size_t)NTOK * D_ * 2) TAKE(h2, (size_t)NTOK * D_ * 2)
    TAKE(eidx, (size_t)NTOK * TOPK_ * 4) TAKE(ewt, (size_t)NTOK * TOPK_ * 4) TAKE(slot_of, (size_t)NTOK * TOPK_ * 4)
    TAKE(ecnt, E_ * 4) TAKE(efill, E_ * 4) TAKE(eoff, (E_ + 1) * 4) TAKE(nunits, 256) TAKE(ulist, (size_t)MAXT * 16) TAKE(slot_tok, (size_t)NSLOT * 4)
    const size_t regA = o;
    TAKE(proj, (size_t)NTOK * NINP * 2) TAKE(rkv, (size_t)NTOK * 3 * RW * 2) TAKE(asmall, (size_t)NTOK * KSM * 2) TAKE(gs, (size_t)NTOK * NGF * 4) TAKE(gsb, (size_t)NTOK * NGB * 2)
    TAKE(yr, (size_t)2 * NTOK * RW * 4) TAKE(og, (size_t)2 * NTOK * GWD * 4) TAKE(U2, (size_t)SNG_ * M5P * KT5 * 2) TAKE(xl, (size_t)SNG_ * M5P * N5AP * 4)
    TAKE(yc, (size_t)NTOK * SW * 2)
    const size_t endA = o; o = regA;
    TAKE(logits, (size_t)NTOK * E_ * 4) TAKE(sact, (size_t)NTOK * FF_ * 2) TAKE(act, (size_t)NSLOT * FF_ * 2) TAKE(Y, (size_t)NSLOT * D_ * 2) TAKE(Ysh, (size_t)NTOK * D_ * 2)
    m.end = o > endA ? o : endA;
#undef TAKE
    return m;
}
constexpr WSMap WS = make_wsmap();

struct P {
    const float *x, *c, *ctx, *c_ctx, *w_mod, *b_mod, *w_in, *rwkv_conv, *rwkv_w0, *rwkv_w_up, *rwkv_a0, *rwkv_a_up, *rwkv_g_up, *rwkv_k_k, *rwkv_k_a,
        *rwkv_r_k, *rwkv_ln_g, *rwkv_ln_b, *gla_a_up, *gla_a_bias, *gla_norm_g, *s5_lam_re, *s5_lam_im, *s5_log_dt, *s5_b_re, *s5_b_im, *s5_c_re, *s5_c_im,
        *s5_d, *s5_glu_w, *s5_glu_b, *w_out, *ln1_g, *ln1_b, *router_w, *router_bias, *exp_w13, *exp_w2, *sh_w13, *sh_w2, *ln2_g, *ln2_b;
    float* out; unsigned char* ws;
};
#define WSP(type, field) ((type*)(p.ws + WS.field))
#define GIDX long gid = (long)wv * NL + lane; const long gsz = (long)nwv * NL
#ifdef CPU_TEST
HD void ld8bf(const bf16_t* q, float* o) { for (int j = 0; j < 8; ++j) o[j] = bf2f(q[j]); }
HD void ld8f(const float* q, float* o) { for (int j = 0; j < 8; ++j) o[j] = q[j]; }
HD void st8f(float* q, const float* v) { for (int j = 0; j < 8; ++j) q[j] = v[j]; }
HD void st8bf(bf16_t* q, const float* v) { for (int j = 0; j < 8; ++j) q[j] = f2bf(v[j]); }
HD void cp8bf(bf16_t* q, const bf16_t* s) { for (int j = 0; j < 8; ++j) q[j] = s[j]; }
HD void z8bf(bf16_t* q) { for (int j = 0; j < 8; ++j) q[j] = 0; }
#else
typedef unsigned U4 __attribute__((ext_vector_type(4)));
HD void ld8bf(const bf16_t* q, float* o) { const U4 w = *(const U4*)q;
#pragma unroll
    for (int j = 0; j < 4; ++j) { o[2 * j] = __uint_as_float(w[j] << 16); o[2 * j + 1] = __uint_as_float(w[j] & 0xffff0000u); } }
HD void ld8f(const float* q, float* o) { const F4 a = *(const F4*)q, b = *(const F4*)(q + 4); o[0] = a[0]; o[1] = a[1]; o[2] = a[2]; o[3] = a[3]; o[4] = b[0]; o[5] = b[1]; o[6] = b[2]; o[7] = b[3]; }
HD void st8f(float* q, const float* v) { *(F4*)q = (F4){v[0], v[1], v[2], v[3]}; *(F4*)(q + 4) = (F4){v[4], v[5], v[6], v[7]}; }
HD void st8bf(bf16_t* q, const float* v) { U4 w;
#pragma unroll
    for (int j = 0; j < 4; ++j) w[j] = (unsigned)f2bf(v[2 * j]) | ((unsigned)f2bf(v[2 * j + 1]) << 16);
    *(U4*)q = w; }
HD void cp8bf(bf16_t* q, const bf16_t* s) { *(U4*)q = *(const U4*)s; }
HD void z8bf(bf16_t* q) { *(U4*)q = (U4){0u, 0u, 0u, 0u}; }
#endif

HD void st_siluc(const P& p, int wv, int nwv, int lane) {
    GIDX; float* sc = WSP(float, silu_c);
    for (long i = gid; i < (long)(B_ + 1) * D_; i += gsz) { const int b = (int)(i / D_), k = (int)(i % D_); const float v = b < B_ ? p.c[(size_t)b * D_ + k] : p.c_ctx[k]; sc[i] = siluf_(v); }
}
HD void st_modv(const P& p, int wv, int nwv, int lane) {
    GIDX; const float* sc = WSP(float, silu_c); float* mv = WSP(float, modv);
    for (long i = gid; i < (long)L_ * 6 * D_; i += gsz) {
        const int l = (int)(i / (6 * D_)), col = (int)(i % (6 * D_));
        float acc[B_ + 1];
#pragma unroll
        for (int b = 0; b <= B_; ++b) acc[b] = 0.f;
        const float* w = p.w_mod + (size_t)l * D_ * 6 * D_ + col;
        for (int k = 0; k < D_; ++k) { const float wk = w[(size_t)k * 6 * D_];
#pragma unroll
            for (int b = 0; b <= B_; ++b) acc[b] += sc[b * D_ + k] * wk; }
        const float bm = p.b_mod[(size_t)l * 6 * D_ + col];
#pragma unroll
        for (int b = 0; b <= B_; ++b) mv[((size_t)l * (B_ + 1) + b) * 6 * D_ + col] = acc[b] + bm;
    }
}
HD void cvt_T(bf16_t* dst, const float* src, int Ndst, int K, int Nsrc, int nvalid, int src_col0, long gid, long gsz) {
    for (long i = gid; i < (long)Ndst * K; i += gsz) { const int n = (int)(i % Ndst), k = (int)(i / Ndst);
        dst[(size_t)n * K + k] = n < nvalid ? f2bf(src[(size_t)k * Nsrc + src_col0 + n]) : (bf16_t)0; }
}
HD void st_cvt1(const P& p, int l, int wv, int nwv, int lane) {
    GIDX;
    cvt_T(WSP(bf16_t, w_inT) + (size_t)l * NINP * D_, p.w_in + (size_t)l * D_ * NIN, NINP, D_, NIN, NIN, 0, gid, gsz);
    cvt_T(WSP(bf16_t, w_outT) + (size_t)l * D_ * MIXW, p.w_out + (size_t)l * MIXW * D_, D_, MIXW, D_, D_, 0, gid, gsz);
    cvt_T(WSP(bf16_t, shw2T) + (size_t)l * D_ * FF_, p.sh_w2 + (size_t)l * FF_ * D_, D_, FF_, D_, D_, 0, gid, gsz);
    cvt_T(WSP(bf16_t, gluT) + (size_t)l * SWP * SW, p.s5_glu_w + (size_t)l * SW * SW, SWP, SW, SW, SW, 0, gid, gsz);
}
HD void st_cvt2(const P& p, int l, int wv, int nwv, int lane) {
    GIDX;
    bf16_t* rs = WSP(bf16_t, rsT) + (size_t)l * NRS * D_;
    cvt_T(rs, p.router_w + (size_t)l * D_ * E_, EP, D_, E_, E_, 0, gid, gsz);
    for (int j = 0; j < FF_ / 128; ++j) {
        cvt_T(rs + (size_t)(EP + 256 * j) * D_, p.sh_w13 + (size_t)l * D_ * 2 * FF_, 128, D_, 2 * FF_, 128, 128 * j, gid, gsz);
        cvt_T(rs + (size_t)(EP + 256 * j + 128) * D_, p.sh_w13 + (size_t)l * D_ * 2 * FF_, 128, D_, 2 * FF_, 128, FF_ + 128 * j, gid, gsz);
    }
}
HD void st_cvt3(const P& p, int l, int wv, int nwv, int lane) {
    GIDX;
    for (long i = gid; i < (long)E_ * 2 * FF_ * D_; i += gsz) {
        const int n = (int)(i % (2 * FF_)); const long r = i / (2 * FF_); const int k = (int)(r % D_), e = (int)(r / D_);
        const int j = n / 256, w = n % 256, srcc = w < 128 ? 128 * j + w : FF_ + 128 * j + (w - 128);
        WSP(bf16_t, w13T)[(((size_t)l * E_ + e) * 2 * FF_ + n) * D_ + k] = f2bf(p.exp_w13[(((size_t)l * E_ + e) * D_ + k) * 2 * FF_ + srcc]);
    }
}
HD void st_cvt4(const P& p, int l, int wv, int nwv, int lane) {
    GIDX;
    for (long i = gid; i < (long)E_ * D_ * FF_; i += gsz) {
        const int n = (int)(i % D_); const long r = i / D_; const int k = (int)(r % FF_), e = (int)(r / FF_);
        WSP(bf16_t, w2T)[(((size_t)l * E_ + e) * D_ + n) * FF_ + k] = f2bf(p.exp_w2[(((size_t)l * E_ + e) * FF_ + k) * D_ + n]);
    }
}
HD void st_cvt5(const P& p, int l, int wv, int nwv, int lane) {
    GIDX;
    bf16_t* ws = WSP(bf16_t, wsmT) + (size_t)l * NSMP * KSM;
    for (long i = gid; i < (long)NSMP * KSM; i += gsz) {
        const int n = (int)(i / KSM), k = (int)(i % KSM); float v = 0.f;
        if (n < 2 * RW) { const int d = n / RW, c = n % RW, r = k - (OWD + d * RDR_); if (r >= 0 && r < RDR_) v = p.rwkv_w_up[(((size_t)l * 2 + d) * RDR_ + r) * RW + c]; }
        else if (n < 4 * RW) { const int d = (n - 2 * RW) / RW, c = n % RW, r = k - (OAD + d * RIR_); if (r >= 0 && r < RIR_) v = p.rwkv_a_up[(((size_t)l * 2 + d) * RIR_ + r) * RW + c]; }
        else if (n < 5 * RW) { const int c = n - 4 * RW, r = k - OGD; if (r >= 0 && r < RGR_) v = p.rwkv_g_up[((size_t)l * RGR_ + r) * RW + c]; }
        else if (n < NSM) { const int q = n - 5 * RW, d = q / GKD, c = q % GKD, r = k - (OGL + d * GGR_); if (r >= 0 && r < GGR_) v = p.gla_a_up[(((size_t)l * 2 + d) * GGR_ + r) * GKD + c]; }
        ws[i] = f2bf(v);
    }
}
HD void st_s5a(const P& p, int wv, int nwv, int lane) {
    GIDX; float* pw = WSP(float, s5pw); float* bb = WSP(float, s5bb);
    for (long i = gid; i < (long)L_ * 2 * SNG_ * SP_ * (CH_ + 1); i += gsz) {
        const int tau = (int)(i % (CH_ + 1)); long r = i / (CH_ + 1); const int pp = (int)(r % SP_); r /= SP_; const int g = (int)(r % SNG_); r /= SNG_; const int d = (int)(r % 2), l = (int)(r / 2);
        const double dt = exp((double)p.s5_log_dt[((size_t)l * 2 + d) * SNG_ + g]);
        const double zr = (double)p.s5_lam_re[((size_t)l * 2 + d) * SP_ + pp] * dt, zi = (double)p.s5_lam_im[((size_t)l * 2 + d) * SP_ + pp] * dt;
        const double mag = exp(zr * tau);
        pw[i * 2] = (float)(mag * cos(zi * tau)); pw[i * 2 + 1] = (float)(mag * sin(zi * tau));
    }
    for (long i = gid; i < (long)L_ * 2 * SNG_ * SP_ * SG_; i += gsz) {
        const int c = (int)(i % SG_); long r = i / SG_; const int pp = (int)(r % SP_); r /= SP_; const int g = (int)(r % SNG_); r /= SNG_; const int d = (int)(r % 2), l = (int)(r / 2);
        const double dt = exp((double)p.s5_log_dt[((size_t)l * 2 + d) * SNG_ + g]);
        const double lr = p.s5_lam_re[((size_t)l * 2 + d) * SP_ + pp], li = p.s5_lam_im[((size_t)l * 2 + d) * SP_ + pp];
        const double zr = lr * dt, zi = li * dt, mag = exp(zr), ar = mag * cos(zi), ai = mag * sin(zi), den = lr * lr + li * li;
        const double fr = ((ar - 1) * lr + ai * li) / den, fi = (ai * lr - (ar - 1) * li) / den;
        const size_t bi = ((((size_t)l * 2 + d) * SNG_ + g) * SP_ + pp) * SG_ + c;
        const double br = p.s5_b_re[bi], bim = p.s5_b_im[bi];
        bb[i * 2] = (float)(fr * br - fi * bim); bb[i * 2 + 1] = (float)(fr * bim + fi * br);
    }
}
HD void st_s5b(const P& p, int wv, int nwv, int lane) {
    GIDX; const float* pw = WSP(float, s5pw); const float* bb = WSP(float, s5bb); float* K = WSP(float, s5K);
    for (long i = gid; i < (long)L_ * 2 * SNG_ * CH_ * SG_ * SG_; i += gsz) {
        const int c2 = (int)(i % SG_); long r = i / SG_; const int c = (int)(r % SG_); r /= SG_; const int tau = (int)(r % CH_); r /= CH_; const long ldg = r;
        float acc = 0.f;
        for (int pp = 0; pp < SP_; ++pp) {
            const float cr = p.s5_c_re[(ldg * SG_ + c) * SP_ + pp], ci = p.s5_c_im[(ldg * SG_ + c) * SP_ + pp];
            const float ar = pw[((ldg * SP_ + pp) * (CH_ + 1) + tau) * 2], ai = pw[((ldg * SP_ + pp) * (CH_ + 1) + tau) * 2 + 1];
            const float br = bb[((ldg * SP_ + pp) * SG_ + c2) * 2], bi = bb[((ldg * SP_ + pp) * SG_ + c2) * 2 + 1];
            const float er = cr * ar - ci * ai, ei = cr * ai + ci * ar;
            acc += er * br - ei * bi;
        }
        K[i] = acc;
    }
}
static_assert(SG_ == 16 && K5 % 8 == 0 && KT5 % 8 == 0 && SP_ % 8 == 0, "s5c item shape");
HD void st_s5c(const P& p, int wv, int nwv, int lane) {
    GIDX; const float* pw = WSP(float, s5pw); const float* bb = WSP(float, s5bb); const float* K = WSP(float, s5K);
    bf16_t* Tb = WSP(bf16_t, s5Tb); bf16_t* Wa = WSP(bf16_t, s5Wa);
    for (long i = gid; i < (long)L_ * SNG_ * K5 * (KT5 / 8); i += gsz) {
        const int k = (int)(i % (KT5 / 8)) * 8; long r = i / (KT5 / 8); const int n = (int)(r % K5); r /= K5; const int g = (int)(r % SNG_), l = (int)(r / SNG_);
        const int t = n / SG_, c = n % SG_; float v[8];
        const long ldg0 = ((long)l * 2 + 0) * SNG_ + g, ldg1 = ((long)l * 2 + 1) * SNG_ + g;
        if (k < K5) { const int s = k / SG_, c2 = k % SG_; const float m0 = s <= t ? 1.f : 0.f, m1 = s >= t ? 1.f : 0.f; const int t0 = s <= t ? t - s : 0, t1 = s >= t ? s - t : 0;
            float a[8], b[8]; ld8f(K + ((ldg0 * CH_ + t0) * SG_ + c) * SG_ + c2, a); ld8f(K + ((ldg1 * CH_ + t1) * SG_ + c) * SG_ + c2, b);
            const float dd = p.s5_d[(size_t)l * SW + g * SG_ + c];
#pragma unroll
            for (int j = 0; j < 8; ++j) v[j] = m0 * a[j] + m1 * b[j] + ((s == t && c == c2 + j) ? dd : 0.f);
        } else { const int q = k - K5, d = q / (2 * SP_), part = (q / SP_) & 1, pp0 = q % SP_; const long ldg = d ? ldg1 : ldg0; const int ex = d ? (CH_ - t) : (t + 1);
            float cr[8], ci[8]; ld8f(p.s5_c_re + (ldg * SG_ + c) * SP_ + pp0, cr); ld8f(p.s5_c_im + (ldg * SG_ + c) * SP_ + pp0, ci);
#pragma unroll
            for (int j = 0; j < 8; ++j) { const float ar = pw[((ldg * SP_ + pp0 + j) * (CH_ + 1) + ex) * 2], ai = pw[((ldg * SP_ + pp0 + j) * (CH_ + 1) + ex) * 2 + 1];
                v[j] = part == 0 ? (cr[j] * ar - ci[j] * ai) : -(cr[j] * ai + ci[j] * ar); } }
        st8bf(Tb + i * 8, v);
    }
    for (long i = gid; i < (long)L_ * SNG_ * N5AP * (K5 / 8); i += gsz) {
        const int k = (int)(i % (K5 / 8)) * 8; long r = i / (K5 / 8); const int n = (int)(r % N5AP); r /= N5AP; const int g = (int)(r % SNG_), l = (int)(r / SNG_);
        float v[8];
#pragma unroll
        for (int j = 0; j < 8; ++j) v[j] = 0.f;
        if (n < N5A) { const int d = n / (2 * SP_), part = (n / SP_) & 1, pp = n % SP_, s = k / SG_, c2 = k % SG_; const long ldg = ((long)l * 2 + d) * SNG_ + g; const int ex = d ? s : (CH_ - 1 - s);
            const float ar = pw[((ldg * SP_ + pp) * (CH_ + 1) + ex) * 2], ai = pw[((ldg * SP_ + pp) * (CH_ + 1) + ex) * 2 + 1];
            float b0[8], b1[8]; ld8f(bb + ((ldg * SP_ + pp) * SG_ + c2) * 2, b0); ld8f(bb + ((ldg * SP_ + pp) * SG_ + c2) * 2 + 8, b1);
#pragma unroll
            for (int j = 0; j < 8; ++j) { const float br = j < 4 ? b0[2 * j] : b1[2 * (j - 4)], bi = j < 4 ? b0[2 * j + 1] : b1[2 * (j - 4) + 1]; v[j] = part == 0 ? (ar * br - ai * bi) : (ar * bi + ai * br); } }
        st8bf(Wa + i * 8, v);
    }
}
HD const float* xsrc0(const P& p, int n) { return n < NLAT ? p.x + (size_t)n * D_ : p.ctx + (size_t)(n - NLAT) * D_; }
HD void ln_stats(const float* z, int lane, float& mu, float& rstd) {
    float s = 0.f; for (int k = lane; k < D_; k += NL) s += z[k]; s = WSUM(s); mu = s * (1.0f / D_);
    float q = 0.f; for (int k = lane; k < D_; k += NL) { const float d = z[k] - mu; q += d * d; } q = WSUM(q); rstd = frsq(q * (1.0f / D_) + LN_EPS);
}
constexpr int PERL = D_ / NL, NCHK = PERL / 4;
HD void row_stats(const float* xv, float& mu, float& rstd) {
    float s = 0.f;
#pragma unroll
    for (int i = 0; i < PERL; ++i) s += xv[i];
    s = WSUM(s); mu = s * (1.0f / D_); float q = 0.f;
#pragma unroll
    for (int i = 0; i < PERL; ++i) { const float d = xv[i] - mu; q += d * d; }
    q = WSUM(q); rstd = frsq(q * (1.0f / D_) + LN_EPS);
}
HD void row_ld(const float* z, int lane, float* xv) {
#pragma unroll
    for (int i = 0; i < NCHK; ++i) { const F4 v = *(const F4*)(z + 4 * lane + 4 * NL * i); xv[4 * i] = v[0]; xv[4 * i + 1] = v[1]; xv[4 * i + 2] = v[2]; xv[4 * i + 3] = v[3]; }
}
HD void st4bf(bf16_t* q, const float* v) {
#ifdef CPU_TEST
    for (int j = 0; j < 4; ++j) q[j] = f2bf(v[j]);
#else
    uint2 w; w.x = (unsigned)f2bf(v[0]) | ((unsigned)f2bf(v[1]) << 16); w.y = (unsigned)f2bf(v[2]) | ((unsigned)f2bf(v[3]) << 16); *(uint2*)q = w;
#endif
}
HD void ld4bf(const bf16_t* q, float* o) {
#ifdef CPU_TEST
    for (int j = 0; j < 4; ++j) o[j] = bf2f(q[j]);
#else
    const uint2 w = *(const uint2*)q; o[0] = __uint_as_float(w.x << 16); o[1] = __uint_as_float(w.x & 0xffff0000u); o[2] = __uint_as_float(w.y << 16); o[3] = __uint_as_float(w.y & 0xffff0000u);
#endif
}
HD void row_mod_store(const float* xv, const float* mv, int sh_off, int sc_off, bf16_t* hrow, int lane) {
    float mu, rstd; row_stats(xv, mu, rstd);
#pragma unroll
    for (int i = 0; i < NCHK; ++i) { const int k = 4 * lane + 4 * NL * i; const F4 sc = *(const F4*)(mv + sc_off + k), sh = *(const F4*)(mv + sh_off + k); float o[4];
#pragma unroll
        for (int j = 0; j < 4; ++j) o[j] = (xv[4 * i + j] - mu) * rstd * (1.0f + sc[j]) + sh[j];
        st4bf(hrow + k, o); }
}
HD void row_affine(float* xv, const float* g, const float* bb, int lane) {
    float mu, rstd; row_stats(xv, mu, rstd);
#pragma unroll
    for (int i = 0; i < NCHK; ++i) { const int k = 4 * lane + 4 * NL * i; const F4 gg = *(const F4*)(g + k), be = *(const F4*)(bb + k);
#pragma unroll
        for (int j = 0; j < 4; ++j) xv[4 * i + j] = (xv[4 * i + j] - mu) * rstd * gg[j] + be[j]; }
}
HD void row_ld_bf(const bf16_t* z, int lane, float* xv) {
#pragma unroll
    for (int i = 0; i < NCHK; ++i) ld4bf(z + 4 * lane + 4 * NL * i, xv + 4 * i);
}
HD void row_st_bf(bf16_t* z, int lane, const float* xv) {
#pragma unroll
    for (int i = 0; i < NCHK; ++i) st4bf(z + 4 * lane + 4 * NL * i, xv + 4 * i);
}
HD void row_ld_x(const P& p, int l, int n, int lane, float* xv) { if (l == 0) row_ld(xsrc0(p, n), lane, xv); else row_ld_bf(WSP(bf16_t, xcur) + (size_t)n * D_, lane, xv); }
HD void row_st(float* z, int lane, const float* xv) {
#pragma unroll
    for (int i = 0; i < NCHK; ++i) { F4 v; v[0] = xv[4 * i]; v[1] = xv[4 * i + 1]; v[2] = xv[4 * i + 2]; v[3] = xv[4 * i + 3]; *(F4*)(z + 4 * lane + 4 * NL * i) = v; }
}
HD void st_hmod(const P& p, int l, int wv, int nwv, int lane) {
    bf16_t* h = WSP(bf16_t, h);
    for (int n = wv; n < NTOK; n += nwv) {
        float xv[PERL]; row_ld_x(p, l, n, lane, xv);
        const float* mv = WSP(float, modv) + ((size_t)l * (B_ + 1) + bidx_of(n)) * 6 * D_;
        row_mod_store(xv, mv, 0, D_, h + (size_t)n * D_, lane);
    }
}
static_assert(RCOLS % 8 == 0 && RW % 8 == 0 && RDR_ % 4 == 0, "prep1 groups");
HD void st_prep1(const P& p, int l, int wv, int nwv, int lane) {
    GIDX; const bf16_t* proj = WSP(bf16_t, proj); bf16_t* rkv = WSP(bf16_t, rkv); bf16_t* as = WSP(bf16_t, asmall); bf16_t* U2 = WSP(bf16_t, U2);
    const float* taps = p.rwkv_conv + (size_t)l * 9 * RCOLS; constexpr int NG = RCOLS / 8;
    for (long i0 = gid; i0 < (long)NTOK * NG; i0 += 2 * gsz) {
#pragma unroll
      for (int u2 = 0; u2 < 2; ++u2) { const long i = i0 + u2 * gsz; if (i < (long)NTOK * NG) {
        const int n = (int)(i / NG), ch = (int)(i % NG) * 8; float acc[8];
#pragma unroll
        for (int j = 0; j < 8; ++j) acc[j] = 0.f;
        if (n < NLAT) { const int b = n / T_, t = n % T_, gr = t / GW_, gc = t % GW_;
#pragma unroll
            for (int a = 0; a < 3; ++a)
#pragma unroll
                for (int j = 0; j < 3; ++j) { const int rr = gr + a - 1, cc = gc + j - 1; const bool ok = rr >= 0 && rr < ROWS_ && cc >= 0 && cc < GW_;
                    const int nn = ok ? b * T_ + rr * GW_ + cc : n; float x[8], w[8]; ld8bf(proj + (size_t)nn * NINP + ch, x); ld8f(taps + (a * 3 + j) * RCOLS + ch, w); const float m = ok ? 1.f : 0.f;
#pragma unroll
                    for (int q = 0; q < 8; ++q) acc[q] += (w[q] * m) * x[q]; }
        } else { const int s = (n - NLAT) % CTX_;
#pragma unroll
            for (int j = 0; j < 3; ++j) { const int ss = s + j - 1; const bool ok = ss >= 0 && ss < CTX_; const int nn = ok ? n + j - 1 : n; float x[8], w[8]; ld8bf(proj + (size_t)nn * NINP + ch, x); ld8f(taps + (3 + j) * RCOLS + ch, w); const float m = ok ? 1.f : 0.f;
#pragma unroll
                for (int q = 0; q < 8; ++q) acc[q] += (w[q] * m) * x[q]; } }
        if (ch < 3 * RW) st8bf(rkv + (size_t)n * 3 * RW + ch, acc);
        else { const int q0 = ch - 3 * RW;
            if (q0 < 2 * RDR_) {
#pragma unroll
                for (int q = 0; q < 8; ++q) acc[q] = ftanh(acc[q]); }
            else if (q0 >= 2 * RDR_ + 2 * RIR_) {
#pragma unroll
                for (int q = 0; q < 8; ++q) acc[q] = sigmoidf_(acc[q]); }
            st8bf(as + (size_t)n * KSM + q0, acc); }
          } }
    }
    constexpr int NT8 = (KSM - OGL) / 8;
    for (long i = gid; i < (long)NTOK * NT8; i += gsz) { const int n = (int)(i / NT8), q = (int)(i % NT8) * 8;
        if (q < 2 * GGR_) cp8bf(as + (size_t)n * KSM + OGL + q, proj + (size_t)n * NINP + GBASE + 2 * GKD + 2 * GWD + q); else z8bf(as + (size_t)n * KSM + OGL + q); }
    for (long i = gid; i < (long)B_ * SPOS * (SW / 8); i += gsz) { const int c = (int)(i % (SW / 8)) * 8; const long r = i / (SW / 8); const int pos = (int)(r % SPOS), b = (int)(r / SPOS);
        const int g = c / SG_, cc = c % SG_, pc = pos / CH_, t = pos % CH_, m = b * NPC + pc;
        cp8bf(U2 + ((size_t)g * M5P + m) * KT5 + t * SG_ + cc, proj + (size_t)row_of(b, pos) * NINP + SBASE + c); }
}
HD void st_s5carry(const P& p, int l, int wv, int nwv, int lane) {
    GIDX; const float* xl = WSP(float, xl); bf16_t* U2 = WSP(bf16_t, U2); const float* pw = WSP(float, s5pw);
    for (long i = gid; i < (long)2 * B_ * SNG_ * SP_; i += gsz) {
        const int pp = (int)(i % SP_); long r = i / SP_; const int g = (int)(r % SNG_); r /= SNG_; const int b = (int)(r % B_), d = (int)(r / B_);
        const long ldg = ((long)l * 2 + d) * SNG_ + g; const float ar = pw[((ldg * SP_ + pp) * (CH_ + 1) + CH_) * 2], ai = pw[((ldg * SP_ + pp) * (CH_ + 1) + CH_) * 2 + 1];
        float xr = 0.f, xi = 0.f;
        for (int q = 0; q < NPC; ++q) {
            const int pc = d == 0 ? q : (q < NPCC ? NPCC - 1 - q : NPC - 1 - (q - NPCC)); const size_t m = (size_t)b * NPC + pc;
            bf16_t* x0 = U2 + ((size_t)g * M5P + m) * KT5 + K5 + d * 2 * SP_; x0[pp] = f2bf(xr); x0[SP_ + pp] = f2bf(xi);
            const float lr = xl[((size_t)g * M5P + m) * N5AP + d * 2 * SP_ + pp], li = xl[((size_t)g * M5P + m) * N5AP + d * 2 * SP_ + SP_ + pp];
            const float nr = ar * xr - ai * xi + lr, ni = ar * xi + ai * xr + li; xr = nr; xi = ni;
        }
    }
}
struct RV { float r, w, k2, a, b, v, kkraw; };
HD void rwkv_elem(const P& p, int l, int d, int n, int hh, int j, float kknorm_rs, RV& o) {
    const bf16_t* rkv = WSP(bf16_t, rkv) + (size_t)n * 3 * RW; const float* gs = WSP(float, gs) + (size_t)n * NGF; const bf16_t* gb = WSP(bf16_t, gsb) + (size_t)n * NGB; const int c = hh * RN_ + j;
    const float k = bf2f(rkv[RW + c]); o.kkraw = k * p.rwkv_k_k[(size_t)l * RW + c]; const float kk = o.kkraw * kknorm_rs;
    const float a = bf2f(gb[d * RW + c]); o.w = fexp(gs[d * RW + c]); o.k2 = k * (1.0f + (a - 1.0f) * p.rwkv_k_a[(size_t)l * RW + c]);
    o.a = -kk; o.b = kk * a; o.r = bf2f(rkv[c]); o.v = bf2f(rkv[2 * RW + c]);
}
HD void st_post(const P& p, int l, int wv, int nwv, int lane) {
    bf16_t* ymix = WSP(bf16_t, ymix); const float* yr = WSP(float, yr); const float* og = WSP(float, og); const bf16_t* proj = WSP(bf16_t, proj); const bf16_t* gsbb = WSP(bf16_t, gsb); const bf16_t* rkvb = WSP(bf16_t, rkv);
    const int nrow = (l == L_ - 1) ? NLAT : NTOK; constexpr int PJ = RN_ / NL;
    for (int n = wv; n < nrow; n += nwv) {
        const bf16_t* rk = rkvb + (size_t)n * 3 * RW; const bf16_t* gb = gsbb + (size_t)n * NGB;
        float r_[RH_][PJ], k_[RH_][PJ], v_[RH_][PJ], y_[RH_][PJ], a0_[RH_][PJ], a1_[RH_][PJ], g_[RH_][PJ], o_[GH_][PJ], gg_[GH_][PJ];
#pragma unroll
        for (int hh = 0; hh < RH_; ++hh)
#pragma unroll
            for (int q = 0; q < PJ; ++q) { const int c = hh * RN_ + lane + NL * q; r_[hh][q] = bf2f(rk[c]); k_[hh][q] = bf2f(rk[RW + c]); v_[hh][q] = bf2f(rk[2 * RW + c]);
                y_[hh][q] = yr[(size_t)n * RW + c] + yr[((size_t)NTOK + n) * RW + c]; a0_[hh][q] = bf2f(gb[c]); a1_[hh][q] = bf2f(gb[RW + c]); g_[hh][q] = bf2f(gb[2 * RW + c]); }
#pragma unroll
        for (int hh = 0; hh < GH_; ++hh)
#pragma unroll
            for (int q = 0; q < PJ; ++q) { const int c = hh * GV_ + lane + NL * q; o_[hh][q] = og[(size_t)n * GWD + c] + og[((size_t)NTOK + n) * GWD + c]; gg_[hh][q] = bf2f(proj[(size_t)n * NINP + GBASE + 2 * GKD + GWD + c]); }
#pragma unroll
        for (int hh = 0; hh < RH_; ++hh) {
            float s = 0.f, bs = 0.f;
#pragma unroll
            for (int q = 0; q < PJ; ++q) { const int c = hh * RN_ + lane + NL * q; const float ka = p.rwkv_k_a[(size_t)l * RW + c];
                const float k20 = k_[hh][q] * (1.0f + (a0_[hh][q] - 1.0f) * ka), k21 = k_[hh][q] * (1.0f + (a1_[hh][q] - 1.0f) * ka);
                s += y_[hh][q]; bs += r_[hh][q] * (k20 + k21) * p.rwkv_r_k[(size_t)l * RW + c]; }
            s = WSUM(s); bs = WSUM(bs); const float mu = s * (1.0f / RN_); float qq = 0.f;
#pragma unroll
            for (int q = 0; q < PJ; ++q) { const float d = y_[hh][q] - mu; qq += d * d; }
            qq = WSUM(qq); const float rstd = 1.0f / sqrtf(qq * (1.0f / RN_) + GN_EPS);
#pragma unroll
            for (int q = 0; q < PJ; ++q) { const int c = hh * RN_ + lane + NL * q; const float gn = (y_[hh][q] - mu) * rstd * p.rwkv_ln_g[(size_t)l * RW + c] + p.rwkv_ln_b[(size_t)l * RW + c];
                ymix[(size_t)n * MIXW + c] = f2bf((gn + bs * v_[hh][q]) * g_[hh][q]); }
        }
#pragma unroll
        for (int hh = 0; hh < GH_; ++hh) { float qq = 0.f;
#pragma unroll
            for (int q = 0; q < PJ; ++q) qq += o_[hh][q] * o_[hh][q];
            qq = WSUM(qq); const float rs = 1.0f / sqrtf(qq * (1.0f / GV_) + 1e-6f);
#pragma unroll
            for (int q = 0; q < PJ; ++q) { const int j = lane + NL * q; ymix[(size_t)n * MIXW + RW + hh * GV_ + j] = f2bf(o_[hh][q] * rs * p.gla_norm_g[(size_t)l * GV_ + j] * siluf_(gg_[hh][q])); }
        }
    }
}
HD void st_ln1(const P& p, int l, int wv, int nwv, int lane) {
    GIDX; const float alpha = sqrtf(2.0f);
    for (long i = gid; i < E_; i += gsz) { WSP(int, ecnt)[i] = 0; WSP(int, efill)[i] = 0; }
    const int nrow = (l == L_ - 1) ? NLAT : NTOK; bf16_t* x1 = WSP(bf16_t, x1); bf16_t* h2 = WSP(bf16_t, h2); const bf16_t* yo = WSP(bf16_t, yo);
    for (int n = wv; n < nrow; n += nwv) {
        const float* mv = WSP(float, modv) + ((size_t)l * (B_ + 1) + bidx_of(n)) * 6 * D_;
        float xv[PERL], yv[PERL]; row_ld_x(p, l, n, lane, xv); row_ld_bf(yo + (size_t)n * D_, lane, yv);
#pragma unroll
        for (int i = 0; i < NCHK; ++i) { const F4 g1 = *(const F4*)(mv + 2 * D_ + 4 * lane + 4 * NL * i);
#pragma unroll
            for (int j = 0; j < 4; ++j) xv[4 * i + j] = alpha * xv[4 * i + j] + g1[j] * yv[4 * i + j]; }
        row_affine(xv, p.ln1_g + (size_t)l * D_, p.ln1_b + (size_t)l * D_, lane);
        row_st_bf(x1 + (size_t)n * D_, lane, xv);
        row_mod_store(xv, mv, 3 * D_, 4 * D_, h2 + (size_t)n * D_, lane);
    }
}
HD void st_topk(const P& p, int l, int wv, int nwv, int lane) {
    GIDX; const int nrow = (l == L_ - 1) ? NLAT : NTOK; const float* lg = WSP(float, logits); constexpr int EG = E_ / NGRP_;
    for (long n = gid; n < nrow; n += gsz) {
        const float* z = lg + (size_t)n * E_; const float* rb = p.router_bias + (size_t)l * E_;
        float gsc[NGRP_];
#pragma unroll
        for (int g = 0; g < NGRP_; ++g) { float m1 = -1e30f, m2 = -1e30f;
            for (int e = 0; e < EG; ++e) { const float s = sigmoidf_(z[g * EG + e]) + rb[g * EG + e]; if (s > m1) { m2 = m1; m1 = s; } else if (s > m2) m2 = s; }
            gsc[g] = m1 + m2; }
        unsigned gmask = 0;
#pragma unroll
        for (int g = 0; g < NGRP_; ++g) { int rank = 0;
#pragma unroll
            for (int g2 = 0; g2 < NGRP_; ++g2) rank += (gsc[g2] > gsc[g] || (gsc[g2] == gsc[g] && g2 < g)) ? 1 : 0;
            if (rank < TKG_) gmask |= 1u << g; }
        float pv = 1e30f; int pi = -1; float wsum = 0.f; int* ei = WSP(int, eidx) + (size_t)n * TOPK_; float* ew = WSP(float, ewt) + (size_t)n * TOPK_;
        for (int kk = 0; kk < TOPK_; ++kk) { float bv = -1e30f; int bi = -1;
            for (int e = 0; e < E_; ++e) { if (!((gmask >> (e / EG)) & 1u)) continue; const float s = sigmoidf_(z[e]) + rb[e];
                const bool after = (s < pv) || (s == pv && e > pi); if (after && s > bv) { bv = s; bi = e; } }
            pv = bv; pi = bi; ei[kk] = bi; const float w = sigmoidf_(z[bi]); ew[kk] = w; wsum += w; }
        for (int kk = 0; kk < TOPK_; ++kk) ew[kk] = ew[kk] / wsum * 2.5f;
#ifdef CPU_TEST
        for (int kk = 0; kk < TOPK_; ++kk) WSP(int, ecnt)[ei[kk]]++;
#else
        for (int kk = 0; kk < TOPK_; ++kk) atomicAdd(WSP(int, ecnt) + ei[kk], 1);
#endif
    }
}
HD void st_offsets(const P& p, int l, int wv, int nwv, int lane) {
    if (wv != 0 || lane != 0) return;
    int* eoff = WSP(int, eoff); const int* ecnt = WSP(int, ecnt); int* ul = WSP(int, ulist); int o = 0, nu = 0;
    for (int e = 0; e < E_; ++e) { eoff[e] = o; const int nt = (ecnt[e] + 255) / 256;
        for (int t = 0; t < nt; ++t) { ul[nu * 4 + 0] = o + 256 * t; ul[nu * 4 + 1] = e; ul[nu * 4 + 2] = (ecnt[e] - 256 * t) < 256 ? (ecnt[e] - 256 * t) : 256; ul[nu * 4 + 3] = 0; ++nu; }
        o += nt * 256; }
    eoff[E_] = o; WSP(int, nunits)[0] = nu;
}
HD void st_scatter0(const P& p, int l, int wv, int nwv, int lane) { GIDX; int* st = WSP(int, slot_tok); for (long i = gid; i < NSLOT; i += gsz) st[i] = 0; }
HD void st_scatter(const P& p, int l, int wv, int nwv, int lane) {
    GIDX; const int nrow = (l == L_ - 1) ? NLAT : NTOK; const int* ei = WSP(int, eidx); const int* eoff = WSP(int, eoff); int* so = WSP(int, slot_of); int* st = WSP(int, slot_tok);
    for (long i = gid; i < (long)nrow * TOPK_; i += gsz) { const int e = ei[i];
#ifdef CPU_TEST
        const int r = WSP(int, efill)[e]++;
#else
        const int r = atomicAdd(WSP(int, efill) + e, 1);
#endif
        const int s = eoff[e] + r; so[i] = s; st[s] = (int)(i / TOPK_); }
}
HD void st_ln2(const P& p, int l, int wv, int nwv, int lane) {
    const float alpha = sqrtf(2.0f); const bool last = (l == L_ - 1); const int nrow = last ? NLAT : NTOK;
    const bf16_t* x1 = WSP(bf16_t, x1); const bf16_t* Y = WSP(bf16_t, Y); const bf16_t* Ysh = WSP(bf16_t, Ysh); const int* so = WSP(int, slot_of); const float* ew = WSP(float, ewt);
    for (int n = wv; n < nrow; n += nwv) {
        const float* mv = WSP(float, modv) + ((size_t)l * (B_ + 1) + bidx_of(n)) * 6 * D_;
        float xv[PERL], fv[PERL]; row_ld_bf(x1 + (size_t)n * D_, lane, xv);
#pragma unroll
        for (int i = 0; i < NCHK; ++i) ld4bf(Ysh + (size_t)n * D_ + 4 * lane + 4 * NL * i, fv + 4 * i);
#pragma unroll
        for (int kk = 0; kk < TOPK_; ++kk) { const float w = ew[(size_t)n * TOPK_ + kk]; const bf16_t* yr_ = Y + (size_t)so[(size_t)n * TOPK_ + kk] * D_;
#pragma unroll
            for (int i = 0; i < NCHK; ++i) { float t4[4]; ld4bf(yr_ + 4 * lane + 4 * NL * i, t4);
#pragma unroll
                for (int j = 0; j < 4; ++j) fv[4 * i + j] += w * t4[j]; } }
#pragma unroll
        for (int i = 0; i < NCHK; ++i) { const F4 g2 = *(const F4*)(mv + 5 * D_ + 4 * lane + 4 * NL * i);
#pragma unroll
            for (int j = 0; j < 4; ++j) xv[4 * i + j] = alpha * xv[4 * i + j] + g2[j] * fv[4 * i + j]; }
        row_affine(xv, p.ln2_g + (size_t)l * D_, p.ln2_b + (size_t)l * D_, lane);
        if (last) row_st(p.out + (size_t)n * D_, lane, xv);
        else { row_st_bf(WSP(bf16_t, xcur) + (size_t)n * D_, lane, xv);
            const float* mv2 = WSP(float, modv) + ((size_t)(l + 1) * (B_ + 1) + bidx_of(n)) * 6 * D_;
            row_mod_store(xv, mv2, 0, D_, WSP(bf16_t, h) + (size_t)n * D_, lane); }
    }
}
struct UnitInfo { int arow0, brow0, g, pm, pn, nv; };
struct GemmArgs { const bf16_t* A; int lda; const int* rowmap; const bf16_t* Bt; int ldb; int K; };

struct StaticSched {
    int nb, nM, nN, aM, bN, G, c;
    HDM void init(int nb_, int M, int N, int aM_, int bN_, int G_, int c_) { nb = nb_; nM = M / 256; nN = N / 256; aM = aM_; bN = bN_; G = G_; c = c_; }
    HDM int max_units() const { return (nb * nM * nN + G - 1) / G; }
    HDM bool next(int i, UnitInfo& u) const {
        const long L = (long)i * G + c; const int per = nM * nN; if (L >= (long)nb * per) return false;
        const int g = (int)(L / per); int wgid = (int)(L % per);
        { const int q = per / 8, r = per % 8, xcd = wgid % 8, off = wgid / 8; wgid = (xcd < r ? xcd * (q + 1) : r * (q + 1) + (xcd - r) * q) + off; }
        const int nig = 8 * nN, gid = wgid / nig, fm = gid * 8, gsz = (nM - fm) < 8 ? (nM - fm) : 8;
        u.pm = fm + ((wgid % nig) % gsz); u.pn = (wgid % nig) / gsz; u.g = g; u.arow0 = g * aM + 256 * u.pm; u.brow0 = g * bN + 256 * u.pn; u.nv = 256; return true;
    }
};
HD int ld_int(const int* q) {
#ifdef CPU_TEST
    return *q;
#else
    return __hip_atomic_load(q, __ATOMIC_RELAXED, __HIP_MEMORY_SCOPE_AGENT);
#endif
}
struct ListSched {
    const int* ulist; const int* nunits; int ntn, bN, G, c;
    HDM int max_units() const { return 0; }
    HDM bool next(int i, UnitInfo& u) const {
        const long L = (long)i * G + c; const int nt = ld_int(nunits); if (L >= (long)((nt + 7) / 8) * 8 * ntn) return false;
        const int r_ = (int)(L % (8 * ntn)); const int t = (r_ & 7) * ((nt + 7) / 8) + (int)(L / (8 * ntn)), pn = r_ >> 3; if (t >= nt) return false;
        const int s0 = ld_int(ulist + 4 * t), e = ld_int(ulist + 4 * t + 1);
        u.arow0 = s0; u.brow0 = e * bN + 256 * pn; u.g = e; u.pm = s0 / 256; u.pn = pn; u.nv = ld_int(ulist + 4 * t + 2); return true;
    }
};

#ifndef PROBE_EpiBf16Plain
#define PROBE_EpiBf16Plain false
#endif
#ifndef PROBE_EpiF32Plain
#define PROBE_EpiF32Plain false
#endif
#ifndef PROBE_EpiSmall
#define PROBE_EpiSmall false
#endif
#ifndef PROBE_EpiS5b
#define PROBE_EpiS5b false
#endif
#ifndef PROBE_EpiGlu
#define PROBE_EpiGlu false
#endif
#ifndef PROBE_EpiRS
#define PROBE_EpiRS false
#endif
#ifndef PROBE_EpiUp
#define PROBE_EpiUp false
#endif
#ifndef PROBE_EpiDown
#define PROBE_EpiDown false
#endif
HD void st4_bf16(bf16_t* q, const F4& v) {
#ifdef CPU_TEST
    for (int j = 0; j < 4; ++j) q[j] = f2bf(v[j]);
#else
    uint2 w; w.x = (unsigned)f2bf(v[0]) | ((unsigned)f2bf(v[1]) << 16); w.y = (unsigned)f2bf(v[2]) | ((unsigned)f2bf(v[3]) << 16); *(uint2*)q = w;
#endif
}
HD void st4_f32(float* q, const F4& v) {
#ifdef CPU_TEST
    for (int j = 0; j < 4; ++j) q[j] = v[j];
#else
    *(F4*)q = v;
#endif
}
HD void st8_bf16(bf16_t* q, const F4& lo, const F4& hi) {
#ifdef CPU_TEST
    for (int j = 0; j < 4; ++j) { q[j] = f2bf(lo[j]); q[4 + j] = f2bf(hi[j]); }
#else
    typedef unsigned U4e __attribute__((ext_vector_type(4))); U4e w;
    w[0] = (unsigned)f2bf(lo[0]) | ((unsigned)f2bf(lo[1]) << 16); w[1] = (unsigned)f2bf(lo[2]) | ((unsigned)f2bf(lo[3]) << 16);
    w[2] = (unsigned)f2bf(hi[0]) | ((unsigned)f2bf(hi[1]) << 16); w[3] = (unsigned)f2bf(hi[2]) | ((unsigned)f2bf(hi[3]) << 16); *(U4e*)q = w;
#endif
}
HD int perm32(int rho) { const int n = rho >> 4, i = rho & 15; return 8 * (i >> 2) + 4 * n + (i & 3); }
struct EpiBf16Plain { static constexpr bool PROBE = PROBE_EpiBf16Plain; bf16_t* O; int ldo; HDM void shift() { O += 800000000; }
    static constexpr bool PERM = true;
    HDM void st8(const UnitInfo& u, int r, int c, const F4& al, const F4& ah, const F4& bl, const F4& bh) const { bf16_t* q = O + (size_t)(256 * u.pm + r) * ldo + 256 * u.pn + c; st8_bf16(q, al, ah); st8_bf16(q + 128, bl, bh); } };
struct EpiF32Plain { static constexpr bool PROBE = PROBE_EpiF32Plain; static constexpr bool PERM = false; HDM void shift() {} float* O; int ldo; size_t gstride;
    HDM void st(const UnitInfo& u, int r, int c, const F4& v0, const F4& v1) const { float* q = O + (size_t)u.g * gstride + (size_t)(256 * u.pm + r) * ldo + 256 * u.pn + c; st4_f32(q, v0); st4_f32(q + 128, v1); } };
struct EpiSmall { static constexpr bool PROBE = PROBE_EpiSmall; static constexpr bool PERM = false; HDM void shift() {} float* gs; bf16_t* gsb; const float* w0; const float* a0; const float* ab;
    HDM void half(int n, int col, const F4& v) const {
        if (col >= NSM) return; F4 o;
        if (col < 2 * RW) { for (int j = 0; j < 4; ++j) { float w = w0[col + j] + v[j]; w = -softplusf_(-w) - 0.5f; o[j] = -fexp(w); } st4_f32(gs + (size_t)n * NGF + col, o); }
        else if (col < 4 * RW) { for (int j = 0; j < 4; ++j) o[j] = sigmoidf_(a0[col - 2 * RW + j] + v[j]); st4_bf16(gsb + (size_t)n * NGB + (col - 2 * RW), o); }
        else if (col < 5 * RW) st4_bf16(gsb + (size_t)n * NGB + 2 * RW + (col - 4 * RW), v);
        else { for (int j = 0; j < 4; ++j) o[j] = -softplusf_(-(v[j] + ab[col - 5 * RW + j])) * (1.0f / 16.0f); st4_f32(gs + (size_t)n * NGF + 2 * RW + (col - 5 * RW), o); }
    }
    HDM void st(const UnitInfo& u, int r, int c, const F4& v0, const F4& v1) const { const int n = 256 * u.pm + r, col = 256 * u.pn + c; half(n, col, v0); half(n, col + 128, v1); } };
struct EpiS5b { static constexpr bool PROBE = PROBE_EpiS5b; static constexpr bool PERM = true; HDM void shift() {} bf16_t* yc;
    HDM void half(const UnitInfo& u, int b, int pc, int col, const F4& lo, const F4& hi) const { const int t = col / SG_, cc = col % SG_; const int n = row_of(b, pc * CH_ + t);
        F4 ol, oh; for (int j = 0; j < 4; ++j) { ol[j] = geluf_(lo[j]); oh[j] = geluf_(hi[j]); } st8_bf16(yc + (size_t)n * SW + u.g * SG_ + cc, ol, oh); }
    HDM void st8(const UnitInfo& u, int r, int c, const F4& al, const F4& ah, const F4& bl, const F4& bh) const {
        const int m = 256 * u.pm + r; if (m >= M5) return; const int b = m / NPC, pc = m % NPC; half(u, b, pc, 256 * u.pn + c, al, ah); half(u, b, pc, 256 * u.pn + c + 128, bl, bh); } };
HD void ld4_bf16(const bf16_t* q, F4& o) {
#ifdef CPU_TEST
    for (int j = 0; j < 4; ++j) o[j] = bf2f(q[j]);
#else
    const uint2 w = *(const uint2*)q; o[0] = __uint_as_float(w.x << 16); o[1] = __uint_as_float(w.x & 0xffff0000u); o[2] = __uint_as_float(w.y << 16); o[3] = __uint_as_float(w.y & 0xffff0000u);
#endif
}
struct EpiGlu { static constexpr bool PROBE = PROBE_EpiGlu; static constexpr bool PERM = true; HDM void shift() {} bf16_t* ymix; const bf16_t* yc; const float* gb;
    HDM void half(int n, int col, const F4& lo, const F4& hi) const { if (col >= SW) return; F4 y0, y1, ol, oh; ld4_bf16(yc + (size_t)n * SW + col, y0); ld4_bf16(yc + (size_t)n * SW + col + 4, y1);
        for (int j = 0; j < 4; ++j) { ol[j] = y0[j] * sigmoidf_(lo[j] + gb[col + j]); oh[j] = y1[j] * sigmoidf_(hi[j] + gb[col + 4 + j]); } st8_bf16(ymix + (size_t)n * MIXW + RW + GWD + col, ol, oh); }
    HDM void st8(const UnitInfo& u, int r, int c, const F4& al, const F4& ah, const F4& bl, const F4& bh) const { const int n = 256 * u.pm + r, col = 256 * u.pn + c; half(n, col, al, ah); half(n, col + 128, bl, bh); } };
struct EpiRS { static constexpr bool PROBE = PROBE_EpiRS; static constexpr bool PERM = true; HDM void shift() {} float* logits; bf16_t* sact;
    HDM void st8(const UnitInfo& u, int r, int c, const F4& al, const F4& ah, const F4& bl, const F4& bh) const {
        const int n = 256 * u.pm + r;
        if (u.pn < EP / 256) { const int col = 256 * u.pn + c; if (col < E_) { st4_f32(logits + (size_t)n * E_ + col, al); st4_f32(logits + (size_t)n * E_ + col + 4, ah); } if (col + 128 < E_) { st4_f32(logits + (size_t)n * E_ + col + 128, bl); st4_f32(logits + (size_t)n * E_ + col + 132, bh); } }
        else { const int j = u.pn - EP / 256; F4 ol, oh; for (int q = 0; q < 4; ++q) { ol[q] = siluf_(al[q]) * bl[q]; oh[q] = siluf_(ah[q]) * bh[q]; } st8_bf16(sact + (size_t)n * FF_ + 128 * j + c, ol, oh); }
    } };
struct EpiUp { static constexpr bool PROBE = PROBE_EpiUp; static constexpr bool PERM = true; HDM void shift() {} bf16_t* act;
    HDM void st8(const UnitInfo& u, int r, int c, const F4& al, const F4& ah, const F4& bl, const F4& bh) const { if (r >= u.nv) return; F4 ol, oh; for (int q = 0; q < 4; ++q) { ol[q] = siluf_(al[q]) * bl[q]; oh[q] = siluf_(ah[q]) * bh[q]; } st8_bf16(act + (size_t)(u.arow0 + r) * FF_ + 128 * u.pn + c, ol, oh); } };
struct EpiDown { static constexpr bool PROBE = PROBE_EpiDown; static constexpr bool PERM = true; HDM void shift() {} bf16_t* Y;
    HDM void st8(const UnitInfo& u, int r, int c, const F4& al, const F4& ah, const F4& bl, const F4& bh) const { if (r >= u.nv) return; bf16_t* q = Y + (size_t)(u.arow0 + r) * D_ + 256 * u.pn + c; st8_bf16(q, al, ah); st8_bf16(q + 128, bl, bh); } };

#ifdef CPU_TEST
template <class Epi, class Sched> static void gemm_phase(const GemmArgs& g, const Sched& S, const Epi& E) {
    UnitInfo u; std::vector<float> arow(g.K);
    for (int i = 0; S.next(i, u); ++i)
        for (int r = 0; r < 256; ++r) {
            const int ar = g.rowmap ? g.rowmap[u.arow0 + r] : u.arow0 + r; const bf16_t* a = g.A + (size_t)ar * g.lda;
            for (int k = 0; k < g.K; ++k) arow[k] = bf2f(a[k]);
            float out[256];
            for (int c = 0; c < 256; ++c) { const bf16_t* b0 = g.Bt + (size_t)(u.brow0 + c) * g.ldb; float s0 = 0.f; for (int k = 0; k < g.K; ++k) s0 += arow[k] * bf2f(b0[k]); out[c] = s0; }
            if constexpr (Epi::PERM) { for (int c = 0; c < 128; c += 8) { F4 al, ah, bl, bh; for (int j = 0; j < 4; ++j) { al[j] = out[c + j]; ah[j] = out[c + 4 + j]; bl[j] = out[128 + c + j]; bh[j] = out[128 + c + 4 + j]; } E.st8(u, r, c, al, ah, bl, bh); } }
            else { for (int c = 0; c < 128; c += 4) { F4 v0, v1; for (int j = 0; j < 4; ++j) { v0[j] = out[c + j]; v1[j] = out[128 + c + j]; } E.st(u, r, c, v0, v1); } }
        }
}
#else
#define LAS __attribute__((address_space(3)))
typedef short bf16x8 __attribute__((ext_vector_type(8)));
constexpr int HTB = 128 * 64 * 2, STAGE_BYTES = 8 * HTB;
HD int lds_byte(int r, int c) { const int st = (r >> 4) * 2 + (c >> 5), rr = r & 15, cc = c & 31, ob = rr * 64 + cc * 2; return st * 1024 + (ob ^ (((ob >> 9) & 1) << 5)); }
HD void stage_rc(int b, int& R, int& C) { const int st = b / 1024, sb = b % 1024, swz = sb ^ (((sb >> 9) & 1) << 5); R = (st >> 1) * 16 + swz / 64; C = (st & 1) * 32 + (swz % 64) / 2; }

struct XcdBarrier; __device__ __forceinline__ void xcd_barrier(const XcdBarrier& b);
#ifndef GP_RS
#define GP_RS 0
#endif
HD int lane_id() { return (int)__builtin_amdgcn_mbcnt_hi(~0u, __builtin_amdgcn_mbcnt_lo(~0u, 0u)); }
template <bool GATHER, class Epi, class Sched>
__device__ __forceinline__ void gemm_phase(LAS unsigned char* lds, const int wid, const GemmArgs g, const Sched& S, const Epi& E, const XcdBarrier* pbar) {
    int lane = lane_id(); asm volatile("" : "+v"(lane)); const int tid = wid * 64 + lane;
    const int wr = wid >> 2, wc = wid & 3, fr = lane & 15, fq = lane >> 4;
    float zero_ = 0.f; asm volatile("" : "+v"(zero_));
    const int nt = g.K / 64;
    const unsigned ldsw = (unsigned)wid * 1024u;
    const int aoff = lds_byte(wr * 64 + fr, fq * 8), boff = lds_byte(wc * 32 + fr, fq * 8);
    const char* Ab = (const char*)g.A; const char* Bb = (const char*)g.Bt;
#define G_SA(b, h) (((b) * 2 + (h)) * HTB)
#define G_SB(b, h) ((4 + (b) * 2 + (h)) * HTB)
#define G_STAGE(bufoff, gbase, voff) do { _Pragma("unroll") for (int _i = 0; _i < 2; ++_i) \
        __builtin_amdgcn_global_load_lds((const unsigned*)((gbase) + (voff)[_i]), (LAS unsigned*)(lds + (bufoff) + ldsw + _i * 8192), 16, 0, 0); } while (0)
#define G_LDA(dst, b, h) do { _Pragma("unroll") for (int m = 0; m < 4; ++m) _Pragma("unroll") for (int k = 0; k < 2; ++k) dst[m][k] = *(const LAS bf16x8*)(lds + G_SA(b, h) + aoff + m * 2048 + k * 1024); } while (0)
#define G_LDB(dst, b, h) do { _Pragma("unroll") for (int n = 0; n < 2; ++n) _Pragma("unroll") for (int k = 0; k < 2; ++k) dst[n][k] = *(const LAS bf16x8*)(lds + G_SB(b, h) + boff + n * 2048 + k * 1024); } while (0)
#define G_MMA(ai, bj, At, Bt) do { __builtin_amdgcn_s_setprio(1); _Pragma("unroll") for (int m = 0; m < 4; ++m) _Pragma("unroll") for (int n = 0; n < 2; ++n) _Pragma("unroll") for (int k = 0; k < 2; ++k) \
        acc[ai][bj][m][n] = __builtin_amdgcn_mfma_f32_16x16x32_bf16(Bt[n][k], At[m][k], acc[ai][bj][m][n], 0, 0, 0); __builtin_amdgcn_s_setprio(0); } while (0)
#define G_WAIT_V(n) asm volatile("s_waitcnt vmcnt(" #n ")" ::: "memory")
#define G_WAIT_L(n) asm volatile("s_waitcnt lgkmcnt(" #n ")" ::: "memory")
#define G_BAR __builtin_amdgcn_s_barrier()
#define G_SCHED __builtin_amdgcn_sched_barrier(0)
    const unsigned hA = 128u * (unsigned)g.lda * 2u, hB = 128u * (unsigned)g.ldb * 2u;
#define G_SETOFF(u) do { int _t = lane_id(); asm volatile("" : "+v"(_t)); _t += wid * 64; _Pragma("unroll") for (int _i = 0; _i < 2; ++_i) { int _R, _C; stage_rc(_t * 16 + _i * 8192, _R, _C); \
        const int _Rb = Epi::PERM ? ((_R & ~31) + perm32(_R & 31)) : _R; OB[_i] = ((unsigned)((u).brow0 + _Rb) * (unsigned)g.ldb + (unsigned)_C) * 2u; \
        if (GATHER) { OA[0][_i] = ((unsigned)ld_int(g.rowmap + (u).arow0 + _R) * (unsigned)g.lda + (unsigned)_C) * 2u; OA[1][_i] = ((unsigned)ld_int(g.rowmap + (u).arow0 + 128 + _R) * (unsigned)g.lda + (unsigned)_C) * 2u; } \
        else { OA[0][_i] = ((unsigned)((u).arow0 + _R) * (unsigned)g.lda + (unsigned)_C) * 2u; } } } while (0)
#define G_STA(bufoff, h, kb) G_STAGE(bufoff, Ab + (kb) + (GATHER ? 0u : (h) * hA), OA[GATHER ? (h) : 0])
#define G_STB(bufoff, h, kb) G_STAGE(bufoff, Bb + (kb) + (h) * hB, OB)
#ifndef GP_K2
#define GP_K2 0
#endif
#ifndef GP_E2
#define GP_E2 0
#endif
    constexpr bool K2 = GP_K2 && Epi::PROBE, E2 = GP_E2 && Epi::PROBE;
    UnitInfo cur, nxt; int ui = 0;
    if (!S.next(0, cur)) return;
    F4 acc[2][2][4][2];
#pragma unroll
    for (int a = 0; a < 2; ++a)
#pragma unroll
        for (int b = 0; b < 2; ++b)
#pragma unroll
            for (int m = 0; m < 4; ++m)
#pragma unroll
                for (int n = 0; n < 2; ++n) acc[a][b][m][n] = (F4){zero_, zero_, zero_, zero_};
    bf16x8 At[4][2], B0[2][2], B1[2][2];
    unsigned OA[GATHER ? 2 : 1][2], OB[2];
    G_SETOFF(cur);
    G_STB(G_SB(0, 0), 0, 0); G_STA(G_SA(0, 0), 0, 0); G_STB(G_SB(0, 1), 1, 0); G_STA(G_SA(0, 1), 1, 0);
    if (wr == 1) G_BAR;
    G_WAIT_V(4); G_BAR;
    G_STB(G_SB(1, 0), 0, 128); G_STA(G_SA(1, 0), 0, 128); G_STB(G_SB(1, 1), 1, 128);
    G_WAIT_V(6); G_BAR;
    for (;;) {
        const bool has_next = K2 ? S.next((ui + 1) >> 1, nxt) : S.next(ui + 1, nxt);
#pragma unroll 1
        for (int t = 0; t < nt; t += 2) {
            const bool last = (t == nt - 2);
            G_LDB(B0, 0, 0); G_SCHED; G_LDA(At, 0, 0); G_STA(G_SA(1, 1), 1, (size_t)(t + 1) * 128);
            if (last && has_next) G_SETOFF(nxt);
            const size_t k2 = last ? 0 : (size_t)(t + 2) * 128, k3 = k2 + 128;
            G_WAIT_L(8); G_BAR; G_WAIT_L(0); G_MMA(0, 0, At, B0); G_BAR; G_SCHED;
            G_LDB(B1, 0, 1); G_STB(G_SB(0, 0), 0, k2);
            G_BAR; G_WAIT_L(0); G_MMA(0, 1, At, B1); G_BAR;
            G_LDA(At, 0, 1); G_STA(G_SA(0, 0), 0, k2);
            G_BAR; G_WAIT_L(0); G_MMA(1, 0, At, B0); G_BAR; G_SCHED;
            G_STB(G_SB(0, 1), 1, k2);
            G_WAIT_V(6); G_BAR; G_MMA(1, 1, At, B1); G_BAR;
            G_LDB(B0, 1, 0); G_SCHED; G_LDA(At, 1, 0); G_STA(G_SA(0, 1), 1, k2);
            G_WAIT_L(8); G_BAR; G_WAIT_L(0); G_MMA(0, 0, At, B0); G_BAR; G_SCHED;
            G_LDB(B1, 1, 1); G_STB(G_SB(1, 0), 0, k3);
            G_BAR; G_WAIT_L(0); G_MMA(0, 1, At, B1); G_BAR;
            G_LDA(At, 1, 1); G_STA(G_SA(1, 0), 0, k3);
            G_BAR; G_WAIT_L(0); G_MMA(1, 0, At, B0); G_BAR; G_SCHED;
            G_STB(G_SB(1, 1), 1, k3);
            G_WAIT_V(6); G_BAR; G_MMA(1, 1, At, B1); G_BAR;
        }
        if (!K2 || (ui & 1)) {
        if (wr == 0) G_BAR;
        int te = lane_id(); asm volatile("" : "+v"(te)); const int ewr = wid >> 2, ewc = wid & 3, efr = te & 15, efq = te >> 4;
#pragma unroll
        for (int ai = 0; ai < 2; ++ai)
#pragma unroll
            for (int m = 0; m < 4; ++m)
            { int rr = ai * 128 + ewr * 64 + m * 16 + efr; asm volatile("" : "+v"(rr) :: "memory"); const float sc_ = K2 ? 0.5f : 1.0f;
                if constexpr (Epi::PERM) { E.st8(cur, rr, ewc * 32 + 8 * efq, acc[ai][0][m][0] * sc_, acc[ai][0][m][1] * sc_, acc[ai][1][m][0] * sc_, acc[ai][1][m][1] * sc_); }
                else {
#pragma unroll
                    for (int n = 0; n < 2; ++n) { E.st(cur, rr, ewc * 32 + n * 16 + 4 * efq, acc[ai][0][m][n] * sc_, acc[ai][1][m][n] * sc_); asm volatile("" ::: "memory"); } } }
        }
        if (GP_RS && Epi::PROBE) xcd_barrier(*pbar);
        if (!has_next) break;
        if (!K2 || (ui & 1)) {
#pragma unroll
        for (int a = 0; a < 2; ++a)
#pragma unroll
            for (int b = 0; b < 2; ++b)
#pragma unroll
                for (int m = 0; m < 4; ++m)
#pragma unroll
                    for (int n = 0; n < 2; ++n) acc[a][b][m][n] = (F4){zero_, zero_, zero_, zero_};
        if (wr == 1) G_BAR;
        }
        cur = nxt; ++ui;
    }
    G_WAIT_V(0);
    if (K2 && !(ui & 1)) { if (wr == 0) G_BAR; }
    G_BAR;
    if (GP_RS && Epi::PROBE) { for (int r_ = ui + 1; r_ < S.max_units(); ++r_) xcd_barrier(*pbar); }
}
#endif
#ifndef MULTI_LAUNCH
#define FUSED 1
#endif
constexpr int NPH_PRO = 3, NPH_LAYER = 16, NPH = NPH_PRO + L_ * NPH_LAYER;

#ifdef CPU_TEST
static void rwkv_scan_all(const P& p, int l) {
    float* yr = WSP(float, yr);
    for (int d = 0; d < 2; ++d) for (int b = 0; b < B_; ++b) for (int hh = 0; hh < RH_; ++hh) {
        static float S[RN_][RN_]; memset(S, 0, sizeof(S));
        for (int idx = 0; idx < SPOS; ++idx) { const int n = row_of(b, seqpos(d, idx)); RV e[RN_]; float q = 0.f;
            for (int j = 0; j < RN_; ++j) { rwkv_elem(p, l, d, n, hh, j, 1.0f, e[j]); q += e[j].kkraw * e[j].kkraw; }
            const float rs = 1.0f / sqrtf(q + 1e-12f);
            for (int j = 0; j < RN_; ++j) { e[j].a *= rs; e[j].b *= rs; }
            for (int i = 0; i < RN_; ++i) { float sa = 0.f; for (int j = 0; j < RN_; ++j) sa += S[i][j] * e[j].a;
                float y = 0.f; for (int j = 0; j < RN_; ++j) { S[i][j] = S[i][j] * e[j].w + sa * e[j].b + e[i].v * e[j].k2; y += S[i][j] * e[j].r; }
                yr[((size_t)d * NTOK + n) * RW + hh * RN_ + i] = y; }
        }
    }
}
static void gla_scan_all(const P& p, int l) {
    float* og = WSP(float, og); const bf16_t* proj = WSP(bf16_t, proj); const float* gs = WSP(float, gs);
    for (int d = 0; d < 2; ++d) for (int b = 0; b < B_; ++b) for (int hh = 0; hh < GH_; ++hh) {
        static float S[GK_][GV_]; memset(S, 0, sizeof(S));
        for (int idx = 0; idx < SPOS; ++idx) { const int n = row_of(b, seqpos(d, idx)); const bf16_t* pr = proj + (size_t)n * NINP + GBASE;
            for (int j = 0; j < GV_; ++j) { const float v = bf2f(pr[2 * GKD + hh * GV_ + j]); float o = 0.f;
                for (int k = 0; k < GK_; ++k) { const float q = bf2f(pr[hh * GK_ + k]) * 0.17677669529663687f, kg = bf2f(pr[GKD + hh * GK_ + k]), al = fexp(gs[(size_t)n * NGF + 2 * RW + d * GKD + hh * GK_ + k]);
                    S[k][j] = S[k][j] * al + kg * v; o += q * S[k][j]; }
                og[((size_t)d * NTOK + n) * GWD + hh * GV_ + j] = o; }
        }
    }
}
#else
__device__ __forceinline__ float dpp_sum8(float v) {
    v += __builtin_bit_cast(float, __builtin_amdgcn_update_dpp(0, __builtin_bit_cast(int, v), 0xB1, 0xF, 0xF, true));
    v += __builtin_bit_cast(float, __builtin_amdgcn_update_dpp(0, __builtin_bit_cast(int, v), 0x4E, 0xF, 0xF, true));
    v += __builtin_bit_cast(float, __builtin_amdgcn_update_dpp(0, __builtin_bit_cast(int, v), 0x141, 0xF, 0xF, true));
    return v;
}
__device__ __forceinline__ float dpp_sum16(float v) {
    v = dpp_sum8(v);
    v += __builtin_bit_cast(float, __builtin_amdgcn_update_dpp(0, __builtin_bit_cast(int, v), 0x140, 0xF, 0xF, true));
    return v;
}
__device__ __forceinline__ float dpp_sum4(float v) {
    v += __builtin_bit_cast(float, __builtin_amdgcn_update_dpp(0, __builtin_bit_cast(int, v), 0xB1, 0xF, 0xF, true));
    v += __builtin_bit_cast(float, __builtin_amdgcn_update_dpp(0, __builtin_bit_cast(int, v), 0x4E, 0xF, 0xF, true));
    return v;
}
constexpr int RT = 16;
__device__ __forceinline__ void rwkv_seq_blk(const P& p, int l, int d, int b, int hh, LAS unsigned char* lds, int wid, int lane) {
    LAS float* stage = (LAS float*)lds;
    LAS float* ybuf = (LAS float*)(lds + 2 * RT * 6 * 64 * 4);
    const int r = lane >> 3, c = lane & 7, i = wid * 8 + r, cj = hh * RN_ + lane;
    const float kkc = p.rwkv_k_k[(size_t)l * RW + cj], kac = p.rwkv_k_a[(size_t)l * RW + cj];
    const bf16_t* rkv = WSP(bf16_t, rkv); const float* gs = WSP(float, gs); const bf16_t* gsb = WSP(bf16_t, gsb); float* yr = WSP(float, yr) + (size_t)d * NTOK * RW;
    float S[8];
#pragma unroll
    for (int q = 0; q < 8; ++q) S[q] = 0.f;
    float rawA[2][5], rawB[2][5];
#define RW_LOAD(chunk, raw) do { _Pragma("unroll") for (int tt = 0; tt < 2; ++tt) { const int n = __builtin_amdgcn_readfirstlane(row_of(b, seqpos(d, (chunk) * RT + 2 * wid + tt))); \
        const bf16_t* rk = rkv + (size_t)n * 3 * RW; \
        raw[tt][0] = bf2f(rk[cj]); raw[tt][1] = bf2f(rk[RW + cj]); raw[tt][2] = bf2f(rk[2 * RW + cj]); raw[tt][3] = gs[(size_t)n * NGF + d * RW + cj]; raw[tt][4] = bf2f(gsb[(size_t)n * NGB + d * RW + cj]); } } while (0)
#define RW_PUT(buf, raw) do { _Pragma("unroll") for (int tt = 0; tt < 2; ++tt) { const float k = raw[tt][1], a = raw[tt][4], kkraw = k * kkc; \
        const float kk = kkraw * (1.0f / sqrtf(WSUM(kkraw * kkraw) + 1e-12f)); LAS float* sv = stage + (((buf) * RT + 2 * wid + tt) * 6) * 64 + lane; \
        sv[0] = fexp(raw[tt][3]); sv[64] = k * (1.0f + (a - 1.0f) * kac); sv[128] = -kk; sv[192] = kk * a; sv[256] = raw[tt][0]; sv[320] = raw[tt][2]; } } while (0)
#define RW_YST(ch_, buf_) do { _Pragma("unroll") for (int tt = 0; tt < 2; ++tt) { const int n = __builtin_amdgcn_readfirstlane(row_of(b, seqpos(d, (ch_) * RT + 2 * wid + tt))); \
        const LAS float* yp = ybuf + (((buf_) * RT + 2 * wid + tt) * 64 + lane) * 8; const F4 ya = *(const LAS F4*)yp, yb = *(const LAS F4*)(yp + 4); \
        yr[(size_t)n * RW + cj] = ((ya[0] + ya[1]) + (ya[2] + ya[3])) + ((yb[0] + yb[1]) + (yb[2] + yb[3])); } } while (0)
    RW_LOAD(0, rawA); RW_PUT(0, rawA); RW_LOAD(1, rawB);
    __syncthreads();
    constexpr int NCH = SPOS / RT; static_assert(NCH % 2 == 0, "chunk pairs");
    for (int ch = 0; ch < NCH; ch += 2) {
        {
            constexpr int buf = 0;
            if (ch + 2 < NCH) RW_LOAD(ch + 2, rawA);
        { F4 cw0, cw1, ck0, ck1, ca0, ca1, cb0, cb1, cr0, cr1; float cvi;
#define RW_LDV(t_, W0, W1, K0, K1, A0, A1, B0, B1, R0, R1, VI) do { const LAS float* sv = stage + ((buf * RT + (t_)) * 6) * 64 + 8 * c; \
            W0 = *(const LAS F4*)(sv); W1 = *(const LAS F4*)(sv + 4); K0 = *(const LAS F4*)(sv + 64); K1 = *(const LAS F4*)(sv + 68); A0 = *(const LAS F4*)(sv + 128); A1 = *(const LAS F4*)(sv + 132); \
            B0 = *(const LAS F4*)(sv + 192); B1 = *(const LAS F4*)(sv + 196); R0 = *(const LAS F4*)(sv + 256); R1 = *(const LAS F4*)(sv + 260); VI = sv[320 - 8 * c + i]; } while (0)
          RW_LDV(0, cw0, cw1, ck0, ck1, ca0, ca1, cb0, cb1, cr0, cr1, cvi);
#pragma unroll
          for (int t = 0; t < RT; ++t) {
            F4 nw0 = cw0, nw1 = cw1, nk0 = ck0, nk1 = ck1, na0 = ca0, na1 = ca1, nb0 = cb0, nb1 = cb1, nr0 = cr0, nr1 = cr1; float nvi = cvi;
            if (t + 1 < RT) RW_LDV(t + 1, nw0, nw1, nk0, nk1, na0, na1, nb0, nb1, nr0, nr1, nvi);
            float sa = ((S[0] * ca0[0] + S[1] * ca0[1]) + (S[2] * ca0[2] + S[3] * ca0[3])) + ((S[4] * ca1[0] + S[5] * ca1[1]) + (S[6] * ca1[2] + S[7] * ca1[3]));
            sa = dpp_sum8(sa);
            float y0 = 0.f, y1 = 0.f;
#pragma unroll
            for (int q = 0; q < 4; ++q) { S[q] = S[q] * cw0[q] + (sa * cb0[q] + cvi * ck0[q]); y0 += S[q] * cr0[q]; S[4 + q] = S[4 + q] * cw1[q] + (sa * cb1[q] + cvi * ck1[q]); y1 += S[4 + q] * cr1[q]; }
            ybuf[((buf * RT + t) * 64 + i) * 8 + c] = y0 + y1;
            cw0 = nw0; cw1 = nw1; ck0 = nk0; ck1 = nk1; ca0 = na0; ca1 = na1; cb0 = nb0; cb1 = nb1; cr0 = nr0; cr1 = nr1; cvi = nvi;
          }
#undef RW_LDV
        }
            RW_PUT(1, rawB);
            __syncthreads();
            RW_YST(ch, 0);
        }
        {
            constexpr int buf = 1;
            if (ch + 3 < NCH) RW_LOAD(ch + 3, rawB);
        { F4 cw0, cw1, ck0, ck1, ca0, ca1, cb0, cb1, cr0, cr1; float cvi;
#define RW_LDV(t_, W0, W1, K0, K1, A0, A1, B0, B1, R0, R1, VI) do { const LAS float* sv = stage + ((buf * RT + (t_)) * 6) * 64 + 8 * c; \
            W0 = *(const LAS F4*)(sv); W1 = *(const LAS F4*)(sv + 4); K0 = *(const LAS F4*)(sv + 64); K1 = *(const LAS F4*)(sv + 68); A0 = *(const LAS F4*)(sv + 128); A1 = *(const LAS F4*)(sv + 132); \
            B0 = *(const LAS F4*)(sv + 192); B1 = *(const LAS F4*)(sv + 196); R0 = *(const LAS F4*)(sv + 256); R1 = *(const LAS F4*)(sv + 260); VI = sv[320 - 8 * c + i]; } while (0)
          RW_LDV(0, cw0, cw1, ck0, ck1, ca0, ca1, cb0, cb1, cr0, cr1, cvi);
#pragma unroll
          for (int t = 0; t < RT; ++t) {
            F4 nw0 = cw0, nw1 = cw1, nk0 = ck0, nk1 = ck1, na0 = ca0, na1 = ca1, nb0 = cb0, nb1 = cb1, nr0 = cr0, nr1 = cr1; float nvi = cvi;
            if (t + 1 < RT) RW_LDV(t + 1, nw0, nw1, nk0, nk1, na0, na1, nb0, nb1, nr0, nr1, nvi);
            float sa = ((S[0] * ca0[0] + S[1] * ca0[1]) + (S[2] * ca0[2] + S[3] * ca0[3])) + ((S[4] * ca1[0] + S[5] * ca1[1]) + (S[6] * ca1[2] + S[7] * ca1[3]));
            sa = dpp_sum8(sa);
            float y0 = 0.f, y1 = 0.f;
#pragma unroll
            for (int q = 0; q < 4; ++q) { S[q] = S[q] * cw0[q] + (sa * cb0[q] + cvi * ck0[q]); y0 += S[q] * cr0[q]; S[4 + q] = S[4 + q] * cw1[q] + (sa * cb1[q] + cvi * ck1[q]); y1 += S[4 + q] * cr1[q]; }
            ybuf[((buf * RT + t) * 64 + i) * 8 + c] = y0 + y1;
            cw0 = nw0; cw1 = nw1; ck0 = nk0; ck1 = nk1; ca0 = na0; ca1 = na1; cb0 = nb0; cb1 = nb1; cr0 = nr0; cr1 = nr1; cvi = nvi;
          }
#undef RW_LDV
        }
            if (ch + 2 < NCH) RW_PUT(0, rawA);
            __syncthreads();
            RW_YST(ch + 1, 1);
        }
    }
    __syncthreads();
#undef RW_YST
#undef RW_LOAD
#undef RW_PUT
}
__device__ __forceinline__ void gla_seq_wave(const P& p, int l, int d, int b, int hh, int hv, LAS float* st, int lane) {
    float S[2][8];
#pragma unroll
    for (int k = 0; k < 8; ++k) { S[0][k] = 0.f; S[1][k] = 0.f; }
    const int vp = lane >> 2, kg = lane & 3;
    float* og = WSP(float, og) + (size_t)d * NTOK * GWD; const bf16_t* proj = WSP(bf16_t, proj); const float* gs = WSP(float, gs);
    constexpr int SB = RT * 128;
    const int kh = lane >> 5, jj = lane & 31;
    float vec[24], vv[RT / 2];
#define GL_LOAD(chunk) do { _Pragma("unroll") for (int it = 0; it < 8; ++it) { const int n = row_of(b, seqpos(d, (chunk) * RT + 2 * it + kh)); const bf16_t* pr = proj + (size_t)n * NINP + GBASE + hh * GK_ + jj; \
        vec[3 * it] = bf2f(pr[0]) * 0.17677669529663687f; vec[3 * it + 1] = bf2f(pr[GKD]); vec[3 * it + 2] = gs[(size_t)n * NGF + 2 * RW + d * GKD + hh * GK_ + jj]; \
        vv[it] = bf2f(pr[2 * GKD - hh * GK_ + hh * GV_ + 32 * hv]); } } while (0)
#define GL_PUT(buf) do { _Pragma("unroll") for (int it = 0; it < 8; ++it) { LAS float* q = st + (buf) * SB + (2 * it + kh) * 128 + jj; q[0] = vec[3 * it]; q[32] = vec[3 * it + 1]; q[64] = fexp(vec[3 * it + 2]); q[96] = vv[it]; } } while (0)
#define WAVE_SYNC() do { __builtin_amdgcn_fence(__ATOMIC_RELEASE, "wavefront"); __builtin_amdgcn_wave_barrier(); __builtin_amdgcn_fence(__ATOMIC_ACQUIRE, "wavefront"); } while (0)
    GL_LOAD(0); GL_PUT(0); WAVE_SYNC();
    constexpr int NCH = SPOS / RT;
    for (int ch = 0; ch < NCH; ++ch) {
        const int buf = ch & 1;
        if (ch + 1 < NCH) GL_LOAD(ch + 1);
        { typedef float F2 __attribute__((ext_vector_type(2))); F4 cq[2], ck[2], ca[2]; F2 cv;
#define GL_LDV(t_, Q, K, A, V) do { const LAS float* sv = st + buf * SB + (t_) * 128 + 8 * kg; _Pragma("unroll") for (int k4 = 0; k4 < 2; ++k4) { Q[k4] = *(const LAS F4*)(sv + 4 * k4); K[k4] = *(const LAS F4*)(sv + 32 + 4 * k4); A[k4] = *(const LAS F4*)(sv + 64 + 4 * k4); } \
            V = *(const LAS F2*)(st + buf * SB + (t_) * 128 + 96 + 2 * vp); } while (0)
          GL_LDV(0, cq, ck, ca, cv);
#pragma unroll
          for (int t = 0; t < RT; ++t) {
            F4 nq[2], nk[2], na[2]; F2 nv = cv;
#pragma unroll
            for (int k4 = 0; k4 < 2; ++k4) { nq[k4] = cq[k4]; nk[k4] = ck[k4]; na[k4] = ca[k4]; }
            if (t + 1 < RT) GL_LDV(t + 1, nq, nk, na, nv);
            float o0 = 0.f, o1 = 0.f;
#pragma unroll
            for (int k4 = 0; k4 < 2; ++k4)
#pragma unroll
                for (int q = 0; q < 4; ++q) { S[0][4 * k4 + q] = S[0][4 * k4 + q] * ca[k4][q] + ck[k4][q] * cv[0]; o0 += cq[k4][q] * S[0][4 * k4 + q]; S[1][4 * k4 + q] = S[1][4 * k4 + q] * ca[k4][q] + ck[k4][q] * cv[1]; o1 += cq[k4][q] * S[1][4 * k4 + q]; }
            o0 = dpp_sum4(o0); o1 = dpp_sum4(o1);
            const int n = __builtin_amdgcn_readfirstlane(row_of(b, seqpos(d, ch * RT + t)));
            if (kg == 0) { F2 oo; oo[0] = o0; oo[1] = o1; *(F2*)(og + (size_t)n * GWD + hh * GV_ + 32 * hv + 2 * vp) = oo; }
#pragma unroll
            for (int k4 = 0; k4 < 2; ++k4) { cq[k4] = nq[k4]; ck[k4] = nk[k4]; ca[k4] = na[k4]; }
            cv = nv;
          }
#undef GL_LDV
        }
        if (ch + 1 < NCH) GL_PUT(buf ^ 1);
        WAVE_SYNC();
    }
#undef GL_LOAD
#undef GL_PUT
}
#define BSYNC() do { asm volatile("s_waitcnt lgkmcnt(0)" ::: "memory"); __builtin_amdgcn_s_barrier(); asm volatile("" ::: "memory"); } while (0)
template <int M, int N, int K, int NW, class F>
__device__ __forceinline__ void bmm(const LAS bf16_t* A, int lda, const LAS bf16_t* Bt, int ldb, int w, int lane, F f) {
    const int r = lane & 15, q = lane >> 4;
#pragma unroll 1
    for (int t = w; t < (M / 16) * (N / 16); t += NW) { const int tm = t / (N / 16), tn = t % (N / 16); F4 acc = (F4){0.f, 0.f, 0.f, 0.f};
#pragma unroll
        for (int kk = 0; kk < K / 32; ++kk) { const bf16x8 a = *(const LAS bf16x8*)(A + (tm * 16 + r) * lda + kk * 32 + 8 * q), bb = *(const LAS bf16x8*)(Bt + (tn * 16 + r) * ldb + kk * 32 + 8 * q);
            acc = __builtin_amdgcn_mfma_f32_16x16x32_bf16(a, bb, acc, 0, 0, 0); }
        f(tm * 16 + 4 * q, tn * 16 + r, acc); }
}
template <int M, int N, int K1, int K2, int NW, class F>
__device__ __forceinline__ void bmm2(const LAS bf16_t* A1, int lda1, const LAS bf16_t* Bt1, int ldb1, const LAS bf16_t* A2, int lda2, const LAS bf16_t* Bt2, int ldb2, int w, int lane, F f) {
    const int r = lane & 15, q = lane >> 4;
#pragma unroll 1
    for (int t = w; t < (M / 16) * (N / 16); t += NW) { const int tm = t / (N / 16), tn = t % (N / 16); F4 acc = (F4){0.f, 0.f, 0.f, 0.f};
#pragma unroll
        for (int kk = 0; kk < K1 / 32; ++kk) { const bf16x8 a = *(const LAS bf16x8*)(A1 + (tm * 16 + r) * lda1 + kk * 32 + 8 * q), bb = *(const LAS bf16x8*)(Bt1 + (tn * 16 + r) * ldb1 + kk * 32 + 8 * q);
            acc = __builtin_amdgcn_mfma_f32_16x16x32_bf16(a, bb, acc, 0, 0, 0); }
#pragma unroll
        for (int kk = 0; kk < K2 / 32; ++kk) { const bf16x8 a = *(const LAS bf16x8*)(A2 + (tm * 16 + r) * lda2 + kk * 32 + 8 * q), bb = *(const LAS bf16x8*)(Bt2 + (tn * 16 + r) * ldb2 + kk * 32 + 8 * q);
            acc = __builtin_amdgcn_mfma_f32_16x16x32_bf16(a, bb, acc, 0, 0, 0); }
        f(tm * 16 + 4 * q, tn * 16 + r, acc); }
}
template <int M, int N, int K1, int K2, int K3, int NW, class F>
__device__ __forceinline__ void bmm3(const LAS bf16_t* A1, int lda1, const LAS bf16_t* Bt1, int ldb1, const LAS bf16_t* A2, int lda2, const LAS bf16_t* Bt2, int ldb2,
                                     const LAS bf16_t* A3, int lda3, const LAS bf16_t* Bt3, int ldb3, int w, int lane, F f) {
    const int r = lane & 15, q = lane >> 4;
#pragma unroll 1
    for (int t = w; t < (M / 16) * (N / 16); t += NW) { const int tm = t / (N / 16), tn = t % (N / 16); F4 acc = (F4){0.f, 0.f, 0.f, 0.f};
#pragma unroll
        for (int kk = 0; kk < K1 / 32; ++kk) acc = __builtin_amdgcn_mfma_f32_16x16x32_bf16(*(const LAS bf16x8*)(A1 + (tm * 16 + r) * lda1 + kk * 32 + 8 * q), *(const LAS bf16x8*)(Bt1 + (tn * 16 + r) * ldb1 + kk * 32 + 8 * q), acc, 0, 0, 0);
#pragma unroll
        for (int kk = 0; kk < K2 / 32; ++kk) acc = __builtin_amdgcn_mfma_f32_16x16x32_bf16(*(const LAS bf16x8*)(A2 + (tm * 16 + r) * lda2 + kk * 32 + 8 * q), *(const LAS bf16x8*)(Bt2 + (tn * 16 + r) * ldb2 + kk * 32 + 8 * q), acc, 0, 0, 0);
#pragma unroll
        for (int kk = 0; kk < K3 / 32; ++kk) acc = __builtin_amdgcn_mfma_f32_16x16x32_bf16(*(const LAS bf16x8*)(A3 + (tm * 16 + r) * lda3 + kk * 32 + 8 * q), *(const LAS bf16x8*)(Bt3 + (tn * 16 + r) * ldb3 + kk * 32 + 8 * q), acc, 0, 0, 0);
        f(tm * 16 + 4 * q, tn * 16 + r, acc); }
}
typedef unsigned u32x2_t __attribute__((ext_vector_type(2)));
typedef unsigned u32x4_t __attribute__((ext_vector_type(4)));
__device__ __forceinline__ unsigned gload_u16(const bf16_t* p) { unsigned x; asm volatile("global_load_ushort %0, %1, off" : "=v"(x) : "v"(p) : "memory"); return x; }
template <int OFF> __device__ __forceinline__ unsigned gload_u16s(const void* sbase, unsigned voff) { unsigned x; asm volatile("global_load_ushort %0, %1, %2 offset:%3" : "=v"(x) : "v"(voff), "s"(sbase), "n"(OFF) : "memory"); return x; }
__device__ __forceinline__ float gload_f32s(const void* sbase, unsigned voff) { float x; asm volatile("global_load_dword %0, %1, %2" : "=v"(x) : "v"(voff), "s"(sbase) : "memory"); return x; }
__device__ __forceinline__ float gload_f32(const float* p) { float x; asm volatile("global_load_dword %0, %1, off" : "=v"(x) : "v"(p) : "memory"); return x; }
__device__ __forceinline__ void rwkv_chunk_blk(const P& p, int l, int d, int b, int hh, LAS unsigned char* lds, int wid, int lane) {
    static_assert(RN_ == 64 && RT == 16, "rwkv chunk geometry");
#define ZF ((LAS float*)lds)
#define ZT ((LAS bf16_t*)(lds + 16384))
#define RHS ((LAS float*)(lds + 34816))
#define LW ((LAS float*)(lds + 38912))
#define UT ((LAS bf16_t*)(lds + 43008))
#define SETB(s) (lds + 48128 + (s) * 29952)
#define AT(s) ((LAS bf16_t*)SETB(s))
#define RTm(s) (AT(s) + 16 * 72)
#define BH(s) (AT(s) + 32 * 72)
#define KH(s) (AT(s) + 48 * 72)
#define BHT(s) ((LAS bf16_t*)(SETB(s) + 9216))
#define KHT(s) (BHT(s) + 64 * 40)
#define VT(s) (BHT(s) + 128 * 40)
#define MAK(s) ((LAS bf16_t*)(SETB(s) + 24576))
#define MRB(s) (MAK(s) + 16 * 40)
#define MRK(s) (MAK(s) + 32 * 40)
#define MABF(s) ((LAS float*)(SETB(s) + 28416))
#define PL(s) ((LAS float*)(SETB(s) + 29440))
#define NR(s) ((LAS int*)(SETB(s) + 29696))
    const int tid = wid * 64 + lane, cj = hh * RN_ + lane;
    const float kkc = p.rwkv_k_k[(size_t)l * RW + cj], kac = p.rwkv_k_a[(size_t)l * RW + cj];
    const bf16_t* rkv = WSP(bf16_t, rkv); const float* gs = WSP(float, gs); const bf16_t* gsb = WSP(bf16_t, gsb); float* yr = WSP(float, yr) + (size_t)d * NTOK * RW;
    F4 za = (F4){0.f, 0.f, 0.f, 0.f}, zb = za;
    for (int i = tid; i < 2 * 64 * 72; i += 512) ZT[i] = 0;
    for (int i = tid; i < 64 * 40; i += 512) UT[i] = 0;
    for (int i = tid; i < 2 * 29952 / 2; i += 512) AT(0)[i] = 0;
    const int ntk = wid == 0 ? 0 : ((wid == 4 || wid == 5) ? 3 : 2);
#define TKI(tt) ((tt) < 2 ? 2 * wid + (tt) : wid - 4)
    unsigned rawu[3][4]; float rawf[3]; int rn[3];
    const unsigned vo2 = (unsigned)cj * 2u, vo4 = (unsigned)cj * 4u;
#define RC_LOAD(chunk) do { _Pragma("unroll") for (int tt = 0; tt < 3; ++tt) { const int n = __builtin_amdgcn_readfirstlane(row_of(b, seqpos(d, (chunk) * RT + (tt < ntk ? TKI(tt) : 0)))); rn[tt] = n;        \
        const bf16_t* rk = rkv + (size_t)n * 3 * RW; const float* gp = gs + (size_t)n * NGF + d * RW; const bf16_t* gb = gsb + (size_t)n * NGB + d * RW; \
        rawu[tt][0] = gload_u16s<0>(rk, vo2); rawu[tt][1] = gload_u16s<2 * RW>(rk, vo2); rawu[tt][2] = gload_u16s<4 * RW>(rk, vo2); rawf[tt] = gload_f32s(gp, vo4); rawu[tt][3] = gload_u16s<0>(gb, vo2); } } while (0)
    float vr[3], vk2[3], va[3], vb[3], vv[3], vlw[3];
#define RC_RETIRE() do { asm volatile("s_waitcnt vmcnt(0)" ::: "memory"); _Pragma("unroll") for (int tt = 0; tt < 3; ++tt) { asm volatile("" : "+v"(rawu[tt][0]), "+v"(rawu[tt][1]), "+v"(rawu[tt][2]), "+v"(rawu[tt][3]), "+v"(rawf[tt])); } } while (0)
#define RC_P0(s) do { \
        _Pragma("unroll") for (int tt = 0; tt < 3; ++tt) if (tt < ntk) { const float k = bf2f((bf16_t)rawu[tt][1]), a = bf2f((bf16_t)rawu[tt][3]), kkraw = k * kkc; const float kk = kkraw * __builtin_amdgcn_rsqf(WSUM(kkraw * kkraw) + 1e-12f); \
            vr[tt] = bf2f((bf16_t)rawu[tt][0]); vk2[tt] = k * (1.0f + (a - 1.0f) * kac); va[tt] = -kk; vb[tt] = kk * a; vv[tt] = bf2f((bf16_t)rawu[tt][2]); vlw[tt] = rawf[tt]; \
            LW[TKI(tt) * 64 + lane] = vlw[tt]; if (lane == 0) NR(s)[TKI(tt)] = rn[tt]; } } while (0)
#define RC_TOK(s, t_, lp_, tt) do { const int t = (t_); const float lp = (lp_); const float em = fexp(lp - vlw[tt]), ep = fexp(lp), en = fexp(-lp); \
            AT(s)[t * 72 + lane] = f2bf(va[tt] * em); RTm(s)[t * 72 + lane] = f2bf(vr[tt] * ep); const bf16_t bh = f2bf(vb[tt] * en), kh = f2bf(vk2[tt] * en); \
            BH(s)[t * 72 + lane] = bh; KH(s)[t * 72 + lane] = kh; BHT(s)[lane * 40 + t] = bh; KHT(s)[lane * 40 + t] = kh; VT(s)[lane * 40 + t] = f2bf(vv[tt]); \
            if (t == RT - 1) PL(s)[lane] = ep; } while (0)
#define RC_P0B(s) do { if (ntk) { float lpb = 0.f, lpc = 0.f; const float l0 = LW[lane]; \
            _Pragma("unroll") for (int q = 0; q < RT - 2; q += 2) { const float x0 = LW[q * 64 + lane], x1 = LW[(q + 1) * 64 + lane]; const bool on = q < 2 * wid; lpb += on ? x0 : 0.f; lpc += on ? x1 : 0.f; } \
            lpb += lpc; lpb += vlw[0]; RC_TOK(s, 2 * wid, lpb, 0); lpb += vlw[1]; RC_TOK(s, 2 * wid + 1, lpb, 1); \
            if (ntk == 3) { const float lp3 = (wid == 5 ? l0 : 0.f) + vlw[2]; RC_TOK(s, wid - 4, lp3, 2); } } } while (0)
#define RC_P1(s, w4) do { const LAS bf16_t* Aop = ((w4) < 2) ? AT(s) : RTm(s); const LAS bf16_t* Bop = ((w4) & 1) ? KH(s) : BH(s); \
            bmm<16, 16, 64, 1>(Aop, 72, Bop, 72, 0, lane, [&](int r0, int cc, const F4& acc) { \
                _Pragma("unroll") for (int j = 0; j < 4; ++j) { const int rr = r0 + j; const bool keep = ((w4) < 2) ? (cc < rr) : (cc <= rr); const float val = keep ? acc[j] : 0.f; \
                    if ((w4) == 0) MABF(s)[cc * 16 + rr] = val; else if ((w4) == 1) MAK(s)[rr * 40 + cc] = f2bf(val); else if ((w4) == 2) MRB(s)[rr * 40 + cc] = f2bf(val); else MRK(s)[rr * 40 + cc] = f2bf(val); } }); } while (0)
    constexpr int NCH = SPOS / RT;
    RC_LOAD(0);
    __syncthreads();
    RC_RETIRE(); RC_P0(0); BSYNC(); RC_LOAD(1); RC_P0B(0); BSYNC(); if (wid < 4) RC_P1(0, wid); BSYNC();
    F4 yacc = (F4){0.f, 0.f, 0.f, 0.f}; int yrow[4] = {0, 0, 0, 0}; int ycol = 0;
#define RC_YST() do { _Pragma("unroll") for (int j = 0; j < 4; ++j) yr[(size_t)yrow[j] * RW + ycol] = yacc[j]; } while (0)
    for (int ch = 0; ch < NCH; ++ch) {
        int lnv = lane; asm volatile("" : "+v"(lnv)); const int lane = lnv;
        const int cs = ch & 1, ns = cs ^ 1; LAS bf16_t* ZTc = ZT + cs * 64 * 72; LAS bf16_t* ZTn = ZT + ns * 64 * 72; const bool more = ch + 1 < NCH;
        if (wid < 4) bmm3<16, 64, 64, 32, 0, 4>(AT(cs), 72, ZTc, 72, MAK(cs), 40, VT(cs), 40, AT(cs), 72, ZTc, 72, wid, lane, [&](int r0, int cc, const F4& acc) {
#pragma unroll
            for (int j = 0; j < 4; ++j) RHS[(r0 + j) * 64 + cc] = acc[j]; });
        RC_RETIRE();
        if (wid < 4 && ch > 0) RC_YST();
        if (more) RC_P0(ns);
        typedef float F2 __attribute__((ext_vector_type(2)));
        constexpr int MPRE = 6;
        F2 mm[RT - 1][RT / 2];
        if (wid == 0) { unsigned mtb = (unsigned)(size_t)MABF(cs); asm volatile("" : "+v"(mtb)); const LAS float* MT = (const LAS float*)(size_t)mtb;
#pragma unroll
            for (int s = 0; s < MPRE; ++s) {
#pragma unroll
                for (int i = (s + 1) >> 1; i < RT / 2; ++i) mm[s][i] = *(const LAS F2*)(MT + s * 16 + 2 * i); } }
        BSYNC();
        RC_LOAD(ch + 2 < NCH ? ch + 2 : NCH - 1);
        if (wid == 0) {
            __builtin_amdgcn_s_setprio(2);
            F2 acc2[RT / 2];
#pragma unroll
            for (int i = 0; i < RT / 2; ++i) { acc2[i][0] = RHS[(2 * i) * 64 + lane]; acc2[i][1] = RHS[(2 * i + 1) * 64 + lane]; }
#pragma unroll
            for (int s = 0; s < RT - 1; ++s) { const float u = acc2[s >> 1][s & 1]; const F2 uu = (F2){u, u};
                if (s == 2) { asm volatile("" ::: "memory"); unsigned mtb = (unsigned)(size_t)MABF(cs); asm volatile("" : "+v"(mtb)); const LAS float* MT = (const LAS float*)(size_t)mtb;
#pragma unroll
                    for (int s2 = MPRE; s2 < RT - 1; ++s2) {
#pragma unroll
                        for (int i = (s2 + 1) >> 1; i < RT / 2; ++i) mm[s2][i] = *(const LAS F2*)(MT + s2 * 16 + 2 * i); } }
#pragma unroll
                for (int i = (s + 1) >> 1; i < RT / 2; ++i) acc2[i] = __builtin_elementwise_fma(mm[s][i], uu, acc2[i]); }
#pragma unroll
            for (int i = 0; i < RT / 2; ++i) { UT[lane * 40 + 2 * i] = f2bf(acc2[i][0]); UT[lane * 40 + 2 * i + 1] = f2bf(acc2[i][1]); }
            __builtin_amdgcn_s_setprio(0); }
        if (more) RC_P0B(ns);
        BSYNC();
        if (wid < 4) bmm3<16, 64, 64, 32, 32, 4>(RTm(cs), 72, ZTc, 72, MRB(cs), 40, UT, 40, MRK(cs), 40, VT(cs), 40, wid, lane, [&](int r0, int cc, const F4& acc) {
#pragma unroll
            for (int j = 0; j < 4; ++j) yrow[j] = NR(cs)[r0 + j];
            yacc = acc; ycol = hh * RN_ + cc; });
        else if (more) RC_P1(ns, wid - 4);
        {
            const int r = lane & 15, q = lane >> 4, tn = wid & 3, cc = tn * 16 + r;
            typedef __bf16 bf2_t __attribute__((ext_vector_type(2))); typedef float F2s __attribute__((ext_vector_type(2)));
#pragma unroll
            for (int h = 0; h < 2; ++h) { const int tm = (wid >> 2) + 2 * h, r0 = tm * 16 + 4 * q; F4 acc = (F4){0.f, 0.f, 0.f, 0.f};
                acc = __builtin_amdgcn_mfma_f32_16x16x32_bf16(*(const LAS bf16x8*)(BHT(cs) + (tm * 16 + r) * 40 + 8 * q), *(const LAS bf16x8*)(UT + cc * 40 + 8 * q), acc, 0, 0, 0);
                acc = __builtin_amdgcn_mfma_f32_16x16x32_bf16(*(const LAS bf16x8*)(KHT(cs) + (tm * 16 + r) * 40 + 8 * q), *(const LAS bf16x8*)(VT(cs) + cc * 40 + 8 * q), acc, 0, 0, 0);
                const F4 pl = *(const LAS F4*)(PL(cs) + r0);
                const F4 zn = pl * ((h ? zb : za) + acc); if (h) zb = zn; else za = zn;
                const bf2_t p01 = __builtin_convertvector((F2s){zn[0], zn[1]}, bf2_t), p23 = __builtin_convertvector((F2s){zn[2], zn[3]}, bf2_t);
                u32x2_t w2; w2[0] = __builtin_bit_cast(unsigned, p01); w2[1] = __builtin_bit_cast(unsigned, p23);
                *(LAS u32x2_t*)(ZTn + cc * 72 + r0) = w2; } }
        BSYNC();
    }
    RC_RETIRE();
    if (wid < 4) RC_YST();
    __syncthreads();
#undef RC_YST
#undef RC_RETIRE
#undef RC_LOAD
#undef RC_P0
#undef RC_P0B
#undef RC_TOK
#undef TKI
#undef RC_P1
#undef ZF
#undef ZT
#undef RHS
#undef LW
#undef UT
#undef SETB
#undef AT
#undef RTm
#undef BH
#undef KH
#undef BHT
#undef KHT
#undef VT
#undef MAK
#undef MRB
#undef MRK
#undef MABF
#undef PL
#undef NR
}
__device__ __forceinline__ u32x2_t gload_x2(const void* p) { u32x2_t x; asm volatile("global_load_dwordx2 %0, %1, off" : "=v"(x) : "v"(p) : "memory"); return x; }
__device__ __forceinline__ u32x4_t gload_x4(const void* p) { u32x4_t x; asm volatile("global_load_dwordx4 %0, %1, off" : "=v"(x) : "v"(p) : "memory"); return x; }
template <int K1, int K2>
__device__ __forceinline__ F4 bmm2_tile(const LAS bf16_t* A1, int lda1, const LAS bf16_t* Bt1, int ldb1, const LAS bf16_t* A2, int lda2, const LAS bf16_t* Bt2, int ldb2, int tm, int tn, int lane) {
    const int r = lane & 15, q = lane >> 4; F4 acc = (F4){0.f, 0.f, 0.f, 0.f};
#pragma unroll
    for (int kk = 0; kk < K1 / 32; ++kk) acc = __builtin_amdgcn_mfma_f32_16x16x32_bf16(*(const LAS bf16x8*)(A1 + (tm * 16 + r) * lda1 + kk * 32 + 8 * q), *(const LAS bf16x8*)(Bt1 + (tn * 16 + r) * ldb1 + kk * 32 + 8 * q), acc, 0, 0, 0);
#pragma unroll
    for (int kk = 0; kk < K2 / 32; ++kk) acc = __builtin_amdgcn_mfma_f32_16x16x32_bf16(*(const LAS bf16x8*)(A2 + (tm * 16 + r) * lda2 + kk * 32 + 8 * q), *(const LAS bf16x8*)(Bt2 + (tn * 16 + r) * ldb2 + kk * 32 + 8 * q), acc, 0, 0, 0);
    return acc;
}
__device__ __forceinline__ void gla_chunk_blk(const P& p, int l, int d, int b, int hh, LAS unsigned char* lds, int wid, int lane) {
    static_assert(GK_ == 32 && GV_ == 64 && CH_ == 64, "gla chunk geometry");
    const int tid = wid * 64 + lane;
    LAS float* LA = (LAS float*)lds;
    LAS float* QR = (LAS float*)(lds + 8192);
    LAS float* KR = (LAS float*)(lds + 16384);
    LAS float* SF = (LAS float*)(lds + 24576);
    LAS bf16_t* QIN = (LAS bf16_t*)(lds + 32768);
    LAS bf16_t* KIN = (LAS bf16_t*)(lds + 32768 + 5120);
    LAS bf16_t* STT = (LAS bf16_t*)(lds + 32768 + 10240);
    LAS bf16_t* KSTT = (LAS bf16_t*)(lds + 32768 + 15360);
    LAS bf16_t* VT = (LAS bf16_t*)(lds + 32768 + 19968);
    LAS bf16_t* ATT = (LAS bf16_t*)(lds + 32768 + 29184);
    LAS int* NR = (LAS int*)(lds + 32768 + 38400);
    const bf16_t* proj = WSP(bf16_t, proj); const float* gs = WSP(float, gs); float* og = WSP(float, og) + (size_t)d * NTOK * GWD;
    for (int i = tid; i < 32 * 64; i += 512) SF[i] = 0.f;
    for (int i = tid; i < 64 * 40; i += 512) STT[i] = 0;
    const int t = tid >> 3, k4 = (tid & 7) * 4, v8 = (tid & 7) * 8;
    u32x2_t rq, rk; u32x4_t rv, rla; int rn_;
#define GC_LOAD(c_) do { rn_ = row_of(b, seqpos(d, (c_) * 64 + t)); const bf16_t* pr = proj + (size_t)rn_ * NINP + GBASE; \
        rq = gload_x2(pr + hh * GK_ + k4); rk = gload_x2(pr + GKD + hh * GK_ + k4); rv = gload_x4(pr + 2 * GKD + hh * GV_ + v8); rla = gload_x4(gs + (size_t)rn_ * NGF + 2 * RW + d * GKD + hh * GK_ + k4); } while (0)
#define GC_WAIT() do { asm volatile("s_waitcnt vmcnt(0)" ::: "memory"); asm volatile("" : "+v"(rq), "+v"(rk), "+v"(rv), "+v"(rla)); } while (0)
#define GC_PUT() do { _Pragma("unroll") for (int j = 0; j < 4; ++j) { const unsigned wq = rq[j >> 1], wk = rk[j >> 1]; const float qf = __builtin_bit_cast(float, (j & 1) ? (wq & 0xFFFF0000u) : (wq << 16)), kf = __builtin_bit_cast(float, (j & 1) ? (wk & 0xFFFF0000u) : (wk << 16)); \
            QR[t * 32 + k4 + j] = qf * 0.17677669529663687f; KR[t * 32 + k4 + j] = kf; } \
        *(LAS u32x4_t*)(LA + t * 32 + k4) = rla; \
        _Pragma("unroll") for (int j = 0; j < 8; ++j) { const unsigned wv_ = rv[j >> 1]; VT[(v8 + j) * 72 + t] = (bf16_t)((j & 1) ? (wv_ >> 16) : (wv_ & 0xFFFFu)); } if ((tid & 7) == 0) NR[t] = rn_; } while (0)
    F4 o0 = (F4){0.f, 0.f, 0.f, 0.f}, o1 = o0; int orow0[4] = {0, 0, 0, 0}, orow1[4] = {0, 0, 0, 0};
    const int ocol = hh * GV_ + (wid & 3) * 16 + (lane & 15);
#define GC_OST() do { _Pragma("unroll") for (int j = 0; j < 4; ++j) { og[(size_t)orow0[j] * GWD + ocol] = o0[j]; og[(size_t)orow1[j] * GWD + ocol] = o1[j]; } } while (0)
    GC_LOAD(0);
    __syncthreads();
#pragma unroll 1
    for (int c = 0; c < NPC; ++c) {
        GC_WAIT();
        if (c > 0) GC_OST();
        GC_PUT();
        BSYNC();
        GC_LOAD(c + 1 < NPC ? c + 1 : NPC - 1);
        if (wid == 0) { const int kc = lane & 31, t0 = (lane >> 5) * 32; float cs[32];
#pragma unroll
            for (int tt = 0; tt < 32; ++tt) cs[tt] = LA[(t0 + tt) * 32 + kc];
#pragma unroll
            for (int tt = 1; tt < 32; ++tt) cs[tt] += cs[tt - 1];
            const float up = __builtin_bit_cast(float, __builtin_amdgcn_ds_bpermute(((lane + 32) & 63) * 4, __builtin_bit_cast(int, cs[31]))); const float add = lane >= 32 ? up : 0.f;
#pragma unroll
            for (int tt = 0; tt < 32; ++tt) LA[(t0 + tt) * 32 + kc] = cs[tt] + add; }
        BSYNC();
#pragma unroll
        for (int j = 0; j < 4; ++j) { const float bb = LA[t * 32 + k4 + j], bl = LA[63 * 32 + k4 + j], qv = QR[t * 32 + k4 + j], kv = KR[t * 32 + k4 + j];
            QIN[t * 40 + k4 + j] = f2bf(qv * fexp(bb)); KIN[t * 40 + k4 + j] = f2bf(kv * fexp(-bb)); KSTT[(k4 + j) * 72 + t] = f2bf(kv * fexp(bl - bb)); }
        BSYNC();
        bmm<64, 64, 32, 8>(QIN, 40, KIN, 40, wid, lane, [&](int r0, int cc, const F4& acc) {
#pragma unroll
            for (int j = 0; j < 4; ++j) ATT[(r0 + j) * 72 + cc] = f2bf(cc <= r0 + j ? acc[j] : 0.f); });
        BSYNC();
        { const int tm0 = wid >> 2, tn = wid & 3, q4 = 4 * (lane >> 4);
          o0 = bmm2_tile<64, 32>(ATT, 72, VT, 72, QIN, 40, STT, 40, tm0, tn, lane); o1 = bmm2_tile<64, 32>(ATT, 72, VT, 72, QIN, 40, STT, 40, tm0 + 2, tn, lane);
#pragma unroll
          for (int j = 0; j < 4; ++j) { orow0[j] = NR[tm0 * 16 + q4 + j]; orow1[j] = NR[(tm0 + 2) * 16 + q4 + j]; } }
        BSYNC();
        bmm<32, 64, 64, 8>(KSTT, 72, VT, 72, wid, lane, [&](int r0, int cc, const F4& acc) {
#pragma unroll
            for (int j = 0; j < 4; ++j) { const float sn = fexp(LA[63 * 32 + r0 + j]) * SF[(r0 + j) * 64 + cc] + acc[j]; SF[(r0 + j) * 64 + cc] = sn; STT[cc * 40 + r0 + j] = f2bf(sn); } });
        BSYNC();
    }
    GC_WAIT();
    GC_OST();
#undef GC_PUT
#undef GC_LOAD
#undef GC_WAIT
#undef GC_OST
}
#endif

#ifndef CPU_TEST
__device__ __forceinline__ void cvt_job(LAS unsigned char* lds, int tid, const float* src, bf16_t* dst, int nb, size_t sbs, size_t dbs, int K, int Nsrc, int Ndst, int nvalid, int perm) {
    LAS unsigned short* tl = (LAS unsigned short*)lds;
    const int tK = K / 64, tN = Ndst / 64, per = tK * tN; const long total = (long)nb * per;
    for (long t = blockIdx.x; t < total; t += gridDim.x) {
        const int e = (int)(t / per), r = (int)(t % per), tn = r / tK, tk = r % tK, n0 = tn * 64, k0 = tk * 64;
        int sc0 = n0; if (perm) { const int j = n0 / 256, w = n0 % 256; sc0 = w < 128 ? 128 * j + w : FF_ + 128 * j + (w - 128); }
        const int nv = nvalid - n0;
        const float* s = src + (size_t)e * sbs + (size_t)(k0 + (tid >> 3)) * Nsrc + sc0 + (tid & 7) * 8; const int c8 = (tid & 7) * 8, kk = tid >> 3;
        float v[8];
        if (c8 + 8 <= nv) { const F4 a = *(const F4*)s, b = *(const F4*)(s + 4); v[0] = a[0]; v[1] = a[1]; v[2] = a[2]; v[3] = a[3]; v[4] = b[0]; v[5] = b[1]; v[6] = b[2]; v[7] = b[3]; }
        else {
#pragma unroll
            for (int j = 0; j < 8; ++j) v[j] = (c8 + j < nv) ? s[j] : 0.f; }
#pragma unroll
        for (int j = 0; j < 8; ++j) tl[(c8 + j) * 72 + kk] = f2bf(v[j]);
        __syncthreads();
        { const int n = tid >> 3, ks = (tid & 7) * 8; typedef unsigned u32x4_t __attribute__((ext_vector_type(4))); const u32x4_t w = *(const LAS u32x4_t*)(tl + n * 72 + ks); *(u32x4_t*)(dst + (size_t)e * dbs + (size_t)(n0 + n) * K + k0 + ks) = w; }
        __syncthreads();
    }
}
__device__ __forceinline__ void st_cvt_tiles(const P& p, int l, LAS unsigned char* lds, int tid) {
    cvt_job(lds, tid, p.w_in + (size_t)l * D_ * NIN, WSP(bf16_t, w_inT) + (size_t)l * NINP * D_, 1, 0, 0, D_, NIN, NINP, NIN, 0);
    cvt_job(lds, tid, p.w_out + (size_t)l * MIXW * D_, WSP(bf16_t, w_outT) + (size_t)l * D_ * MIXW, 1, 0, 0, MIXW, D_, D_, D_, 0);
    cvt_job(lds, tid, p.sh_w2 + (size_t)l * FF_ * D_, WSP(bf16_t, shw2T) + (size_t)l * D_ * FF_, 1, 0, 0, FF_, D_, D_, D_, 0);
    cvt_job(lds, tid, p.s5_glu_w + (size_t)l * SW * SW, WSP(bf16_t, gluT) + (size_t)l * SWP * SW, 1, 0, 0, SW, SW, SWP, SW, 0);
    cvt_job(lds, tid, p.router_w + (size_t)l * D_ * E_, WSP(bf16_t, rsT) + (size_t)l * NRS * D_, 1, 0, 0, D_, E_, EP, E_, 0);
    cvt_job(lds, tid, p.sh_w13 + (size_t)l * D_ * 2 * FF_, WSP(bf16_t, rsT) + (size_t)l * NRS * D_ + (size_t)EP * D_, 1, 0, 0, D_, 2 * FF_, 2 * FF_, 2 * FF_, 1);
    cvt_job(lds, tid, p.exp_w13 + (size_t)l * E_ * D_ * 2 * FF_, WSP(bf16_t, w13T) + (size_t)l * E_ * 2 * FF_ * D_, E_, (size_t)D_ * 2 * FF_, (size_t)2 * FF_ * D_, D_, 2 * FF_, 2 * FF_, 2 * FF_, 1);
    cvt_job(lds, tid, p.exp_w2 + (size_t)l * E_ * FF_ * D_, WSP(bf16_t, w2T) + (size_t)l * E_ * D_ * FF_, E_, (size_t)FF_ * D_, (size_t)D_ * FF_, FF_, D_, D_, D_, 0);
}
#endif

#ifndef CPU_TEST
__device__ __forceinline__ void st_prep1_blk(const P& p, int l, int wid, int lane, int wv, int nwv) {
    const bf16_t* proj = WSP(bf16_t, proj); bf16_t* rkv = WSP(bf16_t, rkv); bf16_t* as = WSP(bf16_t, asmall); bf16_t* U2 = WSP(bf16_t, U2);
    const float* taps = p.rwkv_conv + (size_t)l * 9 * RCOLS; constexpr int NG = RCOLS / 8, TPB = 512 / NG;
    const int tid = wid * 64 + lane;
    if (tid < TPB * NG) {
        const int cg = tid % NG, ts = tid / NG, ch = cg * 8; const int step = (int)gridDim.x * TPB;
        float w[9][8];
#pragma unroll
        for (int k = 0; k < 9; ++k) ld8f(taps + k * RCOLS + ch, w[k]);
#define P1_OUT(n_, acc) do { if (ch < 3 * RW) st8bf(rkv + (size_t)(n_) * 3 * RW + ch, acc); else { const int q0 = ch - 3 * RW; \
            if (q0 < 2 * RDR_) { _Pragma("unroll") for (int q = 0; q < 8; ++q) acc[q] = ftanh(acc[q]); } \
            else if (q0 >= 2 * RDR_ + 2 * RIR_) { _Pragma("unroll") for (int q = 0; q < 8; ++q) acc[q] = sigmoidf_(acc[q]); } \
            st8bf(as + (size_t)(n_) * KSM + q0, acc); } } while (0)
#define P1_FMA(acc, xv, k) do { _Pragma("unroll") for (int j_ = 0; j_ < 4; ++j_) { acc[2 * j_] += w[k][2 * j_] * __uint_as_float((xv)[j_] << 16); acc[2 * j_ + 1] += w[k][2 * j_ + 1] * __uint_as_float((xv)[j_] & 0xffff0000u); } } while (0)
        constexpr int NPT = 4; static_assert(GW_ % NPT == 0 && NLAT % NPT == 0, "token groups");
        for (int pi = (int)blockIdx.x * TPB + ts; pi < NLAT / NPT; pi += step) { const int n0 = NPT * pi, t_ = n0 % T_, gr = t_ / GW_, gc = t_ % GW_; const bf16_t* pb_ = proj + (size_t)n0 * NINP + ch;
            const bool rok0 = gr > 0, rok2 = gr < ROWS_ - 1, cokl = gc > 0, cokr = gc + NPT < GW_; U4 xw[3][NPT + 2];
#pragma unroll
            for (int a = 0; a < 3; ++a)
#pragma unroll
                for (int jw = 0; jw < NPT + 2; ++jw) { const bool ok = (a == 0 ? rok0 : a == 2 ? rok2 : true) && (jw == 0 ? cokl : jw == NPT + 1 ? cokr : true);
                    const int off_ = ok ? ((a - 1) * GW_ + (jw - 1)) * NINP : 0; const U4 v = *(const U4*)(pb_ + off_); xw[a][jw] = ok ? v : (U4){0u, 0u, 0u, 0u}; }
#pragma unroll
            for (int tk = 0; tk < NPT; ++tk) { float acc[8];
#pragma unroll
                for (int q = 0; q < 8; ++q) acc[q] = 0.f;
#pragma unroll
                for (int a = 0; a < 3; ++a)
#pragma unroll
                    for (int jj = 0; jj < 3; ++jj) P1_FMA(acc, xw[a][tk + jj], a * 3 + jj);
                P1_OUT(n0 + tk, acc); } }
        for (int n = NLAT + (int)blockIdx.x * TPB + ts; n < NTOK; n += step) { const int s_ = (n - NLAT) % CTX_; U4 xc[3];
#pragma unroll
            for (int j = 0; j < 3; ++j) { const int ss = s_ + j - 1; const bool ok = ss >= 0 && ss < CTX_; const int nn = ok ? n + j - 1 : n; const U4 v = *(const U4*)(proj + (size_t)nn * NINP + ch); xc[j] = ok ? v : (U4){0u, 0u, 0u, 0u}; }
            float acc[8];
#pragma unroll
            for (int q = 0; q < 8; ++q) acc[q] = 0.f;
#pragma unroll
            for (int jj = 0; jj < 3; ++jj) P1_FMA(acc, xc[jj], 3 + jj);
            P1_OUT(n, acc); }
#undef P1_FMA
#undef P1_OUT
    }
    GIDX;
    constexpr int NT8 = (KSM - OGL) / 8;
    for (long i = gid; i < (long)NTOK * NT8; i += gsz) { const int n = (int)(i / NT8), q = (int)(i % NT8) * 8;
        if (q < 2 * GGR_) cp8bf(as + (size_t)n * KSM + OGL + q, proj + (size_t)n * NINP + GBASE + 2 * GKD + 2 * GWD + q); else z8bf(as + (size_t)n * KSM + OGL + q); }
    for (long i = gid; i < (long)B_ * SPOS * (SW / 8); i += gsz) { const int c = (int)(i % (SW / 8)) * 8; const long r = i / (SW / 8); const int pos = (int)(r % SPOS), b = (int)(r / SPOS);
        const int g = c / SG_, cc = c % SG_, pc = pos / CH_, t = pos % CH_, m = b * NPC + pc;
        cp8bf(U2 + ((size_t)g * M5P + m) * KT5 + t * SG_ + cc, proj + (size_t)row_of(b, pos) * NINP + SBASE + c); }
}
#define DPP_MOVF(v, ctrl) __builtin_bit_cast(float, __builtin_amdgcn_update_dpp(0, __builtin_bit_cast(int, v), ctrl, 0xF, 0xF, true))
#define DPP_MOVI(v, ctrl) __builtin_amdgcn_update_dpp(0, v, ctrl, 0xF, 0xF, true)
__device__ __forceinline__ void st_topk_wave(const P& p, int l, int wv, int nwv, int lane, LAS unsigned char* lds) {
    LAS int* hist = (LAS int*)lds;
    { const int tid_ = (int)threadIdx.x; if (tid_ < E_) hist[tid_] = 0; }
    __syncthreads();
    static_assert(E_ == 256 && NGRP_ == 8 && TKG_ == 4 && TOPK_ == 8, "wave top-k is written for 256 experts in 8 groups");
    const int nrow = (l == L_ - 1) ? NLAT : NTOK; const float* lg = WSP(float, logits); const F4 rb = *(const F4*)(p.router_bias + (size_t)l * E_ + 4 * lane);
    for (int n = wv; n < nrow; n += nwv) {
        const F4 z = *(const F4*)(lg + (size_t)n * E_ + 4 * lane); float sg[4], sv[4];
#pragma unroll
        for (int j = 0; j < 4; ++j) { sg[j] = sigmoidf_(z[j]); sv[j] = sg[j] + rb[j]; }
        float m1 = fmaxf(fmaxf(sv[0], sv[1]), fmaxf(sv[2], sv[3])), m2;
        { float a = fmaxf(sv[0], sv[1]), b = fminf(sv[0], sv[1]), c = fmaxf(sv[2], sv[3]), d = fminf(sv[2], sv[3]); m2 = fmaxf(fminf(a, c), fmaxf(b, d)); }
        { float o1 = DPP_MOVF(m1, 0xB1), o2 = DPP_MOVF(m2, 0xB1); float n1 = fmaxf(m1, o1), n2 = fmaxf(fminf(m1, o1), fmaxf(m2, o2)); m1 = n1; m2 = n2;
          o1 = DPP_MOVF(m1, 0x4E); o2 = DPP_MOVF(m2, 0x4E); n1 = fmaxf(m1, o1); n2 = fmaxf(fminf(m1, o1), fmaxf(m2, o2)); m1 = n1; m2 = n2;
          o1 = DPP_MOVF(m1, 0x141); o2 = DPP_MOVF(m2, 0x141); n1 = fmaxf(m1, o1); n2 = fmaxf(fminf(m1, o1), fmaxf(m2, o2)); m1 = n1; m2 = n2; }
        const float gsc = m1 + m2; const int g = lane >> 3, gb = __builtin_bit_cast(int, gsc); int rank = 0;
#pragma unroll
        for (int g2 = 0; g2 < 8; ++g2) { const float o = __builtin_bit_cast(float, __builtin_amdgcn_readlane(gb, 8 * g2)); rank += (o > gsc || (o == gsc && g2 < g)) ? 1 : 0; }
        const bool sel = rank < TKG_;
        int ck[4];
#pragma unroll
        for (int j = 0; j < 4; ++j) ck[j] = (sel && sv[j] > 0.f) ? __builtin_bit_cast(int, sv[j]) : 0;
        float myw = 0.f; int mye = 0; float wsum = 0.f;
#pragma unroll
        for (int kk = 0; kk < TOPK_; ++kk) {
            int bk = ck[0] > ck[1] ? ck[0] : ck[1]; { const int b2 = ck[2] > ck[3] ? ck[2] : ck[3]; bk = bk > b2 ? bk : b2; }
            int mk = bk;
            { int o = DPP_MOVI(mk, 0xB1); mk = mk > o ? mk : o; o = DPP_MOVI(mk, 0x4E); mk = mk > o ? mk : o; o = DPP_MOVI(mk, 0x141); mk = mk > o ? mk : o; o = DPP_MOVI(mk, 0x140); mk = mk > o ? mk : o; }
            const int r0 = __builtin_amdgcn_readlane(mk, 0), r1 = __builtin_amdgcn_readlane(mk, 16), r2 = __builtin_amdgcn_readlane(mk, 32), r3 = __builtin_amdgcn_readlane(mk, 48);
            const int K = (r0 > r1 ? r0 : r1) > (r2 > r3 ? r2 : r3) ? (r0 > r1 ? r0 : r1) : (r2 > r3 ? r2 : r3);
            const unsigned long long ball = __ballot(bk == K); const int wl = __builtin_amdgcn_readfirstlane((int)__ffsll((long long)ball) - 1);
            int wj = 0; float sgw = 0.f;
            if (lane == wl) {
#pragma unroll
                for (int j = 3; j >= 0; --j) if (ck[j] == K) wj = j;
#pragma unroll
                for (int j = 0; j < 4; ++j) if (wj == j) { ck[j] = 0; sgw = sg[j]; } }
            const int wjb = __builtin_amdgcn_readlane(wj, wl); sgw = __builtin_bit_cast(float, __builtin_amdgcn_readlane(__builtin_bit_cast(int, sgw), wl)); wsum += sgw;
            if (lane == kk) { myw = sgw; mye = 4 * wl + wjb; }
        }
        if (lane < TOPK_) { WSP(int, eidx)[(size_t)n * TOPK_ + lane] = mye; WSP(float, ewt)[(size_t)n * TOPK_ + lane] = myw / wsum * 2.5f; __hip_atomic_fetch_add(hist + mye, 1, __ATOMIC_RELAXED, __HIP_MEMORY_SCOPE_WORKGROUP); }
    }
    __syncthreads();
    { const int tid_ = (int)threadIdx.x; if (tid_ < E_) { const int c = hist[tid_]; if (c > 0) atomicAdd(WSP(int, ecnt) + tid_, c); } }
    __syncthreads();
}
__device__ __forceinline__ void st_scatter_blk(const P& p, int l, LAS unsigned char* lds, int wid, int lane, int wv, int nwv) {
    LAS int* eo = (LAS int*)lds;
    if (wid == 0) {
        const int* ecnt = WSP(int, ecnt); int c4[4], t4[4], tsum = 0;
#pragma unroll
        for (int j = 0; j < 4; ++j) { c4[j] = ld_int(ecnt + 4 * lane + j); t4[j] = (c4[j] + 255) / 256; tsum += t4[j]; }
        int incl = tsum;
#pragma unroll
        for (int o = 1; o < 64; o <<= 1) { const int v = __shfl_up(incl, o); if (lane >= o) incl += v; }
        int tb = incl - tsum;
#pragma unroll
        for (int j = 0; j < 4; ++j) { eo[4 * lane + j] = tb * 256;
            if (blockIdx.x == 0) { WSP(int, eoff)[4 * lane + j] = tb * 256; for (int t = 0; t < t4[j]; ++t) { int* u = WSP(int, ulist) + (size_t)(tb + t) * 4; u[0] = (tb + t) * 256; u[1] = 4 * lane + j; u[2] = (c4[j] - 256 * t) < 256 ? (c4[j] - 256 * t) : 256; u[3] = 0; } }
            tb += t4[j]; }
        if (lane == 63) { eo[E_] = tb * 256; if (blockIdx.x == 0) { WSP(int, eoff)[E_] = tb * 256; WSP(int, nunits)[0] = tb; } }
    }
    __syncthreads();
    const long gid = (long)wv * 64 + lane, gsz = (long)nwv * 64; const int nrow = (l == L_ - 1) ? NLAT : NTOK; const int* ei = WSP(int, eidx); int* so = WSP(int, slot_of); int* st = WSP(int, slot_tok);
    LAS int* lc = eo + E_ + 1;
    constexpr int MAXI = 4; const long total = (long)nrow * TOPK_;
#pragma unroll 1
    for (long base = 0; base < total; base += (long)MAXI * gsz) {
        if ((int)threadIdx.x < E_) lc[threadIdx.x] = 0;
        __syncthreads();
        int ie[MAXI], ir[MAXI];
#pragma unroll
        for (int u = 0; u < MAXI; ++u) { const long i = base + gid + (long)u * gsz; ie[u] = -1; ir[u] = 0; if (i < total) { ie[u] = ei[i]; ir[u] = __hip_atomic_fetch_add(lc + ie[u], 1, __ATOMIC_RELAXED, __HIP_MEMORY_SCOPE_WORKGROUP); } }
        __syncthreads();
        if ((int)threadIdx.x < E_) { const int c = lc[threadIdx.x]; lc[threadIdx.x] = c > 0 ? atomicAdd(WSP(int, efill) + threadIdx.x, c) : 0; }
        __syncthreads();
#pragma unroll
        for (int u = 0; u < MAXI; ++u) { const long i = base + gid + (long)u * gsz; if (ie[u] >= 0) { const int s = eo[ie[u]] + lc[ie[u]] + ir[u]; so[i] = s; st[s] = (int)(i / TOPK_); } }
        __syncthreads();
    }
}
#endif

#ifndef CPU_TEST
__device__ __forceinline__ void st_post_wave(const P& p, int l, int wv, int nwv, int lane) {
    static_assert(RH_ == 6 && GH_ == 6 && RN_ == 64 && GV_ == 64, "post_wave geometry");
    bf16_t* ymix = WSP(bf16_t, ymix); const float* yr = WSP(float, yr); const float* og = WSP(float, og); const bf16_t* proj = WSP(bf16_t, proj); const bf16_t* gsb = WSP(bf16_t, gsb); const bf16_t* rkv = WSP(bf16_t, rkv);
    static_assert(NLAT % 2 == 0 && NTOK % 2 == 0, "token pairs");
    const int nrow = (l == L_ - 1) ? NLAT : NTOK; const int hq = (lane >> 4) & 1, c4 = (lane & 15) * 4;
    for (int n0 = 2 * wv; n0 < nrow; n0 += 2 * nwv) { const int n = n0 + (lane >> 5);
        float o[6][4];
#pragma unroll
        for (int i = 0; i < 6; ++i) {
            const int hd = hq + 2 * i;
            if (i < 3) { const int c = hd * RN_ + c4; float r[4], k[4], v[4], a0[4], a1[4], g[4];
                ld4bf(rkv + (size_t)n * 3 * RW + c, r); ld4bf(rkv + (size_t)n * 3 * RW + RW + c, k); ld4bf(rkv + (size_t)n * 3 * RW + 2 * RW + c, v);
                ld4bf(gsb + (size_t)n * NGB + c, a0); ld4bf(gsb + (size_t)n * NGB + RW + c, a1); ld4bf(gsb + (size_t)n * NGB + 2 * RW + c, g);
                const F4 y0 = *(const F4*)(yr + (size_t)n * RW + c), y1 = *(const F4*)(yr + ((size_t)NTOK + n) * RW + c);
                const F4 ka = *(const F4*)(p.rwkv_k_a + (size_t)l * RW + c), rk = *(const F4*)(p.rwkv_r_k + (size_t)l * RW + c), lg = *(const F4*)(p.rwkv_ln_g + (size_t)l * RW + c), lb = *(const F4*)(p.rwkv_ln_b + (size_t)l * RW + c);
                float y[4], s = 0.f, bs = 0.f;
#pragma unroll
                for (int j = 0; j < 4; ++j) { y[j] = y0[j] + y1[j]; s += y[j]; const float k20 = k[j] * (1.0f + (a0[j] - 1.0f) * ka[j]), k21 = k[j] * (1.0f + (a1[j] - 1.0f) * ka[j]); bs += r[j] * (k20 + k21) * rk[j]; }
                s = dpp_sum16(s); bs = dpp_sum16(bs); const float mu = s * (1.0f / RN_); float qq = 0.f;
#pragma unroll
                for (int j = 0; j < 4; ++j) { const float dlt = y[j] - mu; qq += dlt * dlt; }
                qq = dpp_sum16(qq); const float rstd = __builtin_amdgcn_rsqf(qq * (1.0f / RN_) + GN_EPS);
#pragma unroll
                for (int j = 0; j < 4; ++j) o[i][j] = ((y[j] - mu) * rstd * lg[j] + lb[j] + bs * v[j]) * g[j];
            } else { const int h2 = hd - RH_, c = h2 * GV_ + c4; float gg[4];
                const F4 o0 = *(const F4*)(og + (size_t)n * GWD + c), o1 = *(const F4*)(og + ((size_t)NTOK + n) * GWD + c); ld4bf(proj + (size_t)n * NINP + GBASE + 2 * GKD + GWD + c, gg);
                const F4 ng = *(const F4*)(p.gla_norm_g + (size_t)l * GV_ + c4); float oo[4], qq = 0.f;
#pragma unroll
                for (int j = 0; j < 4; ++j) { oo[j] = o0[j] + o1[j]; qq += oo[j] * oo[j]; }
                qq = dpp_sum16(qq); const float rs = __builtin_amdgcn_rsqf(qq * (1.0f / GV_) + 1e-6f);
#pragma unroll
                for (int j = 0; j < 4; ++j) o[i][j] = oo[j] * rs * ng[j] * siluf_(gg[j]);
            }
        }
#pragma unroll
        for (int i = 0; i < 6; ++i) st4bf(ymix + (size_t)n * MIXW + (hq + 2 * i) * 64 + c4, o[i]);
    }
}
#endif

#ifndef CPU_TEST
__device__ __forceinline__ void st_modv_blk(const P& p, LAS unsigned char* lds, int tid) {
    static_assert(D_ == 1024 && B_ + 1 <= 17, "modv_blk geometry");
    LAS float* sc = (LAS float*)lds;
    LAS float* red = (LAS float*)(lds + 17 * 1024 * 4);
    const float* scg = WSP(float, silu_c); float* mv = WSP(float, modv);
    for (int i = tid; i < (B_ + 1) * D_; i += 512) sc[i] = scg[i];
    __syncthreads();
    const int cl = tid & 63, ks = tid >> 6;
    for (int task = blockIdx.x; task < L_ * 6 * D_ / 64; task += gridDim.x) {
        const int l = task / (6 * D_ / 64), col = (task % (6 * D_ / 64)) * 64 + cl;
        float acc[B_ + 1];
#pragma unroll
        for (int b = 0; b <= B_; ++b) acc[b] = 0.f;
        const float* w = p.w_mod + (size_t)l * D_ * 6 * D_ + col;
#pragma unroll 4
        for (int k = ks * 128; k < ks * 128 + 128; ++k) { const float wk = w[(size_t)k * 6 * D_];
#pragma unroll
            for (int b = 0; b <= B_; ++b) acc[b] += sc[b * D_ + k] * wk; }
#pragma unroll
        for (int b = 0; b <= B_; ++b) red[(ks * (B_ + 1) + b) * 64 + cl] = acc[b];
        __syncthreads();
        for (int i = tid; i < (B_ + 1) * 64; i += 512) { const int b = i >> 6, c2 = i & 63; float s = p.b_mod[(size_t)l * 6 * D_ + (task % (6 * D_ / 64)) * 64 + c2];
#pragma unroll
            for (int q = 0; q < 8; ++q) s += red[(q * (B_ + 1) + b) * 64 + c2];
            mv[((size_t)l * (B_ + 1) + b) * 6 * D_ + (task % (6 * D_ / 64)) * 64 + c2] = s; }
        __syncthreads();
    }
}
#endif

#ifdef CPU_TEST
#define GEMM_CALL(g, S, E) gemm_phase(g, S, E)
#define GEMM_CALL_G(g, S, E) gemm_phase(g, S, E)
#define SCHED_GC 1, 0
#define SYNC(k)
#define LOADP
#else
#define CAS __attribute__((address_space(4)))
#define LOADP const CAS P* _q = pk; asm volatile("" : "+s"(_q)); const P& p = *(const P*)_q; int lane = lane_id(); asm volatile("" : "+v"(lane)); \
    const int wv = blockIdx.x * 8 + wid, nwv = gridDim.x * 8; (void)lane; (void)wv; (void)nwv;
#define GEMM_CALL(g, S, E) gemm_phase<false>(lds, wid, g, S, E, &bar)
#define GEMM_CALL_G(g, S, E) gemm_phase<true>(lds, wid, g, S, E, &bar)
#define SCHED_GC (int)gridDim.x, sched_id((const unsigned*)(p.ws + WS.ctl), lds)
#define VC_WORD(x) (3584 + 64 * (x))
__device__ __forceinline__ int sched_id(const unsigned* ctl, LAS unsigned char* lds) {
    const unsigned G = gridDim.x; bool ok = (G % 8u) == 0u;
#pragma unroll
    for (int x = 0; x < 8; ++x) ok = ok && (__hip_atomic_load(ctl + VC_WORD(x), __ATOMIC_RELAXED, __HIP_MEMORY_SCOPE_AGENT) == G / 8u);
    const unsigned v = ((volatile LAS unsigned*)(lds + STAGE_BYTES))[2];
    return __builtin_amdgcn_readfirstlane(ok ? (int)v : (int)blockIdx.x);
}
#define SYNC(k) if (lo <= (k) && (k) + 1 < hi) xcd_barrier(bar);
#define XB_TMO      128
#define XB_XCNT(j)  (256  + 64 * (j))
#define XB_XSUB(j)  (1280 + 64 * (j))
#define XB_XGEN(j)  (2304 + 64 * (j))
#define XB_TOP      3328
#define XB_TOPGEN   3392
#define XCD_BAR_WORDS 3456
#define XB_SPIN_CAP (1u << 18)
__device__ __forceinline__ unsigned xb_ld(unsigned* p)              { return __hip_atomic_load(p, __ATOMIC_RELAXED, __HIP_MEMORY_SCOPE_AGENT); }
__device__ __forceinline__ unsigned xb_add(unsigned* p, unsigned v) { return __hip_atomic_fetch_add(p, v, __ATOMIC_RELAXED, __HIP_MEMORY_SCOPE_AGENT); }
__device__ __forceinline__ unsigned xb_xcc_id() { return (unsigned)__builtin_amdgcn_s_getreg((3 << 11) | 20) & 0xFu; }
#define XB_SPIN(cond, bar) do { unsigned _sp = 0; while (cond) { __builtin_amdgcn_s_sleep(1); \
    if ((++_sp & 255u) == 0u) { if (xb_ld(&(bar)[XB_TMO])) break; if (_sp > XB_SPIN_CAP) { atomicAdd(&(bar)[XB_TMO], 1u); break; } } } } while (0)
struct XcdBarrier { unsigned* bar; unsigned x; volatile LAS unsigned* st; int wid; };
__device__ __forceinline__ XcdBarrier xcd_barrier_post(unsigned* bar, volatile LAS unsigned* st) {
    XcdBarrier b; b.bar = bar; b.x = xb_xcc_id(); b.st = st; b.wid = 0;
    if (threadIdx.x == 0) (void)xb_add(&bar[XB_XCNT(b.x)], 1u);
    return b;
}
__device__ __forceinline__ void xcd_barrier_complete(unsigned* bar, unsigned x, unsigned& nloc, unsigned& nx) {
    const unsigned G = gridDim.x * gridDim.y * gridDim.z;
    unsigned sum, cnt, mine, sp = 0u;
    for (;;) {
        sum = 0u; cnt = 0u; mine = 0u;
#pragma unroll
        for (unsigned j = 0; j < 16; ++j) { const unsigned c = xb_ld(&bar[XB_XCNT(j)]); sum += c; cnt += (c > 0u) ? 1u : 0u; mine = (j == x) ? c : mine; }
        if (sum == G) break;
        __builtin_amdgcn_s_sleep(1);
        if ((++sp & 255u) == 0u) { if (xb_ld(&bar[XB_TMO])) break; if (sp > XB_SPIN_CAP) { atomicAdd(&bar[XB_TMO], 1u); break; } }
    }
    nloc = mine > 0u ? mine : 1u; nx = cnt > 0u ? cnt : 1u;
}
__device__ __forceinline__ void xcd_barrier(const XcdBarrier& b) {
    asm volatile("s_waitcnt vmcnt(0)" ::: "memory");
    __syncthreads();
    if (b.wid == 0 && lane_id() == 0) {
        unsigned* bar = b.bar;
        __builtin_amdgcn_s_waitcnt(0);
        unsigned nloc = b.st[0], nx = b.st[1];
        if (nloc == 0u) { xcd_barrier_complete(bar, b.x, nloc, nx); b.st[0] = nloc; b.st[1] = nx; }
        const unsigned old = xb_add(&bar[XB_XSUB(b.x)], 1u);
        const unsigned gen = old / nloc;
        if (old + 1u == (gen + 1u) * nloc) {
            __builtin_amdgcn_fence(__ATOMIC_RELEASE, "agent");
            asm volatile("s_waitcnt vmcnt(0)" ::: "memory");
            const unsigned og = xb_add(&bar[XB_TOP], 1u);
            const unsigned tg = og / nx;
            if (og + 1u == (tg + 1u) * nx) xb_add(&bar[XB_TOPGEN], 1u);
            else XB_SPIN(xb_ld(&bar[XB_TOPGEN]) == tg, bar);
            __builtin_amdgcn_fence(__ATOMIC_ACQUIRE, "agent");
            xb_add(&bar[XB_XGEN(b.x)], 1u);
            asm volatile("s_waitcnt vmcnt(0)" ::: "memory");
        } else {
            XB_SPIN(xb_ld(&bar[XB_XGEN(b.x)]) == gen, bar);
            __builtin_amdgcn_fence(__ATOMIC_ACQUIRE, "agent");
            asm volatile("s_waitcnt vmcnt(0)" ::: "memory");
        }
    }
    __syncthreads();
}
#endif

#define IN(k) (lo <= (k) && (k) < hi)
#ifndef PROBE_MASK
#define PROBE_MASK 0
#endif
#ifdef CPU_TEST
#define REP_BEGIN(k)
#define REP_END
#else
#define REP_BEGIN(k) for (int rep_ = 0; rep_ < (((PROBE_MASK) >> (k)) & 1) + 1; ++rep_) { if (rep_) xcd_barrier(bar);
#define REP_END }
#endif
#ifdef CPU_TEST
template <int lo, int hi, int l> static void run_layer(const P& p) { const int wv = 0, nwv = 1, lane = 0; (void)wv; (void)nwv; (void)lane;
#else
template <int lo, int hi, int l> __device__ __forceinline__ void run_layer(const CAS P* pk, LAS unsigned char* lds, const int wid, const XcdBarrier& bar) {
#endif

        const int pb = NPH_PRO + l * NPH_LAYER; const bool last = (l == L_ - 1); const int MR = last ? NLAT : NTOK;
        if (IN(pb + 0)) { REP_BEGIN(0) LOADP GemmArgs g{WSP(bf16_t, h), D_, nullptr, WSP(bf16_t, w_inT) + (size_t)l * NINP * D_, D_, D_}; StaticSched S; S.init(1, NTOK, NINP, 0, 0, SCHED_GC);
            EpiBf16Plain E{WSP(bf16_t, proj), NINP}; GEMM_CALL(g, S, E); REP_END } SYNC(pb + 0)
#ifdef CPU_TEST
        if (IN(pb + 1)) { REP_BEGIN(1) LOADP st_prep1(p, l, wv, nwv, lane); REP_END } SYNC(pb + 1)
#else
        if (IN(pb + 1)) { REP_BEGIN(1) LOADP st_prep1_blk(p, l, wid, lane, wv, nwv); REP_END } SYNC(pb + 1)
#endif
        if (IN(pb + 2)) { REP_BEGIN(2) LOADP
            { GemmArgs g{WSP(bf16_t, asmall), KSM, nullptr, WSP(bf16_t, wsmT) + (size_t)l * NSMP * KSM, KSM, KSM}; StaticSched S; S.init(1, NTOK, NSMP, 0, 0, SCHED_GC);
              EpiSmall E{WSP(float, gs), WSP(bf16_t, gsb), p.rwkv_w0 + (size_t)l * 2 * RW, p.rwkv_a0 + (size_t)l * 2 * RW, p.gla_a_bias + (size_t)l * 2 * GKD}; GEMM_CALL(g, S, E); }
            { GemmArgs g{WSP(bf16_t, U2), KT5, nullptr, WSP(bf16_t, s5Wa) + (size_t)l * SNG_ * N5AP * K5, K5, K5}; StaticSched S; S.init(SNG_, M5P, N5AP, M5P, N5AP, SCHED_GC);
              EpiF32Plain E{WSP(float, xl), N5AP, (size_t)M5P * N5AP}; GEMM_CALL(g, S, E); }
        REP_END } SYNC(pb + 2)
        if (IN(pb + 3)) { REP_BEGIN(3) LOADP
#ifdef CPU_TEST
            rwkv_scan_all(p, l); gla_scan_all(p, l);
#else
            { constexpr int NRS_ = 2 * B_ * RH_, NGS_ = 2 * B_ * GH_, NGG = (NGS_ + 2) / 3;
              for (int task = blockIdx.x; task < NRS_; task += gridDim.x) { const int hh = task % RH_, b = (task / RH_) % B_, d = task / (RH_ * B_); rwkv_chunk_blk(p, l, d, b, hh, lds, wid, lane); } }
            { LOADP constexpr int NRS_ = 2 * B_ * RH_, NGS_ = 2 * B_ * GH_, NGG = (NGS_ + 2) / 3;
              for (int task = (int)blockIdx.x + (((int)blockIdx.x < NRS_) ? (int)gridDim.x * ((NRS_ - 1 - (int)blockIdx.x) / (int)gridDim.x + 1) : 0); task < NRS_ + NGG; task += gridDim.x) {
                  for (int s3 = 0; s3 < 3; ++s3) { const int t2 = (task - NRS_) + NGG * s3; if (t2 < NGS_) { const int hh = t2 % GH_, b = (t2 / GH_) % B_, d = t2 / (GH_ * B_); gla_chunk_blk(p, l, d, b, hh, lds, wid, lane); } __syncthreads(); } } }
#endif
            st_s5carry(p, l, wv, nwv, lane); REP_END } SYNC(pb + 3)
        if (IN(pb + 4)) { REP_BEGIN(4) LOADP
            { GemmArgs g{WSP(bf16_t, U2), KT5, nullptr, WSP(bf16_t, s5Tb) + (size_t)l * SNG_ * K5 * KT5, KT5, KT5}; StaticSched S; S.init(SNG_, M5P, K5, M5P, K5, SCHED_GC);
              EpiS5b E{WSP(bf16_t, yc)}; GEMM_CALL(g, S, E); }
#ifdef CPU_TEST
            st_post(p, l, wv, nwv, lane);
#else
            st_post_wave(p, l, wv, nwv, lane);
#endif
            REP_END } SYNC(pb + 4)
        if (IN(pb + 5)) { REP_BEGIN(5) LOADP GemmArgs g{WSP(bf16_t, yc), SW, nullptr, WSP(bf16_t, gluT) + (size_t)l * SWP * SW, SW, SW}; StaticSched S; S.init(1, MR, SWP, 0, 0, SCHED_GC);
            EpiGlu E{WSP(bf16_t, ymix), WSP(bf16_t, yc), p.s5_glu_b + (size_t)l * SW}; GEMM_CALL(g, S, E); REP_END } SYNC(pb + 5)
        if (IN(pb + 6)) { REP_BEGIN(6) LOADP GemmArgs g{WSP(bf16_t, ymix), MIXW, nullptr, WSP(bf16_t, w_outT) + (size_t)l * D_ * MIXW, MIXW, MIXW}; StaticSched S; S.init(1, MR, D_, 0, 0, SCHED_GC);
            EpiBf16Plain E{WSP(bf16_t, yo), D_}; GEMM_CALL(g, S, E); REP_END } SYNC(pb + 6)
        if (IN(pb + 7)) { REP_BEGIN(7) LOADP st_ln1(p, l, wv, nwv, lane); REP_END } SYNC(pb + 7)
        if (IN(pb + 8)) { REP_BEGIN(8) LOADP GemmArgs g{WSP(bf16_t, h2), D_, nullptr, WSP(bf16_t, rsT) + (size_t)l * NRS * D_, D_, D_}; StaticSched S; S.init(1, MR, NRS, 0, 0, SCHED_GC);
            EpiRS E{WSP(float, logits), WSP(bf16_t, sact)}; GEMM_CALL(g, S, E); REP_END } SYNC(pb + 8)
        if (IN(pb + 9)) { REP_BEGIN(9) LOADP
#ifdef CPU_TEST
            st_topk(p, l, wv, nwv, lane);
#else
            st_topk_wave(p, l, wv, nwv, lane, lds);
#endif
            st_scatter0(p, l, wv, nwv, lane); REP_END } SYNC(pb + 9)
#ifdef CPU_TEST
        if (IN(pb + 10)) { LOADP st_offsets(p, l, wv, nwv, lane); }
        if (IN(pb + 11)) { LOADP st_scatter(p, l, wv, nwv, lane); }
#else
        if (IN(pb + 11)) { LOADP st_scatter_blk(p, l, lds, wid, lane, wv, nwv); } SYNC(pb + 11)
#endif
        if (IN(pb + 12)) { REP_BEGIN(12) LOADP
            { GemmArgs g{WSP(bf16_t, h2), D_, WSP(int, slot_tok), WSP(bf16_t, w13T) + (size_t)l * E_ * 2 * FF_ * D_, D_, D_}; ListSched S{WSP(int, ulist), WSP(int, nunits), 2 * FF_ / 256, 2 * FF_, SCHED_GC};
              EpiUp E{WSP(bf16_t, act)}; GEMM_CALL_G(g, S, E); }
            { GemmArgs g{WSP(bf16_t, sact), FF_, nullptr, WSP(bf16_t, shw2T) + (size_t)l * D_ * FF_, FF_, FF_}; StaticSched S; S.init(1, MR, D_, 0, 0, SCHED_GC);
              EpiBf16Plain E{WSP(bf16_t, Ysh), D_}; GEMM_CALL(g, S, E); }
        REP_END } SYNC(pb + 12)
        if (IN(pb + 13)) { REP_BEGIN(13) LOADP GemmArgs g{WSP(bf16_t, act), FF_, nullptr, WSP(bf16_t, w2T) + (size_t)l * E_ * D_ * FF_, FF_, FF_}; ListSched S{WSP(int, ulist), WSP(int, nunits), D_ / 256, D_, SCHED_GC};
            EpiDown E{WSP(bf16_t, Y)}; GEMM_CALL(g, S, E); REP_END } SYNC(pb + 13)
        if (IN(pb + 14)) { REP_BEGIN(14) LOADP st_ln2(p, l, wv, nwv, lane); REP_END } SYNC(pb + 14)
    }
#ifdef CPU_TEST
template <int lo, int hi> static void run_program(const P& p) { const int wv = 0, nwv = 1, lane = 0;
#else
template <int lo, int hi> __device__ __forceinline__ void run_program(const CAS P* pk, LAS unsigned char* lds, const int wid, const XcdBarrier& bar) {
#endif
    if (IN(0)) { { LOADP st_siluc(p, wv, nwv, lane); } { LOADP st_s5a(p, wv, nwv, lane); }
#ifdef CPU_TEST
        { LOADP st_cvt1(p, 0, wv, nwv, lane); } { LOADP st_cvt2(p, 0, wv, nwv, lane); } { LOADP st_cvt3(p, 0, wv, nwv, lane); } { LOADP st_cvt4(p, 0, wv, nwv, lane); }
        { LOADP st_cvt1(p, 1, wv, nwv, lane); } { LOADP st_cvt2(p, 1, wv, nwv, lane); } { LOADP st_cvt3(p, 1, wv, nwv, lane); } { LOADP st_cvt4(p, 1, wv, nwv, lane); }
#else
        { LOADP st_cvt_tiles(p, 0, lds, wid * 64 + lane); } { LOADP st_cvt_tiles(p, 1, lds, wid * 64 + lane); }
#endif
        { LOADP st_cvt5(p, 0, wv, nwv, lane); } { LOADP st_cvt5(p, 1, wv, nwv, lane); } } SYNC(0)
#ifdef CPU_TEST
    if (IN(1)) { { LOADP st_modv(p, wv, nwv, lane); } { LOADP st_s5b(p, wv, nwv, lane); } } SYNC(1)
#else
#ifndef PRO_PROBE
#define PRO_PROBE 0
#endif
    if (IN(1)) { { LOADP st_modv_blk(p, lds, wid * 64 + lane); } for (int rp_ = 0; rp_ < ((PRO_PROBE & 1) ? 2 : 1); ++rp_) { LOADP st_s5b(p, wv, nwv, lane); } } SYNC(1)
#endif
#ifdef CPU_TEST
    if (IN(2)) { { LOADP st_s5c(p, wv, nwv, lane); } { LOADP st_hmod(p, 0, wv, nwv, lane); } } SYNC(2)
#else
    if (IN(2)) { for (int rp_ = 0; rp_ < ((PRO_PROBE & 2) ? 2 : 1); ++rp_) { LOADP st_s5c(p, wv, nwv, lane); } for (int rp_ = 0; rp_ < ((PRO_PROBE & 4) ? 2 : 1); ++rp_) { LOADP st_hmod(p, 0, wv, nwv, lane); } } SYNC(2)
#endif
#ifdef CPU_TEST
    run_layer<lo, hi, 0>(p); run_layer<lo, hi, 1>(p);
#else
    run_layer<lo, hi, 0>(pk, lds, wid, bar); run_layer<lo, hi, 1>(pk, lds, wid, bar);
#endif
}
#undef IN
#ifndef CPU_TEST
constexpr int LDS_BYTES = STAGE_BYTES + 1024;
struct KArgs { P p; };
template <int LO, int HI> __global__ void __launch_bounds__(512, 2) fwd_kernel(KArgs a) {
    extern __shared__ __attribute__((aligned(16))) unsigned char lds_raw[];
    LAS unsigned char* lds = (LAS unsigned char*)lds_raw;
    volatile LAS unsigned* xbw = (volatile LAS unsigned*)(lds + STAGE_BYTES);
    const int wid = __builtin_amdgcn_readfirstlane(threadIdx.x >> 6);
    const CAS P* pk = (const CAS P*)__builtin_amdgcn_kernarg_segment_ptr();
    if (threadIdx.x < 4) xbw[threadIdx.x] = 0u;
    __syncthreads();
    if (threadIdx.x == 0) { const unsigned xcc = xb_xcc_id() & 7u; const unsigned rank = xb_add((unsigned*)(pk->ws + WS.ctl) + VC_WORD(xcc), 1u); xbw[2] = rank * 8u + xcc; }
    __syncthreads();
    XcdBarrier bar; bar.bar = (unsigned*)(pk->ws + WS.ctl); bar.x = 0; bar.st = xbw; bar.wid = wid;
    if (HI - LO > 1) { bar = xcd_barrier_post((unsigned*)(pk->ws + WS.ctl), xbw); bar.wid = wid; }
    run_program<LO, HI>(pk, lds, wid, bar);
}
template <int PH> static void launch_each(int grid, hipStream_t stream, const KArgs& a) {
    if constexpr (PH < NPH) {
        static bool attr = false;
        if (!attr) { (void)hipFuncSetAttribute((const void*)fwd_kernel<PH, PH + 1>, hipFuncAttributeMaxDynamicSharedMemorySize, LDS_BYTES); attr = true; }
        hipLaunchKernelGGL((fwd_kernel<PH, PH + 1>), dim3(grid), dim3(512), LDS_BYTES, stream, a);
        launch_each<PH + 1>(grid, stream, a);
    }
}
extern "C" void kernel_launch(void* const* d_in, const int* in_sizes, int n_in, void* d_out, int out_size, void* d_ws, size_t ws_size, hipStream_t stream) {
    static int grid = 0;
    if (grid == 0) {
        if (n_in != 42 || ws_size < WS.end) { fprintf(stderr, "kernel_launch: bad inputs (n_in %d, ws %zu, need %zu)\n", n_in, ws_size, (size_t)WS.end); grid = -1; return; }
        int dev = 0, cus = 0; (void)hipGetDevice(&dev); (void)hipDeviceGetAttribute(&cus, hipDeviceAttributeMultiprocessorCount, dev);
        grid = cus;
    }
    if (grid < 0) return;
    KArgs a{}; const float** pp = (const float**)&a.p;
    for (int i = 0; i < 42; ++i) pp[i] = (const float*)d_in[i];
    a.p.out = (float*)d_out; a.p.ws = (unsigned char*)d_ws;
    (void)hipMemsetAsync((char*)d_ws + WS.ctl, 0, 16384, stream);
#ifdef FUSED
    static bool attr = false;
    if (!attr) { (void)hipFuncSetAttribute((const void*)fwd_kernel<0, NPH>, hipFuncAttributeMaxDynamicSharedMemorySize, LDS_BYTES); attr = true; }
    hipLaunchKernelGGL((fwd_kernel<0, NPH>), dim3(grid), dim3(512), LDS_BYTES, stream, a);
#else
    launch_each<0>(grid, stream, a);
#endif
}
#else
static void cpu_forward(const P& p) { run_program<0, NPH>(p); }
#endif
```
